# Optimizing an MI355X kernel written in HIP

```python
import math
import jax
import jax.numpy as jnp
from jax import lax
import numpy as np

D_MODEL = 1024
BATCH = 4
SEQ = 8192
DEPTH = 4

CHUNK = 64
N_MIXERS = 3
NL_A = len(range(0, DEPTH, N_MIXERS))
NL_B = len(range(1, DEPTH, N_MIXERS))
NL_C = len(range(2, DEPTH, N_MIXERS))
NORM_EPS = 1e-6

DK_A = 128
DV_A = 128
H_A = D_MODEL // DK_A
KEY_A = H_A * DK_A
VAL_A = H_A * DV_A
CONV_A = 4
QKV_A = 2 * KEY_A + VAL_A
IN_A = QKV_A + VAL_A + 2 * H_A
DK_B = 128
H_B = D_MODEL // DK_B
DV_B = D_MODEL // H_B
KEY_B = H_B * DK_B
VAL_B = H_B * DV_B
IN_B = 2 * KEY_B + 2 * VAL_B
HS_C = 64
H_C = D_MODEL // HS_C
LORA_W = 64
LORA_A = 64
LORA_G = 128
GN_EPS = 1e-5 * HS_C * HS_C
D_FF = ((8 * D_MODEL) // 3 + 255) // 256 * 256
CONV_F = 3

kernel_name = 'hybrid_deltanet_hgrn2_rwkv7_convffn_trunk'


def rms_norm(x, g):
    xf = x.astype(jnp.float32)
    y = xf * lax.rsqrt(jnp.mean(xf * xf, axis=-1, keepdims=True) + NORM_EPS)
    return (y * g.astype(jnp.float32)).astype(x.dtype)


def l2norm(x):
    return x * lax.rsqrt(jnp.sum(x * x, axis=-1, keepdims=True) + 1e-6)


def causal_dwconv(x, w):
    K = w.shape[0]
    T = x.shape[1]
    xp = jnp.pad(x, ((0, 0), (K - 1, 0), (0, 0)))
    y = xp[:, 0:T] * w[0]
    for kk in range(1, K):
        y = y + xp[:, kk:kk + T] * w[kk]
    return y


def to_chunks(t):
    b, s, h, d = t.shape
    return t.reshape(b, s // CHUNK, CHUNK, h, d).transpose(1, 0, 3, 2, 4)


def from_chunks(t):
    n, b, h, c, d = t.shape
    return t.transpose(1, 0, 3, 2, 4).reshape(b, n * c, h, d)


def chunk_gated_delta_rule(q, k, v, beta, g):
    dk = q.shape[-1]
    q, k, v = to_chunks(q), to_chunks(k), to_chunks(v)
    beta = to_chunks(beta[..., None])
    G = jnp.cumsum(to_chunks(g[..., None])[..., 0], axis=-1)
    idx = jnp.arange(CHUNK)
    incl = idx[:, None] >= idx[None, :]
    strict = idx[:, None] > idx[None, :]
    decay = jnp.exp(jnp.where(incl, G[..., :, None] - G[..., None, :], -jnp.inf))
    kb = k * beta
    L = jnp.where(strict, jnp.einsum('nbhid,nbhjd->nbhij', kb, k) * decay, 0.0)
    eye = jnp.eye(CHUNK, dtype=L.dtype)
    rhs = jnp.concatenate([kb * jnp.exp(G)[..., None], v * beta], axis=-1)
    wu = lax.linalg.triangular_solve(eye + L, rhs, left_side=True, lower=True, unit_diagonal=True)
    w, u = wu[..., :dk], wu[..., dk:]
    attn = jnp.einsum('nbhid,nbhjd->nbhij', q, k) * decay
    q_dec = q * jnp.exp(G)[..., None]
    k_dec = k * jnp.exp(G[..., -1:] - G)[..., None]
    g_last = jnp.exp(G[..., -1])[..., None, None]

    def step(S, xs):
        w_n, u_n, q_n, k_n, a_n, gl_n = xs
        v_new = u_n - w_n @ S
        o_n = q_n @ S + a_n @ v_new
        S = S * gl_n + jnp.swapaxes(k_n, -1, -2) @ v_new
        return S, o_n

    S0 = jnp.zeros(q.shape[1:3] + (dk, v.shape[-1]), jnp.float32)
    _, o = lax.scan(step, S0, (w, u, q_dec, k_dec, attn, g_last))
    return from_chunks(o)


def chunk_gla(q, k, v, log_f):
    q, k, v, log_f = to_chunks(q), to_chunks(k), to_chunks(v), to_chunks(log_f)
    bc = jnp.cumsum(log_f, axis=-2)
    q_dec = q * jnp.exp(bc)
    k_dec = k * jnp.exp(bc[..., -1:, :] - bc)
    f_last = jnp.exp(bc[..., -1, :])[..., :, None]
    idx = jnp.arange(CHUNK)
    incl = (idx[:, None] >= idx[None, :])[:, :, None]

    def step(S, xs):
        q_n, k_n, v_n, b_n, qd_n, kd_n, fl_n = xs
        dec = jnp.exp(jnp.where(incl, b_n[..., :, None, :] - b_n[..., None, :, :], -jnp.inf))
        a_n = jnp.einsum('bhid,bhjd,bhijd->bhij', q_n, k_n, dec)
        o_n = qd_n @ S + a_n @ v_n
        S = S * fl_n + jnp.swapaxes(kd_n, -1, -2) @ v_n
        return S, o_n

    S0 = jnp.zeros(q.shape[1:3] + (q.shape[-1], v.shape[-1]), jnp.float32)
    _, o = lax.scan(step, S0, (q, k, v, bc, q_dec, k_dec, f_last))
    return from_chunks(o)


def rwkv7_scan(r, decay, k, v, a_vec, b_vec):
    xs = tuple(jnp.swapaxes(t, 0, 1) for t in (r, decay, k, v, a_vec, b_vec))

    def step(S, inp):
        r_t, d_t, k_t, v_t, a_t, b_t = inp
        sa = jnp.einsum('bhvk,bhk->bhv', S, a_t)
        S = S * d_t[:, :, None, :] + sa[..., None] * b_t[:, :, None, :] + v_t[..., None] * k_t[:, :, None, :]
        return S, jnp.einsum('bhvk,bhk->bhv', S, r_t)

    bsz, _, hh, n = r.shape
    _, y = lax.scan(step, jnp.zeros((bsz, hh, n, n), jnp.float32), xs)
    return jnp.swapaxes(y, 0, 1)


def group_norm_heads(y, w, b):
    mean = jnp.mean(y, axis=-1, keepdims=True)
    var = jnp.mean(jnp.square(y - mean), axis=-1, keepdims=True)
    return (y - mean) * lax.rsqrt(var + GN_EPS) * w + b


def gated_deltanet(u, w_in, conv_w, A_log, dt_bias, norm_w, w_out):
    bsz, T, _ = u.shape
    f32 = jnp.float32
    proj = u @ w_in
    qkv = jax.nn.silu(causal_dwconv(proj[..., :QKV_A], conv_w)).astype(f32)
    z = proj[..., QKV_A:QKV_A + VAL_A].astype(f32)
    a_raw = proj[..., QKV_A + VAL_A:QKV_A + VAL_A + H_A].astype(f32)
    b_raw = proj[..., QKV_A + VAL_A + H_A:].astype(f32)
    q = l2norm(qkv[..., :KEY_A].reshape(bsz, T, H_A, DK_A)) * DK_A ** -0.5
    k = l2norm(qkv[..., KEY_A:2 * KEY_A].reshape(bsz, T, H_A, DK_A))
    v = qkv[..., 2 * KEY_A:].reshape(bsz, T, H_A, DV_A)
    beta = jax.nn.sigmoid(b_raw)
    g = -jnp.exp(A_log.astype(f32)) * jax.nn.softplus(a_raw + dt_bias.astype(f32))
    o = chunk_gated_delta_rule(q, k, v, beta, g)
    o = rms_norm(o, norm_w) * jax.nn.silu(z.reshape(bsz, T, H_A, DV_A))
    return o.reshape(bsz, T, VAL_A).astype(u.dtype) @ w_out


def hgrn2(u, w_in, lower_bound, norm_w, w_out):
    bsz, T, _ = u.shape
    f32 = jnp.float32
    proj = u @ w_in
    q = jax.nn.silu(proj[..., :KEY_B].astype(f32))
    f = lower_bound + (1.0 - lower_bound) * jax.nn.sigmoid(proj[..., KEY_B:2 * KEY_B].astype(f32))
    i_in = proj[..., 2 * KEY_B:2 * KEY_B + VAL_B].astype(f32)
    gate = proj[..., 2 * KEY_B + VAL_B:].astype(f32)
    kh = lambda t: t.reshape(bsz, T, H_B, DK_B)
    vh = lambda t: t.reshape(bsz, T, H_B, DV_B)
    o = chunk_gla(kh(q), kh(1.0 - f), vh(i_in), kh(jnp.log(f)))
    o = rms_norm(o, norm_w) * jax.nn.silu(vh(gate))
    return o.reshape(bsz, T, VAL_B).astype(u.dtype) @ w_out


def rwkv7_time_mix(u, mu, w_rkv, w0, w1, w2, a0, a1, a2, g1, g2, k_k, k_a, r_k, ln_w, ln_b, w_out):
    bsz, T, D = u.shape
    f32 = jnp.float32
    dx = jnp.pad(u, ((0, 0), (1, 0), (0, 0)))[:, :-1] - u
    xr, xw, xk, xv, xa, xg = (u + dx * mu[s] for s in range(6))
    r, k, v = jnp.einsum('sbtd,sde->sbte', jnp.stack([xr, xk, xv]), w_rkv).astype(f32)
    w = -jax.nn.softplus(-(w0 + jnp.tanh(xw @ w1) @ w2).astype(f32)) - 0.5
    decay = jnp.exp(-jnp.exp(w))
    a = jax.nn.sigmoid((a0 + (xa @ a1) @ a2).astype(f32))
    g = (jax.nn.sigmoid(xg @ g1) @ g2).astype(f32)
    heads = lambda t: t.reshape(bsz, T, H_C, HS_C)
    kk = l2norm(heads(k * k_k.astype(f32)))
    k = heads(k * (1.0 + (a - 1.0) * k_a.astype(f32)))
    r, v, a, decay = heads(r), heads(v), heads(a), heads(decay)
    y = rwkv7_scan(r, decay, k, v, -kk, kk * a)
    y = group_norm_heads(y, ln_w.reshape(H_C, HS_C).astype(f32), ln_b.reshape(H_C, HS_C).astype(f32))
    y = y + jnp.sum(r * k * r_k.astype(f32), axis=-1, keepdims=True) * v
    return (y.reshape(bsz, T, D) * g).astype(u.dtype) @ w_out


def conv_glu_ffn(u, w_up, conv_w, conv_b, w_down):
    hid = causal_dwconv(u @ w_up, conv_w) + conv_b
    val, gate = jnp.split(hid, 2, axis=-1)
    return (val * jax.nn.silu(gate)) @ w_down


def setup_inputs(seed: int = 0) -> dict:
    key = jax.random.key(seed)
    ks = iter(jax.random.split(key, 40))

    def nrm(shape, scale):
        return scale * jax.random.normal(next(ks), shape, jnp.float32)

    def unif(shape, lo, hi):
        return jax.random.uniform(next(ks), shape, jnp.float32, lo, hi)

    D = D_MODEL
    x = nrm((BATCH, SEQ, D), 1.0)
    c = nrm((BATCH, D), 1.0)
    norm_g = 1.0 + nrm((DEPTH, 2, D), 0.02)
    ada_w = nrm((DEPTH, D, 6 * D), 0.5 * D ** -0.5)
    ada_b = nrm((DEPTH, 6 * D), 0.02)
    dt = jnp.exp(unif((NL_A, H_A), math.log(1e-3), math.log(1e-1)))
    a_dt_bias = dt + jnp.log(-jnp.expm1(-dt))
    return {
        'x': x,
        'c': c,
        'norm_g': norm_g,
        'ada_w': ada_w,
        'ada_b': ada_b,
        'a_w_in': nrm((NL_A, D, IN_A), D ** -0.5),
        'a_conv': nrm((NL_A, CONV_A, QKV_A), CONV_A ** -0.5),
        'a_A_log': jnp.log(unif((NL_A, H_A), 1.0, 16.0)),
        'a_dt_bias': a_dt_bias,
        'a_norm': 1.0 + nrm((NL_A, DV_A), 0.02),
        'a_w_out': nrm((NL_A, VAL_A, D), VAL_A ** -0.5),
        'b_w_in': nrm((NL_B, D, IN_B), D ** -0.5),
        'hgrn_lb_logits': nrm((DEPTH, KEY_B), 0.1),
        'b_norm': 1.0 + nrm((NL_B, DV_B), 0.02),
        'b_w_out': nrm((NL_B, VAL_B, D), VAL_B ** -0.5),
        'c_mu': unif((NL_C, 6, D), 0.0, 1.0),
        'c_w_rkv': nrm((NL_C, 3, D, D), D ** -0.5),
        'c_w0': unif((NL_C, D), -6.5, -1.5),
        'c_w1': nrm((NL_C, D, LORA_W), D ** -0.5),
        'c_w2': nrm((NL_C, LORA_W, D), 0.1 * LORA_W ** -0.5),
        'c_a0': nrm((NL_C, D), 0.1),
        'c_a1': nrm((NL_C, D, LORA_A), D ** -0.5),
        'c_a2': nrm((NL_C, LORA_A, D), 0.1 * LORA_A ** -0.5),
        'c_g1': nrm((NL_C, D, LORA_G), D ** -0.5),
        'c_g2': nrm((NL_C, LORA_G, D), LORA_G ** -0.5),
        'c_k_k': 0.85 + nrm((NL_C, D), 0.02),
        'c_k_a': 1.0 + nrm((NL_C, D), 0.02),
        'c_r_k': nrm((NL_C, H_C, HS_C), 0.1),
        'c_ln_w': 1.0 + nrm((NL_C, D), 0.02),
        'c_ln_b': nrm((NL_C, D), 0.02),
        'c_w_out': nrm((NL_C, D, D), D ** -0.5),
        'f_w_up': nrm((DEPTH, D, 2 * D_FF), D ** -0.5),
        'f_conv_w': nrm((DEPTH, CONV_F, 2 * D_FF), CONV_F ** -0.5),
        'f_conv_b': nrm((DEPTH, 2 * D_FF), 0.02),
        'f_w_down': nrm((DEPTH, D_FF, D), D_FF ** -0.5),
        'final_g': 1.0 + nrm((D,), 0.02),
    }


def reference(x, c, norm_g, ada_w, ada_b, a_w_in, a_conv, a_A_log, a_dt_bias, a_norm, a_w_out,
              b_w_in, hgrn_lb_logits, b_norm, b_w_out,
              c_mu, c_w_rkv, c_w0, c_w1, c_w2, c_a0, c_a1, c_a2, c_g1, c_g2, c_k_k, c_k_a, c_r_k,
              c_ln_w, c_ln_b, c_w_out,
              f_w_up, f_conv_w, f_conv_b, f_w_down, final_g):
    bsz = x.shape[0]
    cond = jax.nn.silu(c)
    lb_p = jax.nn.softmax(hgrn_lb_logits.astype(jnp.float32), axis=0)
    lower_bounds = jnp.cumsum(lb_p, axis=0) - lb_p[0]
    h = x
    for i in range(DEPTH):
        mod = (cond @ ada_w[i] + ada_b[i]).reshape(bsz, 6, 1, D_MODEL)
        shift1, scale1, gate1, shift2, scale2, gate2 = (mod[:, s] for s in range(6))
        u = rms_norm(h, norm_g[i, 0]) * (1.0 + scale1) + shift1
        kind, j = i % N_MIXERS, i // N_MIXERS
        if kind == 0:
            y = gated_deltanet(u, a_w_in[j], a_conv[j], a_A_log[j], a_dt_bias[j], a_norm[j], a_w_out[j])
        elif kind == 1:
            y = hgrn2(u, b_w_in[j], lower_bounds[i], b_norm[j], b_w_out[j])
        else:
            y = rwkv7_time_mix(u, c_mu[j], c_w_rkv[j], c_w0[j], c_w1[j], c_w2[j], c_a0[j], c_a1[j], c_a2[j],
                               c_g1[j], c_g2[j], c_k_k[j], c_k_a[j], c_r_k[j], c_ln_w[j], c_ln_b[j], c_w_out[j])
        h = h + gate1 * y
        u = rms_norm(h, norm_g[i, 1]) * (1.0 + scale2) + shift2
        h = h + gate2 * conv_glu_ffn(u, f_w_up[i], f_conv_w[i], f_conv_b[i], f_w_down[i])
    return rms_norm(h, final_g)
```

```cpp
#include <hip/hip_runtime.h>
#include <hip/hip_cooperative_groups.h>
#include <cstdio>
namespace cg = cooperative_groups;

#ifndef PHMASK
#define PHMASK 0xFFFFFF
#endif
#ifndef REPMASK
#define REPMASK 0
#endif
#ifndef REPL
#define REPL 0xF
#endif
#ifndef SINGLE_LAUNCH
#define SINGLE_LAUNCH 1
#endif

#define LAS __attribute__((address_space(3)))
typedef unsigned short bf16_t;
typedef short bf16x8 __attribute__((ext_vector_type(8)));
typedef float f32x4 __attribute__((ext_vector_type(4)));
typedef float f32x2 __attribute__((ext_vector_type(2)));
typedef unsigned u32x4 __attribute__((ext_vector_type(4)));
typedef unsigned u32x2 __attribute__((ext_vector_type(2)));

constexpr int MROWS = 32768, SEQ = 8192, DM = 1024;
constexpr size_t MiB = 1ull << 20;
constexpr size_t WS_W = 0;
constexpr size_t W_IN = 0, W_L2 = 13 * MiB, W_OUT = 15 * MiB, W_UP = 17 * MiB, W_DN = 28 * MiB;
constexpr size_t WS_MISC = 34 * MiB;
constexpr size_t WS_R1 = 36 * MiB;
constexpr size_t WS_PROJ = 164 * MiB;
constexpr size_t WS_PROJC = 228 * MiB;
constexpr size_t WS_OC = 436 * MiB;
constexpr size_t WS_HID = 100 * MiB;
constexpr size_t WS_ACT = 292 * MiB;

struct Params {
    const float* in[36];
    float* out;
    unsigned char* ws;
    int ph_lo, ph_hi;
};
typedef const Params* PPTR;

__device__ __forceinline__ float bf2f(unsigned v) { return __uint_as_float(v << 16); }
__device__ __forceinline__ float bflo(unsigned v) { return __uint_as_float(v << 16); }
__device__ __forceinline__ float bfhi(unsigned v) { return __uint_as_float(v & 0xffff0000u); }
typedef __bf16 bf16v2 __attribute__((ext_vector_type(2)));
__device__ __forceinline__ unsigned pack2(float lo, float hi) { const f32x2 v = {lo, hi}; const bf16v2 r = __builtin_convertvector(v, bf16v2); return __builtin_bit_cast(unsigned, r); }
__device__ __forceinline__ unsigned f2bf(float f) { return pack2(f, 0.f) & 0xffffu; }
__device__ __forceinline__ float sigmoidf_(float x) { return __builtin_amdgcn_rcpf(1.0f + __expf(-x)); }
__device__ __forceinline__ float siluf_(float x) { return x * __builtin_amdgcn_rcpf(1.0f + __expf(-x)); }
__device__ __forceinline__ float softplusf_(float x) { return x > 15.0f ? x : __logf(1.0f + __expf(x)); }
template <int CTRL> __device__ __forceinline__ float dpp_f(float x) { return __int_as_float(__builtin_amdgcn_update_dpp(0, __float_as_int(x), CTRL, 0xf, 0xf, false)); }
__device__ __forceinline__ float rowred16(float x) { x += dpp_f<0x128>(x); x += dpp_f<0x124>(x); x += dpp_f<0x122>(x); x += dpp_f<0x121>(x); return x; }
__device__ __forceinline__ float wave_allsum(float v) {
    float r = rowred16(v);
    r += __int_as_float(__builtin_amdgcn_update_dpp(0, __float_as_int(r), 0x142, 0xa, 0xf, false));
    r += __int_as_float(__builtin_amdgcn_update_dpp(0, __float_as_int(r), 0x143, 0xc, 0xf, false));
    return __int_as_float(__builtin_amdgcn_readlane(__float_as_int(r), 63));
}
struct StepRegs { f32x4 a, b, c, d, e; float vr, x0, x1; };
template <int KIND> __device__ __forceinline__ void step_load(StepRegs& r, LAS const float* rec, int li, int row) {
    r.a = *(LAS const f32x4*)(rec + 4 * li); r.b = *(LAS const f32x4*)(rec + 64 + 4 * li); r.c = *(LAS const f32x4*)(rec + 128 + 4 * li); r.d = *(LAS const f32x4*)(rec + 192 + 4 * li);
    if (KIND == 0) { r.vr = rec[256 + row]; r.x0 = rec[272]; r.x1 = rec[273]; }
    else if (KIND == 1) { r.vr = rec[256 + row]; }
    else { r.e = *(LAS const f32x4*)(rec + 256 + 4 * li); r.vr = rec[320 + row]; }
}
template <int KIND> __device__ __forceinline__ float step_compute(const StepRegs& r, f32x2 (&s)[4]) {
    if (KIND == 0) {
        const f32x2 k[4] = {{r.a[0], r.a[1]}, {r.a[2], r.a[3]}, {r.b[0], r.b[1]}, {r.b[2], r.b[3]}};
        const f32x2 q[4] = {{r.c[0], r.c[1]}, {r.c[2], r.c[3]}, {r.d[0], r.d[1]}, {r.d[2], r.d[3]}};
        f32x2 pa = s[0] * k[0] + s[1] * k[1]; const f32x2 pb = s[2] * k[2] + s[3] * k[3]; pa += pb;
        const float pp = rowred16(pa.x + pa.y);
        const float cc = r.x0 * (r.vr - r.x1 * pp);
        const f32x2 eg2 = {r.x1, r.x1}, cc2 = {cc, cc};
#pragma unroll
        for (int i = 0; i < 4; ++i) s[i] = s[i] * eg2 + cc2 * k[i];
        f32x2 oa = s[0] * q[0] + s[1] * q[1]; const f32x2 ob = s[2] * q[2] + s[3] * q[3]; oa += ob;
        return rowred16(oa.x + oa.y);
    } else if (KIND == 1) {
        const f32x2 q[4] = {{r.a[0], r.a[1]}, {r.a[2], r.a[3]}, {r.b[0], r.b[1]}, {r.b[2], r.b[3]}};
        const f32x2 f[4] = {{r.c[0], r.c[1]}, {r.c[2], r.c[3]}, {r.d[0], r.d[1]}, {r.d[2], r.d[3]}};
        const f32x2 v2 = {r.vr, r.vr};
#pragma unroll
        for (int i = 0; i < 4; ++i) s[i] = s[i] * f[i] + v2 * (1.0f - f[i]);
        f32x2 oa = s[0] * q[0] + s[1] * q[1]; const f32x2 ob = s[2] * q[2] + s[3] * q[3]; oa += ob;
        return rowred16(oa.x + oa.y);
    } else {
        const f32x2 a2[2] = {{r.a[0], r.a[1]}, {r.a[2], r.a[3]}}, b2[2] = {{r.b[0], r.b[1]}, {r.b[2], r.b[3]}}, d2[2] = {{r.c[0], r.c[1]}, {r.c[2], r.c[3]}};
        const f32x2 k2[2] = {{r.d[0], r.d[1]}, {r.d[2], r.d[3]}}, r2[2] = {{r.e[0], r.e[1]}, {r.e[2], r.e[3]}};
        const f32x2 pa = s[0] * a2[0] + s[1] * a2[1];
        const float sa = rowred16(pa.x + pa.y);
        const f32x2 sa2 = {sa, sa}, v2 = {r.vr, r.vr};
        s[0] = s[0] * d2[0] + sa2 * b2[0] + v2 * k2[0]; s[1] = s[1] * d2[1] + sa2 * b2[1] + v2 * k2[1];
        const f32x2 oa = s[0] * r2[0] + s[1] * r2[1];
        return rowred16(oa.x + oa.y);
    }
}
__device__ __forceinline__ int tidx() { int t = threadIdx.x; asm volatile("" : "+v"(t)); return t; }
__device__ __forceinline__ int bidx() { int t = blockIdx.x; asm volatile("" : "+s"(t)); return t; }
__device__ __forceinline__ int gdim() { int t = gridDim.x; asm volatile("" : "+s"(t)); return t; }
__device__ __forceinline__ void lds_barrier() { asm volatile("s_waitcnt lgkmcnt(0)" ::: "memory"); __builtin_amdgcn_s_barrier(); asm volatile("" ::: "memory"); }

namespace pg8 {
constexpr int BM = 256, BK = 64, HALF = 128, HTB = HALF * BK * 2, STAGE_BYTES = 8 * HTB, NXCD = 8, WGM = 8;
__device__ __forceinline__ int lds_byte(int r, int c) { const int st = (r >> 4) * 2 + (c >> 5), rr = r & 15, cc = c & 31, ob = rr * 64 + cc * 2; return st * 1024 + (ob ^ (((ob >> 9) & 1) << 5)); }
__device__ __forceinline__ void stage_rc(int b, int& R, int& C) { const int st = b / 1024, sb = b % 1024, swz = sb ^ (((sb >> 9) & 1) << 5); R = (st >> 1) * 16 + swz / 64; C = (st & 1) * 32 + (swz % 64) / 2; }
__device__ __forceinline__ int perm32(int rho) { const int n = rho >> 4, i = rho & 15; return 8 * (i >> 2) + 4 * n + (i & 3); }
struct Unit { int pm, pn; };
struct Gemm { const bf16_t* A; const bf16_t* Bt; int M, N, K, lda; };
struct StaticOrder {
    int nM, nN, nwg, G, c;
    __device__ void init(int M, int N, int G_, int c_) { nM = M / BM; nN = N / BM; nwg = nM * nN; G = G_; c = c_; }
    __device__ bool next(int i, Unit& u) const {
        const long L = (long)i * G + c; if (L >= nwg) return false;
        int wgid = (int)L; { const int q = nwg / NXCD, r = nwg % NXCD, xcd = wgid % NXCD, off = wgid / NXCD; wgid = (xcd < r ? xcd * (q + 1) : r * (q + 1) + (xcd - r) * q) + off; }
        const int nig = WGM * nN, gid = wgid / nig, fm = gid * WGM, gsz = (nM - fm) < WGM ? (nM - fm) : WGM;
        u.pm = fm + ((wgid % nig) % gsz); u.pn = (wgid % nig) / gsz; return true;
    }
};
__device__ __forceinline__ unsigned cvt_pk_bf16(float lo, float hi) { return pack2(lo, hi); }

struct EpiBf16S {
    static constexpr bool PERM = true;
    bf16_t* O; int ldc; int act;
    __device__ __forceinline__ void operator()(const f32x4 (&acc)[2][2][4][2], const Unit& u, int wr, int wc, int fr, int fq) const {
        const int row0 = u.pm * BM + wr * 64 + fr; const int col0 = u.pn * BM + wc * 32 + 8 * fq;
#pragma unroll
        for (int ai = 0; ai < 2; ++ai)
#pragma unroll
            for (int m = 0; m < 4; ++m) { bf16_t* rowp = O + (size_t)(row0 + ai * HALF + m * 16) * ldc + col0;
#pragma unroll
                for (int bj = 0; bj < 2; ++bj) { f32x4 v0 = acc[ai][bj][m][0], v1 = acc[ai][bj][m][1];
                    if (act) { const int c = col0 + bj * HALF;
                        if (c >= 3072 && c < 3136) {
#pragma unroll
                            for (int j = 0; j < 4; ++j) { v0[j] = 1.0f - 2.0f * __builtin_amdgcn_rcpf(1.0f + __expf(2.0f * v0[j])); v1[j] = 1.0f - 2.0f * __builtin_amdgcn_rcpf(1.0f + __expf(2.0f * v1[j])); } }
                        else if (c >= 3200) {
#pragma unroll
                            for (int j = 0; j < 4; ++j) { v0[j] = sigmoidf_(v0[j]); v1[j] = sigmoidf_(v1[j]); } } }
                    u32x4 w; w.x = cvt_pk_bf16(v0[0], v0[1]); w.y = cvt_pk_bf16(v0[2], v0[3]); w.z = cvt_pk_bf16(v1[0], v1[1]); w.w = cvt_pk_bf16(v1[2], v1[3]);
                    *(u32x4*)(rowp + bj * HALF) = w; } }
    }
};
struct EpiRes {
    static constexpr bool PERM = false;
    const float* res; float* out; const float* gate;
    __device__ __forceinline__ void operator()(const f32x4 (&acc)[2][2][4][2], const Unit& u, int wr, int wc, int fr, int fq) const {
        const int row0 = u.pm * BM + wr * 64 + fr, col0 = u.pn * BM + wc * 32 + 4 * fq; const int b = (u.pm * BM) / SEQ;
        f32x4 gv[2][2];
#pragma unroll
        for (int bj = 0; bj < 2; ++bj)
#pragma unroll
            for (int n = 0; n < 2; ++n) gv[bj][n] = *(const f32x4*)(gate + (size_t)b * 6144 + col0 + bj * HALF + n * 16);
#pragma unroll
        for (int ai = 0; ai < 2; ++ai)
#pragma unroll
            for (int m = 0; m < 4; ++m) { const size_t off = (size_t)(row0 + ai * HALF + m * 16) * DM + col0;
#pragma unroll
                for (int bj = 0; bj < 2; ++bj)
#pragma unroll
                    for (int n = 0; n < 2; ++n) { const f32x4 r = *(const f32x4*)(res + off + bj * HALF + n * 16);
                        *(f32x4*)(out + off + bj * HALF + n * 16) = r + gv[bj][n] * acc[ai][bj][m][n]; } }
    }
};

template <class Epi>
__device__ __forceinline__ void gemm_phase(LAS unsigned char* lds, const Gemm g, const StaticOrder& S, const Epi& E) {
    const int tid = tidx(), wid = __builtin_amdgcn_readfirstlane(tid >> 6), lane = tid & 63, wr = wid >> 2, wc = wid & 3, fr = lane & 15, fq = lane >> 4;
    const int K = g.K, nt = K / BK, lda = g.lda;
    unsigned voffA[2], voffB[2];
#pragma unroll
    for (int i = 0; i < 2; ++i) { int R, C; stage_rc(tid * 16 + i * 8192, R, C); const int Rb = Epi::PERM ? ((R & ~31) + perm32(R & 31)) : R;
        voffA[i] = (unsigned)(R * lda + C) * 2u; voffB[i] = (unsigned)(Rb * K + C) * 2u; }
    const size_t kstep = (size_t)(BK * 2);
    const size_t hstepA = (size_t)HALF * lda * 2, hstepB = (size_t)HALF * K * 2;
    const size_t tstepA = 2 * hstepA, tstepB = 2 * hstepB;
    const unsigned ldsw = (unsigned)wid * 1024u;
    const int aoff = lds_byte(wr * 64 + fr, fq * 8), boff = lds_byte(wc * 32 + fr, fq * 8);
#define PG8_SA(b, h) (((b) * 2 + (h)) * HTB)
#define PG8_SB(b, h) ((4 + (b) * 2 + (h)) * HTB)
#define PG8_STAGE(bufoff, gbase, voff) do { _Pragma("unroll") for (int _i = 0; _i < 2; ++_i) \
        __builtin_amdgcn_global_load_lds((const unsigned*)((const char*)(gbase) + (voff)[_i]), (LAS unsigned*)(lds + (bufoff) + ldsw + _i * 8192), 16, 0, 0); } while (0)
#define PG8_LDA(dst, b, h) do { _Pragma("unroll") for (int m = 0; m < 4; ++m) _Pragma("unroll") for (int k = 0; k < 2; ++k) dst[m][k] = *(const LAS bf16x8*)(lds + PG8_SA(b, h) + aoff + m * 2048 + k * 1024); } while (0)
#define PG8_LDB(dst, b, h) do { _Pragma("unroll") for (int n = 0; n < 2; ++n) _Pragma("unroll") for (int k = 0; k < 2; ++k) dst[n][k] = *(const LAS bf16x8*)(lds + PG8_SB(b, h) + boff + n * 2048 + k * 1024); } while (0)
#define PG8_MMA(ai, bj, At, Bt) do { __builtin_amdgcn_s_setprio(1); _Pragma("unroll") for (int m = 0; m < 4; ++m) _Pragma("unroll") for (int n = 0; n < 2; ++n) _Pragma("unroll") for (int k = 0; k < 2; ++k) \
        acc[ai][bj][m][n] = __builtin_amdgcn_mfma_f32_16x16x32_bf16(Bt[n][k], At[m][k], acc[ai][bj][m][n], 0, 0, 0); __builtin_amdgcn_s_setprio(0); } while (0)
#define PG8_WAIT_V(n) asm volatile("s_waitcnt vmcnt(" #n ")" ::: "memory")
#define PG8_WAIT_L(n) asm volatile("s_waitcnt lgkmcnt(" #n ")" ::: "memory")
#define PG8_BAR __builtin_amdgcn_s_barrier()
#define PG8_SCHED __builtin_amdgcn_sched_barrier(0)
    Unit cur, nxt; int ui = 0;
    if (!S.next(0, cur)) return;
    f32x4 acc[2][2][4][2];
#pragma unroll
    for (int a = 0; a < 2; ++a)
#pragma unroll
        for (int b = 0; b < 2; ++b)
#pragma unroll
            for (int m = 0; m < 4; ++m)
#pragma unroll
                for (int n = 0; n < 2; ++n) acc[a][b][m][n] = (f32x4){0.f, 0.f, 0.f, 0.f};
    bf16x8 At[4][2], B0[2][2], B1[2][2];
    const char* cA = (const char*)g.A + (size_t)cur.pm * tstepA; const char* cB = (const char*)g.Bt + (size_t)cur.pn * tstepB;
    PG8_STAGE(PG8_SB(0, 0), cB, voffB); PG8_STAGE(PG8_SA(0, 0), cA, voffA); PG8_STAGE(PG8_SB(0, 1), cB + hstepB, voffB); PG8_STAGE(PG8_SA(0, 1), cA + hstepA, voffA);
    if (wr == 1) PG8_BAR;
    PG8_WAIT_V(4); PG8_BAR;
    PG8_STAGE(PG8_SB(1, 0), cB + kstep, voffB); PG8_STAGE(PG8_SA(1, 0), cA + kstep, voffA); PG8_STAGE(PG8_SB(1, 1), cB + hstepB + kstep, voffB);
    PG8_WAIT_V(6); PG8_BAR;
    for (;;) {
        const bool has_next = S.next(ui + 1, nxt);
        const char* nA = has_next ? (const char*)g.A + (size_t)nxt.pm * tstepA : cA; const char* nB = has_next ? (const char*)g.Bt + (size_t)nxt.pn * tstepB : cB;
        for (int t = 0; t < nt; t += 2) {
            const bool last = (t == nt - 2);
            const char* a1 = cA + (size_t)(t + 1) * kstep;
            const char* a2 = last ? nA : cA + (size_t)(t + 2) * kstep; const char* b2 = last ? nB : cB + (size_t)(t + 2) * kstep;
            const char* a3 = a2 + kstep; const char* b3 = b2 + kstep;
            PG8_LDB(B0, 0, 0); PG8_SCHED; PG8_LDA(At, 0, 0); PG8_STAGE(PG8_SA(1, 1), a1 + hstepA, voffA);
            PG8_WAIT_L(8); PG8_BAR; PG8_WAIT_L(0); PG8_MMA(0, 0, At, B0); PG8_BAR; PG8_SCHED;
            PG8_LDB(B1, 0, 1); PG8_STAGE(PG8_SB(0, 0), b2, voffB);
            PG8_BAR; PG8_WAIT_L(0); PG8_MMA(0, 1, At, B1); PG8_BAR;
            PG8_LDA(At, 0, 1); PG8_STAGE(PG8_SA(0, 0), a2, voffA);
            PG8_BAR; PG8_WAIT_L(0); PG8_MMA(1, 0, At, B0); PG8_BAR; PG8_SCHED;
            PG8_STAGE(PG8_SB(0, 1), b2 + hstepB, voffB);
            PG8_WAIT_V(6); PG8_BAR; PG8_MMA(1, 1, At, B1); PG8_BAR;
            PG8_LDB(B0, 1, 0); PG8_SCHED; PG8_LDA(At, 1, 0); PG8_STAGE(PG8_SA(0, 1), a2 + hstepA, voffA);
            PG8_WAIT_L(8); PG8_BAR; PG8_WAIT_L(0); PG8_MMA(0, 0, At, B0); PG8_BAR; PG8_SCHED;
            PG8_LDB(B1, 1, 1); PG8_STAGE(PG8_SB(1, 0), b3, voffB);
            PG8_BAR; PG8_WAIT_L(0); PG8_MMA(0, 1, At, B1); PG8_BAR;
            PG8_LDA(At, 1, 1); PG8_STAGE(PG8_SA(1, 0), a3, voffA);
            PG8_BAR; PG8_WAIT_L(0); PG8_MMA(1, 0, At, B0); PG8_BAR; PG8_SCHED;
            PG8_STAGE(PG8_SB(1, 1), b3 + hstepB, voffB);
            PG8_WAIT_V(6); PG8_BAR; PG8_MMA(1, 1, At, B1); PG8_BAR;
        }
        E(acc, cur, wr, wc, fr, fq);
        if (!has_next) break;
#pragma unroll
        for (int a = 0; a < 2; ++a)
#pragma unroll
            for (int b = 0; b < 2; ++b)
#pragma unroll
                for (int m = 0; m < 4; ++m)
#pragma unroll
                    for (int n = 0; n < 2; ++n) acc[a][b][m][n] = (f32x4){0.f, 0.f, 0.f, 0.f};
        cur = nxt; cA = nA; cB = nB; ++ui;
    }
    PG8_WAIT_V(0);
    if (wr == 0) PG8_BAR;
    PG8_BAR;
#undef PG8_SA
#undef PG8_SB
#undef PG8_STAGE
#undef PG8_LDA
#undef PG8_LDB
#undef PG8_MMA
#undef PG8_WAIT_V
#undef PG8_WAIT_L
#undef PG8_BAR
#undef PG8_SCHED
}
}

template <class Epi>
__device__ __forceinline__ void run_gemm(LAS unsigned char* lds, const bf16_t* A, int lda, const bf16_t* Bt, int N, int K, const Epi& E) {
    pg8::Gemm g; g.A = A; g.Bt = Bt; g.M = MROWS; g.N = N; g.K = K; g.lda = lda;
    pg8::StaticOrder S; S.init(MROWS, N, (int)gdim(), (int)bidx());
    pg8::gemm_phase<Epi>(lds, g, S, E);
}

__device__ __forceinline__ void cvt_job(LAS float* tile, bf16_t* dst, int ldd, const float* src, int srcN, int nK, int nNdst, int nNsrc, const float* scale, int noff) {
    const int tid = tidx(); const int tilesK = nK / 64, tilesN = nNdst / 64;
    for (int tl = bidx(); tl < tilesK * tilesN; tl += gdim()) {
        const int tk = tl % tilesK, tn = tl / tilesK, k0 = tk * 64, n0 = tn * 64;
#pragma unroll
        for (int ps = 0; ps < 8; ++ps) { const int kk = ps * 8 + (tid >> 6), nn = tid & 63, n = n0 + nn;
            float v = 0.f; if (src && n < nNsrc) { v = src[(size_t)(k0 + kk) * srcN + noff + n]; if (scale) v *= scale[k0 + kk]; }
            tile[kk * 65 + nn] = v; }
        __syncthreads();
#pragma unroll
        for (int ps = 0; ps < 4; ++ps) { const int kk2 = tid & 31, nn = (tid >> 5) + 16 * ps;
            const unsigned w = pack2(tile[(2 * kk2) * 65 + nn], tile[(2 * kk2 + 1) * 65 + nn]);
            *(unsigned*)(dst + (size_t)(n0 + nn) * ldd + k0 + 2 * kk2) = w; }
        __syncthreads();
    }
}

__device__ __forceinline__ void cvt_layer(LAS unsigned char* lds, PPTR p, int layer) {
    LAS float* tile = (LAS float*)lds;
    bf16_t* W = (bf16_t*)(p->ws + WS_W);
    bf16_t* w_in = W + W_IN / 2; bf16_t* w_l2 = W + W_L2 / 2; bf16_t* w_out = W + W_OUT / 2; bf16_t* w_up = W + W_UP / 2; bf16_t* w_dn = W + W_DN / 2;
    const int kind = layer % 3, j = layer / 3;
    const int nmix = (kind == 2) ? 20 : 2;
    for (int jb = 0; jb < nmix + 5; ++jb) {
        bf16_t* dst = w_in; int ldd = 1024; const float* src = nullptr; int srcN = 1024, nK = 1024, nNdst = 1024, nNsrc = 1024, noff = 0; const float* scale = nullptr;
        if (jb >= nmix) {
            const int f = jb - nmix;
            if (f < 4) { const int g = f >> 1, gate = f & 1; const int nch = g ? 1280 : 1536, ch0 = g ? 1536 : 0;
                dst = w_up + (size_t)((g ? 3072 : 0) + nch * gate) * 1024; src = p->in[31] + (size_t)layer * 1024 * 5632; srcN = 5632; nNdst = nch; nNsrc = nch; noff = 2816 * gate + ch0; }
            else { dst = w_dn; ldd = 2816; src = p->in[34] + (size_t)layer * 2816 * 1024; nK = 2816; }
        } else if (kind == 0) {
            if (jb == 0) { src = p->in[5] + (size_t)j * 1024 * 4112; srcN = 4112; nNdst = 4352; nNsrc = 4112; }
            else { dst = w_out; src = p->in[10] + (size_t)j * 1024 * 1024; }
        } else if (kind == 1) {
            if (jb == 0) { src = p->in[11]; srcN = 4096; nNdst = 4096; nNsrc = 4096; }
            else { dst = w_out; src = p->in[14]; }
        } else {
            const float* mu = p->in[15];
            if (jb < 6) { const int sI = jb >> 1, hi = jb & 1; const int mi = (sI == 0) ? 0 : (sI == 1 ? 2 : 3);
                dst = w_in + (size_t)sI * 1024 * 2048 + hi * 1024; ldd = 2048; src = p->in[16] + (size_t)sI * 1024 * 1024; if (hi) scale = mu + mi * 1024; }
            else if (jb < 12) { const int q = (jb - 6) >> 1, hi = jb & 1;
                const int rowo = (q == 0) ? 3072 : (q == 1 ? 3136 : 3200); const int nc = (q == 2) ? 128 : 64; const int mi = (q == 0) ? 1 : (q == 1 ? 4 : 5);
                dst = w_in + (size_t)rowo * 2048 + hi * 1024; ldd = 2048; src = (q == 0) ? p->in[18] : (q == 1 ? p->in[21] : p->in[23]); srcN = nc; nNdst = nc; nNsrc = nc; if (hi) scale = mu + mi * 1024; }
            else if (jb < 19) { ldd = 256; nNdst = 1024; nNsrc = 1024;
                const int q = jb - 12;
                if (q == 0) { dst = w_l2; src = p->in[19]; nK = 64; }
                else if (q == 1) { dst = w_l2 + 64; nK = 192; }
                else if (q == 2) { dst = w_l2 + (size_t)1024 * 256; nK = 64; }
                else if (q == 3) { dst = w_l2 + (size_t)1024 * 256 + 64; src = p->in[22]; nK = 64; }
                else if (q == 4) { dst = w_l2 + (size_t)1024 * 256 + 128; nK = 128; }
                else if (q == 5) { dst = w_l2 + (size_t)2048 * 256; nK = 128; }
                else { dst = w_l2 + (size_t)2048 * 256 + 128; src = p->in[24]; nK = 128; } }
            else { dst = w_out; src = p->in[30]; }
        }
        cvt_job(tile, dst, ldd, src, srcN, nK, nNdst, nNsrc, scale, noff);
    }
}

template <bool SHIFT>
__device__ __forceinline__ void norm_phase(const float* h, const float* g, const float* modl, int s_shift, bf16_t* U, int ldu) {
    const int lane = tidx() & 63, wave = tidx() >> 6;
    const int gw = bidx() * 8 + wave, nw = gdim() * 8;
    constexpr int RU = SHIFT ? 2 : 4;
    for (int row0 = gw; row0 < MROWS; row0 += nw * RU) {
        f32x4 x[RU][4], xp[RU][4];
#pragma unroll
        for (int q = 0; q < RU; ++q) { const int row = row0 + q * nw;
            if (row < MROWS) {
#pragma unroll
                for (int i = 0; i < 4; ++i) x[q][i] = *(const f32x4*)(h + (size_t)row * DM + i * 256 + lane * 4);
                if (SHIFT) { const size_t prow = ((row & (SEQ - 1)) > 0) ? (size_t)(row - 1) : (size_t)row;
#pragma unroll
                    for (int i = 0; i < 4; ++i) xp[q][i] = *(const f32x4*)(h + prow * DM + i * 256 + lane * 4); } } }
#pragma unroll
        for (int q = 0; q < RU; ++q) { const int row = row0 + q * nw;
            if (row < MROWS) {
                const int b = row >> 13, t = row & (SEQ - 1);
                const float* sh = modl + (size_t)b * 6144 + s_shift * 1024; const float* sc = sh + 1024;
                float ss = 0.f;
#pragma unroll
                for (int i = 0; i < 4; ++i) ss += x[q][i][0] * x[q][i][0] + x[q][i][1] * x[q][i][1] + x[q][i][2] * x[q][i][2] + x[q][i][3] * x[q][i][3];
                ss = wave_allsum(ss); const float rstd = __builtin_amdgcn_rsqf(ss * (1.0f / 1024.0f) + 1e-6f);
                float rstdp = 0.f;
                if (SHIFT) { float ssp = 0.f;
#pragma unroll
                    for (int i = 0; i < 4; ++i) ssp += xp[q][i][0] * xp[q][i][0] + xp[q][i][1] * xp[q][i][1] + xp[q][i][2] * xp[q][i][2] + xp[q][i][3] * xp[q][i][3];
                    ssp = wave_allsum(ssp); rstdp = __builtin_amdgcn_rsqf(ssp * (1.0f / 1024.0f) + 1e-6f); }
#pragma unroll
                for (int i = 0; i < 4; ++i) { const int c = i * 256 + lane * 4; const f32x4 gg = *(const f32x4*)(g + c), s1 = *(const f32x4*)(sc + c), s0 = *(const f32x4*)(sh + c);
                    const f32x4 u = x[q][i] * rstd * gg * (1.0f + s1) + s0;
                    u32x2 w; w.x = pack2(u[0], u[1]); w.y = pack2(u[2], u[3]); *(u32x2*)(U + (size_t)row * ldu + c) = w;
                    if (SHIFT) { f32x4 up = xp[q][i] * rstdp * gg * (1.0f + s1) + s0; if (t == 0) up = (f32x4){0.f, 0.f, 0.f, 0.f};
                        const f32x4 dx = up - u; u32x2 w2; w2.x = pack2(dx[0], dx[1]); w2.y = pack2(dx[2], dx[3]); *(u32x2*)(U + (size_t)row * ldu + 1024 + c) = w2; } }
            } }
    }
}

__device__ __forceinline__ void final_phase(float* h, const float* g) {
    const int lane = tidx() & 63, wave = tidx() >> 6;
    const int gw = bidx() * 8 + wave, nw = gdim() * 8;
    for (int row0 = gw; row0 < MROWS; row0 += nw * 4) {
        f32x4 x[4][4];
#pragma unroll
        for (int q = 0; q < 4; ++q) { const int row = row0 + q * nw; if (row < MROWS) {
#pragma unroll
            for (int i = 0; i < 4; ++i) x[q][i] = *(const f32x4*)(h + (size_t)row * DM + i * 256 + lane * 4); } }
#pragma unroll
        for (int q = 0; q < 4; ++q) { const int row = row0 + q * nw; if (row < MROWS) {
            float ss = 0.f;
#pragma unroll
            for (int i = 0; i < 4; ++i) ss += x[q][i][0] * x[q][i][0] + x[q][i][1] * x[q][i][1] + x[q][i][2] * x[q][i][2] + x[q][i][3] * x[q][i][3];
            ss = wave_allsum(ss); const float rstd = __builtin_amdgcn_rsqf(ss * (1.0f / 1024.0f) + 1e-6f);
#pragma unroll
            for (int i = 0; i < 4; ++i) { const int c = i * 256 + lane * 4; const f32x4 gg = *(const f32x4*)(g + c);
                *(f32x4*)(h + (size_t)row * DM + c) = x[q][i] * rstd * gg; } } }
    }
}

__device__ __forceinline__ void pre_phase(LAS unsigned char* lds, PPTR p) {
    LAS float* cond = (LAS float*)lds;
    LAS float* red = cond + 4096;
    const int tid = tidx(), lane = tid & 63, wave = tid >> 6;
    float* mod = (float*)(p->ws + WS_MISC); float* lb = mod + 4 * 4 * 6144;
    for (int i = tid; i < 4096; i += 512) cond[i] = siluf_(p->in[1][i]);
    __syncthreads();
    for (int task = bidx(); task < 384; task += gdim()) {
        const int l = task / 96, cb = task % 96, col = cb * 64 + lane;
        float a0 = 0.f, a1 = 0.f, a2 = 0.f, a3 = 0.f;
        const float* wp = p->in[3] + ((size_t)l * 1024 + wave * 128) * 6144 + col;
#pragma unroll 8
        for (int k = 0; k < 128; ++k) { const float wv = wp[(size_t)k * 6144]; const int kk = wave * 128 + k;
            a0 += cond[kk] * wv; a1 += cond[1024 + kk] * wv; a2 += cond[2048 + kk] * wv; a3 += cond[3072 + kk] * wv; }
        red[(wave * 4 + 0) * 64 + lane] = a0; red[(wave * 4 + 1) * 64 + lane] = a1; red[(wave * 4 + 2) * 64 + lane] = a2; red[(wave * 4 + 3) * 64 + lane] = a3;
        __syncthreads();
        if (tid < 256) { const int b = tid >> 6; float s = 0.f;
#pragma unroll
            for (int w = 0; w < 8; ++w) s += red[(w * 4 + b) * 64 + lane];
            mod[((size_t)l * 4 + b) * 6144 + col] = s + p->in[4][(size_t)l * 6144 + col]; }
        __syncthreads();
    }
    for (int c = bidx() * 512 + tid; c < 1024; c += gdim() * 512) {
        const float l0 = p->in[12][c], l1 = p->in[12][1024 + c], l2 = p->in[12][2048 + c], l3 = p->in[12][3072 + c];
        const float mx = fmaxf(fmaxf(l0, l1), fmaxf(l2, l3));
        const float e0 = __expf(l0 - mx), e1 = __expf(l1 - mx), e2 = __expf(l2 - mx), e3 = __expf(l3 - mx);
        lb[c] = e1 / (e0 + e1 + e2 + e3);
    }
}

__device__ __forceinline__ void convglu_phase(const bf16_t* HID, bf16_t* ACT, int g, const float* cw, const float* cb) {
    const int nch = g ? 1280 : 1536, ch0 = g ? 1536 : 0, ld = 2 * nch, ncg = nch / 8;
    const int total = (MROWS / 16) * ncg;
    for (int task = bidx() * 512 + tidx(); task < total; task += gdim() * 512) {
        const int cgi = task % ncg, run = task / ncg, row0 = run * 16, t0 = row0 & (SEQ - 1), j0 = cgi * 8, ch = ch0 + j0;
        float wv[3][8], wg[3][8], bv[8], bg[8];
#pragma unroll
        for (int k = 0; k < 3; ++k)
#pragma unroll
            for (int e = 0; e < 8; ++e) { wv[k][e] = cw[k * 5632 + ch + e]; wg[k][e] = cw[k * 5632 + 2816 + ch + e]; }
#pragma unroll
        for (int e = 0; e < 8; ++e) { bv[e] = cb[ch + e]; bg[e] = cb[2816 + ch + e]; }
        u32x4 v2 = (u32x4){0, 0, 0, 0}, v1 = v2, g2 = v2, g1 = v2;
        if (t0 >= 2) {
            v2 = *(const u32x4*)(HID + (size_t)(row0 - 2) * ld + j0); g2 = *(const u32x4*)(HID + (size_t)(row0 - 2) * ld + nch + j0);
            v1 = *(const u32x4*)(HID + (size_t)(row0 - 1) * ld + j0); g1 = *(const u32x4*)(HID + (size_t)(row0 - 1) * ld + nch + j0);
        }
        u32x4 va[4], ga[4], vb4[4], gb4[4];
#define CG_LOAD(V, G, r0) do { _Pragma("unroll") for (int q_ = 0; q_ < 4; ++q_) { V[q_] = *(const u32x4*)(HID + (size_t)(row0 + (r0) + q_) * ld + j0); G[q_] = *(const u32x4*)(HID + (size_t)(row0 + (r0) + q_) * ld + nch + j0); } } while (0)
#define CG_ROWS(V, G, r0) do { _Pragma("unroll") for (int q_ = 0; q_ < 4; ++q_) { const u32x4 v0 = V[q_], g0 = G[q_]; u32x4 o; \
            _Pragma("unroll") for (int q = 0; q < 4; ++q) { \
                const float yv0 = wv[0][2 * q] * bflo(v2[q]) + wv[1][2 * q] * bflo(v1[q]) + wv[2][2 * q] * bflo(v0[q]) + bv[2 * q]; \
                const float yv1 = wv[0][2 * q + 1] * bfhi(v2[q]) + wv[1][2 * q + 1] * bfhi(v1[q]) + wv[2][2 * q + 1] * bfhi(v0[q]) + bv[2 * q + 1]; \
                const float yg0 = wg[0][2 * q] * bflo(g2[q]) + wg[1][2 * q] * bflo(g1[q]) + wg[2][2 * q] * bflo(g0[q]) + bg[2 * q]; \
                const float yg1 = wg[0][2 * q + 1] * bfhi(g2[q]) + wg[1][2 * q + 1] * bfhi(g1[q]) + wg[2][2 * q + 1] * bfhi(g0[q]) + bg[2 * q + 1]; \
                o[q] = pack2(yv0 * siluf_(yg0), yv1 * siluf_(yg1)); } \
            *(u32x4*)(ACT + (size_t)(row0 + (r0) + q_) * 2816 + ch) = o; \
            v2 = v1; v1 = v0; g2 = g1; g1 = g0; } } while (0)
        CG_LOAD(va, ga, 0);
        CG_LOAD(vb4, gb4, 4);
        CG_ROWS(va, ga, 0);
        CG_LOAD(va, ga, 8);
        CG_ROWS(vb4, gb4, 4);
        CG_LOAD(vb4, gb4, 12);
        CG_ROWS(va, ga, 8);
        CG_ROWS(vb4, gb4, 12);
#undef CG_LOAD
#undef CG_ROWS
    }
}

template <int KIND>
__device__ __forceinline__ void scan_phase(LAS unsigned char* lds, PPTR p, int j) {
    constexpr int N = (KIND == 2) ? 64 : 128;
    constexpr int NH = (KIND == 2) ? 16 : 8;
    constexpr int RG = N / 16;
    constexpr int STRIDE = (KIND == 0) ? 288 : (KIND == 1 ? 272 : 336);
    constexpr int TC = 32, NC = SEQ / TC;
    constexpr int LDP = (KIND == 0) ? 4352 : (KIND == 1 ? 4096 : 3328);
    LAS float* buf = (LAS float*)lds;
    LAS float* ob = buf + 2 * TC * STRIDE;
    const int tid = tidx(), wave = tid >> 6, lane = tid & 63;
    const bool is_loader = wave >= 4; const int lw = wave - 4;
    const int li = lane & 15, row = (wave & 3) * 4 + (lane >> 4);
    const bf16_t* P = (const bf16_t*)(p->ws + (KIND == 2 ? WS_PROJC : WS_PROJ));
    const bf16_t* L2 = (const bf16_t*)(p->ws + WS_R1);
    bf16_t* O = (bf16_t*)(p->ws + (KIND == 2 ? WS_OC : WS_R1));
    const int G = gdim(); const int vcu = (G % 8 == 0) ? (int)(bidx() % 8) * (G / 8) + (int)(bidx() / 8) : (int)bidx();
    for (int task = vcu; task < 256; task += G) {
        const int bh = task / RG, rg = task % RG, b = bh / NH, h = bh % NH;
        const size_t rbase = (size_t)b * SEQ;
        float cwq[4][2], cwk[4][2], cwv[4]; float expA = 0.f, dtb = 0.f; float lbv[2]; float w0v = 0.f, a0v = 0.f, kkc = 0.f, kac = 0.f;
        if (KIND == 0) { const float* cv = p->in[6] + (size_t)j * 4 * 3072;
#pragma unroll
            for (int jj = 0; jj < 4; ++jj) { cwq[jj][0] = cv[jj * 3072 + h * 128 + 2 * lane]; cwq[jj][1] = cv[jj * 3072 + h * 128 + 2 * lane + 1];
                cwk[jj][0] = cv[jj * 3072 + 1024 + h * 128 + 2 * lane]; cwk[jj][1] = cv[jj * 3072 + 1024 + h * 128 + 2 * lane + 1];
                cwv[jj] = cv[jj * 3072 + 2048 + h * 128 + 16 * rg + (lane & 15)]; }
            expA = __expf(p->in[7][j * 8 + h]); dtb = p->in[8][j * 8 + h]; }
        if (KIND == 1) { const float* lbp = (const float*)(p->ws + WS_MISC) + 4 * 4 * 6144; lbv[0] = lbp[h * 128 + 2 * lane]; lbv[1] = lbp[h * 128 + 2 * lane + 1]; }
        if (KIND == 2) { const int ch = h * 64 + lane; w0v = p->in[17][ch]; a0v = p->in[20][ch]; kkc = p->in[25][ch]; kac = p->in[26][ch]; }
        unsigned x0[11], x1[11], x2[11], x3[8], x4[8];
        f32x2 s[4];
#pragma unroll
        for (int e = 0; e < 4; ++e) s[e] = (f32x2){0.f, 0.f};

#define SCAN_LOAD(cc) do { const int c_ = (cc); \
        if (KIND == 0) { const int tfirst = c_ * TC + 8 * lw - 3; \
            _Pragma("unroll") for (int q = 0; q < 11; ++q) { const int t_ = tfirst + q; const bool valid = t_ >= 0; const bf16_t* rowp = P + (rbase + (valid ? t_ : 0)) * LDP; \
                const unsigned vq = *(const unsigned*)(rowp + h * 128 + 2 * lane), vk = *(const unsigned*)(rowp + 1024 + h * 128 + 2 * lane); \
                const int mcol = lane < 16 ? 2048 + h * 128 + 16 * rg + lane : (lane == 32 ? 4096 + h : (lane == 33 ? 4104 + h : 2048 + h * 128)); \
                const unsigned vm = rowp[mcol]; x0[q] = valid ? vq : 0u; x1[q] = valid ? vk : 0u; x2[q] = valid ? vm : 0u; } } \
        else if (KIND == 1) { const int tfirst = c_ * TC + 8 * lw; \
            _Pragma("unroll") for (int q = 0; q < 8; ++q) { const bf16_t* rowp = P + (rbase + tfirst + q) * LDP; \
                x0[q] = *(const unsigned*)(rowp + h * 128 + 2 * lane); x1[q] = *(const unsigned*)(rowp + 1024 + h * 128 + 2 * lane); \
                x2[q] = rowp[2048 + h * 128 + 16 * rg + (lane & 15)]; } } \
        else { const int tfirst = c_ * TC + 8 * lw; \
            _Pragma("unroll") for (int q = 0; q < 8; ++q) { const bf16_t* rowp = P + (rbase + tfirst + q) * LDP; const bf16_t* l2p = L2 + (rbase + tfirst + q) * 3072; \
                x0[q] = rowp[h * 64 + lane]; x1[q] = rowp[1024 + h * 64 + lane]; x2[q] = rowp[2048 + h * 64 + 16 * rg + (lane & 15)]; \
                x3[q] = l2p[h * 64 + lane]; x4[q] = l2p[1024 + h * 64 + lane]; } } } while (0)

#define SCAN_FLUSH(cc) do { const int c_ = (cc); LAS const float* src = ob + (c_ & 1) * (TC * 16) + (lane >> 1) * 16 + (lane & 1) * 8; \
        u32x4 w; w.x = pack2(src[0], src[1]); w.y = pack2(src[2], src[3]); w.z = pack2(src[4], src[5]); w.w = pack2(src[6], src[7]); \
        *(u32x4*)(O + (rbase + c_ * TC + (lane >> 1)) * DM + h * N + 16 * rg + (lane & 1) * 8) = w; } while (0)

        if (is_loader) SCAN_LOAD(0);
        for (int it = 0; it <= NC; ++it) {
            if (is_loader) {
                if (it < NC) {
                    LAS float* bw = buf + (it & 1) * (TC * STRIDE);
#pragma unroll
                    for (int i = 0; i < 8; ++i) {
                        LAS float* rec = bw + (8 * lw + i) * STRIDE;
                        if (KIND == 0) {
                            float yq0 = 0.f, yq1 = 0.f, yk0 = 0.f, yk1 = 0.f, yv = 0.f;
#pragma unroll
                            for (int jj = 0; jj < 4; ++jj) { yq0 += cwq[jj][0] * bflo(x0[i + jj]); yq1 += cwq[jj][1] * bfhi(x0[i + jj]);
                                yk0 += cwk[jj][0] * bflo(x1[i + jj]); yk1 += cwk[jj][1] * bfhi(x1[i + jj]); yv += cwv[jj] * bf2f(x2[i + jj]); }
                            yq0 = siluf_(yq0); yq1 = siluf_(yq1); yk0 = siluf_(yk0); yk1 = siluf_(yk1);
                            const float ssq = wave_allsum(yq0 * yq0 + yq1 * yq1), ssk = wave_allsum(yk0 * yk0 + yk1 * yk1);
                            const float rq = __builtin_amdgcn_rsqf(ssq + 1e-6f) * 0.08838834764831845f, rk = __builtin_amdgcn_rsqf(ssk + 1e-6f);
                            *(LAS f32x2*)(rec + 2 * lane) = (f32x2){yk0 * rk, yk1 * rk};
                            *(LAS f32x2*)(rec + 128 + 2 * lane) = (f32x2){yq0 * rq, yq1 * rq};
                            const float m3 = bf2f(x2[i + 3]);
                            if (lane < 16) rec[256 + lane] = siluf_(yv);
                            else if (lane == 32) rec[273] = __expf(-expA * softplusf_(m3 + dtb));
                            else if (lane == 33) rec[272] = sigmoidf_(m3);
                        } else if (KIND == 1) {
                            const float q0 = siluf_(bflo(x0[i])), q1 = siluf_(bfhi(x0[i]));
                            const float f0 = lbv[0] + (1.0f - lbv[0]) * sigmoidf_(bflo(x1[i])), f1 = lbv[1] + (1.0f - lbv[1]) * sigmoidf_(bfhi(x1[i]));
                            *(LAS f32x2*)(rec + 2 * lane) = (f32x2){q0, q1};
                            *(LAS f32x2*)(rec + 128 + 2 * lane) = (f32x2){f0, f1};
                            if (lane < 16) rec[256 + lane] = bf2f(x2[i]);
                        } else {
                            const float r = bf2f(x0[i]), kraw = bf2f(x1[i]), whi = bf2f(x3[i]), ahi = bf2f(x4[i]);
                            const float wv = -softplusf_(-(w0v + whi)) - 0.5f; const float d = __expf(-__expf(wv));
                            const float ag = sigmoidf_(a0v + ahi);
                            const float kkx = kraw * kkc; const float ss = wave_allsum(kkx * kkx); const float kk = kkx * __builtin_amdgcn_rsqf(ss + 1e-6f);
                            const float kp = kraw * (1.0f + (ag - 1.0f) * kac);
                            rec[lane] = -kk; rec[64 + lane] = kk * ag; rec[128 + lane] = d; rec[192 + lane] = kp; rec[256 + lane] = r;
                            if (lane < 16) rec[320 + lane] = bf2f(x2[i]);
                        }
                    }
                    if (it + 1 < NC) SCAN_LOAD(it + 1);
                }
                if (it >= 2 && lw == 0) SCAN_FLUSH(it - 2);
            } else if (it >= 1) {
                LAS const float* bc = buf + ((it - 1) & 1) * (TC * STRIDE);
                LAS float* oc = ob + ((it - 1) & 1) * (TC * 16);
                StepRegs R[2][2];
                step_load<KIND>(R[0][0], bc, li, row); step_load<KIND>(R[0][1], bc + STRIDE, li, row);
                float osel = 0.f;
#pragma unroll
                for (int g = 0; g < 16; ++g) {
                    if (g + 1 < 16) { step_load<KIND>(R[(g + 1) & 1][0], bc + (2 * g + 2) * STRIDE, li, row); step_load<KIND>(R[(g + 1) & 1][1], bc + (2 * g + 3) * STRIDE, li, row); }
#pragma unroll
                    for (int u = 0; u < 2; ++u) { const float o = step_compute<KIND>(R[g & 1][u], s); osel = (li == ((2 * g + u) & 15)) ? o : osel; }
                    if (g == 7 || g == 15) oc[((g == 15 ? 16 : 0) + li) * 16 + row] = osel;
                }
            }
            lds_barrier();
        }
        if (is_loader && lw == 0) SCAN_FLUSH(NC - 1);
        lds_barrier();
#undef SCAN_LOAD
#undef SCAN_FLUSH
    }
}


typedef short bf16x4 __attribute__((ext_vector_type(4)));
__device__ __forceinline__ bf16x8 cat4(bf16x4 lo, bf16x4 hi) { return __builtin_shufflevector(lo, hi, 0, 1, 2, 3, 4, 5, 6, 7); }
__device__ __forceinline__ bf16x4 cvt4(f32x4 v) { u32x2 w; w.x = pg8::cvt_pk_bf16(v[0], v[1]); w.y = pg8::cvt_pk_bf16(v[2], v[3]); return __builtin_bit_cast(bf16x4, w); }
constexpr size_t WS_KG = WS_R1 + 64 * MiB;
constexpr size_t WS_AM = 420 * MiB;
constexpr size_t WS_DEC = 428 * MiB;

__device__ __forceinline__ void prep_gla(LAS unsigned char* lds, PPTR p) {
    const int tid = tidx(), w = tid >> 6, lane = tid & 63, n = lane & 15, kg = lane >> 4;
    LAS unsigned char* qs = lds + w * 8704; LAS unsigned char* ks = qs + 4352;
    const bf16_t* P = (const bf16_t*)(p->ws + WS_PROJ);
    bf16_t* Qg = (bf16_t*)(p->ws + WS_R1); bf16_t* Kg = (bf16_t*)(p->ws + WS_KG);
    bf16_t* Amg = (bf16_t*)(p->ws + WS_AM); float* Decg = (float*)(p->ws + WS_DEC);
    const float* lbp = (const float*)(p->ws + WS_MISC) + 4 * 4 * 6144;
    for (int task = bidx() * 8 + w; task < 4 * 512 * 8; task += gdim() * 8) {
        const int h = task & 7, rc = task >> 3; const size_t row0 = (size_t)rc * 16;
        const float lb0 = lbp[h * 128 + 2 * lane], lb1 = lbp[h * 128 + 2 * lane + 1];
        unsigned xq[16], xf[16];
#pragma unroll
        for (int t = 0; t < 16; ++t) { const bf16_t* rowp = P + (row0 + t) * 4096 + h * 128 + 2 * lane; xq[t] = *(const unsigned*)rowp; xf[t] = *(const unsigned*)(rowp + 1024); }
        float bc0 = 0.f, bc1 = 0.f; float kk0[16], kk1[16], bs0[16], bs1[16];
#pragma unroll
        for (int t = 0; t < 16; ++t) {
            const float q0 = siluf_(bflo(xq[t])), q1 = siluf_(bfhi(xq[t]));
            const float f0 = lb0 + (1.0f - lb0) * sigmoidf_(bflo(xf[t])), f1 = lb1 + (1.0f - lb1) * sigmoidf_(bfhi(xf[t]));
            bc0 += __logf(f0); bc1 += __logf(f1);
            kk0[t] = 1.0f - f0; kk1[t] = 1.0f - f1; bs0[t] = bc0; bs1[t] = bc1;
            const unsigned qp = pack2(q0 * __expf(bc0), q1 * __expf(bc1));
            *(unsigned*)(Qg + (row0 + t) * 1024 + h * 128 + 2 * lane) = qp;
            *(LAS unsigned*)(qs + t * 272 + 4 * lane) = qp;
        }
#pragma unroll
        for (int t = 0; t < 16; ++t) {
            *(unsigned*)(Kg + (row0 + t) * 1024 + h * 128 + 2 * lane) = pack2(kk0[t] * __expf(bc0 - bs0[t]), kk1[t] * __expf(bc1 - bs1[t]));
            *(LAS unsigned*)(ks + t * 272 + 4 * lane) = pack2(kk0[t] * __expf(-bs0[t]), kk1[t] * __expf(-bs1[t]));
        }
        *(f32x2*)(Decg + (size_t)task * 128 + 2 * lane) = (f32x2){__expf(bc0), __expf(bc1)};
        asm volatile("s_waitcnt lgkmcnt(0)" ::: "memory");
        f32x4 acc = (f32x4){0.f, 0.f, 0.f, 0.f};
#pragma unroll
        for (int a = 0; a < 4; ++a) {
            const bf16x8 af = *(LAS const bf16x8*)(qs + n * 272 + (32 * a + 8 * kg) * 2);
            const bf16x8 bfr = *(LAS const bf16x8*)(ks + n * 272 + (32 * a + 8 * kg) * 2);
            acc = __builtin_amdgcn_mfma_f32_16x16x32_bf16(af, bfr, acc, 0, 0, 0);
        }
#pragma unroll
        for (int jj = 0; jj < 4; ++jj) { const int t = 4 * kg + jj; Amg[(size_t)task * 256 + t * 16 + n] = (bf16_t)f2bf(n <= t ? acc[jj] : 0.f); }
        asm volatile("s_waitcnt lgkmcnt(0)" ::: "memory");
    }
}

__device__ __forceinline__ void scan_gla(LAS unsigned char* lds, PPTR p) {
    constexpr int QOFF = 0, KTOFF = 4352, VOFF = 9472, AMOFF = 13824, DECOFF = 14336, BUFB = 14848;
    const int tid = tidx(), w = tid >> 6, lane = tid & 63, n = lane & 15, kg = lane >> 4;
    const bf16_t* P = (const bf16_t*)(p->ws + WS_PROJ);
    bf16_t* Qg = (bf16_t*)(p->ws + WS_R1); const bf16_t* Kg = (const bf16_t*)(p->ws + WS_KG);
    const bf16_t* Amg = (const bf16_t*)(p->ws + WS_AM); const float* Decg = (const float*)(p->ws + WS_DEC);
    bf16_t* Og = (bf16_t*)(p->ws + WS_OC);
    const bf16x4 z4 = (bf16x4){0, 0, 0, 0};
    for (int task = bidx(); task < 32; task += gdim()) {
        const int b = task >> 3, h = task & 7; const size_t rowbase = (size_t)b * SEQ;
        f32x4 S[8]; bf16x8 Sb[4];
#pragma unroll
        for (int i = 0; i < 8; ++i) S[i] = (f32x4){0.f, 0.f, 0.f, 0.f};
#pragma unroll
        for (int a = 0; a < 4; ++a) Sb[a] = (bf16x8){0, 0, 0, 0, 0, 0, 0, 0};
        const int lt = (tid & 255) >> 4, pc = tid & 15;
        constexpr int PD = 8;
        u32x4 g0[PD], g1[PD];
#define GLA_LOAD(cc, sl) do { const int c_ = (cc); const size_t r_ = rowbase + (size_t)c_ * 16 + lt; \
            if (tid < 256) { g0[sl] = *(const u32x4*)(Qg + r_ * 1024 + h * 128 + 8 * pc); g1[sl] = *(const u32x4*)(P + r_ * 4096 + 2048 + h * 128 + 8 * pc); } \
            else { g0[sl] = *(const u32x4*)(Kg + r_ * 1024 + h * 128 + 8 * pc); const size_t ch_ = ((size_t)(b * 512 + c_) * 8 + h); \
                if (tid < 288) g1[sl] = *(const u32x4*)(Amg + ch_ * 256 + (tid - 256) * 8); else if (tid < 320) g1[sl] = *(const u32x4*)(Decg + ch_ * 128 + (tid - 288) * 4); } } while (0)
#define GLA_STORE(cc, sl) do { LAS unsigned char* bb_ = lds + ((cc) & 1) * BUFB; \
            if (tid < 256) { *(LAS u32x4*)(bb_ + QOFF + lt * 272 + 16 * pc) = g0[sl]; *(LAS u32x4*)(bb_ + VOFF + lt * 272 + 16 * pc) = g1[sl]; } \
            else { _Pragma("unroll") for (int e = 0; e < 4; ++e) { *(LAS unsigned short*)(bb_ + KTOFF + (8 * pc + 2 * e) * 40 + 2 * lt) = (unsigned short)(g0[sl][e] & 0xffffu); \
                    *(LAS unsigned short*)(bb_ + KTOFF + (8 * pc + 2 * e + 1) * 40 + 2 * lt) = (unsigned short)(g0[sl][e] >> 16); } \
                if (tid < 288) *(LAS u32x4*)(bb_ + AMOFF + (tid - 256) * 16) = g1[sl]; else if (tid < 320) *(LAS u32x4*)(bb_ + DECOFF + (tid - 288) * 16) = g1[sl]; } } while (0)
#pragma unroll
        for (int d = 0; d < PD; ++d) GLA_LOAD(d, d);
        GLA_STORE(0, 0); lds_barrier();
        for (int c0 = 0; c0 < 512; c0 += PD) {
#pragma unroll
          for (int d = 0; d < PD; ++d) {
            const int c = c0 + d;
            if (c + PD < 512) GLA_LOAD(c + PD, d);
            LAS const unsigned char* bb = lds + (c & 1) * BUFB;
            f32x4 Z = (f32x4){0.f, 0.f, 0.f, 0.f};
#pragma unroll
            for (int a = 0; a < 4; ++a) {
                const bf16x4 lo = *(LAS const bf16x4*)(bb + QOFF + n * 272 + (32 * a + 4 * kg) * 2), hi = *(LAS const bf16x4*)(bb + QOFF + n * 272 + (32 * a + 16 + 4 * kg) * 2);
                Z = __builtin_amdgcn_mfma_f32_16x16x32_bf16(cat4(lo, hi), Sb[a], Z, 0, 0, 0);
            }
            bf16x4 vb;
#pragma unroll
            for (int j = 0; j < 4; ++j) vb[j] = *(LAS const short*)(bb + VOFF + (4 * kg + j) * 272 + (16 * w + n) * 2);
            const bf16x8 Vb = cat4(vb, z4);
            const bf16x4 am = *(LAS const bf16x4*)(bb + AMOFF + n * 32 + 8 * kg);
            const f32x4 o = __builtin_amdgcn_mfma_f32_16x16x32_bf16(cat4(am, z4), Vb, Z, 0, 0, 0);
#pragma unroll
            for (int i = 0; i < 8; ++i) {
                const f32x4 d4 = *(LAS const f32x4*)(bb + DECOFF + (16 * i + 4 * kg) * 4);
                const bf16x4 kt = *(LAS const bf16x4*)(bb + KTOFF + (16 * i + n) * 40 + 8 * kg);
                S[i] = __builtin_amdgcn_mfma_f32_16x16x32_bf16(cat4(kt, z4), Vb, S[i] * d4, 0, 0, 0);
            }
#pragma unroll
            for (int a = 0; a < 4; ++a) Sb[a] = cat4(cvt4(S[2 * a]), cvt4(S[2 * a + 1]));
#pragma unroll
            for (int j = 0; j < 4; ++j) Og[(rowbase + (size_t)c * 16 + 4 * kg + j) * 1024 + h * 128 + 16 * w + n] = (bf16_t)f2bf(o[j]);
            if (c + 1 < 512) GLA_STORE(c + 1, (d + 1) % PD);
            lds_barrier();
          }
        }
#undef GLA_LOAD
#undef GLA_STORE
    }
}


template <int SGN>
__device__ __forceinline__ void tri_inv16(LAS const float* Lm, int n, float (&x)[16]) {
    x[0] = (n == 0) ? 1.f : 0.f;
    {
        f32x4 la[12];
#pragma unroll
        for (int t = 1; t <= 4; ++t) la[t - 1] = *(LAS const f32x4*)(Lm + t * 16);
#pragma unroll
        for (int t = 5; t <= 8; ++t) { la[4 + 2 * (t - 5)] = *(LAS const f32x4*)(Lm + t * 16); la[5 + 2 * (t - 5)] = *(LAS const f32x4*)(Lm + t * 16 + 4); }
        __builtin_amdgcn_sched_barrier(0);
#pragma unroll
        for (int t = 1; t <= 8; ++t) { float acc = (n == t) ? 1.f : 0.f;
#pragma unroll
            for (int q = 0; q < (t + 3) / 4; ++q) { const f32x4 l4 = (t <= 4) ? la[t - 1] : la[4 + 2 * (t - 5) + q];
#pragma unroll
                for (int e = 0; e < 4; ++e) if (4 * q + e < t) acc += (float)SGN * l4[e] * x[4 * q + e]; }
            x[t] = acc; }
    }
    __builtin_amdgcn_sched_barrier(0);
    {   f32x4 lb[12];
#pragma unroll
        for (int t = 9; t <= 12; ++t)
#pragma unroll
            for (int q = 0; q < 3; ++q) lb[3 * (t - 9) + q] = *(LAS const f32x4*)(Lm + t * 16 + 4 * q);
        __builtin_amdgcn_sched_barrier(0);
#pragma unroll
        for (int t = 9; t <= 12; ++t) { float acc = (n == t) ? 1.f : 0.f;
#pragma unroll
            for (int q = 0; q < 3; ++q) { const f32x4 l4 = lb[3 * (t - 9) + q];
#pragma unroll
                for (int e = 0; e < 4; ++e) if (4 * q + e < t) acc += (float)SGN * l4[e] * x[4 * q + e]; }
            x[t] = acc; }
    }
    __builtin_amdgcn_sched_barrier(0);
    {   f32x4 lc[12];
#pragma unroll
        for (int t = 13; t <= 15; ++t)
#pragma unroll
            for (int q = 0; q < 4; ++q) lc[4 * (t - 13) + q] = *(LAS const f32x4*)(Lm + t * 16 + 4 * q);
        __builtin_amdgcn_sched_barrier(0);
#pragma unroll
        for (int t = 13; t <= 15; ++t) { float acc = (n == t) ? 1.f : 0.f;
#pragma unroll
            for (int q = 0; q < 4; ++q) { const f32x4 l4 = lc[4 * (t - 13) + q];
#pragma unroll
                for (int e = 0; e < 4; ++e) if (4 * q + e < t) acc += (float)SGN * l4[e] * x[4 * q + e]; }
            x[t] = acc; }
    }
}

constexpr size_t WS_TA = 436 * MiB;
constexpr size_t WS_AMA = 444 * MiB;
constexpr size_t WS_SCA = 452 * MiB;

__device__ __forceinline__ void prep_delta(LAS unsigned char* lds, PPTR p, int j) {
    const int tid = tidx(), w = tid >> 6, lane = tid & 63, n = lane & 15, kg = lane >> 4;
    LAS unsigned char* qs = lds + w * 9984; LAS unsigned char* ks = qs + 4352; LAS float* Lm = (LAS float*)(ks + 4352); LAS float* sc = Lm + 256;
    const bf16_t* P = (const bf16_t*)(p->ws + WS_PROJ);
    bf16_t* Qg = (bf16_t*)(p->ws + WS_R1); bf16_t* Kg = (bf16_t*)(p->ws + WS_KG);
    bf16_t* Tg = (bf16_t*)(p->ws + WS_TA); bf16_t* Amg = (bf16_t*)(p->ws + WS_AMA); float* Scg = (float*)(p->ws + WS_SCA);
    const float* cv = p->in[6] + (size_t)j * 4 * 3072;
    for (int task = bidx() * 8 + w; task < 4 * 512 * 8; task += gdim() * 8) {
        const int h = task & 7, rc = task >> 3; const size_t row0 = (size_t)rc * 16; const int t0 = (rc & 511) * 16;
        float cwq[4][2], cwk[4][2];
#pragma unroll
        for (int jj = 0; jj < 4; ++jj) { cwq[jj][0] = cv[jj * 3072 + h * 128 + 2 * lane]; cwq[jj][1] = cv[jj * 3072 + h * 128 + 2 * lane + 1];
            cwk[jj][0] = cv[jj * 3072 + 1024 + h * 128 + 2 * lane]; cwk[jj][1] = cv[jj * 3072 + 1024 + h * 128 + 2 * lane + 1]; }
        unsigned xq[19], xk[19];
#pragma unroll
        for (int r = 0; r < 19; ++r) { const bool valid = (t0 + r - 3) >= 0; const bf16_t* rowp = P + (row0 + (valid ? r - 3 : 0)) * 4352 + h * 128 + 2 * lane;
            const unsigned vq = *(const unsigned*)rowp, vk = *(const unsigned*)(rowp + 1024); xq[r] = valid ? vq : 0u; xk[r] = valid ? vk : 0u; }
        float beta, G;
        { const bf16_t* rowp = P + (row0 + n) * 4352; const float a_raw = bf2f(rowp[4096 + h]), b_raw = bf2f(rowp[4104 + h]);
          beta = sigmoidf_(b_raw); G = -__expf(p->in[7][j * 8 + h]) * softplusf_(a_raw + p->in[8][j * 8 + h]);
          float tq; tq = __int_as_float(__builtin_amdgcn_update_dpp(0, __float_as_int(G), 0x111, 0xf, 0xf, true)); G += tq;
          tq = __int_as_float(__builtin_amdgcn_update_dpp(0, __float_as_int(G), 0x112, 0xf, 0xf, true)); G += tq;
          tq = __int_as_float(__builtin_amdgcn_update_dpp(0, __float_as_int(G), 0x114, 0xf, 0xf, true)); G += tq;
          tq = __int_as_float(__builtin_amdgcn_update_dpp(0, __float_as_int(G), 0x118, 0xf, 0xf, true)); G += tq; }
        const float G15 = __int_as_float(__builtin_amdgcn_readlane(__float_as_int(G), 15));
        if (lane < 16) { sc[lane] = beta; sc[16 + lane] = G;
            float* so = Scg + (size_t)task * 64; so[lane] = beta; so[16 + lane] = __expf(G); so[32 + lane] = __expf(G15 - G); if (lane == 0) so[48] = __expf(G15); }
#pragma unroll
        for (int t = 0; t < 16; ++t) {
            float yq0 = 0.f, yq1 = 0.f, yk0 = 0.f, yk1 = 0.f;
#pragma unroll
            for (int jj = 0; jj < 4; ++jj) { yq0 += cwq[jj][0] * bflo(xq[t + jj]); yq1 += cwq[jj][1] * bfhi(xq[t + jj]); yk0 += cwk[jj][0] * bflo(xk[t + jj]); yk1 += cwk[jj][1] * bfhi(xk[t + jj]); }
            yq0 = siluf_(yq0); yq1 = siluf_(yq1); yk0 = siluf_(yk0); yk1 = siluf_(yk1);
            const float ssq = wave_allsum(yq0 * yq0 + yq1 * yq1), ssk = wave_allsum(yk0 * yk0 + yk1 * yk1);
            const float rq = __builtin_amdgcn_rsqf(ssq + 1e-6f) * 0.08838834764831845f, rk = __builtin_amdgcn_rsqf(ssk + 1e-6f);
            const unsigned qp = pack2(yq0 * rq, yq1 * rq), kp = pack2(yk0 * rk, yk1 * rk);
            *(unsigned*)(Qg + (row0 + t) * 1024 + h * 128 + 2 * lane) = qp; *(unsigned*)(Kg + (row0 + t) * 1024 + h * 128 + 2 * lane) = kp;
            *(LAS unsigned*)(qs + t * 272 + 4 * lane) = qp; *(LAS unsigned*)(ks + t * 272 + 4 * lane) = kp;
        }
        asm volatile("s_waitcnt lgkmcnt(0)" ::: "memory");
        f32x4 akk = (f32x4){0.f, 0.f, 0.f, 0.f}, aqk = akk;
#pragma unroll
        for (int a = 0; a < 4; ++a) {
            const bf16x8 qf = *(LAS const bf16x8*)(qs + n * 272 + (32 * a + 8 * kg) * 2);
            const bf16x8 kf = *(LAS const bf16x8*)(ks + n * 272 + (32 * a + 8 * kg) * 2);
            akk = __builtin_amdgcn_mfma_f32_16x16x32_bf16(kf, kf, akk, 0, 0, 0);
            aqk = __builtin_amdgcn_mfma_f32_16x16x32_bf16(qf, kf, aqk, 0, 0, 0);
        }
        { const float Gn = sc[16 + n]; const f32x4 bt = *(LAS const f32x4*)(sc + 4 * kg), Gt = *(LAS const f32x4*)(sc + 16 + 4 * kg);
#pragma unroll
          for (int jj = 0; jj < 4; ++jj) { const int t = 4 * kg + jj; const float dec = __expf(Gt[jj] - Gn);
              Lm[t * 16 + n] = (n < t) ? bt[jj] * akk[jj] * dec : 0.f;
              Amg[(size_t)task * 256 + t * 16 + n] = (bf16_t)f2bf(n <= t ? aqk[jj] * dec : 0.f); } }
        asm volatile("s_waitcnt lgkmcnt(0)" ::: "memory");
        float x[16];
        tri_inv16<-1>(Lm, n, x);
#pragma unroll
        for (int jj = 0; jj < 4; ++jj) { const float v = (kg == 0) ? x[jj] : (kg == 1 ? x[4 + jj] : (kg == 2 ? x[8 + jj] : x[12 + jj]));
            Tg[(size_t)task * 256 + (4 * kg + jj) * 16 + n] = (bf16_t)f2bf(v); }
        asm volatile("s_waitcnt lgkmcnt(0)" ::: "memory");
    }
}

__device__ __forceinline__ void scan_delta(LAS unsigned char* lds, PPTR p, int j) {
    constexpr int QOFF = 0, KOFF = 4352, KTOFF = 8704, VOFF = 13824, TOFF = 18992, AMOFF = 19504, SCOFF = 20016, BUFB = 20272;
    const int tid = tidx(), w = tid >> 6, lane = tid & 63, n = lane & 15, kg = lane >> 4;
    const bf16_t* P = (const bf16_t*)(p->ws + WS_PROJ);
    bf16_t* Qg = (bf16_t*)(p->ws + WS_R1); const bf16_t* Kg = (const bf16_t*)(p->ws + WS_KG);
    const bf16_t* Tg = (const bf16_t*)(p->ws + WS_TA); const bf16_t* Amg = (const bf16_t*)(p->ws + WS_AMA); const float* Scg = (const float*)(p->ws + WS_SCA);
    const float* cv = p->in[6] + (size_t)j * 4 * 3072;
    const bf16x4 z4 = (bf16x4){0, 0, 0, 0};
    for (int task = bidx(); task < 32; task += gdim()) {
        const int b = task >> 3, h = task & 7; const size_t rowbase = (size_t)b * SEQ;
        float cwv[4];
#pragma unroll
        for (int jj = 0; jj < 4; ++jj) cwv[jj] = cv[jj * 3072 + 2048 + h * 128 + 16 * w + n];
        f32x4 S[8]; bf16x8 Sb[4];
#pragma unroll
        for (int i = 0; i < 8; ++i) S[i] = (f32x4){0.f, 0.f, 0.f, 0.f};
#pragma unroll
        for (int a = 0; a < 4; ++a) Sb[a] = (bf16x8){0, 0, 0, 0, 0, 0, 0, 0};
        const int lt = (tid & 255) >> 4, pc = tid & 15, vr = tid >> 4;
        constexpr int PD = 8;
        u32x4 g0[PD], g1[PD];
#define DL_LOAD(cc, sl) do { const int c_ = (cc); const size_t r_ = rowbase + (size_t)c_ * 16 + lt; const size_t ch_ = ((size_t)(b * 512 + c_) * 8 + h); \
            if (tid < 256) g0[sl] = *(const u32x4*)(Qg + r_ * 1024 + h * 128 + 8 * pc); else g0[sl] = *(const u32x4*)(Kg + r_ * 1024 + h * 128 + 8 * pc); \
            if (tid < 304) { const int tv_ = c_ * 16 + vr - 3; const u32x4 vv_ = *(const u32x4*)(P + (rowbase + (tv_ >= 0 ? tv_ : 0)) * 4352 + 2048 + h * 128 + 8 * pc); g1[sl] = (tv_ >= 0) ? vv_ : (u32x4){0u, 0u, 0u, 0u}; } \
            else if (tid >= 320 && tid < 352) g1[sl] = *(const u32x4*)(Tg + ch_ * 256 + (tid - 320) * 8); \
            else if (tid >= 352 && tid < 384) g1[sl] = *(const u32x4*)(Amg + ch_ * 256 + (tid - 352) * 8); \
            else if (tid >= 384 && tid < 400) g1[sl] = *(const u32x4*)(Scg + ch_ * 64 + (tid - 384) * 4); } while (0)
#define DL_STORE(cc, sl) do { LAS unsigned char* bb_ = lds + ((cc) & 1) * BUFB; \
            if (tid < 256) *(LAS u32x4*)(bb_ + QOFF + lt * 272 + 16 * pc) = g0[sl]; \
            else { *(LAS u32x4*)(bb_ + KOFF + lt * 272 + 16 * pc) = g0[sl]; \
                _Pragma("unroll") for (int e = 0; e < 4; ++e) { *(LAS unsigned short*)(bb_ + KTOFF + (8 * pc + 2 * e) * 40 + 2 * lt) = (unsigned short)(g0[sl][e] & 0xffffu); \
                    *(LAS unsigned short*)(bb_ + KTOFF + (8 * pc + 2 * e + 1) * 40 + 2 * lt) = (unsigned short)(g0[sl][e] >> 16); } } \
            if (tid < 304) *(LAS u32x4*)(bb_ + VOFF + vr * 272 + 16 * pc) = g1[sl]; \
            else if (tid >= 320 && tid < 352) *(LAS u32x4*)(bb_ + TOFF + (tid - 320) * 16) = g1[sl]; \
            else if (tid >= 352 && tid < 384) *(LAS u32x4*)(bb_ + AMOFF + (tid - 352) * 16) = g1[sl]; \
            else if (tid >= 384 && tid < 400) *(LAS u32x4*)(bb_ + SCOFF + (tid - 384) * 16) = g1[sl]; } while (0)
#pragma unroll
        for (int d = 0; d < PD; ++d) DL_LOAD(d, d);
        DL_STORE(0, 0); lds_barrier();
        for (int c0 = 0; c0 < 512; c0 += PD) {
#pragma unroll
          for (int d = 0; d < PD; ++d) {
            const int c = c0 + d;
            if (c + PD < 512) DL_LOAD(c + PD, d);
            LAS const unsigned char* bb = lds + (c & 1) * BUFB;
            float vraw[7];
#pragma unroll
            for (int r = 0; r < 7; ++r) vraw[r] = bf2f(*(LAS const unsigned short*)(bb + VOFF + (4 * kg + r) * 272 + (16 * w + n) * 2));
            f32x4 v4;
#pragma unroll
            for (int jj = 0; jj < 4; ++jj) v4[jj] = siluf_(cwv[0] * vraw[jj] + cwv[1] * vraw[jj + 1] + cwv[2] * vraw[jj + 2] + cwv[3] * vraw[jj + 3]);
            f32x4 X = (f32x4){0.f, 0.f, 0.f, 0.f}, Z = X;
#pragma unroll
            for (int a = 0; a < 4; ++a) {
                const bf16x4 klo = *(LAS const bf16x4*)(bb + KOFF + n * 272 + (32 * a + 4 * kg) * 2), khi = *(LAS const bf16x4*)(bb + KOFF + n * 272 + (32 * a + 16 + 4 * kg) * 2);
                X = __builtin_amdgcn_mfma_f32_16x16x32_bf16(cat4(klo, khi), Sb[a], X, 0, 0, 0);
                const bf16x4 qlo = *(LAS const bf16x4*)(bb + QOFF + n * 272 + (32 * a + 4 * kg) * 2), qhi = *(LAS const bf16x4*)(bb + QOFF + n * 272 + (32 * a + 16 + 4 * kg) * 2);
                Z = __builtin_amdgcn_mfma_f32_16x16x32_bf16(cat4(qlo, qhi), Sb[a], Z, 0, 0, 0);
            }
            const f32x4 be4 = *(LAS const f32x4*)(bb + SCOFF + (4 * kg) * 4), eg4 = *(LAS const f32x4*)(bb + SCOFF + (16 + 4 * kg) * 4), egl4 = *(LAS const f32x4*)(bb + SCOFF + (32 + 4 * kg) * 4);
            const float glast = *(LAS const float*)(bb + SCOFF + 48 * 4);
            const f32x4 R = be4 * (v4 - eg4 * X);
            const bf16x4 tf = *(LAS const bf16x4*)(bb + TOFF + n * 32 + 8 * kg);
            const f32x4 vnew = __builtin_amdgcn_mfma_f32_16x16x32_bf16(cat4(tf, z4), cat4(cvt4(R), z4), (f32x4){0.f, 0.f, 0.f, 0.f}, 0, 0, 0);
            const bf16x4 am = *(LAS const bf16x4*)(bb + AMOFF + n * 32 + 8 * kg);
            const f32x4 o = __builtin_amdgcn_mfma_f32_16x16x32_bf16(cat4(am, z4), cat4(cvt4(vnew), z4), Z * eg4, 0, 0, 0);
            const bf16x8 B2 = cat4(cvt4(vnew * egl4), z4);
#pragma unroll
            for (int i = 0; i < 8; ++i) {
                const bf16x4 kt = *(LAS const bf16x4*)(bb + KTOFF + (16 * i + n) * 40 + 8 * kg);
                S[i] = __builtin_amdgcn_mfma_f32_16x16x32_bf16(cat4(kt, z4), B2, S[i] * glast, 0, 0, 0);
            }
#pragma unroll
            for (int a = 0; a < 4; ++a) Sb[a] = cat4(cvt4(S[2 * a]), cvt4(S[2 * a + 1]));
#pragma unroll
            for (int jj = 0; jj < 4; ++jj) Qg[(rowbase + (size_t)c * 16 + 4 * kg + jj) * 1024 + h * 128 + 16 * w + n] = (bf16_t)f2bf(o[jj]);
            if (c + 1 < 512) DL_STORE(c + 1, (d + 1) % PD);
            lds_barrier();
          }
        }
#undef DL_LOAD
#undef DL_STORE
    }
}


constexpr size_t WS_GCG = 500 * MiB;
constexpr size_t WS_BNG = 508 * MiB;
__device__ __forceinline__ void prep_rwkv_elem(PPTR p) {
    const int tid = tidx(), w = tid >> 6, lane = tid & 63;
    bf16_t* P = (bf16_t*)(p->ws + WS_PROJC); bf16_t* L2 = (bf16_t*)(p->ws + WS_R1);
    float* GCg = (float*)(p->ws + WS_GCG); float* BNg = (float*)(p->ws + WS_BNG);
    for (int task = bidx() * 8 + w; task < 4 * 512 * 16; task += gdim() * 8) {
        const int h = task & 15, rc = task >> 4; const size_t row0 = (size_t)rc * 16; const int ch = h * 64 + lane;
        const float w0v = p->in[17][ch], a0v = p->in[20][ch], kkc = p->in[25][ch], kac = p->in[26][ch], rkc = p->in[27][ch];
        unsigned xr[16], xk[16], xw[16], xa[16];
#pragma unroll
        for (int t = 0; t < 16; ++t) { const bf16_t* rowp = P + (row0 + t) * 3328 + ch; const bf16_t* l2p = L2 + (row0 + t) * 3072 + ch;
            xr[t] = rowp[0]; xk[t] = rowp[1024]; xw[t] = l2p[0]; xa[t] = l2p[1024]; }
        float lg = 0.f;
#pragma unroll
        for (int t = 0; t < 16; ++t) {
            const float r = bf2f(xr[t]), kraw = bf2f(xk[t]), whi = bf2f(xw[t]), ahi = bf2f(xa[t]);
            const float wv = -softplusf_(-(w0v + whi)) - 0.5f; const float ew = __expf(wv);
            const float lgp = lg; lg -= ew;
            const float ag = sigmoidf_(a0v + ahi);
            const float kkx = kraw * kkc; const float ss = wave_allsum(kkx * kkx); const float kk = kkx * __builtin_amdgcn_rsqf(ss + 1e-6f);
            const float kp = kraw * (1.0f + (ag - 1.0f) * kac);
            const float bonus = wave_allsum(r * kp * rkc);
            const float inv = __expf(-lg);
            bf16_t* rowp = P + (row0 + t) * 3328 + ch; bf16_t* l2p = L2 + (row0 + t) * 3072 + ch;
            rowp[0] = (bf16_t)f2bf(-kk * __expf(lgp)); rowp[1024] = (bf16_t)f2bf(r * __expf(lg));
            l2p[0] = (bf16_t)f2bf(kk * ag * inv); l2p[1024] = (bf16_t)f2bf(kp * inv);
            if (lane == 0) BNg[(row0 + t) * 16 + h] = bonus;
        }
        GCg[(size_t)task * 64 + lane] = __expf(lg);
    }
}

__device__ __forceinline__ void scan_rwkv(LAS unsigned char* lds, PPTR p) {
    constexpr int AH = 0, RH = 2304, BMT = 4608, KMT = 7168, TM = 9728, LAK = 10240, MRB = 10752, MRK = 11264, VV = 11776, GC = 14080, SLOT = 14336;
    constexpr int PRIV = 8 * SLOT, PRIVSZ = 5632;
    const int tid = tidx(), wave = tid >> 6, lane = tid & 63, n = lane & 15, kg = lane >> 4;
    const bf16_t* P = (const bf16_t*)(p->ws + WS_PROJC); const bf16_t* L2 = (const bf16_t*)(p->ws + WS_R1);
    bf16_t* Og = (bf16_t*)(p->ws + WS_OC);
    const int G = gdim(); const int vcu = (G % 8 == 0) ? (int)(bidx() % 8) * (G / 8) + (int)(bidx() / 8) : (int)bidx();
    for (int task = vcu; task < 256; task += G) {
        const int bh = task >> 2, slice = task & 3, b = bh >> 4, h = bh & 15; const size_t rowbase = (size_t)b * SEQ;
        const int pwr = (wave >= 1 && wave <= 3) ? wave - 1 : (wave == 5 ? 3 : -1);
        if (pwr >= 0) {
            const int pw = pwr; const int ch = h * 64 + lane;
            LAS unsigned char* bh = lds + PRIV + pw * PRIVSZ; LAS unsigned char* kh = bh + 2304; LAS float* Lm = (LAS float*)(kh + 2304);
            const float* GCg = (const float*)(p->ws + WS_GCG);
            unsigned xr[16], xk[16], xv[16], xw[16], xa[16]; float gCn;
#define RW_LOAD(cc, T0) do { _Pragma("unroll") for (int t = (T0); t < (T0) + 8; ++t) { const size_t r_ = rowbase + (size_t)(cc) * 16 + t; const bf16_t* rowp = P + r_ * 3328 + ch; const bf16_t* l2p = L2 + r_ * 3072 + ch; \
                xr[t] = rowp[0]; xk[t] = rowp[1024]; xv[t] = rowp[2048]; xw[t] = l2p[0]; xa[t] = l2p[1024]; } \
                if ((T0) == 8) gCn = GCg[((size_t)(b * 512 + (cc)) * 16 + h) * 64 + lane]; } while (0)
            RW_LOAD(pw, 0); RW_LOAD(pw, 8);
            for (int m = -1; m < 128; ++m) {
                const int cc = 4 * (m + 1) + pw;
                if (cc < 512) {
                    LAS unsigned char* sl = lds + (cc & 7) * SLOT;
                    const float gC = gCn; float bhat[16], khat[16];
#pragma unroll
                    for (int t = 0; t < 16; ++t) {
                        bhat[t] = bf2f(xw[t]); khat[t] = bf2f(xa[t]);
                        *(LAS unsigned short*)(sl + AH + t * 144 + 2 * lane) = (unsigned short)xr[t];
                        *(LAS unsigned short*)(sl + RH + t * 144 + 2 * lane) = (unsigned short)xk[t];
                        *(LAS unsigned short*)(bh + t * 144 + 2 * lane) = (unsigned short)xw[t];
                        *(LAS unsigned short*)(kh + t * 144 + 2 * lane) = (unsigned short)xa[t];
                        *(LAS unsigned short*)(sl + VV + t * 144 + 2 * lane) = (unsigned short)xv[t];
                    }
                    if (cc + 4 < 512) { RW_LOAD(cc + 4, 0); RW_LOAD(cc + 4, 8); }
                    *(LAS float*)(sl + GC + 4 * lane) = gC;
#pragma unroll
                    for (int q = 0; q < 4; ++q) {
                        u32x2 wb, wk; wb.x = pack2(bhat[4 * q] * gC, bhat[4 * q + 1] * gC); wb.y = pack2(bhat[4 * q + 2] * gC, bhat[4 * q + 3] * gC);
                        wk.x = pack2(khat[4 * q] * gC, khat[4 * q + 1] * gC); wk.y = pack2(khat[4 * q + 2] * gC, khat[4 * q + 3] * gC);
                        *(LAS u32x2*)(sl + BMT + lane * 40 + 8 * q) = wb; *(LAS u32x2*)(sl + KMT + lane * 40 + 8 * q) = wk;
                    }
                    asm volatile("s_waitcnt lgkmcnt(0)" ::: "memory");
                    f32x4 lab = (f32x4){0.f, 0.f, 0.f, 0.f}, lak = lab, mrb = lab, mrk = lab;
#pragma unroll
                    for (int a = 0; a < 2; ++a) {
                        const bf16x8 af = *(LAS const bf16x8*)(sl + AH + n * 144 + (32 * a + 8 * kg) * 2), rf = *(LAS const bf16x8*)(sl + RH + n * 144 + (32 * a + 8 * kg) * 2);
                        const bf16x8 bf_ = *(LAS const bf16x8*)(bh + n * 144 + (32 * a + 8 * kg) * 2), kf = *(LAS const bf16x8*)(kh + n * 144 + (32 * a + 8 * kg) * 2);
                        lab = __builtin_amdgcn_mfma_f32_16x16x32_bf16(af, bf_, lab, 0, 0, 0); lak = __builtin_amdgcn_mfma_f32_16x16x32_bf16(af, kf, lak, 0, 0, 0);
                        mrb = __builtin_amdgcn_mfma_f32_16x16x32_bf16(rf, bf_, mrb, 0, 0, 0); mrk = __builtin_amdgcn_mfma_f32_16x16x32_bf16(rf, kf, mrk, 0, 0, 0);
                    }
#pragma unroll
                    for (int jj = 0; jj < 4; ++jj) { const int t = 4 * kg + jj;
                        Lm[t * 16 + n] = (n < t) ? lab[jj] : 0.f;
                        *(LAS unsigned short*)(sl + LAK + t * 32 + 2 * n) = (unsigned short)f2bf(n < t ? lak[jj] : 0.f);
                        *(LAS unsigned short*)(sl + MRB + t * 32 + 2 * n) = (unsigned short)f2bf(n <= t ? mrb[jj] : 0.f);
                        *(LAS unsigned short*)(sl + MRK + t * 32 + 2 * n) = (unsigned short)f2bf(n <= t ? mrk[jj] : 0.f); }
                    asm volatile("s_waitcnt lgkmcnt(0)" ::: "memory");
                    float x[16];
                    tri_inv16<1>(Lm, n, x);
#pragma unroll
                    for (int jj = 0; jj < 4; ++jj) { const float v = (kg == 0) ? x[jj] : (kg == 1 ? x[4 + jj] : (kg == 2 ? x[8 + jj] : x[12 + jj]));
                        *(LAS unsigned short*)(sl + TM + (4 * kg + jj) * 32 + 2 * n) = (unsigned short)f2bf(v); }
                }
                lds_barrier();
            }
#undef RW_LOAD
        } else if (wave != 0) {
            for (int m = -1; m < 128; ++m) lds_barrier();
        } else {
            const int w = slice;
            f32x4 Zt[4]; bf16x8 Zb[2];
#pragma unroll
            for (int i = 0; i < 4; ++i) Zt[i] = (f32x4){0.f, 0.f, 0.f, 0.f};
            Zb[0] = (bf16x8){0, 0, 0, 0, 0, 0, 0, 0}; Zb[1] = Zb[0];
            struct RwOps { bf16x4 alo[2], ahi[2], rlo[2], rhi[2], vf, lakf, tf, mb, mk, bt[4], kt[4]; f32x4 g4[4]; };
#define RW_OPLOAD(R, cidx) do { LAS const unsigned char* sl_ = lds + ((cidx) & 7) * SLOT; \
                _Pragma("unroll") for (int a = 0; a < 2; ++a) { \
                    R.alo[a] = *(LAS const bf16x4*)(sl_ + AH + n * 144 + (32 * a + 4 * kg) * 2); R.ahi[a] = *(LAS const bf16x4*)(sl_ + AH + n * 144 + (32 * a + 16 + 4 * kg) * 2); \
                    R.rlo[a] = *(LAS const bf16x4*)(sl_ + RH + n * 144 + (32 * a + 4 * kg) * 2); R.rhi[a] = *(LAS const bf16x4*)(sl_ + RH + n * 144 + (32 * a + 16 + 4 * kg) * 2); } \
                _Pragma("unroll") for (int jj = 0; jj < 4; ++jj) R.vf[jj] = *(LAS const short*)(sl_ + VV + (4 * kg + jj) * 144 + (16 * w + n) * 2); \
                R.lakf = *(LAS const bf16x4*)(sl_ + LAK + n * 32 + 8 * kg); R.tf = *(LAS const bf16x4*)(sl_ + TM + n * 32 + 8 * kg); \
                R.mb = *(LAS const bf16x4*)(sl_ + MRB + n * 32 + 8 * kg); R.mk = *(LAS const bf16x4*)(sl_ + MRK + n * 32 + 8 * kg); \
                _Pragma("unroll") for (int i = 0; i < 4; ++i) { R.g4[i] = *(LAS const f32x4*)(sl_ + GC + (16 * i + 4 * kg) * 4); \
                    R.bt[i] = *(LAS const bf16x4*)(sl_ + BMT + (16 * i + n) * 40 + 8 * kg); R.kt[i] = *(LAS const bf16x4*)(sl_ + KMT + (16 * i + n) * 40 + 8 * kg); } } while (0)
#define RW_COMPUTE(R, cidx) do { \
                f32x4 P1 = (f32x4){0.f, 0.f, 0.f, 0.f}, Oa = P1; \
                _Pragma("unroll") for (int a = 0; a < 2; ++a) { P1 = __builtin_amdgcn_mfma_f32_16x16x32_bf16(cat4(R.alo[a], R.ahi[a]), Zb[a], P1, 0, 0, 0); \
                    Oa = __builtin_amdgcn_mfma_f32_16x16x32_bf16(cat4(R.rlo[a], R.rhi[a]), Zb[a], Oa, 0, 0, 0); } \
                P1 = __builtin_amdgcn_mfma_f32_16x16x32_bf16(cat4(R.lakf, z4), cat4(R.vf, z4), P1, 0, 0, 0); \
                const f32x4 Y = __builtin_amdgcn_mfma_f32_16x16x32_bf16(cat4(R.tf, z4), cat4(cvt4(P1), z4), (f32x4){0.f, 0.f, 0.f, 0.f}, 0, 0, 0); \
                const bf16x8 Byv = cat4(cvt4(Y), R.vf); \
                Oa = __builtin_amdgcn_mfma_f32_16x16x32_bf16(cat4(R.mb, R.mk), Byv, Oa, 0, 0, 0); \
                _Pragma("unroll") for (int i = 0; i < 4; ++i) Zt[i] = __builtin_amdgcn_mfma_f32_16x16x32_bf16(cat4(R.bt[i], R.kt[i]), Byv, Zt[i] * R.g4[i], 0, 0, 0); \
                Zb[0] = cat4(cvt4(Zt[0]), cvt4(Zt[1])); Zb[1] = cat4(cvt4(Zt[2]), cvt4(Zt[3])); \
                _Pragma("unroll") for (int jj = 0; jj < 4; ++jj) Og[(rowbase + (size_t)(cidx) * 16 + 4 * kg + jj) * 1024 + h * 64 + 16 * w + n] = (bf16_t)f2bf(Oa[jj]); } while (0)
            const bf16x4 z4 = (bf16x4){0, 0, 0, 0};
            lds_barrier();
            for (int m = 0; m < 128; ++m) {
                RwOps OA, OB;
                RW_OPLOAD(OA, 4 * m);
                RW_OPLOAD(OB, 4 * m + 1); __builtin_amdgcn_sched_barrier(0);
                RW_COMPUTE(OA, 4 * m); __builtin_amdgcn_sched_barrier(0);
                RW_OPLOAD(OA, 4 * m + 2); __builtin_amdgcn_sched_barrier(0);
                RW_COMPUTE(OB, 4 * m + 1); __builtin_amdgcn_sched_barrier(0);
                RW_OPLOAD(OB, 4 * m + 3); __builtin_amdgcn_sched_barrier(0);
                RW_COMPUTE(OA, 4 * m + 2); __builtin_amdgcn_sched_barrier(0);
                RW_COMPUTE(OB, 4 * m + 3);
                lds_barrier();
            }
#undef RW_OPLOAD
#undef RW_COMPUTE
        }
    }
}


template <int KIND>
__device__ __forceinline__ void scan_chunked(LAS unsigned char* lds, PPTR p, int j) {
    constexpr int QOFF = 0, KOFF = 4352, KTOFF = 8704, VOFF = 13824, TOFF = 14464, AMOFF = 14976, SCOFF = 15488, OBOFF = 16000, BUFB = 17024;
    constexpr int LDP = (KIND == 0) ? 4352 : 4096;
    constexpr int VROWS = (KIND == 0) ? 19 : 16, VEND = 512 + 2 * VROWS;
    constexpr int TEND = (KIND == 0) ? VEND + 32 : VEND, AEND = TEND + 32, SEND = AEND + ((KIND == 0) ? 16 : 32);
    const int tid = tidx(), wave = tid >> 6, lane = tid & 63, n = lane & 15, kg = lane >> 4;
    const bf16_t* P = (const bf16_t*)(p->ws + WS_PROJ);
    const bf16_t* Qg = (const bf16_t*)(p->ws + WS_R1); const bf16_t* Kg = (const bf16_t*)(p->ws + WS_KG);
    const bf16_t* Tg = (const bf16_t*)(p->ws + WS_TA);
    const bf16_t* Amg = (const bf16_t*)(p->ws + (KIND == 0 ? WS_AMA : WS_AM));
    const float* Scg = (const float*)(p->ws + (KIND == 0 ? WS_SCA : WS_DEC));
    bf16_t* Og = (KIND == 0) ? (bf16_t*)(p->ws + WS_PROJ) : (bf16_t*)(p->ws + WS_OC);
    constexpr int LDO = (KIND == 0) ? 4352 : 1024;
    const bf16x4 z4 = (bf16x4){0, 0, 0, 0};
    const int G = gdim(); const int vcu = (G % 8 == 0) ? (int)(bidx() % 8) * (G / 8) + (int)(bidx() / 8) : (int)bidx();
    for (int task = vcu; task < 256; task += G) {
        const int bh = task >> 3, w = task & 7, b = bh >> 3, h = bh & 7; const size_t rowbase = (size_t)b * SEQ;
        if (wave == 0) {
            float cwv[4] = {0.f, 0.f, 0.f, 0.f};
            if (KIND == 0) { const float* cv = p->in[6] + (size_t)j * 4 * 3072;
#pragma unroll
                for (int jj = 0; jj < 4; ++jj) cwv[jj] = cv[jj * 3072 + 2048 + h * 128 + 16 * w + n]; }
            f32x4 S[8]; bf16x8 Sb[4];
#pragma unroll
            for (int i = 0; i < 8; ++i) S[i] = (f32x4){0.f, 0.f, 0.f, 0.f};
#pragma unroll
            for (int a = 0; a < 4; ++a) Sb[a] = (bf16x8){0, 0, 0, 0, 0, 0, 0, 0};
            lds_barrier();
            for (int c2 = 0; c2 < 512; c2 += 4) {
#pragma unroll 1
              for (int u = 0; u < 4; ++u) { const int c = c2 + u;
                LAS unsigned char* bb = lds + (c & 7) * BUFB;
                bf16x4 klo[4], khi[4], qlo[4], qhi[4], kt[8], am, tf = z4; f32x4 be4, eg4, egl4, d4[8]; float glast = 0.f; unsigned vr16[7]; bf16x4 vb = z4;
#pragma unroll
                for (int a = 0; a < 4; ++a) {
                    if (KIND == 0) { klo[a] = *(LAS const bf16x4*)(bb + KOFF + n * 272 + (32 * a + 4 * kg) * 2); khi[a] = *(LAS const bf16x4*)(bb + KOFF + n * 272 + (32 * a + 16 + 4 * kg) * 2); }
                    qlo[a] = *(LAS const bf16x4*)(bb + QOFF + n * 272 + (32 * a + 4 * kg) * 2); qhi[a] = *(LAS const bf16x4*)(bb + QOFF + n * 272 + (32 * a + 16 + 4 * kg) * 2); }
                if (KIND == 0) {
#pragma unroll
                    for (int r = 0; r < 7; ++r) vr16[r] = *(LAS const unsigned short*)(bb + VOFF + (4 * kg + r) * 32 + 2 * n);
                    be4 = *(LAS const f32x4*)(bb + SCOFF + (4 * kg) * 4); eg4 = *(LAS const f32x4*)(bb + SCOFF + (16 + 4 * kg) * 4); egl4 = *(LAS const f32x4*)(bb + SCOFF + (32 + 4 * kg) * 4);
                    glast = *(LAS const float*)(bb + SCOFF + 48 * 4); tf = *(LAS const bf16x4*)(bb + TOFF + n * 32 + 8 * kg);
                } else {
#pragma unroll
                    for (int jj = 0; jj < 4; ++jj) vb[jj] = *(LAS const short*)(bb + VOFF + (4 * kg + jj) * 32 + 2 * n);
#pragma unroll
                    for (int i = 0; i < 8; ++i) d4[i] = *(LAS const f32x4*)(bb + SCOFF + (16 * i + 4 * kg) * 4);
                }
                am = *(LAS const bf16x4*)(bb + AMOFF + n * 32 + 8 * kg);
#pragma unroll
                for (int i = 0; i < 8; ++i) kt[i] = *(LAS const bf16x4*)(bb + KTOFF + (16 * i + n) * 40 + 8 * kg);
                __builtin_amdgcn_sched_barrier(0);
                asm volatile("s_waitcnt lgkmcnt(0)" ::: "memory");
                __builtin_amdgcn_sched_barrier(0);
                f32x4 v4 = (f32x4){0.f, 0.f, 0.f, 0.f};
                if (KIND == 0) {
#pragma unroll
                    for (int jj = 0; jj < 4; ++jj) v4[jj] = siluf_(cwv[0] * bf2f(vr16[jj]) + cwv[1] * bf2f(vr16[jj + 1]) + cwv[2] * bf2f(vr16[jj + 2]) + cwv[3] * bf2f(vr16[jj + 3]));
                }
                f32x4 X = (f32x4){0.f, 0.f, 0.f, 0.f}, Z = X;
#pragma unroll
                for (int a = 0; a < 4; ++a) {
                    if (KIND == 0) X = __builtin_amdgcn_mfma_f32_16x16x32_bf16(cat4(klo[a], khi[a]), Sb[a], X, 0, 0, 0);
                    Z = __builtin_amdgcn_mfma_f32_16x16x32_bf16(cat4(qlo[a], qhi[a]), Sb[a], Z, 0, 0, 0);
                }
                f32x4 o; bf16x8 B2;
                if (KIND == 0) {
                    const f32x4 R = be4 * (v4 - eg4 * X);
                    const f32x4 vnew = __builtin_amdgcn_mfma_f32_16x16x32_bf16(cat4(tf, z4), cat4(cvt4(R), z4), (f32x4){0.f, 0.f, 0.f, 0.f}, 0, 0, 0);
                    o = __builtin_amdgcn_mfma_f32_16x16x32_bf16(cat4(am, z4), cat4(cvt4(vnew), z4), Z * eg4, 0, 0, 0);
                    B2 = cat4(cvt4(vnew * egl4), z4);
#pragma unroll
                    for (int i = 0; i < 8; ++i) S[i] = __builtin_amdgcn_mfma_f32_16x16x32_bf16(cat4(kt[i], z4), B2, S[i] * glast, 0, 0, 0);
                } else {
                    B2 = cat4(vb, z4);
                    o = __builtin_amdgcn_mfma_f32_16x16x32_bf16(cat4(am, z4), B2, Z, 0, 0, 0);
#pragma unroll
                    for (int i = 0; i < 8; ++i) S[i] = __builtin_amdgcn_mfma_f32_16x16x32_bf16(cat4(kt[i], z4), B2, S[i] * d4[i], 0, 0, 0);
                }
                *(LAS f32x4*)(bb + OBOFF + lane * 16) = o;
#pragma unroll
                for (int a = 0; a < 4; ++a) Sb[a] = cat4(cvt4(S[2 * a]), cvt4(S[2 * a + 1]));
              }
                lds_barrier();
            }
            lds_barrier();
        } else {
            const int lt = tid - 64, pb = lt + 448;
            const int arow = (lt & 255) >> 4, apc = lt & 15;
            const bf16_t* srcA = (lt < 256 ? Qg : Kg) + (rowbase + arow) * 1024 + h * 128 + 8 * apc;
            const char* srcB; size_t strideB; int kindB;
            if (pb < 512) { kindB = 0; srcB = (const char*)(Kg + (rowbase + ((pb - 256) >> 4)) * 1024 + h * 128 + 8 * (pb & 15)); strideB = (size_t)16 * 1024 * 2; }
            else if (pb < VEND) { kindB = 1; const int vr_ = (pb - 512) >> 1, hf_ = (pb - 512) & 1; srcB = (const char*)(P + (rowbase + vr_) * LDP + 2048 + h * 128 + 16 * w + 8 * hf_); strideB = (size_t)16 * LDP * 2; }
            else if (pb < TEND) { kindB = 2; srcB = (const char*)(Tg + ((size_t)(b * 512) * 8 + h) * 256 + (pb - VEND) * 8); strideB = (size_t)8 * 256 * 2; }
            else if (pb < AEND) { kindB = 3; srcB = (const char*)(Amg + ((size_t)(b * 512) * 8 + h) * 256 + (pb - TEND) * 8); strideB = (size_t)8 * 256 * 2; }
            else if (pb < SEND) { kindB = 4; srcB = (const char*)(Scg + ((size_t)(b * 512) * 8 + h) * (KIND == 0 ? 64 : 128) + (pb - AEND) * 4); strideB = (size_t)8 * (KIND == 0 ? 64 : 128) * 4; }
            else { kindB = 5; srcB = (const char*)srcA; strideB = (size_t)16 * 1024 * 2; }
            const int vrow = (pb - 512) >> 1;
            const bool doflush = (wave == 2);
            constexpr int PD = 8;
            u32x4 g0[PD], g1[PD];
#define SC_LOAD(cc, sl) do { const int c_ = (cc); g0[sl] = *(const u32x4*)(srcA + (size_t)c_ * 16 * 1024); \
                const int tv_ = c_ * 16 + vrow - 3; const bool vh_ = (KIND == 0) && (kindB == 1); \
                const ptrdiff_t ofs_ = vh_ ? (ptrdiff_t)(tv_ >= 0 ? tv_ - vrow : -vrow) * (LDP * 2) : (ptrdiff_t)((size_t)c_ * strideB); \
                const u32x4 vv_ = *(const u32x4*)(srcB + ofs_); g1[sl] = (vh_ && tv_ < 0) ? (u32x4){0u, 0u, 0u, 0u} : vv_; } while (0)
#define SC_KSTORE(bb_, reg, row, pc) do { if (KIND == 0) *(LAS u32x4*)((bb_) + KOFF + (row) * 272 + 16 * (pc)) = (reg); \
                _Pragma("unroll") for (int e = 0; e < 4; ++e) { *(LAS unsigned short*)((bb_) + KTOFF + (8 * (pc) + 2 * e) * 40 + 2 * (row)) = (unsigned short)((reg)[e] & 0xffffu); \
                    *(LAS unsigned short*)((bb_) + KTOFF + (8 * (pc) + 2 * e + 1) * 40 + 2 * (row)) = (unsigned short)((reg)[e] >> 16); } } while (0)
#define SC_STORE(cc, sl) do { LAS unsigned char* bb_ = lds + ((cc) & 7) * BUFB; \
                if (lt < 256) *(LAS u32x4*)(bb_ + QOFF + arow * 272 + 16 * apc) = g0[sl]; else SC_KSTORE(bb_, g0[sl], arow, apc); \
                if (kindB == 0) SC_KSTORE(bb_, g1[sl], ((pb - 256) >> 4), (pb & 15)); \
                else if (kindB == 1) *(LAS u32x4*)(bb_ + VOFF + vrow * 32 + 16 * ((pb - 512) & 1)) = g1[sl]; \
                else if (kindB == 2) *(LAS u32x4*)(bb_ + TOFF + (pb - VEND) * 16) = g1[sl]; \
                else if (kindB == 3) *(LAS u32x4*)(bb_ + AMOFF + (pb - TEND) * 16) = g1[sl]; \
                else if (kindB == 4) *(LAS u32x4*)(bb_ + SCOFF + (pb - AEND) * 16) = g1[sl]; } while (0)
#define SC_OFLUSH(cc) do { const int c_ = (cc); const f32x4 o_ = *(LAS const f32x4*)(lds + (c_ & 7) * BUFB + OBOFF + lane * 16); \
                _Pragma("unroll") for (int jj = 0; jj < 4; ++jj) Og[(rowbase + (size_t)c_ * 16 + 4 * kg + jj) * LDO + h * 128 + 16 * w + n] = (bf16_t)f2bf(o_[jj]); } while (0)
#define SC_LOADER_LOOP(FLUSH) do { \
                _Pragma("unroll") for (int d = 0; d < PD; ++d) SC_LOAD(d, d); \
                SC_STORE(0, 0); SC_STORE(1, 1); SC_STORE(2, 2); SC_STORE(3, 3); \
                SC_LOAD(8, 0); SC_LOAD(9, 1); SC_LOAD(10, 2); SC_LOAD(11, 3); \
                lds_barrier(); \
                for (int c0 = 0; c0 < 512; c0 += PD) { \
                    _Pragma("unroll") for (int d = 0; d < PD; d += 4) { const int c = c0 + d; \
                        if (c + 4 < 512) { _Pragma("unroll") for (int u = 0; u < 4; ++u) SC_STORE(c + 4 + u, (d + 4 + u) % PD); } \
                        if (c + 12 < 512) { _Pragma("unroll") for (int u = 0; u < 4; ++u) SC_LOAD(c + 12 + u, (d + 4 + u) % PD); } \
                        if (FLUSH) { if (c > 0) { _Pragma("unroll") for (int u = 0; u < 4; ++u) SC_OFLUSH(c - 4 + u); } } \
                        lds_barrier(); } } \
                if (FLUSH) { _Pragma("unroll") for (int u = 0; u < 4; ++u) SC_OFLUSH(508 + u); } \
                lds_barrier(); } while (0)
            if (doflush) SC_LOADER_LOOP(true); else SC_LOADER_LOOP(false);
#undef SC_LOAD
#undef SC_KSTORE
#undef SC_STORE
#undef SC_OFLUSH
#undef SC_LOADER_LOOP
        }
    }
}

template <int KIND>
__device__ __forceinline__ void post_phase(PPTR p, int j) {
    const int lane = tidx() & 63, wave = tidx() >> 6;
    const int gw = bidx() * 8 + wave, nw = gdim() * 8;
    bf16_t* O = (bf16_t*)(p->ws + (KIND != 0 ? WS_OC : WS_PROJ));
    constexpr int LDO = (KIND == 0) ? 4352 : 1024;
    const bf16_t* P = (const bf16_t*)(p->ws + (KIND == 2 ? WS_PROJC : WS_PROJ));
    if (KIND != 2) {
        const float* nwp = (KIND == 0) ? p->in[9] + j * 128 : p->in[13];
        const float n0 = nwp[2 * lane], n1 = nwp[2 * lane + 1];
        constexpr int LDP = (KIND == 0) ? 4352 : 4096; constexpr int ZOFF = 3072;
        for (int row = gw; row < MROWS; row += nw) {
            unsigned ov[8], zv[8];
#pragma unroll
            for (int h = 0; h < 8; ++h) { ov[h] = *(const unsigned*)(O + (size_t)row * LDO + h * 128 + 2 * lane); zv[h] = *(const unsigned*)(P + (size_t)row * LDP + ZOFF + h * 128 + 2 * lane); }
#pragma unroll
            for (int h = 0; h < 8; ++h) {
                const float o0 = bflo(ov[h]), o1 = bfhi(ov[h]);
                const float ss = wave_allsum(o0 * o0 + o1 * o1); const float rstd = __builtin_amdgcn_rsqf(ss * (1.0f / 128.0f) + 1e-6f);
                *(unsigned*)(O + (size_t)row * LDO + h * 128 + 2 * lane) = pack2(o0 * rstd * n0 * siluf_(bflo(zv[h])), o1 * rstd * n1 * siluf_(bfhi(zv[h])));
            }
        }
    } else {
        const bf16_t* L2 = (const bf16_t*)(p->ws + WS_R1); const float* BNg = (const float*)(p->ws + WS_BNG);
        for (int task = gw; task < MROWS * 2; task += nw) {
            const int row = task >> 1, h0 = (task & 1) * 8;
            unsigned xy[8], xv[8], xg[8]; float bn[8];
#pragma unroll
            for (int hh = 0; hh < 8; ++hh) { const int ch = (h0 + hh) * 64 + lane; const bf16_t* rowp = P + (size_t)row * 3328; const bf16_t* l2p = L2 + (size_t)row * 3072;
                xy[hh] = O[(size_t)row * DM + ch]; xv[hh] = rowp[2048 + ch]; xg[hh] = l2p[2048 + ch]; bn[hh] = BNg[(size_t)row * 16 + h0 + hh]; }
#pragma unroll
            for (int hh = 0; hh < 8; ++hh) { const int ch = (h0 + hh) * 64 + lane;
                const float y = bf2f(xy[hh]);
                const float mean = wave_allsum(y) * (1.0f / 64.0f); const float dd = y - mean;
                const float var = wave_allsum(dd * dd) * (1.0f / 64.0f);
                const float gn = dd * __builtin_amdgcn_rsqf(var + 0.04096f) * p->in[28][ch] + p->in[29][ch];
                O[(size_t)row * DM + ch] = (bf16_t)f2bf((gn + bn[hh] * bf2f(xv[hh])) * bf2f(xg[hh]));
            }
        }
    }
}

#define XB_TMO      128
#define XB_XCNT(j)  (256  + 64 * (j))
#define XB_XSUB(j)  (1280 + 64 * (j))
#define XB_XGEN(j)  (2304 + 64 * (j))
#define XB_TOP      3328
#define XB_TOPGEN   3392
#define XCD_BAR_WORDS 3456
#define XB_SPIN_CAP (1u << 18)
constexpr size_t WS_BAR = WS_MISC + 1 * MiB;
__device__ __forceinline__ unsigned xb_ld(unsigned* p)              { return __hip_atomic_load(p, __ATOMIC_RELAXED, __HIP_MEMORY_SCOPE_AGENT); }
__device__ __forceinline__ unsigned xb_add(unsigned* p, unsigned v) { return __hip_atomic_fetch_add(p, v, __ATOMIC_RELAXED, __HIP_MEMORY_SCOPE_AGENT); }
__device__ __forceinline__ unsigned xb_xcc_id() { return (unsigned)__builtin_amdgcn_s_getreg((3 << 11) | 20) & 0xFu; }
#define XB_SPIN(cond, bar) do { unsigned _sp = 0; while (cond) { __builtin_amdgcn_s_sleep(1); \
    if ((++_sp & 255u) == 0u) { if (xb_ld(&(bar)[XB_TMO])) break; if (_sp > XB_SPIN_CAP) { atomicAdd(&(bar)[XB_TMO], 1u); break; } } } } while (0)
struct XcdBarrier { unsigned* bar; unsigned x; volatile LAS unsigned* st; };
__device__ __forceinline__ XcdBarrier xcd_barrier_post(unsigned* bar, volatile LAS unsigned* st) {
    XcdBarrier b; b.bar = bar; b.x = xb_xcc_id(); b.st = st;
    if (threadIdx.x == 0) (void)xb_add(&bar[XB_XCNT(b.x)], 1u);
    return b;
}
__device__ __forceinline__ void xcd_barrier_complete(unsigned* bar, unsigned x, unsigned& nloc, unsigned& nx) {
    const unsigned G = gridDim.x * gridDim.y * gridDim.z;
    unsigned sum, cnt, mine, sp = 0u;
    for (;;) {
        sum = 0u; cnt = 0u; mine = 0u;
#pragma unroll
        for (unsigned j = 0; j < 16; ++j) { const unsigned c = xb_ld(&bar[XB_XCNT(j)]); sum += c; cnt += (c > 0u) ? 1u : 0u; mine = (j == x) ? c : mine; }
        if (sum == G) break;
        __builtin_amdgcn_s_sleep(1);
        if ((++sp & 255u) == 0u) { if (xb_ld(&bar[XB_TMO])) break; if (sp > XB_SPIN_CAP) { atomicAdd(&bar[XB_TMO], 1u); break; } }
    }
    nloc = mine > 0u ? mine : 1u; nx = cnt > 0u ? cnt : 1u;
}
__device__ __forceinline__ void xcd_barrier(const XcdBarrier& b) {
    asm volatile("s_waitcnt vmcnt(0)" ::: "memory");
    __syncthreads();
    if (threadIdx.x == 0) {
        unsigned* bar = b.bar;
        __builtin_amdgcn_s_waitcnt(0);
        unsigned nloc = b.st[0], nx = b.st[1];
        if (nloc == 0u) { xcd_barrier_complete(bar, b.x, nloc, nx); b.st[0] = nloc; b.st[1] = nx; }
        const unsigned old = xb_add(&bar[XB_XSUB(b.x)], 1u);
        const unsigned gen = old / nloc;
        if (old + 1u == (gen + 1u) * nloc) {
            __builtin_amdgcn_fence(__ATOMIC_RELEASE, "agent");
            asm volatile("s_waitcnt vmcnt(0)" ::: "memory");
            const unsigned og = xb_add(&bar[XB_TOP], 1u);
            const unsigned tg = og / nx;
            if (og + 1u == (tg + 1u) * nx) xb_add(&bar[XB_TOPGEN], 1u);
            else XB_SPIN(xb_ld(&bar[XB_TOPGEN]) == tg, bar);
            __builtin_amdgcn_fence(__ATOMIC_ACQUIRE, "agent");
            xb_add(&bar[XB_XGEN(b.x)], 1u);
            asm volatile("s_waitcnt vmcnt(0)" ::: "memory");
        } else {
            XB_SPIN(xb_ld(&bar[XB_XGEN(b.x)]) == gen, bar);
            __builtin_amdgcn_fence(__ATOMIC_ACQUIRE, "agent");
            asm volatile("s_waitcnt vmcnt(0)" ::: "memory");
        }
    }
    __syncthreads();
}

constexpr int NPH = 54;
__host__ __device__ inline int step_of(int ph) { const int si = (ph - 1) % 13; return si < 3 ? si : (si == 3 ? 12 : si - 1); }
__host__ __device__ inline bool phase_is_noop(int ph) {
    if (ph == 0 || ph == NPH - 1) return false;
    const int l = (ph - 1) / 13, st = step_of(ph);
    return st == 12 && (l % 3) != 2;
}

__global__ void __launch_bounds__(512, 2) mega(const Params pv) {
    extern __shared__ __attribute__((aligned(16))) unsigned char shm[];
    PPTR p = &pv;
    LAS unsigned char* lds = (LAS unsigned char*)shm;
    cg::grid_group grid = cg::this_grid();
    volatile LAS unsigned* xb_st = (volatile LAS unsigned*)(lds + 147440);
    if (threadIdx.x == 0) { xb_st[0] = 0u; xb_st[1] = 0u; }
    __syncthreads();
    const XcdBarrier xb = xcd_barrier_post((unsigned*)(pv.ws + WS_BAR), xb_st);
    const int ph_lo = p->ph_lo, ph_hi = p->ph_hi;
    for (int ph = ph_lo; ph < ph_hi; ++ph) {
        if (phase_is_noop(ph)) continue;
        float* mod = (float*)(p->ws + WS_MISC);
        bf16_t* W = (bf16_t*)(p->ws + WS_W);
        if (ph == 0) { pre_phase(lds, p); __syncthreads(); cvt_layer(lds, p, 0); }
        else if (ph == NPH - 1) { if (PHMASK & 2) final_phase(p->out, p->in[35]); }
        else {
            const int l = (ph - 1) / 13, st = step_of(ph), kind = l % 3, j = l / 3;
            const float* hin = (l == 0) ? p->in[0] : p->out;
            const float* modl = mod + (size_t)l * 4 * 6144;
            bf16_t* R1 = (bf16_t*)(p->ws + WS_R1);
            for (int rep = 0; rep < 1 + (((REPMASK >> st) & 1) & ((REPL >> l) & 1)); ++rep) {
            if (rep) grid.sync();
            if (!(PHMASK & (4 << st))) {} else if (st == 0) {
                if (l > 0) cvt_layer(lds, p, l);
                if (kind == 2) norm_phase<true>(hin, p->in[2] + (size_t)(l * 2 + 0) * 1024, modl, 0, R1, 2048);
                else norm_phase<false>(hin, p->in[2] + (size_t)(l * 2 + 0) * 1024, modl, 0, R1, 1024);
            } else if (st == 12) {
                prep_rwkv_elem(p);
            } else if (st == 2 && kind == 1) {
                prep_gla(lds, p);
            } else if (st == 2 && kind == 0) {
                prep_delta(lds, p, j);
            } else if (st == 1 || st == 2 || st == 7 || st == 9) {
                pg8::EpiBf16S E; E.act = 0; const bf16_t* A; const bf16_t* Bt; int lda, N, K;
                if (st == 1) {
                    A = R1; Bt = W + W_IN / 2;
                    if (kind == 0) { E.O = (bf16_t*)(p->ws + WS_PROJ); E.ldc = 4352; lda = 1024; N = 4352; K = 1024; }
                    else if (kind == 1) { E.O = (bf16_t*)(p->ws + WS_PROJ); E.ldc = 4096; lda = 1024; N = 4096; K = 1024; }
                    else { E.O = (bf16_t*)(p->ws + WS_PROJC); E.ldc = 3328; E.act = 1; lda = 2048; N = 3328; K = 2048; }
                } else if (st == 2) {
                    A = (const bf16_t*)(p->ws + WS_PROJC) + 3072; Bt = W + W_L2 / 2; E.O = R1; E.ldc = 3072; lda = 3328; N = 3072; K = 256;
                } else {
                    const int g = (st == 9);
                    A = R1; Bt = W + W_UP / 2 + (size_t)(g ? 3072 : 0) * 1024; N = g ? 2560 : 3072; E.O = (bf16_t*)(p->ws + WS_HID); E.ldc = N; lda = 1024; K = 1024;
                }
                run_gemm(lds, A, lda, Bt, N, K, E);
            } else if (st == 5 || st == 11) {
                pg8::EpiRes E; const bf16_t* A; const bf16_t* Bt; int lda, K;
                if (st == 5) { E.res = hin; E.out = p->out; E.gate = modl + 2 * 1024; A = (const bf16_t*)(p->ws + (kind != 0 ? WS_OC : WS_PROJ)); lda = (kind == 0) ? 4352 : 1024; Bt = W + W_OUT / 2; K = 1024; }
                else { E.res = p->out; E.out = p->out; E.gate = modl + 5 * 1024; A = (const bf16_t*)(p->ws + WS_ACT); lda = 2816; Bt = W + W_DN / 2; K = 2816; }
                run_gemm(lds, A, lda, Bt, 1024, K, E);
            } else if (st == 3) {
                if (kind == 0) scan_chunked<0>(lds, p, j); else if (kind == 1) scan_chunked<1>(lds, p, j); else scan_rwkv(lds, p);
            } else if (st == 4) {
                if (kind == 0) post_phase<0>(p, j); else if (kind == 1) post_phase<1>(p, j); else post_phase<2>(p, j);
            } else if (st == 6) {
                norm_phase<false>(p->out, p->in[2] + (size_t)(l * 2 + 1) * 1024, modl, 3, R1, 1024);
            } else if (st == 8 || st == 10) {
                const int g = (st == 10);
                convglu_phase((const bf16_t*)(p->ws + WS_HID), (bf16_t*)(p->ws + WS_ACT), g, p->in[32] + (size_t)l * 3 * 5632, p->in[33] + (size_t)l * 5632);
            }
            }
        }
        if (ph + 1 < ph_hi) { if (ph == ph_lo) grid.sync(); else xcd_barrier(xb); }
    }
}

extern "C" void kernel_launch(void* const* d_in, const int* in_sizes, int n_in, void* d_out, int out_size, void* d_ws, size_t ws_size, hipStream_t stream) {
    constexpr int LDS_BYTES = 144 * 1024;
    static int grid_blocks = 0;
    if (!grid_blocks) {
        int dev = 0, cus = 0, per_cu = 0;
        hipGetDevice(&dev);
        hipDeviceGetAttribute(&cus, hipDeviceAttributeMultiprocessorCount, dev);
        if (hipFuncSetAttribute((const void*)mega, hipFuncAttributeMaxDynamicSharedMemorySize, LDS_BYTES) != hipSuccess) fprintf(stderr, "hipFuncSetAttribute failed\n");
        hipOccupancyMaxActiveBlocksPerMultiprocessor(&per_cu, (const void*)mega, 512, LDS_BYTES);
        if (per_cu < 1) per_cu = 1;
        if (per_cu > 1) per_cu = 1;
        grid_blocks = cus * per_cu;
        if (ws_size < 512 * MiB) fprintf(stderr, "workspace too small: %zu\n", ws_size);
    }
    (void)hipMemsetAsync((char*)d_ws + WS_BAR, 0, XCD_BAR_WORDS * sizeof(unsigned), stream);
    Params p{};
    for (int i = 0; i < 36; ++i) p.in[i] = (const float*)d_in[i];
    p.out = (float*)d_out; p.ws = (unsigned char*)d_ws;
#if SINGLE_LAUNCH
    p.ph_lo = 0; p.ph_hi = NPH;
    void* args[] = {&p};
    hipError_t e = hipLaunchCooperativeKernel((const void*)mega, dim3(grid_blocks), dim3(512), args, LDS_BYTES, stream);
    if (e != hipSuccess) fprintf(stderr, "cooperative launch failed: %s (grid %d)\n", hipGetErrorString(e), grid_blocks);
#else
    for (int ph = 0; ph < NPH; ++ph) {
        if (phase_is_noop(ph)) continue;
        p.ph_lo = ph; p.ph_hi = ph + 1;
        hipLaunchKernelGGL(mega, dim3(grid_blocks), dim3(512), LDS_BYTES, stream, p);
    }
#endif
}
```

```cpp
#include <hip/hip_runtime.h>
#include <hip/hip_cooperative_groups.h>
#include <cstdio>
namespace cg = cooperative_groups;

#ifndef PHMASK
#define PHMASK 0xFFFFFF
#endif
#ifndef REPMASK
#define REPMASK 0
#endif
#ifndef REPL
#define REPL 0xF
#endif
#ifndef SINGLE_LAUNCH
#define SINGLE_LAUNCH 1
#endif

#define LAS __attribute__((address_space(3)))
typedef unsigned short bf16_t;
typedef short bf16x8 __attribute__((ext_vector_type(8)));
typedef float f32x4 __attribute__((ext_vector_type(4)));
typedef float f32x2 __attribute__((ext_vector_type(2)));
typedef unsigned u32x4 __attribute__((ext_vector_type(4)));
typedef unsigned u32x2 __attribute__((ext_vector_type(2)));

constexpr int MROWS = 32768, SEQ = 8192, DM = 1024;
constexpr size_t MiB = 1ull << 20;
constexpr size_t WS_W = 0;
constexpr size_t W_IN = 0, W_L2 = 13 * MiB, W_OUT = 15 * MiB, W_UP = 17 * MiB, W_DN = 28 * MiB;
constexpr size_t WS_MISC = 34 * MiB;
constexpr size_t WS_R1 = 36 * MiB;
constexpr size_t WS_PROJ = 164 * MiB;
constexpr size_t WS_PROJC = 228 * MiB;
constexpr size_t WS_OC = 436 * MiB;
constexpr size_t WS_HID = 100 * MiB;
constexpr size_t WS_ACT = 292 * MiB;

struct Params {
    const float* in[36];
    float* out;
    unsigned char* ws;
    int ph_lo, ph_hi;
};
typedef const Params* PPTR;

__device__ __forceinline__ float bf2f(unsigned v) { return __uint_as_float(v << 16); }
__device__ __forceinline__ float bflo(unsigned v) { return __uint_as_float(v << 16); }
__device__ __forceinline__ float bfhi(unsigned v) { return __uint_as_float(v & 0xffff0000u); }
typedef __bf16 bf16v2 __attribute__((ext_vector_type(2)));
__device__ __forceinline__ unsigned pack2(float lo, float hi) { const f32x2 v = {lo, hi}; const bf16v2 r = __builtin_convertvector(v, bf16v2); return __builtin_bit_cast(unsigned, r); }
__device__ __forceinline__ unsigned f2bf(float f) { return pack2(f, 0.f) & 0xffffu; }
__device__ __forceinline__ float sigmoidf_(float x) { return __builtin_amdgcn_rcpf(1.0f + __expf(-x)); }
__device__ __forceinline__ float siluf_(float x) { return x * __builtin_amdgcn_rcpf(1.0f + __expf(-x)); }
__device__ __forceinline__ float softplusf_(float x) { return x > 15.0f ? x : __logf(1.0f + __expf(x)); }
template <int CTRL> __device__ __forceinline__ float dpp_f(float x) { return __int_as_float(__builtin_amdgcn_update_dpp(0, __float_as_int(x), CTRL, 0xf, 0xf, false)); }
__device__ __forceinline__ float rowred16(float x) { x += dpp_f<0x128>(x); x += dpp_f<0x124>(x); x += dpp_f<0x122>(x); x += dpp_f<0x121>(x); return x; }
__device__ __forceinline__ float wave_allsum(float v) {
    float r = rowred16(v);
    r += __int_as_float(__builtin_amdgcn_update_dpp(0, __float_as_int(r), 0x142, 0xa, 0xf, false));
    r += __int_as_float(__builtin_amdgcn_update_dpp(0, __float_as_int(r), 0x143, 0xc, 0xf, false));
    return __int_as_float(__builtin_amdgcn_readlane(__float_as_int(r), 63));
}
struct StepRegs { f32x4 a, b, c, d, e; float vr, x0, x1; };
template <int KIND> __device__ __forceinline__ void step_load(StepRegs& r, LAS const float* rec, int li, int row) {
    r.a = *(LAS const f32x4*)(rec + 4 * li); r.b = *(LAS const f32x4*)(rec + 64 + 4 * li); r.c = *(LAS const f32x4*)(rec + 128 + 4 * li); r.d = *(LAS const f32x4*)(rec + 192 + 4 * li);
    if (KIND == 0) { r.vr = rec[256 + row]; r.x0 = rec[272]; r.x1 = rec[273]; }
    else if (KIND == 1) { r.vr = rec[256 + row]; }
    else { r.e = *(LAS const f32x4*)(rec + 256 + 4 * li); r.vr = rec[320 + row]; }
}
template <int KIND> __device__ __forceinline__ float step_compute(const StepRegs& r, f32x2 (&s)[4]) {
    if (KIND == 0) {
        const f32x2 k[4] = {{r.a[0], r.a[1]}, {r.a[2], r.a[3]}, {r.b[0], r.b[1]}, {r.b[2], r.b[3]}};
        const f32x2 q[4] = {{r.c[0], r.c[1]}, {r.c[2], r.c[3]}, {r.d[0], r.d[1]}, {r.d[2], r.d[3]}};
        f32x2 pa = s[0] * k[0] + s[1] * k[1]; const f32x2 pb = s[2] * k[2] + s[3] * k[3]; pa += pb;
        const float pp = rowred16(pa.x + pa.y);
        const float cc = r.x0 * (r.vr - r.x1 * pp);
        const f32x2 eg2 = {r.x1, r.x1}, cc2 = {cc, cc};
#pragma unroll
        for (int i = 0; i < 4; ++i) s[i] = s[i] * eg2 + cc2 * k[i];
        f32x2 oa = s[0] * q[0] + s[1] * q[1]; const f32x2 ob = s[2] * q[2] + s[3] * q[3]; oa += ob;
        return rowred16(oa.x + oa.y);
    } else if (KIND == 1) {
        const f32x2 q[4] = {{r.a[0], r.a[1]}, {r.a[2], r.a[3]}, {r.b[0], r.b[1]}, {r.b[2], r.b[3]}};
        const f32x2 f[4] = {{r.c[0], r.c[1]}, {r.c[2], r.c[3]}, {r.d[0], r.d[1]}, {r.d[2], r.d[3]}};
        const f32x2 v2 = {r.vr, r.vr};
#pragma unroll
        for (int i = 0; i < 4; ++i) s[i] = s[i] * f[i] + v2 * (1.0f - f[i]);
        f32x2 oa = s[0] * q[0] + s[1] * q[1]; const f32x2 ob = s[2] * q[2] + s[3] * q[3]; oa += ob;
        return rowred16(oa.x + oa.y);
    } else {
        const f32x2 a2[2] = {{r.a[0], r.a[1]}, {r.a[2], r.a[3]}}, b2[2] = {{r.b[0], r.b[1]}, {r.b[2], r.b[3]}}, d2[2] = {{r.c[0], r.c[1]}, {r.c[2], r.c[3]}};
        const f32x2 k2[2] = {{r.d[0], r.d[1]}, {r.d[2], r.d[3]}}, r2[2] = {{r.e[0], r.e[1]}, {r.e[2], r.e[3]}};
        const f32x2 pa = s[0] * a2[0] + s[1] * a2[1];
        const float sa = rowred16(pa.x + pa.y);
        const f32x2 sa2 = {sa, sa}, v2 = {r.vr, r.vr};
        s[0] = s[0] * d2[0] + sa2 * b2[0] + v2 * k2[0]; s[1] = s[1] * d2[1] + sa2 * b2[1] + v2 * k2[1];
        const f32x2 oa = s[0] * r2[0] + s[1] * r2[1];
        return rowred16(oa.x + oa.y);
    }
}
__device__ __forceinline__ int tidx() { int t = threadIdx.x; asm volatile("" : "+v"(t)); return t; }
__device__ __forceinline__ int bidx() { int t = blockIdx.x; asm volatile("" : "+s"(t)); return t; }
__device__ __forceinline__ int gdim() { int t = gridDim.x; asm volatile("" : "+s"(t)); return t; }
__device__ __forceinline__ void lds_barrier() { asm volatile("s_waitcnt lgkmcnt(0)" ::: "memory"); __builtin_amdgcn_s_barrier(); asm volatile("" ::: "memory"); }

namespace pg8 {
constexpr int BM = 256, BK = 64, HALF = 128, HTB = HALF * BK * 2, STAGE_BYTES = 8 * HTB, NXCD = 8, WGM = 8;
__device__ __forceinline__ int lds_byte(int r, int c) { const int st = (r >> 4) * 2 + (c >> 5), rr = r & 15, cc = c & 31, ob = rr * 64 + cc * 2; return st * 1024 + (ob ^ (((ob >> 9) & 1) << 5)); }
__device__ __forceinline__ void stage_rc(int b, int& R, int& C) { const int st = b / 1024, sb = b % 1024, swz = sb ^ (((sb >> 9) & 1) << 5); R = (st >> 1) * 16 + swz / 64; C = (st & 1) * 32 + (swz % 64) / 2; }
__device__ __forceinline__ int perm32(int rho) { const int n = rho >> 4, i = rho & 15; return 8 * (i >> 2) + 4 * n + (i & 3); }
struct Unit { int pm, pn; };
struct Gemm { const bf16_t* A; const bf16_t* Bt; int M, N, K, lda; };
struct StaticOrder {
    int nM, nN, nwg, G, c;
    __device__ void init(int M, int N, int G_, int c_) { nM = M / BM; nN = N / BM; nwg = nM * nN; G = G_; c = c_; }
    __device__ bool next(int i, Unit& u) const {
        const long L = (long)i * G + c; if (L >= nwg) return false;
        int wgid = (int)L; { const int q = nwg / NXCD, r = nwg % NXCD, xcd = wgid % NXCD, off = wgid / NXCD; wgid = (xcd < r ? xcd * (q + 1) : r * (q + 1) + (xcd - r) * q) + off; }
        const int nig = WGM * nN, gid = wgid / nig, fm = gid * WGM, gsz = (nM - fm) < WGM ? (nM - fm) : WGM;
        u.pm = fm + ((wgid % nig) % gsz); u.pn = (wgid % nig) / gsz; return true;
    }
};
__device__ __forceinline__ unsigned cvt_pk_bf16(float lo, float hi) { return pack2(lo, hi); }

struct EpiBf16S {
    static constexpr bool PERM = true;
    bf16_t* O; int ldc; int act;
    __device__ __forceinline__ void operator()(const f32x4 (&acc)[2][2][4][2], const Unit& u, int wr, int wc, int fr, int fq) const {
        const int row0 = u.pm * BM + wr * 64 + fr; const int col0 = u.pn * BM + wc * 32 + 8 * fq;
#pragma unroll
        for (int ai = 0; ai < 2; ++ai)
#pragma unroll
            for (int m = 0; m < 4; ++m) { bf16_t* rowp = O + (size_t)(row0 + ai * HALF + m * 16) * ldc + col0;
#pragma unroll
                for (int bj = 0; bj < 2; ++bj) { f32x4 v0 = acc[ai][bj][m][0], v1 = acc[ai][bj][m][1];
                    if (act) { const int c = col0 + bj * HALF;
                        if (c >= 3072 && c < 3136) {
#pragma unroll
                            for (int j = 0; j < 4; ++j) { v0[j] = 1.0f - 2.0f * __builtin_amdgcn_rcpf(1.0f + __expf(2.0f * v0[j])); v1[j] = 1.0f - 2.0f * __builtin_amdgcn_rcpf(1.0f + __expf(2.0f * v1[j])); } }
                        else if (c >= 3200) {
#pragma unroll
                            for (int j = 0; j < 4; ++j) { v0[j] = sigmoidf_(v0[j]); v1[j] = sigmoidf_(v1[j]); } } }
                    u32x4 w; w.x = cvt_pk_bf16(v0[0], v0[1]); w.y = cvt_pk_bf16(v0[2], v0[3]); w.z = cvt_pk_bf16(v1[0], v1[1]); w.w = cvt_pk_bf16(v1[2], v1[3]);
                    *(u32x4*)(rowp + bj * HALF) = w; } }
    }
};
struct EpiRes {
    static constexpr bool PERM = false;
    const float* res; float* out; const float* gate;
    __device__ __forceinline__ void operator()(const f32x4 (&acc)[2][2][4][2], const Unit& u, int wr, int wc, int fr, int fq) const {
        const int row0 = u.pm * BM + wr * 64 + fr, col0 = u.pn * BM + wc * 32 + 4 * fq; const int b = (u.pm * BM) / SEQ;
        f32x4 gv[2][2];
#pragma unroll
        for (int bj = 0; bj < 2; ++bj)
#pragma unroll
            for (int n = 0; n < 2; ++n) gv[bj][n] = *(const f32x4*)(gate + (size_t)b * 6144 + col0 + bj * HALF + n * 16);
#pragma unroll
        for (int ai = 0; ai < 2; ++ai)
#pragma unroll
            for (int m = 0; m < 4; ++m) { const size_t off = (size_t)(row0 + ai * HALF + m * 16) * DM + col0;
#pragma unroll
                for (int bj = 0; bj < 2; ++bj)
#pragma unroll
                    for (int n = 0; n < 2; ++n) { const f32x4 r = *(const f32x4*)(res + off + bj * HALF + n * 16);
                        *(f32x4*)(out + off + bj * HALF + n * 16) = r + gv[bj][n] * acc[ai][bj][m][n]; } }
    }
};

template <class Epi>
__device__ __forceinline__ void gemm_phase(LAS unsigned char* lds, const Gemm g, const StaticOrder& S, const Epi& E) {
    const int tid = tidx(), wid = __builtin_amdgcn_readfirstlane(tid >> 6), lane = tid & 63, wr = wid >> 2, wc = wid & 3, fr = lane & 15, fq = lane >> 4;
    const int K = g.K, nt = K / BK, lda = g.lda;
    unsigned voffA[2], voffB[2];
#pragma unroll
    for (int i = 0; i < 2; ++i) { int R, C; stage_rc(tid * 16 + i * 8192, R, C); const int Rb = Epi::PERM ? ((R & ~31) + perm32(R & 31)) : R;
        voffA[i] = (unsigned)(R * lda + C) * 2u; voffB[i] = (unsigned)(Rb * K + C) * 2u; }
    const size_t kstep = (size_t)(BK * 2);
    const size_t hstepA = (size_t)HALF * lda * 2, hstepB = (size_t)HALF * K * 2;
    const size_t tstepA = 2 * hstepA, tstepB = 2 * hstepB;
    const unsigned ldsw = (unsigned)wid * 1024u;
    const int aoff = lds_byte(wr * 64 + fr, fq * 8), boff = lds_byte(wc * 32 + fr, fq * 8);
#define PG8_SA(b, h) (((b) * 2 + (h)) * HTB)
#define PG8_SB(b, h) ((4 + (b) * 2 + (h)) * HTB)
#define PG8_STAGE(bufoff, gbase, voff) do { _Pragma("unroll") for (int _i = 0; _i < 2; ++_i) \
        __builtin_amdgcn_global_load_lds((const unsigned*)((const char*)(gbase) + (voff)[_i]), (LAS unsigned*)(lds + (bufoff) + ldsw + _i * 8192), 16, 0, 0); } while (0)
#define PG8_LDA(dst, b, h) do { _Pragma("unroll") for (int m = 0; m < 4; ++m) _Pragma("unroll") for (int k = 0; k < 2; ++k) dst[m][k] = *(const LAS bf16x8*)(lds + PG8_SA(b, h) + aoff + m * 2048 + k * 1024); } while (0)
#define PG8_LDB(dst, b, h) do { _Pragma("unroll") for (int n = 0; n < 2; ++n) _Pragma("unroll") for (int k = 0; k < 2; ++k) dst[n][k] = *(const LAS bf16x8*)(lds + PG8_SB(b, h) + boff + n * 2048 + k * 1024); } while (0)
#define PG8_MMA(ai, bj, At, Bt) do { __builtin_amdgcn_s_setprio(1); _Pragma("unroll") for (int m = 0; m < 4; ++m) _Pragma("unroll") for (int n = 0; n < 2; ++n) _Pragma("unroll") for (int k = 0; k < 2; ++k) \
        acc[ai][bj][m][n] = __builtin_amdgcn_mfma_f32_16x16x32_bf16(Bt[n][k], At[m][k], acc[ai][bj][m][n], 0, 0, 0); __builtin_amdgcn_s_setprio(0); } while (0)
#define PG8_WAIT_V(n) asm volatile("s_waitcnt vmcnt(" #n ")" ::: "memory")
#define PG8_WAIT_L(n) asm volatile("s_waitcnt lgkmcnt(" #n ")" ::: "memory")
#define PG8_BAR __builtin_amdgcn_s_barrier()
#define PG8_SCHED __builtin_amdgcn_sched_barrier(0)
    Unit cur, nxt; int ui = 0;
    if (!S.next(0, cur)) return;
    f32x4 acc[2][2][4][2];
#pragma unroll
    for (int a = 0; a < 2; ++a)
#pragma unroll
        for (int b = 0; b < 2; ++b)
#pragma unroll
            for (int m = 0; m < 4; ++m)
#pragma unroll
                for (int n = 0; n < 2; ++n) acc[a][b][m][n] = (f32x4){0.f, 0.f, 0.f, 0.f};
    bf16x8 At[4][2], B0[2][2], B1[2][2];
    const char* cA = (const char*)g.A + (size_t)cur.pm * tstepA; const char* cB = (const char*)g.Bt + (size_t)cur.pn * tstepB;
    PG8_STAGE(PG8_SB(0, 0), cB, voffB); PG8_STAGE(PG8_SA(0, 0), cA, voffA); PG8_STAGE(PG8_SB(0, 1), cB + hstepB, voffB); PG8_STAGE(PG8_SA(0, 1), cA + hstepA, voffA);
    if (wr == 1) PG8_BAR;
    PG8_WAIT_V(4); PG8_BAR;
    PG8_STAGE(PG8_SB(1, 0), cB + kstep, voffB); PG8_STAGE(PG8_SA(1, 0), cA + kstep, voffA); PG8_STAGE(PG8_SB(1, 1), cB + hstepB + kstep, voffB);
    PG8_WAIT_V(6); PG8_BAR;
    for (;;) {
        const bool has_next = S.next(ui + 1, nxt);
        const char* nA = has_next ? (const char*)g.A + (size_t)nxt.pm * tstepA : cA; const char* nB = has_next ? (const char*)g.Bt + (size_t)nxt.pn * tstepB : cB;
        for (int t = 0; t < nt; t += 2) {
            const bool last = (t == nt - 2);
            const char* a1 = cA + (size_t)(t + 1) * kstep;
            const char* a2 = last ? nA : cA + (size_t)(t + 2) * kstep; const char* b2 = last ? nB : cB + (size_t)(t + 2) * kstep;
            const char* a3 = a2 + kstep; const char* b3 = b2 + kstep;
            PG8_LDB(B0, 0, 0); PG8_SCHED; PG8_LDA(At, 0, 0); PG8_STAGE(PG8_SA(1, 1), a1 + hstepA, voffA);
            PG8_WAIT_L(8); PG8_BAR; PG8_WAIT_L(0); PG8_MMA(0, 0, At, B0); PG8_BAR; PG8_SCHED;
            PG8_LDB(B1, 0, 1); PG8_STAGE(PG8_SB(0, 0), b2, voffB);
            PG8_BAR; PG8_WAIT_L(0); PG8_MMA(0, 1, At, B1); PG8_BAR;
            PG8_LDA(At, 0, 1); PG8_STAGE(PG8_SA(0, 0), a2, voffA);
            PG8_BAR; PG8_WAIT_L(0); PG8_MMA(1, 0, At, B0); PG8_BAR; PG8_SCHED;
            PG8_STAGE(PG8_SB(0, 1), b2 + hstepB, voffB);
            PG8_WAIT_V(6); PG8_BAR; PG8_MMA(1, 1, At, B1); PG8_BAR;
            PG8_LDB(B0, 1, 0); PG8_SCHED; PG8_LDA(At, 1, 0); PG8_STAGE(PG8_SA(0, 1), a2 + hstepA, voffA);
            PG8_WAIT_L(8); PG8_BAR; PG8_WAIT_L(0); PG8_MMA(0, 0, At, B0); PG8_BAR; PG8_SCHED;
            PG8_LDB(B1, 1, 1); PG8_STAGE(PG8_SB(1, 0), b3, voffB);
            PG8_BAR; PG8_WAIT_L(0); PG8_MMA(0, 1, At, B1); PG8_BAR;
            PG8_LDA(At, 1, 1); PG8_STAGE(PG8_SA(1, 0), a3, voffA);
            PG8_BAR; PG8_WAIT_L(0); PG8_MMA(1, 0, At, B0); PG8_BAR; PG8_SCHED;
            PG8_STAGE(PG8_SB(1, 1), b3 + hstepB, voffB);
            PG8_WAIT_V(6); PG8_BAR; PG8_MMA(1, 1, At, B1); PG8_BAR;
        }
        E(acc, cur, wr, wc, fr, fq);
        if (!has_next) break;
#pragma unroll
        for (int a = 0; a < 2; ++a)
#pragma unroll
            for (int b = 0; b < 2; ++b)
#pragma unroll
                for (int m = 0; m < 4; ++m)
#pragma unroll
                    for (int n = 0; n < 2; ++n) acc[a][b][m][n] = (f32x4){0.f, 0.f, 0.f, 0.f};
        cur = nxt; cA = nA; cB = nB; ++ui;
    }
    PG8_WAIT_V(0);
    if (wr == 0) PG8_BAR;
    PG8_BAR;
#undef PG8_SA
#undef PG8_SB
#undef PG8_STAGE
#undef PG8_LDA
#undef PG8_LDB
#undef PG8_MMA
#undef PG8_WAIT_V
#undef PG8_WAIT_L
#undef PG8_BAR
#undef PG8_SCHED
}
}

template <class Epi>
__device__ __forceinline__ void run_gemm(LAS unsigned char* lds, const bf16_t* A, int lda, const bf16_t* Bt, int N, int K, const Epi& E) {
    pg8::Gemm g; g.A = A; g.Bt = Bt; g.M = MROWS; g.N = N; g.K = K; g.lda = lda;
    pg8::StaticOrder S; S.init(MROWS, N, (int)gdim(), (int)bidx());
    pg8::gemm_phase<Epi>(lds, g, S, E);
}

__device__ __forceinline__ void cvt_job(LAS float* tile, bf16_t* dst, int ldd, const float* src, int srcN, int nK, int nNdst, int nNsrc, const float* scale, int noff) {
    const int tid = tidx(); const int tilesK = nK / 64, tilesN = nNdst / 64, ntl = tilesK * tilesN, G = gdim();
    const int kr = tid >> 6, nn = tid & 63;
    for (int tl0 = bidx(); tl0 < ntl; tl0 += 2 * G) {
        float v[2][8];
#pragma unroll
        for (int u = 0; u < 2; ++u) { const int tl = tl0 + u * G; const bool tv = tl < ntl; const int tk = tv ? tl % tilesK : 0, tn = tv ? tl / tilesK : 0, k0 = tk * 64, n = tn * 64 + nn;
            const bool ld_ = tv && src && n < nNsrc;
#pragma unroll
            for (int ps = 0; ps < 8; ++ps) { const int kk = ps * 8 + kr; float x = 0.f;
                if (ld_) { x = src[(size_t)(k0 + kk) * srcN + noff + n]; if (scale) x *= scale[k0 + kk]; }
                v[u][ps] = x; } }
#pragma unroll
        for (int u = 0; u < 2; ++u)
#pragma unroll
            for (int ps = 0; ps < 8; ++ps) tile[u * 4160 + (ps * 8 + kr) * 65 + nn] = v[u][ps];
        __syncthreads();
#pragma unroll
        for (int u = 0; u < 2; ++u) { const int tl = tl0 + u * G;
            if (tl < ntl) { const int tk = tl % tilesK, tn = tl / tilesK, k0 = tk * 64, n0 = tn * 64;
#pragma unroll
                for (int ps = 0; ps < 4; ++ps) { const int kk2 = tid & 31, n2 = (tid >> 5) + 16 * ps;
                    const unsigned w = pack2(tile[u * 4160 + (2 * kk2) * 65 + n2], tile[u * 4160 + (2 * kk2 + 1) * 65 + n2]);
                    *(unsigned*)(dst + (size_t)(n0 + n2) * ldd + k0 + 2 * kk2) = w; } } }
        __syncthreads();
    }
}

__device__ __forceinline__ void cvt_layer(LAS unsigned char* lds, PPTR p, int layer) {
    LAS float* tile = (LAS float*)lds;
    bf16_t* W = (bf16_t*)(p->ws + WS_W);
    bf16_t* w_in = W + W_IN / 2; bf16_t* w_l2 = W + W_L2 / 2; bf16_t* w_out = W + W_OUT / 2; bf16_t* w_up = W + W_UP / 2; bf16_t* w_dn = W + W_DN / 2;
    const int kind = layer % 3, j = layer / 3;
    const int nmix = (kind == 2) ? 20 : 2;
    for (int jb = 0; jb < nmix + 5; ++jb) {
        bf16_t* dst = w_in; int ldd = 1024; const float* src = nullptr; int srcN = 1024, nK = 1024, nNdst = 1024, nNsrc = 1024, noff = 0; const float* scale = nullptr;
        if (jb >= nmix) {
            const int f = jb - nmix;
            if (f < 4) { const int g = f >> 1, gate = f & 1; const int nch = g ? 1280 : 1536, ch0 = g ? 1536 : 0;
                dst = w_up + (size_t)((g ? 3072 : 0) + nch * gate) * 1024; src = p->in[31] + (size_t)layer * 1024 * 5632; srcN = 5632; nNdst = nch; nNsrc = nch; noff = 2816 * gate + ch0; }
            else { dst = w_dn; ldd = 2816; src = p->in[34] + (size_t)layer * 2816 * 1024; nK = 2816; }
        } else if (kind == 0) {
            if (jb == 0) { src = p->in[5] + (size_t)j * 1024 * 4112; srcN = 4112; nNdst = 4352; nNsrc = 4112; }
            else { dst = w_out; src = p->in[10] + (size_t)j * 1024 * 1024; }
        } else if (kind == 1) {
            if (jb == 0) { src = p->in[11]; srcN = 4096; nNdst = 4096; nNsrc = 4096; }
            else { dst = w_out; src = p->in[14]; }
        } else {
            const float* mu = p->in[15];
            if (jb < 6) { const int sI = jb >> 1, hi = jb & 1; const int mi = (sI == 0) ? 0 : (sI == 1 ? 2 : 3);
                dst = w_in + (size_t)sI * 1024 * 2048 + hi * 1024; ldd = 2048; src = p->in[16] + (size_t)sI * 1024 * 1024; if (hi) scale = mu + mi * 1024; }
            else if (jb < 12) { const int q = (jb - 6) >> 1, hi = jb & 1;
                const int rowo = (q == 0) ? 3072 : (q == 1 ? 3136 : 3200); const int nc = (q == 2) ? 128 : 64; const int mi = (q == 0) ? 1 : (q == 1 ? 4 : 5);
                dst = w_in + (size_t)rowo * 2048 + hi * 1024; ldd = 2048; src = (q == 0) ? p->in[18] : (q == 1 ? p->in[21] : p->in[23]); srcN = nc; nNdst = nc; nNsrc = nc; if (hi) scale = mu + mi * 1024; }
            else if (jb < 19) { ldd = 256; nNdst = 1024; nNsrc = 1024;
                const int q = jb - 12;
                if (q == 0) { dst = w_l2; src = p->in[19]; nK = 64; }
                else if (q == 1) { dst = w_l2 + 64; nK = 192; }
                else if (q == 2) { dst = w_l2 + (size_t)1024 * 256; nK = 64; }
                else if (q == 3) { dst = w_l2 + (size_t)1024 * 256 + 64; src = p->in[22]; nK = 64; }
                else if (q == 4) { dst = w_l2 + (size_t)1024 * 256 + 128; nK = 128; }
                else if (q == 5) { dst = w_l2 + (size_t)2048 * 256; nK = 128; }
                else { dst = w_l2 + (size_t)2048 * 256 + 128; src = p->in[24]; nK = 128; } }
            else { dst = w_out; src = p->in[30]; }
        }
        cvt_job(tile, dst, ldd, src, srcN, nK, nNdst, nNsrc, scale, noff);
    }
}

template <bool SHIFT>
__device__ __forceinline__ void norm_phase(const float* h, const float* g, const float* modl, int s_shift, bf16_t* U, int ldu) {
    const int lane = tidx() & 63, wave = tidx() >> 6;
    const int gw = bidx() * 8 + wave, nw = gdim() * 8;
    constexpr int RU = SHIFT ? 2 : 4;
    for (int row0 = gw; row0 < MROWS; row0 += nw * RU) {
        f32x4 x[RU][4], xp[RU][4];
#pragma unroll
        for (int q = 0; q < RU; ++q) { const int row = row0 + q * nw;
            if (row < MROWS) {
#pragma unroll
                for (int i = 0; i < 4; ++i) x[q][i] = *(const f32x4*)(h + (size_t)row * DM + i * 256 + lane * 4);
                if (SHIFT) { const size_t prow = ((row & (SEQ - 1)) > 0) ? (size_t)(row - 1) : (size_t)row;
#pragma unroll
                    for (int i = 0; i < 4; ++i) xp[q][i] = *(const f32x4*)(h + prow * DM + i * 256 + lane * 4); } } }
#pragma unroll
        for (int q = 0; q < RU; ++q) { const int row = row0 + q * nw;
            if (row < MROWS) {
                const int b = row >> 13, t = row & (SEQ - 1);
                const float* sh = modl + (size_t)b * 6144 + s_shift * 1024; const float* sc = sh + 1024;
                float ss = 0.f;
#pragma unroll
                for (int i = 0; i < 4; ++i) ss += x[q][i][0] * x[q][i][0] + x[q][i][1] * x[q][i][1] + x[q][i][2] * x[q][i][2] + x[q][i][3] * x[q][i][3];
                ss = wave_allsum(ss); const float rstd = __builtin_amdgcn_rsqf(ss * (1.0f / 1024.0f) + 1e-6f);
                float rstdp = 0.f;
                if (SHIFT) { float ssp = 0.f;
#pragma unroll
                    for (int i = 0; i < 4; ++i) ssp += xp[q][i][0] * xp[q][i][0] + xp[q][i][1] * xp[q][i][1] + xp[q][i][2] * xp[q][i][2] + xp[q][i][3] * xp[q][i][3];
                    ssp = wave_allsum(ssp); rstdp = __builtin_amdgcn_rsqf(ssp * (1.0f / 1024.0f) + 1e-6f); }
#pragma unroll
                for (int i = 0; i < 4; ++i) { const int c = i * 256 + lane * 4; const f32x4 gg = *(const f32x4*)(g + c), s1 = *(const f32x4*)(sc + c), s0 = *(const f32x4*)(sh + c);
                    const f32x4 u = x[q][i] * rstd * gg * (1.0f + s1) + s0;
                    u32x2 w; w.x = pack2(u[0], u[1]); w.y = pack2(u[2], u[3]); *(u32x2*)(U + (size_t)row * ldu + c) = w;
                    if (SHIFT) { f32x4 up = xp[q][i] * rstdp * gg * (1.0f + s1) + s0; if (t == 0) up = (f32x4){0.f, 0.f, 0.f, 0.f};
                        const f32x4 dx = up - u; u32x2 w2; w2.x = pack2(dx[0], dx[1]); w2.y = pack2(dx[2], dx[3]); *(u32x2*)(U + (size_t)row * ldu + 1024 + c) = w2; } }
            } }
    }
}

__device__ __forceinline__ void final_phase(float* h, const float* g) {
    const int lane = tidx() & 63, wave = tidx() >> 6;
    const int gw = bidx() * 8 + wave, nw = gdim() * 8;
    for (int row0 = gw; row0 < MROWS; row0 += nw * 4) {
        f32x4 x[4][4];
#pragma unroll
        for (int q = 0; q < 4; ++q) { const int row = row0 + q * nw; if (row < MROWS) {
#pragma unroll
            for (int i = 0; i < 4; ++i) x[q][i] = *(const f32x4*)(h + (size_t)row * DM + i * 256 + lane * 4); } }
#pragma unroll
        for (int q = 0; q < 4; ++q) { const int row = row0 + q * nw; if (row < MROWS) {
            float ss = 0.f;
#pragma unroll
            for (int i = 0; i < 4; ++i) ss += x[q][i][0] * x[q][i][0] + x[q][i][1] * x[q][i][1] + x[q][i][2] * x[q][i][2] + x[q][i][3] * x[q][i][3];
            ss = wave_allsum(ss); const float rstd = __builtin_amdgcn_rsqf(ss * (1.0f / 1024.0f) + 1e-6f);
#pragma unroll
            for (int i = 0; i < 4; ++i) { const int c = i * 256 + lane * 4; const f32x4 gg = *(const f32x4*)(g + c);
                *(f32x4*)(h + (size_t)row * DM + c) = x[q][i] * rstd * gg; } } }
    }
}

__device__ __forceinline__ void pre_phase(LAS unsigned char* lds, PPTR p) {
    LAS float* cond = (LAS float*)lds;
    LAS float* red = cond + 4096;
    const int tid = tidx(), lane = tid & 63, wave = tid >> 6;
    float* mod = (float*)(p->ws + WS_MISC); float* lb = mod + 4 * 4 * 6144;
    for (int i = tid; i < 4096; i += 512) cond[i] = siluf_(p->in[1][i]);
    __syncthreads();
    for (int task = bidx(); task < 384; task += gdim()) {
        const int l = task / 96, cb = task % 96, col = cb * 64 + lane;
        float a0 = 0.f, a1 = 0.f, a2 = 0.f, a3 = 0.f;
        const float* wp = p->in[3] + ((size_t)l * 1024 + wave * 128) * 6144 + col;
#pragma unroll 8
        for (int k = 0; k < 128; ++k) { const float wv = wp[(size_t)k * 6144]; const int kk = wave * 128 + k;
            a0 += cond[kk] * wv; a1 += cond[1024 + kk] * wv; a2 += cond[2048 + kk] * wv; a3 += cond[3072 + kk] * wv; }
        red[(wave * 4 + 0) * 64 + lane] = a0; red[(wave * 4 + 1) * 64 + lane] = a1; red[(wave * 4 + 2) * 64 + lane] = a2; red[(wave * 4 + 3) * 64 + lane] = a3;
        __syncthreads();
        if (tid < 256) { const int b = tid >> 6; float s = 0.f;
#pragma unroll
            for (int w = 0; w < 8; ++w) s += red[(w * 4 + b) * 64 + lane];
            mod[((size_t)l * 4 + b) * 6144 + col] = s + p->in[4][(size_t)l * 6144 + col]; }
        __syncthreads();
    }
    for (int c = bidx() * 512 + tid; c < 1024; c += gdim() * 512) {
        const float l0 = p->in[12][c], l1 = p->in[12][1024 + c], l2 = p->in[12][2048 + c], l3 = p->in[12][3072 + c];
        const float mx = fmaxf(fmaxf(l0, l1), fmaxf(l2, l3));
        const float e0 = __expf(l0 - mx), e1 = __expf(l1 - mx), e2 = __expf(l2 - mx), e3 = __expf(l3 - mx);
        lb[c] = e1 / (e0 + e1 + e2 + e3);
    }
}

__device__ __forceinline__ void convglu_phase(const bf16_t* HID, bf16_t* ACT, int g, const float* cw, const float* cb) {
    const int nch = g ? 1280 : 1536, ch0 = g ? 1536 : 0, ld = 2 * nch, ncg = nch / 8;
    const int total = (MROWS / 16) * ncg;
    for (int task = bidx() * 512 + tidx(); task < total; task += gdim() * 512) {
        const int cgi = task % ncg, run = task / ncg, row0 = run * 16, t0 = row0 & (SEQ - 1), j0 = cgi * 8, ch = ch0 + j0;
        float wv[3][8], wg[3][8], bv[8], bg[8];
#pragma unroll
        for (int k = 0; k < 3; ++k)
#pragma unroll
            for (int e = 0; e < 8; ++e) { wv[k][e] = cw[k * 5632 + ch + e]; wg[k][e] = cw[k * 5632 + 2816 + ch + e]; }
#pragma unroll
        for (int e = 0; e < 8; ++e) { bv[e] = cb[ch + e]; bg[e] = cb[2816 + ch + e]; }
        u32x4 v2 = (u32x4){0, 0, 0, 0}, v1 = v2, g2 = v2, g1 = v2;
        if (t0 >= 2) {
            v2 = *(const u32x4*)(HID + (size_t)(row0 - 2) * ld + j0); g2 = *(const u32x4*)(HID + (size_t)(row0 - 2) * ld + nch + j0);
            v1 = *(const u32x4*)(HID + (size_t)(row0 - 1) * ld + j0); g1 = *(const u32x4*)(HID + (size_t)(row0 - 1) * ld + nch + j0);
        }
        u32x4 va[4], ga[4], vb4[4], gb4[4];
#define CG_LOAD(V, G, r0) do { _Pragma("unroll") for (int q_ = 0; q_ < 4; ++q_) { V[q_] = *(const u32x4*)(HID + (size_t)(row0 + (r0) + q_) * ld + j0); G[q_] = *(const u32x4*)(HID + (size_t)(row0 + (r0) + q_) * ld + nch + j0); } } while (0)
#define CG_ROWS(V, G, r0) do { _Pragma("unroll") for (int q_ = 0; q_ < 4; ++q_) { const u32x4 v0 = V[q_], g0 = G[q_]; u32x4 o; \
            _Pragma("unroll") for (int q = 0; q < 4; ++q) { \
                const float yv0 = wv[0][2 * q] * bflo(v2[q]) + wv[1][2 * q] * bflo(v1[q]) + wv[2][2 * q] * bflo(v0[q]) + bv[2 * q]; \
                const float yv1 = wv[0][2 * q + 1] * bfhi(v2[q]) + wv[1][2 * q + 1] * bfhi(v1[q]) + wv[2][2 * q + 1] * bfhi(v0[q]) + bv[2 * q + 1]; \
                const float yg0 = wg[0][2 * q] * bflo(g2[q]) + wg[1][2 * q] * bflo(g1[q]) + wg[2][2 * q] * bflo(g0[q]) + bg[2 * q]; \
                const float yg1 = wg[0][2 * q + 1] * bfhi(g2[q]) + wg[1][2 * q + 1] * bfhi(g1[q]) + wg[2][2 * q + 1] * bfhi(g0[q]) + bg[2 * q + 1]; \
                o[q] = pack2(yv0 * siluf_(yg0), yv1 * siluf_(yg1)); } \
            *(u32x4*)(ACT + (size_t)(row0 + (r0) + q_) * 2816 + ch) = o; \
            v2 = v1; v1 = v0; g2 = g1; g1 = g0; } } while (0)
        CG_LOAD(va, ga, 0);
        CG_LOAD(vb4, gb4, 4);
        CG_ROWS(va, ga, 0);
        CG_LOAD(va, ga, 8);
        CG_ROWS(vb4, gb4, 4);
        CG_LOAD(vb4, gb4, 12);
        CG_ROWS(va, ga, 8);
        CG_ROWS(vb4, gb4, 12);
#undef CG_LOAD
#undef CG_ROWS
    }
}

template <int KIND>
__device__ __forceinline__ void scan_phase(LAS unsigned char* lds, PPTR p, int j) {
    constexpr int N = (KIND == 2) ? 64 : 128;
    constexpr int NH = (KIND == 2) ? 16 : 8;
    constexpr int RG = N / 16;
    constexpr int STRIDE = (KIND == 0) ? 288 : (KIND == 1 ? 272 : 336);
    constexpr int TC = 32, NC = SEQ / TC;
    constexpr int LDP = (KIND == 0) ? 4352 : (KIND == 1 ? 4096 : 3328);
    LAS float* buf = (LAS float*)lds;
    LAS float* ob = buf + 2 * TC * STRIDE;
    const int tid = tidx(), wave = tid >> 6, lane = tid & 63;
    const bool is_loader = wave >= 4; const int lw = wave - 4;
    const int li = lane & 15, row = (wave & 3) * 4 + (lane >> 4);
    const bf16_t* P = (const bf16_t*)(p->ws + (KIND == 2 ? WS_PROJC : WS_PROJ));
    const bf16_t* L2 = (const bf16_t*)(p->ws + WS_R1);
    bf16_t* O = (bf16_t*)(p->ws + (KIND == 2 ? WS_OC : WS_R1));
    const int G = gdim(); const int vcu = (G % 8 == 0) ? (int)(bidx() % 8) * (G / 8) + (int)(bidx() / 8) : (int)bidx();
    for (int task = vcu; task < 256; task += G) {
        const int bh = task / RG, rg = task % RG, b = bh / NH, h = bh % NH;
        const size_t rbase = (size_t)b * SEQ;
        float cwq[4][2], cwk[4][2], cwv[4]; float expA = 0.f, dtb = 0.f; float lbv[2]; float w0v = 0.f, a0v = 0.f, kkc = 0.f, kac = 0.f;
        if (KIND == 0) { const float* cv = p->in[6] + (size_t)j * 4 * 3072;
#pragma unroll
            for (int jj = 0; jj < 4; ++jj) { cwq[jj][0] = cv[jj * 3072 + h * 128 + 2 * lane]; cwq[jj][1] = cv[jj * 3072 + h * 128 + 2 * lane + 1];
                cwk[jj][0] = cv[jj * 3072 + 1024 + h * 128 + 2 * lane]; cwk[jj][1] = cv[jj * 3072 + 1024 + h * 128 + 2 * lane + 1];
                cwv[jj] = cv[jj * 3072 + 2048 + h * 128 + 16 * rg + (lane & 15)]; }
            expA = __expf(p->in[7][j * 8 + h]); dtb = p->in[8][j * 8 + h]; }
        if (KIND == 1) { const float* lbp = (const float*)(p->ws + WS_MISC) + 4 * 4 * 6144; lbv[0] = lbp[h * 128 + 2 * lane]; lbv[1] = lbp[h * 128 + 2 * lane + 1]; }
        if (KIND == 2) { const int ch = h * 64 + lane; w0v = p->in[17][ch]; a0v = p->in[20][ch]; kkc = p->in[25][ch]; kac = p->in[26][ch]; }
        unsigned x0[11], x1[11], x2[11], x3[8], x4[8];
        f32x2 s[4];
#pragma unroll
        for (int e = 0; e < 4; ++e) s[e] = (f32x2){0.f, 0.f};

#define SCAN_LOAD(cc) do { const int c_ = (cc); \
        if (KIND == 0) { const int tfirst = c_ * TC + 8 * lw - 3; \
            _Pragma("unroll") for (int q = 0; q < 11; ++q) { const int t_ = tfirst + q; const bool valid = t_ >= 0; const bf16_t* rowp = P + (rbase + (valid ? t_ : 0)) * LDP; \
                const unsigned vq = *(const unsigned*)(rowp + h * 128 + 2 * lane), vk = *(const unsigned*)(rowp + 1024 + h * 128 + 2 * lane); \
                const int mcol = lane < 16 ? 2048 + h * 128 + 16 * rg + lane : (lane == 32 ? 4096 + h : (lane == 33 ? 4104 + h : 2048 + h * 128)); \
                const unsigned vm = rowp[mcol]; x0[q] = valid ? vq : 0u; x1[q] = valid ? vk : 0u; x2[q] = valid ? vm : 0u; } } \
        else if (KIND == 1) { const int tfirst = c_ * TC + 8 * lw; \
            _Pragma("unroll") for (int q = 0; q < 8; ++q) { const bf16_t* rowp = P + (rbase + tfirst + q) * LDP; \
                x0[q] = *(const unsigned*)(rowp + h * 128 + 2 * lane); x1[q] = *(const unsigned*)(rowp + 1024 + h * 128 + 2 * lane); \
                x2[q] = rowp[2048 + h * 128 + 16 * rg + (lane & 15)]; } } \
        else { const int tfirst = c_ * TC + 8 * lw; \
            _Pragma("unroll") for (int q = 0; q < 8; ++q) { const bf16_t* rowp = P + (rbase + tfirst + q) * LDP; const bf16_t* l2p = L2 + (rbase + tfirst + q) * 3072; \
                x0[q] = rowp[h * 64 + lane]; x1[q] = rowp[1024 + h * 64 + lane]; x2[q] = rowp[2048 + h * 64 + 16 * rg + (lane & 15)]; \
                x3[q] = l2p[h * 64 + lane]; x4[q] = l2p[1024 + h * 64 + lane]; } } } while (0)

#define SCAN_FLUSH(cc) do { const int c_ = (cc); LAS const float* src = ob + (c_ & 1) * (TC * 16) + (lane >> 1) * 16 + (lane & 1) * 8; \
        u32x4 w; w.x = pack2(src[0], src[1]); w.y = pack2(src[2], src[3]); w.z = pack2(src[4], src[5]); w.w = pack2(src[6], src[7]); \
        *(u32x4*)(O + (rbase + c_ * TC + (lane >> 1)) * DM + h * N + 16 * rg + (lane & 1) * 8) = w; } while (0)

        if (is_loader) SCAN_LOAD(0);
        for (int it = 0; it <= NC; ++it) {
            if (is_loader) {
                if (it < NC) {
                    LAS float* bw = buf + (it & 1) * (TC * STRIDE);
#pragma unroll
                    for (int i = 0; i < 8; ++i) {
                        LAS float* rec = bw + (8 * lw + i) * STRIDE;
                        if (KIND == 0) {
                            float yq0 = 0.f, yq1 = 0.f, yk0 = 0.f, yk1 = 0.f, yv = 0.f;
#pragma unroll
                            for (int jj = 0; jj < 4; ++jj) { yq0 += cwq[jj][0] * bflo(x0[i + jj]); yq1 += cwq[jj][1] * bfhi(x0[i + jj]);
                                yk0 += cwk[jj][0] * bflo(x1[i + jj]); yk1 += cwk[jj][1] * bfhi(x1[i + jj]); yv += cwv[jj] * bf2f(x2[i + jj]); }
                            yq0 = siluf_(yq0); yq1 = siluf_(yq1); yk0 = siluf_(yk0); yk1 = siluf_(yk1);
                            const float ssq = wave_allsum(yq0 * yq0 + yq1 * yq1), ssk = wave_allsum(yk0 * yk0 + yk1 * yk1);
                            const float rq = __builtin_amdgcn_rsqf(ssq + 1e-6f) * 0.08838834764831845f, rk = __builtin_amdgcn_rsqf(ssk + 1e-6f);
                            *(LAS f32x2*)(rec + 2 * lane) = (f32x2){yk0 * rk, yk1 * rk};
                            *(LAS f32x2*)(rec + 128 + 2 * lane) = (f32x2){yq0 * rq, yq1 * rq};
                            const float m3 = bf2f(x2[i + 3]);
                            if (lane < 16) rec[256 + lane] = siluf_(yv);
                            else if (lane == 32) rec[273] = __expf(-expA * softplusf_(m3 + dtb));
                            else if (lane == 33) rec[272] = sigmoidf_(m3);
                        } else if (KIND == 1) {
                            const float q0 = siluf_(bflo(x0[i])), q1 = siluf_(bfhi(x0[i]));
                            const float f0 = lbv[0] + (1.0f - lbv[0]) * sigmoidf_(bflo(x1[i])), f1 = lbv[1] + (1.0f - lbv[1]) * sigmoidf_(bfhi(x1[i]));
                            *(LAS f32x2*)(rec + 2 * lane) = (f32x2){q0, q1};
                            *(LAS f32x2*)(rec + 128 + 2 * lane) = (f32x2){f0, f1};
                            if (lane < 16) rec[256 + lane] = bf2f(x2[i]);
                        } else {
                            const float r = bf2f(x0[i]), kraw = bf2f(x1[i]), whi = bf2f(x3[i]), ahi = bf2f(x4[i]);
                            const float wv = -softplusf_(-(w0v + whi)) - 0.5f; const float d = __expf(-__expf(wv));
                            const float ag = sigmoidf_(a0v + ahi);
                            const float kkx = kraw * kkc; const float ss = wave_allsum(kkx * kkx); const float kk = kkx * __builtin_amdgcn_rsqf(ss + 1e-6f);
                            const float kp = kraw * (1.0f + (ag - 1.0f) * kac);
                            rec[lane] = -kk; rec[64 + lane] = kk * ag; rec[128 + lane] = d; rec[192 + lane] = kp; rec[256 + lane] = r;
                            if (lane < 16) rec[320 + lane] = bf2f(x2[i]);
                        }
                    }
                    if (it + 1 < NC) SCAN_LOAD(it + 1);
                }
                if (it >= 2 && lw == 0) SCAN_FLUSH(it - 2);
            } else if (it >= 1) {
                LAS const float* bc = buf + ((it - 1) & 1) * (TC * STRIDE);
                LAS float* oc = ob + ((it - 1) & 1) * (TC * 16);
                StepRegs R[2][2];
                step_load<KIND>(R[0][0], bc, li, row); step_load<KIND>(R[0][1], bc + STRIDE, li, row);
                float osel = 0.f;
#pragma unroll
                for (int g = 0; g < 16; ++g) {
                    if (g + 1 < 16) { step_load<KIND>(R[(g + 1) & 1][0], bc + (2 * g + 2) * STRIDE, li, row); step_load<KIND>(R[(g + 1) & 1][1], bc + (2 * g + 3) * STRIDE, li, row); }
#pragma unroll
                    for (int u = 0; u < 2; ++u) { const float o = step_compute<KIND>(R[g & 1][u], s); osel = (li == ((2 * g + u) & 15)) ? o : osel; }
                    if (g == 7 || g == 15) oc[((g == 15 ? 16 : 0) + li) * 16 + row] = osel;
                }
            }
            lds_barrier();
        }
        if (is_loader && lw == 0) SCAN_FLUSH(NC - 1);
        lds_barrier();
#undef SCAN_LOAD
#undef SCAN_FLUSH
    }
}


typedef short bf16x4 __attribute__((ext_vector_type(4)));
__device__ __forceinline__ bf16x8 cat4(bf16x4 lo, bf16x4 hi) { return __builtin_shufflevector(lo, hi, 0, 1, 2, 3, 4, 5, 6, 7); }
__device__ __forceinline__ bf16x4 cvt4(f32x4 v) { u32x2 w; w.x = pg8::cvt_pk_bf16(v[0], v[1]); w.y = pg8::cvt_pk_bf16(v[2], v[3]); return __builtin_bit_cast(bf16x4, w); }
constexpr size_t WS_KG = WS_R1 + 64 * MiB;
constexpr size_t WS_AM = 420 * MiB;
constexpr size_t WS_DEC = 428 * MiB;

__device__ __forceinline__ void prep_gla(LAS unsigned char* lds, PPTR p) {
    const int tid = tidx(), w = tid >> 6, lane = tid & 63, n = lane & 15, kg = lane >> 4;
    LAS unsigned char* qs = lds + w * 8704; LAS unsigned char* ks = qs + 4352;
    const bf16_t* P = (const bf16_t*)(p->ws + WS_PROJ);
    bf16_t* Qg = (bf16_t*)(p->ws + WS_R1); bf16_t* Kg = (bf16_t*)(p->ws + WS_KG);
    bf16_t* Amg = (bf16_t*)(p->ws + WS_AM); float* Decg = (float*)(p->ws + WS_DEC);
    const float* lbp = (const float*)(p->ws + WS_MISC) + 4 * 4 * 6144;
    for (int task = bidx() * 8 + w; task < 4 * 512 * 8; task += gdim() * 8) {
        const int h = task & 7, rc = task >> 3; const size_t row0 = (size_t)rc * 16;
        const float lb0 = lbp[h * 128 + 2 * lane], lb1 = lbp[h * 128 + 2 * lane + 1];
        unsigned xq[16], xf[16];
#pragma unroll
        for (int t = 0; t < 16; ++t) { const bf16_t* rowp = P + (row0 + t) * 4096 + h * 128 + 2 * lane; xq[t] = *(const unsigned*)rowp; xf[t] = *(const unsigned*)(rowp + 1024); }
        float bc0 = 0.f, bc1 = 0.f; float kk0[16], kk1[16], bs0[16], bs1[16];
#pragma unroll
        for (int t = 0; t < 16; ++t) {
            const float q0 = siluf_(bflo(xq[t])), q1 = siluf_(bfhi(xq[t]));
            const float f0 = lb0 + (1.0f - lb0) * sigmoidf_(bflo(xf[t])), f1 = lb1 + (1.0f - lb1) * sigmoidf_(bfhi(xf[t]));
            bc0 += __logf(f0); bc1 += __logf(f1);
            kk0[t] = 1.0f - f0; kk1[t] = 1.0f - f1; bs0[t] = bc0; bs1[t] = bc1;
            const unsigned qp = pack2(q0 * __expf(bc0), q1 * __expf(bc1));
            *(unsigned*)(Qg + (row0 + t) * 1024 + h * 128 + 2 * lane) = qp;
            *(LAS unsigned*)(qs + t * 272 + 4 * lane) = qp;
        }
#pragma unroll
        for (int t = 0; t < 16; ++t) {
            *(unsigned*)(Kg + (row0 + t) * 1024 + h * 128 + 2 * lane) = pack2(kk0[t] * __expf(bc0 - bs0[t]), kk1[t] * __expf(bc1 - bs1[t]));
            *(LAS unsigned*)(ks + t * 272 + 4 * lane) = pack2(kk0[t] * __expf(-bs0[t]), kk1[t] * __expf(-bs1[t]));
        }
        *(f32x2*)(Decg + (size_t)task * 128 + 2 * lane) = (f32x2){__expf(bc0), __expf(bc1)};
        asm volatile("s_waitcnt lgkmcnt(0)" ::: "memory");
        f32x4 acc = (f32x4){0.f, 0.f, 0.f, 0.f};
#pragma unroll
        for (int a = 0; a < 4; ++a) {
            const bf16x8 af = *(LAS const bf16x8*)(qs + n * 272 + (32 * a + 8 * kg) * 2);
            const bf16x8 bfr = *(LAS const bf16x8*)(ks + n * 272 + (32 * a + 8 * kg) * 2);
            acc = __builtin_amdgcn_mfma_f32_16x16x32_bf16(af, bfr, acc, 0, 0, 0);
        }
#pragma unroll
        for (int jj = 0; jj < 4; ++jj) { const int t = 4 * kg + jj; Amg[(size_t)task * 256 + t * 16 + n] = (bf16_t)f2bf(n <= t ? acc[jj] : 0.f); }
        asm volatile("s_waitcnt lgkmcnt(0)" ::: "memory");
    }
}

__device__ __forceinline__ void scan_gla(LAS unsigned char* lds, PPTR p) {
    constexpr int QOFF = 0, KTOFF = 4352, VOFF = 9472, AMOFF = 13824, DECOFF = 14336, BUFB = 14848;
    const int tid = tidx(), w = tid >> 6, lane = tid & 63, n = lane & 15, kg = lane >> 4;
    const bf16_t* P = (const bf16_t*)(p->ws + WS_PROJ);
    bf16_t* Qg = (bf16_t*)(p->ws + WS_R1); const bf16_t* Kg = (const bf16_t*)(p->ws + WS_KG);
    const bf16_t* Amg = (const bf16_t*)(p->ws + WS_AM); const float* Decg = (const float*)(p->ws + WS_DEC);
    bf16_t* Og = (bf16_t*)(p->ws + WS_OC);
    const bf16x4 z4 = (bf16x4){0, 0, 0, 0};
    for (int task = bidx(); task < 32; task += gdim()) {
        const int b = task >> 3, h = task & 7; const size_t rowbase = (size_t)b * SEQ;
        f32x4 S[8]; bf16x8 Sb[4];
#pragma unroll
        for (int i = 0; i < 8; ++i) S[i] = (f32x4){0.f, 0.f, 0.f, 0.f};
#pragma unroll
        for (int a = 0; a < 4; ++a) Sb[a] = (bf16x8){0, 0, 0, 0, 0, 0, 0, 0};
        const int lt = (tid & 255) >> 4, pc = tid & 15;
        constexpr int PD = 8;
        u32x4 g0[PD], g1[PD];
#define GLA_LOAD(cc, sl) do { const int c_ = (cc); const size_t r_ = rowbase + (size_t)c_ * 16 + lt; \
            if (tid < 256) { g0[sl] = *(const u32x4*)(Qg + r_ * 1024 + h * 128 + 8 * pc); g1[sl] = *(const u32x4*)(P + r_ * 4096 + 2048 + h * 128 + 8 * pc); } \
            else { g0[sl] = *(const u32x4*)(Kg + r_ * 1024 + h * 128 + 8 * pc); const size_t ch_ = ((size_t)(b * 512 + c_) * 8 + h); \
                if (tid < 288) g1[sl] = *(const u32x4*)(Amg + ch_ * 256 + (tid - 256) * 8); else if (tid < 320) g1[sl] = *(const u32x4*)(Decg + ch_ * 128 + (tid - 288) * 4); } } while (0)
#define GLA_STORE(cc, sl) do { LAS unsigned char* bb_ = lds + ((cc) & 1) * BUFB; \
            if (tid < 256) { *(LAS u32x4*)(bb_ + QOFF + lt * 272 + 16 * pc) = g0[sl]; *(LAS u32x4*)(bb_ + VOFF + lt * 272 + 16 * pc) = g1[sl]; } \
            else { _Pragma("unroll") for (int e = 0; e < 4; ++e) { *(LAS unsigned short*)(bb_ + KTOFF + (8 * pc + 2 * e) * 40 + 2 * lt) = (unsigned short)(g0[sl][e] & 0xffffu); \
                    *(LAS unsigned short*)(bb_ + KTOFF + (8 * pc + 2 * e + 1) * 40 + 2 * lt) = (unsigned short)(g0[sl][e] >> 16); } \
                if (tid < 288) *(LAS u32x4*)(bb_ + AMOFF + (tid - 256) * 16) = g1[sl]; else if (tid < 320) *(LAS u32x4*)(bb_ + DECOFF + (tid - 288) * 16) = g1[sl]; } } while (0)
#pragma unroll
        for (int d = 0; d < PD; ++d) GLA_LOAD(d, d);
        GLA_STORE(0, 0); lds_barrier();
        for (int c0 = 0; c0 < 512; c0 += PD) {
#pragma unroll
          for (int d = 0; d < PD; ++d) {
            const int c = c0 + d;
            if (c + PD < 512) GLA_LOAD(c + PD, d);
            LAS const unsigned char* bb = lds + (c & 1) * BUFB;
            f32x4 Z = (f32x4){0.f, 0.f, 0.f, 0.f};
#pragma unroll
            for (int a = 0; a < 4; ++a) {
                const bf16x4 lo = *(LAS const bf16x4*)(bb + QOFF + n * 272 + (32 * a + 4 * kg) * 2), hi = *(LAS const bf16x4*)(bb + QOFF + n * 272 + (32 * a + 16 + 4 * kg) * 2);
                Z = __builtin_amdgcn_mfma_f32_16x16x32_bf16(cat4(lo, hi), Sb[a], Z, 0, 0, 0);
            }
            bf16x4 vb;
#pragma unroll
            for (int j = 0; j < 4; ++j) vb[j] = *(LAS const short*)(bb + VOFF + (4 * kg + j) * 272 + (16 * w + n) * 2);
            const bf16x8 Vb = cat4(vb, z4);
            const bf16x4 am = *(LAS const bf16x4*)(bb + AMOFF + n * 32 + 8 * kg);
            const f32x4 o = __builtin_amdgcn_mfma_f32_16x16x32_bf16(cat4(am, z4), Vb, Z, 0, 0, 0);
#pragma unroll
            for (int i = 0; i < 8; ++i) {
                const f32x4 d4 = *(LAS const f32x4*)(bb + DECOFF + (16 * i + 4 * kg) * 4);
                const bf16x4 kt = *(LAS const bf16x4*)(bb + KTOFF + (16 * i + n) * 40 + 8 * kg);
                S[i] = __builtin_amdgcn_mfma_f32_16x16x32_bf16(cat4(kt, z4), Vb, S[i] * d4, 0, 0, 0);
            }
#pragma unroll
            for (int a = 0; a < 4; ++a) Sb[a] = cat4(cvt4(S[2 * a]), cvt4(S[2 * a + 1]));
#pragma unroll
            for (int j = 0; j < 4; ++j) Og[(rowbase + (size_t)c * 16 + 4 * kg + j) * 1024 + h * 128 + 16 * w + n] = (bf16_t)f2bf(o[j]);
            if (c + 1 < 512) GLA_STORE(c + 1, (d + 1) % PD);
            lds_barrier();
          }
        }
#undef GLA_LOAD
#undef GLA_STORE
    }
}


template <int SGN>
__device__ __forceinline__ void tri_inv16(LAS const float* Lm, int n, float (&x)[16]) {
    x[0] = (n == 0) ? 1.f : 0.f;
    {
        f32x4 la[12];
#pragma unroll
        for (int t = 1; t <= 4; ++t) la[t - 1] = *(LAS const f32x4*)(Lm + t * 16);
#pragma unroll
        for (int t = 5; t <= 8; ++t) { la[4 + 2 * (t - 5)] = *(LAS const f32x4*)(Lm + t * 16); la[5 + 2 * (t - 5)] = *(LAS const f32x4*)(Lm + t * 16 + 4); }
        __builtin_amdgcn_sched_barrier(0);
#pragma unroll
        for (int t = 1; t <= 8; ++t) { float acc = (n == t) ? 1.f : 0.f;
#pragma unroll
            for (int q = 0; q < (t + 3) / 4; ++q) { const f32x4 l4 = (t <= 4) ? la[t - 1] : la[4 + 2 * (t - 5) + q];
#pragma unroll
                for (int e = 0; e < 4; ++e) if (4 * q + e < t) acc += (float)SGN * l4[e] * x[4 * q + e]; }
            x[t] = acc; }
    }
    __builtin_amdgcn_sched_barrier(0);
    {   f32x4 lb[12];
#pragma unroll
        for (int t = 9; t <= 12; ++t)
#pragma unroll
            for (int q = 0; q < 3; ++q) lb[3 * (t - 9) + q] = *(LAS const f32x4*)(Lm + t * 16 + 4 * q);
        __builtin_amdgcn_sched_barrier(0);
#pragma unroll
        for (int t = 9; t <= 12; ++t) { float acc = (n == t) ? 1.f : 0.f;
#pragma unroll
            for (int q = 0; q < 3; ++q) { const f32x4 l4 = lb[3 * (t - 9) + q];
#pragma unroll
                for (int e = 0; e < 4; ++e) if (4 * q + e < t) acc += (float)SGN * l4[e] * x[4 * q + e]; }
            x[t] = acc; }
    }
    __builtin_amdgcn_sched_barrier(0);
    {   f32x4 lc[12];
#pragma unroll
        for (int t = 13; t <= 15; ++t)
#pragma unroll
            for (int q = 0; q < 4; ++q) lc[4 * (t - 13) + q] = *(LAS const f32x4*)(Lm + t * 16 + 4 * q);
        __builtin_amdgcn_sched_barrier(0);
#pragma unroll
        for (int t = 13; t <= 15; ++t) { float acc = (n == t) ? 1.f : 0.f;
#pragma unroll
            for (int q = 0; q < 4; ++q) { const f32x4 l4 = lc[4 * (t - 13) + q];
#pragma unroll
                for (int e = 0; e < 4; ++e) if (4 * q + e < t) acc += (float)SGN * l4[e] * x[4 * q + e]; }
            x[t] = acc; }
    }
}

constexpr size_t WS_TA = 436 * MiB;
constexpr size_t WS_AMA = 444 * MiB;
constexpr size_t WS_SCA = 452 * MiB;

__device__ __forceinline__ void prep_delta(LAS unsigned char* lds, PPTR p, int j) {
    const int tid = tidx(), w = tid >> 6, lane = tid & 63, n = lane & 15, kg = lane >> 4;
    LAS unsigned char* qs = lds + w * 9984; LAS unsigned char* ks = qs + 4352; LAS float* Lm = (LAS float*)(ks + 4352); LAS float* sc = Lm + 256;
    const bf16_t* P = (const bf16_t*)(p->ws + WS_PROJ);
    bf16_t* Qg = (bf16_t*)(p->ws + WS_R1); bf16_t* Kg = (bf16_t*)(p->ws + WS_KG);
    bf16_t* Tg = (bf16_t*)(p->ws + WS_TA); bf16_t* Amg = (bf16_t*)(p->ws + WS_AMA); float* Scg = (float*)(p->ws + WS_SCA);
    const float* cv = p->in[6] + (size_t)j * 4 * 3072;
    for (int task = bidx() * 8 + w; task < 4 * 512 * 8; task += gdim() * 8) {
        const int h = task & 7, rc = task >> 3; const size_t row0 = (size_t)rc * 16; const int t0 = (rc & 511) * 16;
        float cwq[4][2], cwk[4][2];
#pragma unroll
        for (int jj = 0; jj < 4; ++jj) { cwq[jj][0] = cv[jj * 3072 + h * 128 + 2 * lane]; cwq[jj][1] = cv[jj * 3072 + h * 128 + 2 * lane + 1];
            cwk[jj][0] = cv[jj * 3072 + 1024 + h * 128 + 2 * lane]; cwk[jj][1] = cv[jj * 3072 + 1024 + h * 128 + 2 * lane + 1]; }
        unsigned xq[19], xk[19];
#pragma unroll
        for (int r = 0; r < 19; ++r) { const bool valid = (t0 + r - 3) >= 0; const bf16_t* rowp = P + (row0 + (valid ? r - 3 : 0)) * 4352 + h * 128 + 2 * lane;
            const unsigned vq = *(const unsigned*)rowp, vk = *(const unsigned*)(rowp + 1024); xq[r] = valid ? vq : 0u; xk[r] = valid ? vk : 0u; }
        float beta, G;
        { const bf16_t* rowp = P + (row0 + n) * 4352; const float a_raw = bf2f(rowp[4096 + h]), b_raw = bf2f(rowp[4104 + h]);
          beta = sigmoidf_(b_raw); G = -__expf(p->in[7][j * 8 + h]) * softplusf_(a_raw + p->in[8][j * 8 + h]);
          float tq; tq = __int_as_float(__builtin_amdgcn_update_dpp(0, __float_as_int(G), 0x111, 0xf, 0xf, true)); G += tq;
          tq = __int_as_float(__builtin_amdgcn_update_dpp(0, __float_as_int(G), 0x112, 0xf, 0xf, true)); G += tq;
          tq = __int_as_float(__builtin_amdgcn_update_dpp(0, __float_as_int(G), 0x114, 0xf, 0xf, true)); G += tq;
          tq = __int_as_float(__builtin_amdgcn_update_dpp(0, __float_as_int(G), 0x118, 0xf, 0xf, true)); G += tq; }
        const float G15 = __int_as_float(__builtin_amdgcn_readlane(__float_as_int(G), 15));
        if (lane < 16) { sc[lane] = beta; sc[16 + lane] = G;
            float* so = Scg + (size_t)task * 64; so[lane] = beta; so[16 + lane] = __expf(G); so[32 + lane] = __expf(G15 - G); if (lane == 0) so[48] = __expf(G15); }
#pragma unroll
        for (int t = 0; t < 16; ++t) {
            float yq0 = 0.f, yq1 = 0.f, yk0 = 0.f, yk1 = 0.f;
#pragma unroll
            for (int jj = 0; jj < 4; ++jj) { yq0 += cwq[jj][0] * bflo(xq[t + jj]); yq1 += cwq[jj][1] * bfhi(xq[t + jj]); yk0 += cwk[jj][0] * bflo(xk[t + jj]); yk1 += cwk[jj][1] * bfhi(xk[t + jj]); }
            yq0 = siluf_(yq0); yq1 = siluf_(yq1); yk0 = siluf_(yk0); yk1 = siluf_(yk1);
            const float ssq = wave_allsum(yq0 * yq0 + yq1 * yq1), ssk = wave_allsum(yk0 * yk0 + yk1 * yk1);
            const float rq = __builtin_amdgcn_rsqf(ssq + 1e-6f) * 0.08838834764831845f, rk = __builtin_amdgcn_rsqf(ssk + 1e-6f);
            const unsigned qp = pack2(yq0 * rq, yq1 * rq), kp = pack2(yk0 * rk, yk1 * rk);
            *(unsigned*)(Qg + (row0 + t) * 1024 + h * 128 + 2 * lane) = qp; *(unsigned*)(Kg + (row0 + t) * 1024 + h * 128 + 2 * lane) = kp;
            *(LAS unsigned*)(qs + t * 272 + 4 * lane) = qp; *(LAS unsigned*)(ks + t * 272 + 4 * lane) = kp;
        }
        asm volatile("s_waitcnt lgkmcnt(0)" ::: "memory");
        f32x4 akk = (f32x4){0.f, 0.f, 0.f, 0.f}, aqk = akk;
#pragma unroll
        for (int a = 0; a < 4; ++a) {
            const bf16x8 qf = *(LAS const bf16x8*)(qs + n * 272 + (32 * a + 8 * kg) * 2);
            const bf16x8 kf = *(LAS const bf16x8*)(ks + n * 272 + (32 * a + 8 * kg) * 2);
            akk = __builtin_amdgcn_mfma_f32_16x16x32_bf16(kf, kf, akk, 0, 0, 0);
            aqk = __builtin_amdgcn_mfma_f32_16x16x32_bf16(qf, kf, aqk, 0, 0, 0);
        }
        { const float Gn = sc[16 + n]; const f32x4 bt = *(LAS const f32x4*)(sc + 4 * kg), Gt = *(LAS const f32x4*)(sc + 16 + 4 * kg);
#pragma unroll
          for (int jj = 0; jj < 4; ++jj) { const int t = 4 * kg + jj; const float dec = __expf(Gt[jj] - Gn);
              Lm[t * 16 + n] = (n < t) ? bt[jj] * akk[jj] * dec : 0.f;
              Amg[(size_t)task * 256 + t * 16 + n] = (bf16_t)f2bf(n <= t ? aqk[jj] * dec : 0.f); } }
        asm volatile("s_waitcnt lgkmcnt(0)" ::: "memory");
        float x[16];
        tri_inv16<-1>(Lm, n, x);
#pragma unroll
        for (int jj = 0; jj < 4; ++jj) { const float v = (kg == 0) ? x[jj] : (kg == 1 ? x[4 + jj] : (kg == 2 ? x[8 + jj] : x[12 + jj]));
            Tg[(size_t)task * 256 + (4 * kg + jj) * 16 + n] = (bf16_t)f2bf(v); }
        asm volatile("s_waitcnt lgkmcnt(0)" ::: "memory");
    }
}

__device__ __forceinline__ void scan_delta(LAS unsigned char* lds, PPTR p, int j) {
    constexpr int QOFF = 0, KOFF = 4352, KTOFF = 8704, VOFF = 13824, TOFF = 18992, AMOFF = 19504, SCOFF = 20016, BUFB = 20272;
    const int tid = tidx(), w = tid >> 6, lane = tid & 63, n = lane & 15, kg = lane >> 4;
    const bf16_t* P = (const bf16_t*)(p->ws + WS_PROJ);
    bf16_t* Qg = (bf16_t*)(p->ws + WS_R1); const bf16_t* Kg = (const bf16_t*)(p->ws + WS_KG);
    const bf16_t* Tg = (const bf16_t*)(p->ws + WS_TA); const bf16_t* Amg = (const bf16_t*)(p->ws + WS_AMA); const float* Scg = (const float*)(p->ws + WS_SCA);
    const float* cv = p->in[6] + (size_t)j * 4 * 3072;
    const bf16x4 z4 = (bf16x4){0, 0, 0, 0};
    for (int task = bidx(); task < 32; task += gdim()) {
        const int b = task >> 3, h = task & 7; const size_t rowbase = (size_t)b * SEQ;
        float cwv[4];
#pragma unroll
        for (int jj = 0; jj < 4; ++jj) cwv[jj] = cv[jj * 3072 + 2048 + h * 128 + 16 * w + n];
        f32x4 S[8]; bf16x8 Sb[4];
#pragma unroll
        for (int i = 0; i < 8; ++i) S[i] = (f32x4){0.f, 0.f, 0.f, 0.f};
#pragma unroll
        for (int a = 0; a < 4; ++a) Sb[a] = (bf16x8){0, 0, 0, 0, 0, 0, 0, 0};
        const int lt = (tid & 255) >> 4, pc = tid & 15, vr = tid >> 4;
        constexpr int PD = 8;
        u32x4 g0[PD], g1[PD];
#define DL_LOAD(cc, sl) do { const int c_ = (cc); const size_t r_ = rowbase + (size_t)c_ * 16 + lt; const size_t ch_ = ((size_t)(b * 512 + c_) * 8 + h); \
            if (tid < 256) g0[sl] = *(const u32x4*)(Qg + r_ * 1024 + h * 128 + 8 * pc); else g0[sl] = *(const u32x4*)(Kg + r_ * 1024 + h * 128 + 8 * pc); \
            if (tid < 304) { const int tv_ = c_ * 16 + vr - 3; const u32x4 vv_ = *(const u32x4*)(P + (rowbase + (tv_ >= 0 ? tv_ : 0)) * 4352 + 2048 + h * 128 + 8 * pc); g1[sl] = (tv_ >= 0) ? vv_ : (u32x4){0u, 0u, 0u, 0u}; } \
            else if (tid >= 320 && tid < 352) g1[sl] = *(const u32x4*)(Tg + ch_ * 256 + (tid - 320) * 8); \
            else if (tid >= 352 && tid < 384) g1[sl] = *(const u32x4*)(Amg + ch_ * 256 + (tid - 352) * 8); \
            else if (tid >= 384 && tid < 400) g1[sl] = *(const u32x4*)(Scg + ch_ * 64 + (tid - 384) * 4); } while (0)
#define DL_STORE(cc, sl) do { LAS unsigned char* bb_ = lds + ((cc) & 1) * BUFB; \
            if (tid < 256) *(LAS u32x4*)(bb_ + QOFF + lt * 272 + 16 * pc) = g0[sl]; \
            else { *(LAS u32x4*)(bb_ + KOFF + lt * 272 + 16 * pc) = g0[sl]; \
                _Pragma("unroll") for (int e = 0; e < 4; ++e) { *(LAS unsigned short*)(bb_ + KTOFF + (8 * pc + 2 * e) * 40 + 2 * lt) = (unsigned short)(g0[sl][e] & 0xffffu); \
                    *(LAS unsigned short*)(bb_ + KTOFF + (8 * pc + 2 * e + 1) * 40 + 2 * lt) = (unsigned short)(g0[sl][e] >> 16); } } \
            if (tid < 304) *(LAS u32x4*)(bb_ + VOFF + vr * 272 + 16 * pc) = g1[sl]; \
            else if (tid >= 320 && tid < 352) *(LAS u32x4*)(bb_ + TOFF + (tid - 320) * 16) = g1[sl]; \
            else if (tid >= 352 && tid < 384) *(LAS u32x4*)(bb_ + AMOFF + (tid - 352) * 16) = g1[sl]; \
            else if (tid >= 384 && tid < 400) *(LAS u32x4*)(bb_ + SCOFF + (tid - 384) * 16) = g1[sl]; } while (0)
#pragma unroll
        for (int d = 0; d < PD; ++d) DL_LOAD(d, d);
        DL_STORE(0, 0); lds_barrier();
        for (int c0 = 0; c0 < 512; c0 += PD) {
#pragma unroll
          for (int d = 0; d < PD; ++d) {
            const int c = c0 + d;
            if (c + PD < 512) DL_LOAD(c + PD, d);
            LAS const unsigned char* bb = lds + (c & 1) * BUFB;
            float vraw[7];
#pragma unroll
            for (int r = 0; r < 7; ++r) vraw[r] = bf2f(*(LAS const unsigned short*)(bb + VOFF + (4 * kg + r) * 272 + (16 * w + n) * 2));
            f32x4 v4;
#pragma unroll
            for (int jj = 0; jj < 4; ++jj) v4[jj] = siluf_(cwv[0] * vraw[jj] + cwv[1] * vraw[jj + 1] + cwv[2] * vraw[jj + 2] + cwv[3] * vraw[jj + 3]);
            f32x4 X = (f32x4){0.f, 0.f, 0.f, 0.f}, Z = X;
#pragma unroll
            for (int a = 0; a < 4; ++a) {
                const bf16x4 klo = *(LAS const bf16x4*)(bb + KOFF + n * 272 + (32 * a + 4 * kg) * 2), khi = *(LAS const bf16x4*)(bb + KOFF + n * 272 + (32 * a + 16 + 4 * kg) * 2);
                X = __builtin_amdgcn_mfma_f32_16x16x32_bf16(cat4(klo, khi), Sb[a], X, 0, 0, 0);
                const bf16x4 qlo = *(LAS const bf16x4*)(bb + QOFF + n * 272 + (32 * a + 4 * kg) * 2), qhi = *(LAS const bf16x4*)(bb + QOFF + n * 272 + (32 * a + 16 + 4 * kg) * 2);
                Z = __builtin_amdgcn_mfma_f32_16x16x32_bf16(cat4(qlo, qhi), Sb[a], Z, 0, 0, 0);
            }
            const f32x4 be4 = *(LAS const f32x4*)(bb + SCOFF + (4 * kg) * 4), eg4 = *(LAS const f32x4*)(bb + SCOFF + (16 + 4 * kg) * 4), egl4 = *(LAS const f32x4*)(bb + SCOFF + (32 + 4 * kg) * 4);
            const float glast = *(LAS const float*)(bb + SCOFF + 48 * 4);
            const f32x4 R = be4 * (v4 - eg4 * X);
            const bf16x4 tf = *(LAS const bf16x4*)(bb + TOFF + n * 32 + 8 * kg);
            const f32x4 vnew = __builtin_amdgcn_mfma_f32_16x16x32_bf16(cat4(tf, z4), cat4(cvt4(R), z4), (f32x4){0.f, 0.f, 0.f, 0.f}, 0, 0, 0);
            const bf16x4 am = *(LAS const bf16x4*)(bb + AMOFF + n * 32 + 8 * kg);
            const f32x4 o = __builtin_amdgcn_mfma_f32_16x16x32_bf16(cat4(am, z4), cat4(cvt4(vnew), z4), Z * eg4, 0, 0, 0);
            const bf16x8 B2 = cat4(cvt4(vnew * egl4), z4);
#pragma unroll
            for (int i = 0; i < 8; ++i) {
                const bf16x4 kt = *(LAS const bf16x4*)(bb + KTOFF + (16 * i + n) * 40 + 8 * kg);
                S[i] = __builtin_amdgcn_mfma_f32_16x16x32_bf16(cat4(kt, z4), B2, S[i] * glast, 0, 0, 0);
            }
#pragma unroll
            for (int a = 0; a < 4; ++a) Sb[a] = cat4(cvt4(S[2 * a]), cvt4(S[2 * a + 1]));
#pragma unroll
            for (int jj = 0; jj < 4; ++jj) Qg[(rowbase + (size_t)c * 16 + 4 * kg + jj) * 1024 + h * 128 + 16 * w + n] = (bf16_t)f2bf(o[jj]);
            if (c + 1 < 512) DL_STORE(c + 1, (d + 1) % PD);
            lds_barrier();
          }
        }
#undef DL_LOAD
#undef DL_STORE
    }
}


constexpr size_t WS_GCG = 500 * MiB;
constexpr size_t WS_BNG = 508 * MiB;
__device__ __forceinline__ void prep_rwkv_elem(PPTR p) {
    const int tid = tidx(), w = tid >> 6, lane = tid & 63;
    bf16_t* P = (bf16_t*)(p->ws + WS_PROJC); bf16_t* L2 = (bf16_t*)(p->ws + WS_R1);
    float* GCg = (float*)(p->ws + WS_GCG); float* BNg = (float*)(p->ws + WS_BNG);
    for (int task = bidx() * 8 + w; task < 4 * 512 * 16; task += gdim() * 8) {
        const int h = task & 15, rc = task >> 4; const size_t row0 = (size_t)rc * 16; const int ch = h * 64 + lane;
        const float w0v = p->in[17][ch], a0v = p->in[20][ch], kkc = p->in[25][ch], kac = p->in[26][ch], rkc = p->in[27][ch];
        unsigned xr[16], xk[16], xw[16], xa[16];
#pragma unroll
        for (int t = 0; t < 16; ++t) { const bf16_t* rowp = P + (row0 + t) * 3328 + ch; const bf16_t* l2p = L2 + (row0 + t) * 3072 + ch;
            xr[t] = rowp[0]; xk[t] = rowp[1024]; xw[t] = l2p[0]; xa[t] = l2p[1024]; }
        float lg = 0.f;
#pragma unroll
        for (int t = 0; t < 16; ++t) {
            const float r = bf2f(xr[t]), kraw = bf2f(xk[t]), whi = bf2f(xw[t]), ahi = bf2f(xa[t]);
            const float wv = -softplusf_(-(w0v + whi)) - 0.5f; const float ew = __expf(wv);
            const float lgp = lg; lg -= ew;
            const float ag = sigmoidf_(a0v + ahi);
            const float kkx = kraw * kkc; const float ss = wave_allsum(kkx * kkx); const float kk = kkx * __builtin_amdgcn_rsqf(ss + 1e-6f);
            const float kp = kraw * (1.0f + (ag - 1.0f) * kac);
            const float bonus = wave_allsum(r * kp * rkc);
            const float inv = __expf(-lg);
            bf16_t* rowp = P + (row0 + t) * 3328 + ch; bf16_t* l2p = L2 + (row0 + t) * 3072 + ch;
            rowp[0] = (bf16_t)f2bf(-kk * __expf(lgp)); rowp[1024] = (bf16_t)f2bf(r * __expf(lg));
            l2p[0] = (bf16_t)f2bf(kk * ag * inv); l2p[1024] = (bf16_t)f2bf(kp * inv);
            if (lane == 0) BNg[(row0 + t) * 16 + h] = bonus;
        }
        GCg[(size_t)task * 64 + lane] = __expf(lg);
    }
}

__device__ __forceinline__ void scan_rwkv(LAS unsigned char* lds, PPTR p) {
    constexpr int AH = 0, RH = 2304, BMT = 4608, KMT = 7168, TM = 9728, LAK = 10240, MRB = 10752, MRK = 11264, VV = 11776, GC = 14080, SLOT = 14336;
    constexpr int PRIV = 8 * SLOT, PRIVSZ = 5632;
    const int tid = tidx(), wave = tid >> 6, lane = tid & 63, n = lane & 15, kg = lane >> 4;
    const bf16_t* P = (const bf16_t*)(p->ws + WS_PROJC); const bf16_t* L2 = (const bf16_t*)(p->ws + WS_R1);
    bf16_t* Og = (bf16_t*)(p->ws + WS_OC);
    const int G = gdim(); const int vcu = (G % 8 == 0) ? (int)(bidx() % 8) * (G / 8) + (int)(bidx() / 8) : (int)bidx();
    for (int task = vcu; task < 256; task += G) {
        const int bh = task >> 2, slice = task & 3, b = bh >> 4, h = bh & 15; const size_t rowbase = (size_t)b * SEQ;
        const int pwr = (wave >= 1 && wave <= 3) ? wave - 1 : (wave == 5 ? 3 : -1);
        if (pwr >= 0) {
            const int pw = pwr; const int ch = h * 64 + lane;
            LAS unsigned char* bh = lds + PRIV + pw * PRIVSZ; LAS unsigned char* kh = bh + 2304; LAS float* Lm = (LAS float*)(kh + 2304);
            const float* GCg = (const float*)(p->ws + WS_GCG);
            unsigned xr[16], xk[16], xv[16], xw[16], xa[16]; float gCn;
#define RW_LOAD(cc, T0) do { _Pragma("unroll") for (int t = (T0); t < (T0) + 8; ++t) { const size_t r_ = rowbase + (size_t)(cc) * 16 + t; const bf16_t* rowp = P + r_ * 3328 + ch; const bf16_t* l2p = L2 + r_ * 3072 + ch; \
                xr[t] = rowp[0]; xk[t] = rowp[1024]; xv[t] = rowp[2048]; xw[t] = l2p[0]; xa[t] = l2p[1024]; } \
                if ((T0) == 8) gCn = GCg[((size_t)(b * 512 + (cc)) * 16 + h) * 64 + lane]; } while (0)
            RW_LOAD(pw, 0); RW_LOAD(pw, 8);
            for (int m = -1; m < 128; ++m) {
                const int cc = 4 * (m + 1) + pw;
                if (cc < 512) {
                    LAS unsigned char* sl = lds + (cc & 7) * SLOT;
                    const float gC = gCn; float bhat[16], khat[16];
#pragma unroll
                    for (int t = 0; t < 16; ++t) {
                        bhat[t] = bf2f(xw[t]); khat[t] = bf2f(xa[t]);
                        *(LAS unsigned short*)(sl + AH + t * 144 + 2 * lane) = (unsigned short)xr[t];
                        *(LAS unsigned short*)(sl + RH + t * 144 + 2 * lane) = (unsigned short)xk[t];
                        *(LAS unsigned short*)(bh + t * 144 + 2 * lane) = (unsigned short)xw[t];
                        *(LAS unsigned short*)(kh + t * 144 + 2 * lane) = (unsigned short)xa[t];
                        *(LAS unsigned short*)(sl + VV + t * 144 + 2 * lane) = (unsigned short)xv[t];
                    }
                    if (cc + 4 < 512) { RW_LOAD(cc + 4, 0); RW_LOAD(cc + 4, 8); }
                    *(LAS float*)(sl + GC + 4 * lane) = gC;
#pragma unroll
                    for (int q = 0; q < 4; ++q) {
                        u32x2 wb, wk; wb.x = pack2(bhat[4 * q] * gC, bhat[4 * q + 1] * gC); wb.y = pack2(bhat[4 * q + 2] * gC, bhat[4 * q + 3] * gC);
                        wk.x = pack2(khat[4 * q] * gC, khat[4 * q + 1] * gC); wk.y = pack2(khat[4 * q + 2] * gC, khat[4 * q + 3] * gC);
                        *(LAS u32x2*)(sl + BMT + lane * 40 + 8 * q) = wb; *(LAS u32x2*)(sl + KMT + lane * 40 + 8 * q) = wk;
                    }
                    asm volatile("s_waitcnt lgkmcnt(0)" ::: "memory");
                    f32x4 lab = (f32x4){0.f, 0.f, 0.f, 0.f}, lak = lab, mrb = lab, mrk = lab;
#pragma unroll
                    for (int a = 0; a < 2; ++a) {
                        const bf16x8 af = *(LAS const bf16x8*)(sl + AH + n * 144 + (32 * a + 8 * kg) * 2), rf = *(LAS const bf16x8*)(sl + RH + n * 144 + (32 * a + 8 * kg) * 2);
                        const bf16x8 bf_ = *(LAS const bf16x8*)(bh + n * 144 + (32 * a + 8 * kg) * 2), kf = *(LAS const bf16x8*)(kh + n * 144 + (32 * a + 8 * kg) * 2);
                        lab = __builtin_amdgcn_mfma_f32_16x16x32_bf16(af, bf_, lab, 0, 0, 0); lak = __builtin_amdgcn_mfma_f32_16x16x32_bf16(af, kf, lak, 0, 0, 0);
                        mrb = __builtin_amdgcn_mfma_f32_16x16x32_bf16(rf, bf_, mrb, 0, 0, 0); mrk = __builtin_amdgcn_mfma_f32_16x16x32_bf16(rf, kf, mrk, 0, 0, 0);
                    }
#pragma unroll
                    for (int jj = 0; jj < 4; ++jj) { const int t = 4 * kg + jj;
                        Lm[t * 16 + n] = (n < t) ? lab[jj] : 0.f;
                        *(LAS unsigned short*)(sl + LAK + t * 32 + 2 * n) = (unsigned short)f2bf(n < t ? lak[jj] : 0.f);
                        *(LAS unsigned short*)(sl + MRB + t * 32 + 2 * n) = (unsigned short)f2bf(n <= t ? mrb[jj] : 0.f);
                        *(LAS unsigned short*)(sl + MRK + t * 32 + 2 * n) = (unsigned short)f2bf(n <= t ? mrk[jj] : 0.f); }
                    asm volatile("s_waitcnt lgkmcnt(0)" ::: "memory");
                    float x[16];
                    tri_inv16<1>(Lm, n, x);
#pragma unroll
                    for (int jj = 0; jj < 4; ++jj) { const float v = (kg == 0) ? x[jj] : (kg == 1 ? x[4 + jj] : (kg == 2 ? x[8 + jj] : x[12 + jj]));
                        *(LAS unsigned short*)(sl + TM + (4 * kg + jj) * 32 + 2 * n) = (unsigned short)f2bf(v); }
                }
                lds_barrier();
            }
#undef RW_LOAD
        } else if (wave != 0) {
            for (int m = -1; m < 128; ++m) lds_barrier();
        } else {
            const int w = slice;
            f32x4 Zt[4]; bf16x8 Zb[2];
#pragma unroll
            for (int i = 0; i < 4; ++i) Zt[i] = (f32x4){0.f, 0.f, 0.f, 0.f};
            Zb[0] = (bf16x8){0, 0, 0, 0, 0, 0, 0, 0}; Zb[1] = Zb[0];
            struct RwOps { bf16x4 alo[2], ahi[2], rlo[2], rhi[2], vf, lakf, tf, mb, mk, bt[4], kt[4]; f32x4 g4[4]; };
#define RW_OPLOAD(R, cidx) do { LAS const unsigned char* sl_ = lds + ((cidx) & 7) * SLOT; \
                _Pragma("unroll") for (int a = 0; a < 2; ++a) { \
                    R.alo[a] = *(LAS const bf16x4*)(sl_ + AH + n * 144 + (32 * a + 4 * kg) * 2); R.ahi[a] = *(LAS const bf16x4*)(sl_ + AH + n * 144 + (32 * a + 16 + 4 * kg) * 2); \
                    R.rlo[a] = *(LAS const bf16x4*)(sl_ + RH + n * 144 + (32 * a + 4 * kg) * 2); R.rhi[a] = *(LAS const bf16x4*)(sl_ + RH + n * 144 + (32 * a + 16 + 4 * kg) * 2); } \
                _Pragma("unroll") for (int jj = 0; jj < 4; ++jj) R.vf[jj] = *(LAS const short*)(sl_ + VV + (4 * kg + jj) * 144 + (16 * w + n) * 2); \
                R.lakf = *(LAS const bf16x4*)(sl_ + LAK + n * 32 + 8 * kg); R.tf = *(LAS const bf16x4*)(sl_ + TM + n * 32 + 8 * kg); \
                R.mb = *(LAS const bf16x4*)(sl_ + MRB + n * 32 + 8 * kg); R.mk = *(LAS const bf16x4*)(sl_ + MRK + n * 32 + 8 * kg); \
                _Pragma("unroll") for (int i = 0; i < 4; ++i) { R.g4[i] = *(LAS const f32x4*)(sl_ + GC + (16 * i + 4 * kg) * 4); \
                    R.bt[i] = *(LAS const bf16x4*)(sl_ + BMT + (16 * i + n) * 40 + 8 * kg); R.kt[i] = *(LAS const bf16x4*)(sl_ + KMT + (16 * i + n) * 40 + 8 * kg); } } while (0)
#define RW_COMPUTE(R, cidx) do { \
                f32x4 P1 = (f32x4){0.f, 0.f, 0.f, 0.f}, Oa = P1; \
                _Pragma("unroll") for (int a = 0; a < 2; ++a) { P1 = __builtin_amdgcn_mfma_f32_16x16x32_bf16(cat4(R.alo[a], R.ahi[a]), Zb[a], P1, 0, 0, 0); \
                    Oa = __builtin_amdgcn_mfma_f32_16x16x32_bf16(cat4(R.rlo[a], R.rhi[a]), Zb[a], Oa, 0, 0, 0); } \
                P1 = __builtin_amdgcn_mfma_f32_16x16x32_bf16(cat4(R.lakf, z4), cat4(R.vf, z4), P1, 0, 0, 0); \
                const f32x4 Y = __builtin_amdgcn_mfma_f32_16x16x32_bf16(cat4(R.tf, z4), cat4(cvt4(P1), z4), (f32x4){0.f, 0.f, 0.f, 0.f}, 0, 0, 0); \
                const bf16x8 Byv = cat4(cvt4(Y), R.vf); \
                Oa = __builtin_amdgcn_mfma_f32_16x16x32_bf16(cat4(R.mb, R.mk), Byv, Oa, 0, 0, 0); \
                _Pragma("unroll") for (int i = 0; i < 4; ++i) Zt[i] = __builtin_amdgcn_mfma_f32_16x16x32_bf16(cat4(R.bt[i], R.kt[i]), Byv, Zt[i] * R.g4[i], 0, 0, 0); \
                Zb[0] = cat4(cvt4(Zt[0]), cvt4(Zt[1])); Zb[1] = cat4(cvt4(Zt[2]), cvt4(Zt[3])); \
                _Pragma("unroll") for (int jj = 0; jj < 4; ++jj) Og[(rowbase + (size_t)(cidx) * 16 + 4 * kg + jj) * 1024 + h * 64 + 16 * w + n] = (bf16_t)f2bf(Oa[jj]); } while (0)
            const bf16x4 z4 = (bf16x4){0, 0, 0, 0};
            lds_barrier();
            for (int m = 0; m < 128; ++m) {
                RwOps OA, OB;
                RW_OPLOAD(OA, 4 * m);
                RW_OPLOAD(OB, 4 * m + 1); __builtin_amdgcn_sched_barrier(0);
                RW_COMPUTE(OA, 4 * m); __builtin_amdgcn_sched_barrier(0);
                RW_OPLOAD(OA, 4 * m + 2); __builtin_amdgcn_sched_barrier(0);
                RW_COMPUTE(OB, 4 * m + 1); __builtin_amdgcn_sched_barrier(0);
                RW_OPLOAD(OB, 4 * m + 3); __builtin_amdgcn_sched_barrier(0);
                RW_COMPUTE(OA, 4 * m + 2); __builtin_amdgcn_sched_barrier(0);
                RW_COMPUTE(OB, 4 * m + 3);
                lds_barrier();
            }
#undef RW_OPLOAD
#undef RW_COMPUTE
        }
    }
}


template <int KIND>
__device__ __forceinline__ void scan_chunked(LAS unsigned char* lds, PPTR p, int j) {
    constexpr int QOFF = 0, KOFF = 4352, KTOFF = 8704, VOFF = 13824, TOFF = 14464, AMOFF = 14976, SCOFF = 15488, OBOFF = 16000, BUFB = 17024;
    constexpr int LDP = (KIND == 0) ? 4352 : 4096;
    constexpr int VROWS = (KIND == 0) ? 19 : 16, VEND = 512 + 2 * VROWS;
    constexpr int TEND = (KIND == 0) ? VEND + 32 : VEND, AEND = TEND + 32, SEND = AEND + ((KIND == 0) ? 16 : 32);
    const int tid = tidx(), wave = tid >> 6, lane = tid & 63, n = lane & 15, kg = lane >> 4;
    const bf16_t* P = (const bf16_t*)(p->ws + WS_PROJ);
    const bf16_t* Qg = (const bf16_t*)(p->ws + WS_R1); const bf16_t* Kg = (const bf16_t*)(p->ws + WS_KG);
    const bf16_t* Tg = (const bf16_t*)(p->ws + WS_TA);
    const bf16_t* Amg = (const bf16_t*)(p->ws + (KIND == 0 ? WS_AMA : WS_AM));
    const float* Scg = (const float*)(p->ws + (KIND == 0 ? WS_SCA : WS_DEC));
    bf16_t* Og = (KIND == 0) ? (bf16_t*)(p->ws + WS_PROJ) : (bf16_t*)(p->ws + WS_OC);
    constexpr int LDO = (KIND == 0) ? 4352 : 1024;
    const bf16x4 z4 = (bf16x4){0, 0, 0, 0};
    const int G = gdim(); const int vcu = (G % 8 == 0) ? (int)(bidx() % 8) * (G / 8) + (int)(bidx() / 8) : (int)bidx();
    for (int task = vcu; task < 256; task += G) {
        const int bh = task >> 3, w = task & 7, b = bh >> 3, h = bh & 7; const size_t rowbase = (size_t)b * SEQ;
        if (wave == 0) {
            float cwv[4] = {0.f, 0.f, 0.f, 0.f};
            if (KIND == 0) { const float* cv = p->in[6] + (size_t)j * 4 * 3072;
#pragma unroll
                for (int jj = 0; jj < 4; ++jj) cwv[jj] = cv[jj * 3072 + 2048 + h * 128 + 16 * w + n]; }
            f32x4 S[8]; bf16x8 Sb[4];
#pragma unroll
            for (int i = 0; i < 8; ++i) S[i] = (f32x4){0.f, 0.f, 0.f, 0.f};
#pragma unroll
            for (int a = 0; a < 4; ++a) Sb[a] = (bf16x8){0, 0, 0, 0, 0, 0, 0, 0};
            lds_barrier();
            for (int c2 = 0; c2 < 512; c2 += 4) {
#pragma unroll 1
              for (int u = 0; u < 4; ++u) { const int c = c2 + u;
                LAS unsigned char* bb = lds + (c & 7) * BUFB;
                bf16x4 klo[4], khi[4], qlo[4], qhi[4], kt[8], am, tf = z4; f32x4 be4, eg4, egl4, d4[8]; float glast = 0.f; unsigned vr16[7]; bf16x4 vb = z4;
#pragma unroll
                for (int a = 0; a < 4; ++a) {
                    if (KIND == 0) { klo[a] = *(LAS const bf16x4*)(bb + KOFF + n * 272 + (32 * a + 4 * kg) * 2); khi[a] = *(LAS const bf16x4*)(bb + KOFF + n * 272 + (32 * a + 16 + 4 * kg) * 2); }
                    qlo[a] = *(LAS const bf16x4*)(bb + QOFF + n * 272 + (32 * a + 4 * kg) * 2); qhi[a] = *(LAS const bf16x4*)(bb + QOFF + n * 272 + (32 * a + 16 + 4 * kg) * 2); }
                if (KIND == 0) {
#pragma unroll
                    for (int r = 0; r < 7; ++r) vr16[r] = *(LAS const unsigned short*)(bb + VOFF + (4 * kg + r) * 32 + 2 * n);
                    be4 = *(LAS const f32x4*)(bb + SCOFF + (4 * kg) * 4); eg4 = *(LAS const f32x4*)(bb + SCOFF + (16 + 4 * kg) * 4); egl4 = *(LAS const f32x4*)(bb + SCOFF + (32 + 4 * kg) * 4);
                    glast = *(LAS const float*)(bb + SCOFF + 48 * 4); tf = *(LAS const bf16x4*)(bb + TOFF + n * 32 + 8 * kg);
                } else {
#pragma unroll
                    for (int jj = 0; jj < 4; ++jj) vb[jj] = *(LAS const short*)(bb + VOFF + (4 * kg + jj) * 32 + 2 * n);
#pragma unroll
                    for (int i = 0; i < 8; ++i) d4[i] = *(LAS const f32x4*)(bb + SCOFF + (16 * i + 4 * kg) * 4);
                }
                am = *(LAS const bf16x4*)(bb + AMOFF + n * 32 + 8 * kg);
#pragma unroll
                for (int i = 0; i < 8; ++i) kt[i] = *(LAS const bf16x4*)(bb + KTOFF + (16 * i + n) * 40 + 8 * kg);
                __builtin_amdgcn_sched_barrier(0);
                asm volatile("s_waitcnt lgkmcnt(0)" ::: "memory");
                __builtin_amdgcn_sched_barrier(0);
                f32x4 v4 = (f32x4){0.f, 0.f, 0.f, 0.f};
                if (KIND == 0) {
#pragma unroll
                    for (int jj = 0; jj < 4; ++jj) v4[jj] = siluf_(cwv[0] * bf2f(vr16[jj]) + cwv[1] * bf2f(vr16[jj + 1]) + cwv[2] * bf2f(vr16[jj + 2]) + cwv[3] * bf2f(vr16[jj + 3]));
                }
                f32x4 X = (f32x4){0.f, 0.f, 0.f, 0.f}, Z = X;
#pragma unroll
                for (int a = 0; a < 4; ++a) {
                    if (KIND == 0) X = __builtin_amdgcn_mfma_f32_16x16x32_bf16(cat4(klo[a], khi[a]), Sb[a], X, 0, 0, 0);
                    Z = __builtin_amdgcn_mfma_f32_16x16x32_bf16(cat4(qlo[a], qhi[a]), Sb[a], Z, 0, 0, 0);
                }
                f32x4 o; bf16x8 B2;
                if (KIND == 0) {
                    const f32x4 R = be4 * (v4 - eg4 * X);
                    const f32x4 vnew = __builtin_amdgcn_mfma_f32_16x16x32_bf16(cat4(tf, z4), cat4(cvt4(R), z4), (f32x4){0.f, 0.f, 0.f, 0.f}, 0, 0, 0);
                    o = __builtin_amdgcn_mfma_f32_16x16x32_bf16(cat4(am, z4), cat4(cvt4(vnew), z4), Z * eg4, 0, 0, 0);
                    B2 = cat4(cvt4(vnew * egl4), z4);
#pragma unroll
                    for (int i = 0; i < 8; ++i) S[i] = __builtin_amdgcn_mfma_f32_16x16x32_bf16(cat4(kt[i], z4), B2, S[i] * glast, 0, 0, 0);
                } else {
                    B2 = cat4(vb, z4);
                    o = __builtin_amdgcn_mfma_f32_16x16x32_bf16(cat4(am, z4), B2, Z, 0, 0, 0);
#pragma unroll
                    for (int i = 0; i < 8; ++i) S[i] = __builtin_amdgcn_mfma_f32_16x16x32_bf16(cat4(kt[i], z4), B2, S[i] * d4[i], 0, 0, 0);
                }
                *(LAS f32x4*)(bb + OBOFF + lane * 16) = o;
#pragma unroll
                for (int a = 0; a < 4; ++a) Sb[a] = cat4(cvt4(S[2 * a]), cvt4(S[2 * a + 1]));
              }
                lds_barrier();
            }
            lds_barrier();
        } else {
            const int lt = tid - 64, pb = lt + 448;
            const int arow = (lt & 255) >> 4, apc = lt & 15;
            const bf16_t* srcA = (lt < 256 ? Qg : Kg) + (rowbase + arow) * 1024 + h * 128 + 8 * apc;
            const char* srcB; size_t strideB; int kindB;
            if (pb < 512) { kindB = 0; srcB = (const char*)(Kg + (rowbase + ((pb - 256) >> 4)) * 1024 + h * 128 + 8 * (pb & 15)); strideB = (size_t)16 * 1024 * 2; }
            else if (pb < VEND) { kindB = 1; const int vr_ = (pb - 512) >> 1, hf_ = (pb - 512) & 1; srcB = (const char*)(P + (rowbase + vr_) * LDP + 2048 + h * 128 + 16 * w + 8 * hf_); strideB = (size_t)16 * LDP * 2; }
            else if (pb < TEND) { kindB = 2; srcB = (const char*)(Tg + ((size_t)(b * 512) * 8 + h) * 256 + (pb - VEND) * 8); strideB = (size_t)8 * 256 * 2; }
            else if (pb < AEND) { kindB = 3; srcB = (const char*)(Amg + ((size_t)(b * 512) * 8 + h) * 256 + (pb - TEND) * 8); strideB = (size_t)8 * 256 * 2; }
            else if (pb < SEND) { kindB = 4; srcB = (const char*)(Scg + ((size_t)(b * 512) * 8 + h) * (KIND == 0 ? 64 : 128) + (pb - AEND) * 4); strideB = (size_t)8 * (KIND == 0 ? 64 : 128) * 4; }
            else { kindB = 5; srcB = (const char*)srcA; strideB = (size_t)16 * 1024 * 2; }
            const int vrow = (pb - 512) >> 1;
            const bool doflush = (wave == 2);
            constexpr int PD = 8;
            u32x4 g0[PD], g1[PD];
#define SC_LOAD(cc, sl) do { const int c_ = (cc); g0[sl] = *(const u32x4*)(srcA + (size_t)c_ * 16 * 1024); \
                const int tv_ = c_ * 16 + vrow - 3; const bool vh_ = (KIND == 0) && (kindB == 1); \
                const ptrdiff_t ofs_ = vh_ ? (ptrdiff_t)(tv_ >= 0 ? tv_ - vrow : -vrow) * (LDP * 2) : (ptrdiff_t)((size_t)c_ * strideB); \
                const u32x4 vv_ = *(const u32x4*)(srcB + ofs_); g1[sl] = (vh_ && tv_ < 0) ? (u32x4){0u, 0u, 0u, 0u} : vv_; } while (0)
#define SC_KSTORE(bb_, reg, row, pc) do { if (KIND == 0) *(LAS u32x4*)((bb_) + KOFF + (row) * 272 + 16 * (pc)) = (reg); \
                _Pragma("unroll") for (int e = 0; e < 4; ++e) { *(LAS unsigned short*)((bb_) + KTOFF + (8 * (pc) + 2 * e) * 40 + 2 * (row)) = (unsigned short)((reg)[e] & 0xffffu); \
                    *(LAS unsigned short*)((bb_) + KTOFF + (8 * (pc) + 2 * e + 1) * 40 + 2 * (row)) = (unsigned short)((reg)[e] >> 16); } } while (0)
#define SC_STORE(cc, sl) do { LAS unsigned char* bb_ = lds + ((cc) & 7) * BUFB; \
                if (lt < 256) *(LAS u32x4*)(bb_ + QOFF + arow * 272 + 16 * apc) = g0[sl]; else SC_KSTORE(bb_, g0[sl], arow, apc); \
                if (kindB == 0) SC_KSTORE(bb_, g1[sl], ((pb - 256) >> 4), (pb & 15)); \
                else if (kindB == 1) *(LAS u32x4*)(bb_ + VOFF + vrow * 32 + 16 * ((pb - 512) & 1)) = g1[sl]; \
                else if (kindB == 2) *(LAS u32x4*)(bb_ + TOFF + (pb - VEND) * 16) = g1[sl]; \
                else if (kindB == 3) *(LAS u32x4*)(bb_ + AMOFF + (pb - TEND) * 16) = g1[sl]; \
                else if (kindB == 4) *(LAS u32x4*)(bb_ + SCOFF + (pb - AEND) * 16) = g1[sl]; } while (0)
#define SC_OFLUSH(cc) do { const int c_ = (cc); const f32x4 o_ = *(LAS const f32x4*)(lds + (c_ & 7) * BUFB + OBOFF + lane * 16); \
                _Pragma("unroll") for (int jj = 0; jj < 4; ++jj) Og[(rowbase + (size_t)c_ * 16 + 4 * kg + jj) * LDO + h * 128 + 16 * w + n] = (bf16_t)f2bf(o_[jj]); } while (0)
#define SC_LOADER_LOOP(FLUSH) do { \
                _Pragma("unroll") for (int d = 0; d < PD; ++d) SC_LOAD(d, d); \
                SC_STORE(0, 0); SC_STORE(1, 1); SC_STORE(2, 2); SC_STORE(3, 3); \
                SC_LOAD(8, 0); SC_LOAD(9, 1); SC_LOAD(10, 2); SC_LOAD(11, 3); \
                lds_barrier(); \
                for (int c0 = 0; c0 < 512; c0 += PD) { \
                    _Pragma("unroll") for (int d = 0; d < PD; d += 4) { const int c = c0 + d; \
                        if (c + 4 < 512) { _Pragma("unroll") for (int u = 0; u < 4; ++u) SC_STORE(c + 4 + u, (d + 4 + u) % PD); } \
                        if (c + 12 < 512) { _Pragma("unroll") for (int u = 0; u < 4; ++u) SC_LOAD(c + 12 + u, (d + 4 + u) % PD); } \
                        if (FLUSH) { if (c > 0) { _Pragma("unroll") for (int u = 0; u < 4; ++u) SC_OFLUSH(c - 4 + u); } } \
                        lds_barrier(); } } \
                if (FLUSH) { _Pragma("unroll") for (int u = 0; u < 4; ++u) SC_OFLUSH(508 + u); } \
                lds_barrier(); } while (0)
            if (doflush) SC_LOADER_LOOP(true); else SC_LOADER_LOOP(false);
#undef SC_LOAD
#undef SC_KSTORE
#undef SC_STORE
#undef SC_OFLUSH
#undef SC_LOADER_LOOP
        }
    }
}

template <int KIND>
__device__ __forceinline__ void post_phase(PPTR p, int j) {
    const int lane = tidx() & 63, wave = tidx() >> 6;
    const int gw = bidx() * 8 + wave, nw = gdim() * 8;
    bf16_t* O = (bf16_t*)(p->ws + (KIND != 0 ? WS_OC : WS_PROJ));
    constexpr int LDO = (KIND == 0) ? 4352 : 1024;
    const bf16_t* P = (const bf16_t*)(p->ws + (KIND == 2 ? WS_PROJC : WS_PROJ));
    if (KIND != 2) {
        const float* nwp = (KIND == 0) ? p->in[9] + j * 128 : p->in[13];
        const float n0 = nwp[2 * lane], n1 = nwp[2 * lane + 1];
        constexpr int LDP = (KIND == 0) ? 4352 : 4096; constexpr int ZOFF = 3072;
        for (int row = gw; row < MROWS; row += nw) {
            unsigned ov[8], zv[8];
#pragma unroll
            for (int h = 0; h < 8; ++h) { ov[h] = *(const unsigned*)(O + (size_t)row * LDO + h * 128 + 2 * lane); zv[h] = *(const unsigned*)(P + (size_t)row * LDP + ZOFF + h * 128 + 2 * lane); }
#pragma unroll
            for (int h = 0; h < 8; ++h) {
                const float o0 = bflo(ov[h]), o1 = bfhi(ov[h]);
                const float ss = wave_allsum(o0 * o0 + o1 * o1); const float rstd = __builtin_amdgcn_rsqf(ss * (1.0f / 128.0f) + 1e-6f);
                *(unsigned*)(O + (size_t)row * LDO + h * 128 + 2 * lane) = pack2(o0 * rstd * n0 * siluf_(bflo(zv[h])), o1 * rstd * n1 * siluf_(bfhi(zv[h])));
            }
        }
    } else {
        const bf16_t* L2 = (const bf16_t*)(p->ws + WS_R1); const float* BNg = (const float*)(p->ws + WS_BNG);
        for (int task = gw; task < MROWS * 2; task += nw) {
            const int row = task >> 1, h0 = (task & 1) * 8;
            unsigned xy[8], xv[8], xg[8]; float bn[8];
#pragma unroll
            for (int hh = 0; hh < 8; ++hh) { const int ch = (h0 + hh) * 64 + lane; const bf16_t* rowp = P + (size_t)row * 3328; const bf16_t* l2p = L2 + (size_t)row * 3072;
                xy[hh] = O[(size_t)row * DM + ch]; xv[hh] = rowp[2048 + ch]; xg[hh] = l2p[2048 + ch]; bn[hh] = BNg[(size_t)row * 16 + h0 + hh]; }
#pragma unroll
            for (int hh = 0; hh < 8; ++hh) { const int ch = (h0 + hh) * 64 + lane;
                const float y = bf2f(xy[hh]);
                const float mean = wave_allsum(y) * (1.0f / 64.0f); const float dd = y - mean;
                const float var = wave_allsum(dd * dd) * (1.0f / 64.0f);
                const float gn = dd * __builtin_amdgcn_rsqf(var + 0.04096f) * p->in[28][ch] + p->in[29][ch];
                O[(size_t)row * DM + ch] = (bf16_t)f2bf((gn + bn[hh] * bf2f(xv[hh])) * bf2f(xg[hh]));
            }
        }
    }
}

#define XB_TMO      128
#define XB_XCNT(j)  (256  + 64 * (j))
#define XB_XSUB(j)  (1280 + 64 * (j))
#define XB_XGEN(j)  (2304 + 64 * (j))
#define XB_TOP      3328
#define XB_TOPGEN   3392
#define XCD_BAR_WORDS 3456
#define XB_SPIN_CAP (1u << 18)
constexpr size_t WS_BAR = WS_MISC + 1 * MiB;
__device__ __forceinline__ unsigned xb_ld(unsigned* p)              { return __hip_atomic_load(p, __ATOMIC_RELAXED, __HIP_MEMORY_SCOPE_AGENT); }
__device__ __forceinline__ unsigned xb_add(unsigned* p, unsigned v) { return __hip_atomic_fetch_add(p, v, __ATOMIC_RELAXED, __HIP_MEMORY_SCOPE_AGENT); }
__device__ __forceinline__ unsigned xb_xcc_id() { return (unsigned)__builtin_amdgcn_s_getreg((3 << 11) | 20) & 0xFu; }
#define XB_SPIN(cond, bar) do { unsigned _sp = 0; while (cond) { __builtin_amdgcn_s_sleep(1); \
    if ((++_sp & 255u) == 0u) { if (xb_ld(&(bar)[XB_TMO])) break; if (_sp > XB_SPIN_CAP) { atomicAdd(&(bar)[XB_TMO], 1u); break; } } } } while (0)
struct XcdBarrier { unsigned* bar; unsigned x; volatile LAS unsigned* st; };
__device__ __forceinline__ XcdBarrier xcd_barrier_post(unsigned* bar, volatile LAS unsigned* st) {
    XcdBarrier b; b.bar = bar; b.x = xb_xcc_id(); b.st = st;
    if (threadIdx.x == 0) (void)xb_add(&bar[XB_XCNT(b.x)], 1u);
    return b;
}
__device__ __forceinline__ void xcd_barrier_complete(unsigned* bar, unsigned x, unsigned& nloc, unsigned& nx) {
    const unsigned G = gridDim.x * gridDim.y * gridDim.z;
    unsigned sum, cnt, mine, sp = 0u;
    for (;;) {
        sum = 0u; cnt = 0u; mine = 0u;
#pragma unroll
        for (unsigned j = 0; j < 16; ++j) { const unsigned c = xb_ld(&bar[XB_XCNT(j)]); sum += c; cnt += (c > 0u) ? 1u : 0u; mine = (j == x) ? c : mine; }
        if (sum == G) break;
        __builtin_amdgcn_s_sleep(1);
        if ((++sp & 255u) == 0u) { if (xb_ld(&bar[XB_TMO])) break; if (sp > XB_SPIN_CAP) { atomicAdd(&bar[XB_TMO], 1u); break; } }
    }
    nloc = mine > 0u ? mine : 1u; nx = cnt > 0u ? cnt : 1u;
}
__device__ __forceinline__ void xcd_barrier(const XcdBarrier& b) {
    asm volatile("s_waitcnt vmcnt(0)" ::: "memory");
    __syncthreads();
    if (threadIdx.x == 0) {
        unsigned* bar = b.bar;
        __builtin_amdgcn_s_waitcnt(0);
        unsigned nloc = b.st[0], nx = b.st[1];
        if (nloc == 0u) { xcd_barrier_complete(bar, b.x, nloc, nx); b.st[0] = nloc; b.st[1] = nx; }
        const unsigned old = xb_add(&bar[XB_XSUB(b.x)], 1u);
        const unsigned gen = old / nloc;
        if (old + 1u == (gen + 1u) * nloc) {
            __builtin_amdgcn_fence(__ATOMIC_RELEASE, "agent");
            asm volatile("s_waitcnt vmcnt(0)" ::: "memory");
            const unsigned og = xb_add(&bar[XB_TOP], 1u);
            const unsigned tg = og / nx;
            if (og + 1u == (tg + 1u) * nx) xb_add(&bar[XB_TOPGEN], 1u);
            else XB_SPIN(xb_ld(&bar[XB_TOPGEN]) == tg, bar);
            __builtin_amdgcn_fence(__ATOMIC_ACQUIRE, "agent");
            xb_add(&bar[XB_XGEN(b.x)], 1u);
            asm volatile("s_waitcnt vmcnt(0)" ::: "memory");
        } else {
            XB_SPIN(xb_ld(&bar[XB_XGEN(b.x)]) == gen, bar);
            __builtin_amdgcn_fence(__ATOMIC_ACQUIRE, "agent");
            asm volatile("s_waitcnt vmcnt(0)" ::: "memory");
        }
    }
    __syncthreads();
}

constexpr int NPH = 54;
__host__ __device__ inline int step_of(int ph) { const int si = (ph - 1) % 13; return si < 3 ? si : (si == 3 ? 12 : si - 1); }
__host__ __device__ inline bool phase_is_noop(int ph) {
    if (ph == 0 || ph == NPH - 1) return false;
    const int l = (ph - 1) / 13, st = step_of(ph);
    return st == 12 && (l % 3) != 2;
}

__global__ void __launch_bounds__(512, 2) mega(const Params pv) {
    extern __shared__ __attribute__((aligned(16))) unsigned char shm[];
    PPTR p = &pv;
    LAS unsigned char* lds = (LAS unsigned char*)shm;
    cg::grid_group grid = cg::this_grid();
    volatile LAS unsigned* xb_st = (volatile LAS unsigned*)(lds + 147440);
    if (threadIdx.x == 0) { xb_st[0] = 0u; xb_st[1] = 0u; }
    __syncthreads();
    const XcdBarrier xb = xcd_barrier_post((unsigned*)(pv.ws + WS_BAR), xb_st);
    const int ph_lo = p->ph_lo, ph_hi = p->ph_hi;
    for (int ph = ph_lo; ph < ph_hi; ++ph) {
        if (phase_is_noop(ph)) continue;
        float* mod = (float*)(p->ws + WS_MISC);
        bf16_t* W = (bf16_t*)(p->ws + WS_W);
        if (ph == 0) { pre_phase(lds, p); __syncthreads(); cvt_layer(lds, p, 0); }
        else if (ph == NPH - 1) { if (PHMASK & 2) final_phase(p->out, p->in[35]); }
        else {
            const int l = (ph - 1) / 13, st = step_of(ph), kind = l % 3, j = l / 3;
            const float* hin = (l == 0) ? p->in[0] : p->out;
            const float* modl = mod + (size_t)l * 4 * 6144;
            bf16_t* R1 = (bf16_t*)(p->ws + WS_R1);
            for (int rep = 0; rep < 1 + (((REPMASK >> st) & 1) & ((REPL >> l) & 1)); ++rep) {
            if (rep) grid.sync();
            if (!(PHMASK & (4 << st))) {} else if (st == 0) {
                if (l > 0) cvt_layer(lds, p, l);
                if (kind == 2) norm_phase<true>(hin, p->in[2] + (size_t)(l * 2 + 0) * 1024, modl, 0, R1, 2048);
                else norm_phase<false>(hin, p->in[2] + (size_t)(l * 2 + 0) * 1024, modl, 0, R1, 1024);
            } else if (st == 12) {
                prep_rwkv_elem(p);
            } else if (st == 2 && kind == 1) {
                prep_gla(lds, p);
            } else if (st == 2 && kind == 0) {
                prep_delta(lds, p, j);
            } else if (st == 1 || st == 2 || st == 7 || st == 9) {
                pg8::EpiBf16S E; E.act = 0; const bf16_t* A; const bf16_t* Bt; int lda, N, K;
                if (st == 1) {
                    A = R1; Bt = W + W_IN / 2;
                    if (kind == 0) { E.O = (bf16_t*)(p->ws + WS_PROJ); E.ldc = 4352; lda = 1024; N = 4352; K = 1024; }
                    else if (kind == 1) { E.O = (bf16_t*)(p->ws + WS_PROJ); E.ldc = 4096; lda = 1024; N = 4096; K = 1024; }
                    else { E.O = (bf16_t*)(p->ws + WS_PROJC); E.ldc = 3328; E.act = 1; lda = 2048; N = 3328; K = 2048; }
                } else if (st == 2) {
                    A = (const bf16_t*)(p->ws + WS_PROJC) + 3072; Bt = W + W_L2 / 2; E.O = R1; E.ldc = 3072; lda = 3328; N = 3072; K = 256;
                } else {
                    const int g = (st == 9);
                    A = R1; Bt = W + W_UP / 2 + (size_t)(g ? 3072 : 0) * 1024; N = g ? 2560 : 3072; E.O = (bf16_t*)(p->ws + WS_HID); E.ldc = N; lda = 1024; K = 1024;
                }
                run_gemm(lds, A, lda, Bt, N, K, E);
            } else if (st == 5 || st == 11) {
                pg8::EpiRes E; const bf16_t* A; const bf16_t* Bt; int lda, K;
                if (st == 5) { E.res = hin; E.out = p->out; E.gate = modl + 2 * 1024; A = (const bf16_t*)(p->ws + (kind != 0 ? WS_OC : WS_PROJ)); lda = (kind == 0) ? 4352 : 1024; Bt = W + W_OUT / 2; K = 1024; }
                else { E.res = p->out; E.out = p->out; E.gate = modl + 5 * 1024; A = (const bf16_t*)(p->ws + WS_ACT); lda = 2816; Bt = W + W_DN / 2; K = 2816; }
                run_gemm(lds, A, lda, Bt, 1024, K, E);
            } else if (st == 3) {
                if (kind == 0) scan_chunked<0>(lds, p, j); else if (kind == 1) scan_chunked<1>(lds, p, j); else scan_rwkv(lds, p);
            } else if (st == 4) {
                if (kind == 0) post_phase<0>(p, j); else if (kind == 1) post_phase<1>(p, j); else post_phase<2>(p, j);
            } else if (st == 6) {
                norm_phase<false>(p->out, p->in[2] + (size_t)(l * 2 + 1) * 1024, modl, 3, R1, 1024);
            } else if (st == 8 || st == 10) {
                const int g = (st == 10);
                convglu_phase((const bf16_t*)(p->ws + WS_HID), (bf16_t*)(p->ws + WS_ACT), g, p->in[32] + (size_t)l * 3 * 5632, p->in[33] + (size_t)l * 5632);
            }
            }
        }
        if (ph + 1 < ph_hi) { if (ph == ph_lo) grid.sync(); else xcd_barrier(xb); }
    }
}

extern "C" void kernel_launch(void* const* d_in, const int* in_sizes, int n_in, void* d_out, int out_size, void* d_ws, size_t ws_size, hipStream_t stream) {
    constexpr int LDS_BYTES = 144 * 1024;
    static int grid_blocks = 0;
    if (!grid_blocks) {
        int dev = 0, cus = 0, per_cu = 0;
        hipGetDevice(&dev);
        hipDeviceGetAttribute(&cus, hipDeviceAttributeMultiprocessorCount, dev);
        if (hipFuncSetAttribute((const void*)mega, hipFuncAttributeMaxDynamicSharedMemorySize, LDS_BYTES) != hipSuccess) fprintf(stderr, "hipFuncSetAttribute failed\n");
        hipOccupancyMaxActiveBlocksPerMultiprocessor(&per_cu, (const void*)mega, 512, LDS_BYTES);
        if (per_cu < 1) per_cu = 1;
        if (per_cu > 1) per_cu = 1;
        grid_blocks = cus * per_cu;
        if (ws_size < 512 * MiB) fprintf(stderr, "workspace too small: %zu\n", ws_size);
    }
    (void)hipMemsetAsync((char*)d_ws + WS_BAR, 0, XCD_BAR_WORDS * sizeof(unsigned), stream);
    Params p{};
    for (int i = 0; i < 36; ++i) p.in[i] = (const float*)d_in[i];
    p.out = (float*)d_out; p.ws = (unsigned char*)d_ws;
#if SINGLE_LAUNCH
    p.ph_lo = 0; p.ph_hi = NPH;
    void* args[] = {&p};
    hipError_t e = hipLaunchCooperativeKernel((const void*)mega, dim3(grid_blocks), dim3(512), args, LDS_BYTES, stream);
    if (e != hipSuccess) fprintf(stderr, "cooperative launch failed: %s (grid %d)\n", hipGetErrorString(e), grid_blocks);
#else
    for (int ph = 0; ph < NPH; ++ph) {
        if (phase_is_noop(ph)) continue;
        p.ph_lo = ph; p.ph_hi = ph + 1;
        hipLaunchKernelGGL(mega, dim3(grid_blocks), dim3(512), LDS_BYTES, stream, p);
    }
#endif
}
```

```cpp
#include <hip/hip_runtime.h>
#include <hip/hip_cooperative_groups.h>
#include <cstdio>
namespace cg = cooperative_groups;

#ifndef PHMASK
#define PHMASK 0xFFFFFF
#endif
#ifndef REPMASK
#define REPMASK 0
#endif
#ifndef REPL
#define REPL 0xF
#endif
#ifndef SINGLE_LAUNCH
#define SINGLE_LAUNCH 1
#endif

#define LAS __attribute__((address_space(3)))
typedef unsigned short bf16_t;
typedef short bf16x8 __attribute__((ext_vector_type(8)));
typedef float f32x4 __attribute__((ext_vector_type(4)));
typedef float f32x2 __attribute__((ext_vector_type(2)));
typedef unsigned u32x4 __attribute__((ext_vector_type(4)));
typedef unsigned u32x2 __attribute__((ext_vector_type(2)));

constexpr int MROWS = 32768, SEQ = 8192, DM = 1024;
constexpr size_t MiB = 1ull << 20;
constexpr size_t WS_W = 0;
constexpr size_t W_IN = 0, W_L2 = 13 * MiB, W_OUT = 15 * MiB, W_UP = 17 * MiB, W_DN = 28 * MiB;
constexpr size_t WS_MISC = 34 * MiB;
constexpr size_t WS_R1 = 36 * MiB;
constexpr size_t WS_PROJ = 164 * MiB;
constexpr size_t WS_PROJC = 228 * MiB;
constexpr size_t WS_OC = 436 * MiB;
constexpr size_t WS_HID = 100 * MiB;
constexpr size_t WS_ACT = 292 * MiB;

struct Params {
    const float* in[36];
    float* out;
    unsigned char* ws;
    int ph_lo, ph_hi;
};
typedef const Params* PPTR;

__device__ __forceinline__ float bf2f(unsigned v) { return __uint_as_float(v << 16); }
__device__ __forceinline__ float bflo(unsigned v) { return __uint_as_float(v << 16); }
__device__ __forceinline__ float bfhi(unsigned v) { return __uint_as_float(v & 0xffff0000u); }
typedef __bf16 bf16v2 __attribute__((ext_vector_type(2)));
__device__ __forceinline__ unsigned pack2(float lo, float hi) { const f32x2 v = {lo, hi}; const bf16v2 r = __builtin_convertvector(v, bf16v2); return __builtin_bit_cast(unsigned, r); }
__device__ __forceinline__ unsigned f2bf(float f) { return pack2(f, 0.f) & 0xffffu; }
__device__ __forceinline__ float sigmoidf_(float x) { return __builtin_amdgcn_rcpf(1.0f + __expf(-x)); }
__device__ __forceinline__ float siluf_(float x) { return x * __builtin_amdgcn_rcpf(1.0f + __expf(-x)); }
__device__ __forceinline__ float softplusf_(float x) { return x > 15.0f ? x : __logf(1.0f + __expf(x)); }
template <int CTRL> __device__ __forceinline__ float dpp_f(float x) { return __int_as_float(__builtin_amdgcn_update_dpp(0, __float_as_int(x), CTRL, 0xf, 0xf, false)); }
__device__ __forceinline__ float rowred16(float x) { x += dpp_f<0x128>(x); x += dpp_f<0x124>(x); x += dpp_f<0x122>(x); x += dpp_f<0x121>(x); return x; }
__device__ __forceinline__ float wave_allsum(float v) {
    float r = rowred16(v);
    r += __int_as_float(__builtin_amdgcn_update_dpp(0, __float_as_int(r), 0x142, 0xa, 0xf, false));
    r += __int_as_float(__builtin_amdgcn_update_dpp(0, __float_as_int(r), 0x143, 0xc, 0xf, false));
    return __int_as_float(__builtin_amdgcn_readlane(__float_as_int(r), 63));
}
struct StepRegs { f32x4 a, b, c, d, e; float vr, x0, x1; };
template <int KIND> __device__ __forceinline__ void step_load(StepRegs& r, LAS const float* rec, int li, int row) {
    r.a = *(LAS const f32x4*)(rec + 4 * li); r.b = *(LAS const f32x4*)(rec + 64 + 4 * li); r.c = *(LAS const f32x4*)(rec + 128 + 4 * li); r.d = *(LAS const f32x4*)(rec + 192 + 4 * li);
    if (KIND == 0) { r.vr = rec[256 + row]; r.x0 = rec[272]; r.x1 = rec[273]; }
    else if (KIND == 1) { r.vr = rec[256 + row]; }
    else { r.e = *(LAS const f32x4*)(rec + 256 + 4 * li); r.vr = rec[320 + row]; }
}
template <int KIND> __device__ __forceinline__ float step_compute(const StepRegs& r, f32x2 (&s)[4]) {
    if (KIND == 0) {
        const f32x2 k[4] = {{r.a[0], r.a[1]}, {r.a[2], r.a[3]}, {r.b[0], r.b[1]}, {r.b[2], r.b[3]}};
        const f32x2 q[4] = {{r.c[0], r.c[1]}, {r.c[2], r.c[3]}, {r.d[0], r.d[1]}, {r.d[2], r.d[3]}};
        f32x2 pa = s[0] * k[0] + s[1] * k[1]; const f32x2 pb = s[2] * k[2] + s[3] * k[3]; pa += pb;
        const float pp = rowred16(pa.x + pa.y);
        const float cc = r.x0 * (r.vr - r.x1 * pp);
        const f32x2 eg2 = {r.x1, r.x1}, cc2 = {cc, cc};
#pragma unroll
        for (int i = 0; i < 4; ++i) s[i] = s[i] * eg2 + cc2 * k[i];
        f32x2 oa = s[0] * q[0] + s[1] * q[1]; const f32x2 ob = s[2] * q[2] + s[3] * q[3]; oa += ob;
        return rowred16(oa.x + oa.y);
    } else if (KIND == 1) {
        const f32x2 q[4] = {{r.a[0], r.a[1]}, {r.a[2], r.a[3]}, {r.b[0], r.b[1]}, {r.b[2], r.b[3]}};
        const f32x2 f[4] = {{r.c[0], r.c[1]}, {r.c[2], r.c[3]}, {r.d[0], r.d[1]}, {r.d[2], r.d[3]}};
        const f32x2 v2 = {r.vr, r.vr};
#pragma unroll
        for (int i = 0; i < 4; ++i) s[i] = s[i] * f[i] + v2 * (1.0f - f[i]);
        f32x2 oa = s[0] * q[0] + s[1] * q[1]; const f32x2 ob = s[2] * q[2] + s[3] * q[3]; oa += ob;
        return rowred16(oa.x + oa.y);
    } else {
        const f32x2 a2[2] = {{r.a[0], r.a[1]}, {r.a[2], r.a[3]}}, b2[2] = {{r.b[0], r.b[1]}, {r.b[2], r.b[3]}}, d2[2] = {{r.c[0], r.c[1]}, {r.c[2], r.c[3]}};
        const f32x2 k2[2] = {{r.d[0], r.d[1]}, {r.d[2], r.d[3]}}, r2[2] = {{r.e[0], r.e[1]}, {r.e[2], r.e[3]}};
        const f32x2 pa = s[0] * a2[0] + s[1] * a2[1];
        const float sa = rowred16(pa.x + pa.y);
        const f32x2 sa2 = {sa, sa}, v2 = {r.vr, r.vr};
        s[0] = s[0] * d2[0] + sa2 * b2[0] + v2 * k2[0]; s[1] = s[1] * d2[1] + sa2 * b2[1] + v2 * k2[1];
        const f32x2 oa = s[0] * r2[0] + s[1] * r2[1];
        return rowred16(oa.x + oa.y);
    }
}
__device__ __forceinline__ int tidx() { int t = threadIdx.x; asm volatile("" : "+v"(t)); return t; }
__device__ __forceinline__ int bidx() { int t = blockIdx.x; asm volatile("" : "+s"(t)); return t; }
__device__ __forceinline__ int gdim() { int t = gridDim.x; asm volatile("" : "+s"(t)); return t; }
__device__ __forceinline__ void lds_barrier() { asm volatile("s_waitcnt lgkmcnt(0)" ::: "memory"); __builtin_amdgcn_s_barrier(); asm volatile("" ::: "memory"); }

namespace pg8 {
constexpr int BM = 256, BK = 64, HALF = 128, HTB = HALF * BK * 2, STAGE_BYTES = 8 * HTB, NXCD = 8, WGM = 8;
__device__ __forceinline__ int lds_byte(int r, int c) { const int st = (r >> 4) * 2 + (c >> 5), rr = r & 15, cc = c & 31, ob = rr * 64 + cc * 2; return st * 1024 + (ob ^ (((ob >> 9) & 1) << 5)); }
__device__ __forceinline__ void stage_rc(int b, int& R, int& C) { const int st = b / 1024, sb = b % 1024, swz = sb ^ (((sb >> 9) & 1) << 5); R = (st >> 1) * 16 + swz / 64; C = (st & 1) * 32 + (swz % 64) / 2; }
__device__ __forceinline__ int perm32(int rho) { const int n = rho >> 4, i = rho & 15; return 8 * (i >> 2) + 4 * n + (i & 3); }
struct Unit { int pm, pn; };
struct Gemm { const bf16_t* A; const bf16_t* Bt; int M, N, K, lda; };
struct StaticOrder {
    int nM, nN, nwg, G, c;
    __device__ void init(int M, int N, int G_, int c_) { nM = M / BM; nN = N / BM; nwg = nM * nN; G = G_; c = c_; }
    __device__ bool next(int i, Unit& u) const {
        const long L = (long)i * G + c; if (L >= nwg) return false;
        int wgid = (int)L; { const int q = nwg / NXCD, r = nwg % NXCD, xcd = wgid % NXCD, off = wgid / NXCD; wgid = (xcd < r ? xcd * (q + 1) : r * (q + 1) + (xcd - r) * q) + off; }
        const int nig = WGM * nN, gid = wgid / nig, fm = gid * WGM, gsz = (nM - fm) < WGM ? (nM - fm) : WGM;
        u.pm = fm + ((wgid % nig) % gsz); u.pn = (wgid % nig) / gsz; return true;
    }
};
__device__ __forceinline__ unsigned cvt_pk_bf16(float lo, float hi) { return pack2(lo, hi); }

struct EpiBf16S {
    static constexpr bool PERM = true;
    bf16_t* O; int ldc; int act;
    __device__ __forceinline__ void operator()(const f32x4 (&acc)[2][2][4][2], const Unit& u, int wr, int wc, int fr, int fq) const {
        const int row0 = u.pm * BM + wr * 64 + fr; const int col0 = u.pn * BM + wc * 32 + 8 * fq;
#pragma unroll
        for (int ai = 0; ai < 2; ++ai)
#pragma unroll
            for (int m = 0; m < 4; ++m) { bf16_t* rowp = O + (size_t)(row0 + ai * HALF + m * 16) * ldc + col0;
#pragma unroll
                for (int bj = 0; bj < 2; ++bj) { f32x4 v0 = acc[ai][bj][m][0], v1 = acc[ai][bj][m][1];
                    if (act) { const int c = col0 + bj * HALF;
                        if (c >= 3072 && c < 3136) {
#pragma unroll
                            for (int j = 0; j < 4; ++j) { v0[j] = 1.0f - 2.0f * __builtin_amdgcn_rcpf(1.0f + __expf(2.0f * v0[j])); v1[j] = 1.0f - 2.0f * __builtin_amdgcn_rcpf(1.0f + __expf(2.0f * v1[j])); } }
                        else if (c >= 3200) {
#pragma unroll
                            for (int j = 0; j < 4; ++j) { v0[j] = sigmoidf_(v0[j]); v1[j] = sigmoidf_(v1[j]); } } }
                    u32x4 w; w.x = cvt_pk_bf16(v0[0], v0[1]); w.y = cvt_pk_bf16(v0[2], v0[3]); w.z = cvt_pk_bf16(v1[0], v1[1]); w.w = cvt_pk_bf16(v1[2], v1[3]);
                    *(u32x4*)(rowp + bj * HALF) = w; } }
    }
};
struct EpiRes {
    static constexpr bool PERM = false;
    const float* res; float* out; const float* gate;
    __device__ __forceinline__ void operator()(const f32x4 (&acc)[2][2][4][2], const Unit& u, int wr, int wc, int fr, int fq) const {
        const int row0 = u.pm * BM + wr * 64 + fr, col0 = u.pn * BM + wc * 32 + 4 * fq; const int b = (u.pm * BM) / SEQ;
        f32x4 gv[2][2];
#pragma unroll
        for (int bj = 0; bj < 2; ++bj)
#pragma unroll
            for (int n = 0; n < 2; ++n) gv[bj][n] = *(const f32x4*)(gate + (size_t)b * 6144 + col0 + bj * HALF + n * 16);
#pragma unroll
        for (int ai = 0; ai < 2; ++ai)
#pragma unroll
            for (int mp = 0; mp < 2; ++mp) {
                f32x4 r[2][2][2];
#pragma unroll
                for (int mm = 0; mm < 2; ++mm) { const size_t off = (size_t)(row0 + ai * HALF + (2 * mp + mm) * 16) * DM + col0;
#pragma unroll
                    for (int bj = 0; bj < 2; ++bj)
#pragma unroll
                        for (int n = 0; n < 2; ++n) r[mm][bj][n] = *(const f32x4*)(res + off + bj * HALF + n * 16); }
                __builtin_amdgcn_sched_barrier(0);
#pragma unroll
                for (int mm = 0; mm < 2; ++mm) { const size_t off = (size_t)(row0 + ai * HALF + (2 * mp + mm) * 16) * DM + col0;
#pragma unroll
                    for (int bj = 0; bj < 2; ++bj)
#pragma unroll
                        for (int n = 0; n < 2; ++n) *(f32x4*)(out + off + bj * HALF + n * 16) = r[mm][bj][n] + gv[bj][n] * acc[ai][bj][2 * mp + mm][n]; }
            }
    }
};

template <class Epi>
__device__ __forceinline__ void gemm_phase(LAS unsigned char* lds, const Gemm g, const StaticOrder& S, const Epi& E) {
    const int tid = tidx(), wid = __builtin_amdgcn_readfirstlane(tid >> 6), lane = tid & 63, wr = wid >> 2, wc = wid & 3, fr = lane & 15, fq = lane >> 4;
    const int K = g.K, nt = K / BK, lda = g.lda;
    unsigned voffA[2], voffB[2];
#pragma unroll
    for (int i = 0; i < 2; ++i) { int R, C; stage_rc(tid * 16 + i * 8192, R, C); const int Rb = Epi::PERM ? ((R & ~31) + perm32(R & 31)) : R;
        voffA[i] = (unsigned)(R * lda + C) * 2u; voffB[i] = (unsigned)(Rb * K + C) * 2u; }
    const size_t kstep = (size_t)(BK * 2);
    const size_t hstepA = (size_t)HALF * lda * 2, hstepB = (size_t)HALF * K * 2;
    const size_t tstepA = 2 * hstepA, tstepB = 2 * hstepB;
    const unsigned ldsw = (unsigned)wid * 1024u;
    const int aoff = lds_byte(wr * 64 + fr, fq * 8), boff = lds_byte(wc * 32 + fr, fq * 8);
#define PG8_SA(b, h) (((b) * 2 + (h)) * HTB)
#define PG8_SB(b, h) ((4 + (b) * 2 + (h)) * HTB)
#define PG8_STAGE(bufoff, gbase, voff) do { _Pragma("unroll") for (int _i = 0; _i < 2; ++_i) \
        __builtin_amdgcn_global_load_lds((const unsigned*)((const char*)(gbase) + (voff)[_i]), (LAS unsigned*)(lds + (bufoff) + ldsw + _i * 8192), 16, 0, 0); } while (0)
#define PG8_LDA(dst, b, h) do { _Pragma("unroll") for (int m = 0; m < 4; ++m) _Pragma("unroll") for (int k = 0; k < 2; ++k) dst[m][k] = *(const LAS bf16x8*)(lds + PG8_SA(b, h) + aoff + m * 2048 + k * 1024); } while (0)
#define PG8_LDB(dst, b, h) do { _Pragma("unroll") for (int n = 0; n < 2; ++n) _Pragma("unroll") for (int k = 0; k < 2; ++k) dst[n][k] = *(const LAS bf16x8*)(lds + PG8_SB(b, h) + boff + n * 2048 + k * 1024); } while (0)
#define PG8_MMA(ai, bj, At, Bt) do { __builtin_amdgcn_s_setprio(1); _Pragma("unroll") for (int m = 0; m < 4; ++m) _Pragma("unroll") for (int n = 0; n < 2; ++n) _Pragma("unroll") for (int k = 0; k < 2; ++k) \
        acc[ai][bj][m][n] = __builtin_amdgcn_mfma_f32_16x16x32_bf16(Bt[n][k], At[m][k], acc[ai][bj][m][n], 0, 0, 0); __builtin_amdgcn_s_setprio(0); } while (0)
#define PG8_WAIT_V(n) asm volatile("s_waitcnt vmcnt(" #n ")" ::: "memory")
#define PG8_WAIT_L(n) asm volatile("s_waitcnt lgkmcnt(" #n ")" ::: "memory")
#define PG8_BAR __builtin_amdgcn_s_barrier()
#define PG8_SCHED __builtin_amdgcn_sched_barrier(0)
    Unit cur, nxt; int ui = 0;
    if (!S.next(0, cur)) return;
    f32x4 acc[2][2][4][2];
#pragma unroll
    for (int a = 0; a < 2; ++a)
#pragma unroll
        for (int b = 0; b < 2; ++b)
#pragma unroll
            for (int m = 0; m < 4; ++m)
#pragma unroll
                for (int n = 0; n < 2; ++n) acc[a][b][m][n] = (f32x4){0.f, 0.f, 0.f, 0.f};
    bf16x8 At[4][2], B0[2][2], B1[2][2];
    const char* cA = (const char*)g.A + (size_t)cur.pm * tstepA; const char* cB = (const char*)g.Bt + (size_t)cur.pn * tstepB;
    PG8_STAGE(PG8_SB(0, 0), cB, voffB); PG8_STAGE(PG8_SA(0, 0), cA, voffA); PG8_STAGE(PG8_SB(0, 1), cB + hstepB, voffB); PG8_STAGE(PG8_SA(0, 1), cA + hstepA, voffA);
    if (wr == 1) PG8_BAR;
    PG8_WAIT_V(4); PG8_BAR;
    PG8_STAGE(PG8_SB(1, 0), cB + kstep, voffB); PG8_STAGE(PG8_SA(1, 0), cA + kstep, voffA); PG8_STAGE(PG8_SB(1, 1), cB + hstepB + kstep, voffB);
    PG8_WAIT_V(6); PG8_BAR;
    for (;;) {
        const bool has_next = S.next(ui + 1, nxt);
        const char* nA = has_next ? (const char*)g.A + (size_t)nxt.pm * tstepA : cA; const char* nB = has_next ? (const char*)g.Bt + (size_t)nxt.pn * tstepB : cB;
        for (int t = 0; t < nt; t += 2) {
            const bool last = (t == nt - 2);
            const char* a1 = cA + (size_t)(t + 1) * kstep;
            const char* a2 = last ? nA : cA + (size_t)(t + 2) * kstep; const char* b2 = last ? nB : cB + (size_t)(t + 2) * kstep;
            const char* a3 = a2 + kstep; const char* b3 = b2 + kstep;
            PG8_LDB(B0, 0, 0); PG8_SCHED; PG8_LDA(At, 0, 0); PG8_STAGE(PG8_SA(1, 1), a1 + hstepA, voffA);
            PG8_WAIT_L(8); PG8_BAR; PG8_WAIT_L(0); PG8_MMA(0, 0, At, B0); PG8_BAR; PG8_SCHED;
            PG8_LDB(B1, 0, 1); PG8_STAGE(PG8_SB(0, 0), b2, voffB);
            PG8_BAR; PG8_WAIT_L(0); PG8_MMA(0, 1, At, B1); PG8_BAR;
            PG8_LDA(At, 0, 1); PG8_STAGE(PG8_SA(0, 0), a2, voffA);
            PG8_BAR; PG8_WAIT_L(0); PG8_MMA(1, 0, At, B0); PG8_BAR; PG8_SCHED;
            PG8_STAGE(PG8_SB(0, 1), b2 + hstepB, voffB);
            PG8_WAIT_V(6); PG8_BAR; PG8_MMA(1, 1, At, B1); PG8_BAR;
            PG8_LDB(B0, 1, 0); PG8_SCHED; PG8_LDA(At, 1, 0); PG8_STAGE(PG8_SA(0, 1), a2 + hstepA, voffA);
            PG8_WAIT_L(8); PG8_BAR; PG8_WAIT_L(0); PG8_MMA(0, 0, At, B0); PG8_BAR; PG8_SCHED;
            PG8_LDB(B1, 1, 1); PG8_STAGE(PG8_SB(1, 0), b3, voffB);
            PG8_BAR; PG8_WAIT_L(0); PG8_MMA(0, 1, At, B1); PG8_BAR;
            PG8_LDA(At, 1, 1); PG8_STAGE(PG8_SA(1, 0), a3, voffA);
            PG8_BAR; PG8_WAIT_L(0); PG8_MMA(1, 0, At, B0); PG8_BAR; PG8_SCHED;
            PG8_STAGE(PG8_SB(1, 1), b3 + hstepB, voffB);
            PG8_WAIT_V(6); PG8_BAR; PG8_MMA(1, 1, At, B1); PG8_BAR;
        }
        E(acc, cur, wr, wc, fr, fq);
        if (!has_next) break;
#pragma unroll
        for (int a = 0; a < 2; ++a)
#pragma unroll
            for (int b = 0; b < 2; ++b)
#pragma unroll
                for (int m = 0; m < 4; ++m)
#pragma unroll
                    for (int n = 0; n < 2; ++n) acc[a][b][m][n] = (f32x4){0.f, 0.f, 0.f, 0.f};
        cur = nxt; cA = nA; cB = nB; ++ui;
    }
    PG8_WAIT_V(0);
    if (wr == 0) PG8_BAR;
    PG8_BAR;
#undef PG8_SA
#undef PG8_SB
#undef PG8_STAGE
#undef PG8_LDA
#undef PG8_LDB
#undef PG8_MMA
#undef PG8_WAIT_V
#undef PG8_WAIT_L
#undef PG8_BAR
#undef PG8_SCHED
}
}

template <class Epi>
__device__ __forceinline__ void run_gemm(LAS unsigned char* lds, const bf16_t* A, int lda, const bf16_t* Bt, int N, int K, const Epi& E) {
    pg8::Gemm g; g.A = A; g.Bt = Bt; g.M = MROWS; g.N = N; g.K = K; g.lda = lda;
    pg8::StaticOrder S; S.init(MROWS, N, (int)gdim(), (int)bidx());
    pg8::gemm_phase<Epi>(lds, g, S, E);
}

__device__ __forceinline__ void cvt_job(LAS float* tile, bf16_t* dst, int ldd, const float* src, int srcN, int nK, int nNdst, int nNsrc, const float* scale, int noff) {
    const int tid = tidx(); const int tilesK = nK / 64, tilesN = nNdst / 64, ntl = tilesK * tilesN, G = gdim();
    const int kr = tid >> 6, nn = tid & 63;
    for (int tl0 = bidx(); tl0 < ntl; tl0 += 2 * G) {
        float v[2][8];
#pragma unroll
        for (int u = 0; u < 2; ++u) { const int tl = tl0 + u * G; const bool tv = tl < ntl; const int tk = tv ? tl % tilesK : 0, tn = tv ? tl / tilesK : 0, k0 = tk * 64, n = tn * 64 + nn;
            const bool ld_ = tv && src && n < nNsrc;
#pragma unroll
            for (int ps = 0; ps < 8; ++ps) { const int kk = ps * 8 + kr; float x = 0.f;
                if (ld_) { x = src[(size_t)(k0 + kk) * srcN + noff + n]; if (scale) x *= scale[k0 + kk]; }
                v[u][ps] = x; } }
#pragma unroll
        for (int u = 0; u < 2; ++u)
#pragma unroll
            for (int ps = 0; ps < 8; ++ps) tile[u * 4160 + (ps * 8 + kr) * 65 + nn] = v[u][ps];
        __syncthreads();
#pragma unroll
        for (int u = 0; u < 2; ++u) { const int tl = tl0 + u * G;
            if (tl < ntl) { const int tk = tl % tilesK, tn = tl / tilesK, k0 = tk * 64, n0 = tn * 64;
#pragma unroll
                for (int ps = 0; ps < 4; ++ps) { const int kk2 = tid & 31, n2 = (tid >> 5) + 16 * ps;
                    const unsigned w = pack2(tile[u * 4160 + (2 * kk2) * 65 + n2], tile[u * 4160 + (2 * kk2 + 1) * 65 + n2]);
                    *(unsigned*)(dst + (size_t)(n0 + n2) * ldd + k0 + 2 * kk2) = w; } } }
        __syncthreads();
    }
}

__device__ __forceinline__ void cvt_layer(LAS unsigned char* lds, PPTR p, int layer) {
    LAS float* tile = (LAS float*)lds;
    bf16_t* W = (bf16_t*)(p->ws + WS_W);
    bf16_t* w_in = W + W_IN / 2; bf16_t* w_l2 = W + W_L2 / 2; bf16_t* w_out = W + W_OUT / 2; bf16_t* w_up = W + W_UP / 2; bf16_t* w_dn = W + W_DN / 2;
    const int kind = layer % 3, j = layer / 3;
    const int nmix = (kind == 2) ? 20 : 2;
    for (int jb = 0; jb < nmix + 5; ++jb) {
        bf16_t* dst = w_in; int ldd = 1024; const float* src = nullptr; int srcN = 1024, nK = 1024, nNdst = 1024, nNsrc = 1024, noff = 0; const float* scale = nullptr;
        if (jb >= nmix) {
            const int f = jb - nmix;
            if (f < 4) { const int g = f >> 1, gate = f & 1; const int nch = g ? 1280 : 1536, ch0 = g ? 1536 : 0;
                dst = w_up + (size_t)((g ? 3072 : 0) + nch * gate) * 1024; src = p->in[31] + (size_t)layer * 1024 * 5632; srcN = 5632; nNdst = nch; nNsrc = nch; noff = 2816 * gate + ch0; }
            else { dst = w_dn; ldd = 2816; src = p->in[34] + (size_t)layer * 2816 * 1024; nK = 2816; }
        } else if (kind == 0) {
            if (jb == 0) { src = p->in[5] + (size_t)j * 1024 * 4112; srcN = 4112; nNdst = 4352; nNsrc = 4112; }
            else { dst = w_out; src = p->in[10] + (size_t)j * 1024 * 1024; }
        } else if (kind == 1) {
            if (jb == 0) { src = p->in[11]; srcN = 4096; nNdst = 4096; nNsrc = 4096; }
            else { dst = w_out; src = p->in[14]; }
        } else {
            const float* mu = p->in[15];
            if (jb < 6) { const int sI = jb >> 1, hi = jb & 1; const int mi = (sI == 0) ? 0 : (sI == 1 ? 2 : 3);
                dst = w_in + (size_t)sI * 1024 * 2048 + hi * 1024; ldd = 2048; src = p->in[16] + (size_t)sI * 1024 * 1024; if (hi) scale = mu + mi * 1024; }
            else if (jb < 12) { const int q = (jb - 6) >> 1, hi = jb & 1;
                const int rowo = (q == 0) ? 3072 : (q == 1 ? 3136 : 3200); const int nc = (q == 2) ? 128 : 64; const int mi = (q == 0) ? 1 : (q == 1 ? 4 : 5);
                dst = w_in + (size_t)rowo * 2048 + hi * 1024; ldd = 2048; src = (q == 0) ? p->in[18] : (q == 1 ? p->in[21] : p->in[23]); srcN = nc; nNdst = nc; nNsrc = nc; if (hi) scale = mu + mi * 1024; }
            else if (jb < 19) { ldd = 256; nNdst = 1024; nNsrc = 1024;
                const int q = jb - 12;
                if (q == 0) { dst = w_l2; src = p->in[19]; nK = 64; }
                else if (q == 1) { dst = w_l2 + 64; nK = 192; }
                else if (q == 2) { dst = w_l2 + (size_t)1024 * 256; nK = 64; }
                else if (q == 3) { dst = w_l2 + (size_t)1024 * 256 + 64; src = p->in[22]; nK = 64; }
                else if (q == 4) { dst = w_l2 + (size_t)1024 * 256 + 128; nK = 128; }
                else if (q == 5) { dst = w_l2 + (size_t)2048 * 256; nK = 128; }
                else { dst = w_l2 + (size_t)2048 * 256 + 128; src = p->in[24]; nK = 128; } }
            else { dst = w_out; src = p->in[30]; }
        }
        cvt_job(tile, dst, ldd, src, srcN, nK, nNdst, nNsrc, scale, noff);
    }
}

template <bool SHIFT>
__device__ __forceinline__ void norm_phase(const float* h, const float* g, const float* modl, int s_shift, bf16_t* U, int ldu) {
    const int lane = tidx() & 63, wave = tidx() >> 6;
    const int gw = bidx() * 8 + wave, nw = gdim() * 8;
    constexpr int RU = SHIFT ? 2 : 4;
    for (int row0 = gw; row0 < MROWS; row0 += nw * RU) {
        f32x4 x[RU][4], xp[RU][4];
#pragma unroll
        for (int q = 0; q < RU; ++q) { const int row = row0 + q * nw;
            if (row < MROWS) {
#pragma unroll
                for (int i = 0; i < 4; ++i) x[q][i] = *(const f32x4*)(h + (size_t)row * DM + i * 256 + lane * 4);
                if (SHIFT) { const size_t prow = ((row & (SEQ - 1)) > 0) ? (size_t)(row - 1) : (size_t)row;
#pragma unroll
                    for (int i = 0; i < 4; ++i) xp[q][i] = *(const f32x4*)(h + prow * DM + i * 256 + lane * 4); } } }
#pragma unroll
        for (int q = 0; q < RU; ++q) { const int row = row0 + q * nw;
            if (row < MROWS) {
                const int b = row >> 13, t = row & (SEQ - 1);
                const float* sh = modl + (size_t)b * 6144 + s_shift * 1024; const float* sc = sh + 1024;
                float ss = 0.f;
#pragma unroll
                for (int i = 0; i < 4; ++i) ss += x[q][i][0] * x[q][i][0] + x[q][i][1] * x[q][i][1] + x[q][i][2] * x[q][i][2] + x[q][i][3] * x[q][i][3];
                ss = wave_allsum(ss); const float rstd = __builtin_amdgcn_rsqf(ss * (1.0f / 1024.0f) + 1e-6f);
                float rstdp = 0.f;
                if (SHIFT) { float ssp = 0.f;
#pragma unroll
                    for (int i = 0; i < 4; ++i) ssp += xp[q][i][0] * xp[q][i][0] + xp[q][i][1] * xp[q][i][1] + xp[q][i][2] * xp[q][i][2] + xp[q][i][3] * xp[q][i][3];
                    ssp = wave_allsum(ssp); rstdp = __builtin_amdgcn_rsqf(ssp * (1.0f / 1024.0f) + 1e-6f); }
#pragma unroll
                for (int i = 0; i < 4; ++i) { const int c = i * 256 + lane * 4; const f32x4 gg = *(const f32x4*)(g + c), s1 = *(const f32x4*)(sc + c), s0 = *(const f32x4*)(sh + c);
                    const f32x4 u = x[q][i] * rstd * gg * (1.0f + s1) + s0;
                    u32x2 w; w.x = pack2(u[0], u[1]); w.y = pack2(u[2], u[3]); *(u32x2*)(U + (size_t)row * ldu + c) = w;
                    if (SHIFT) { f32x4 up = xp[q][i] * rstdp * gg * (1.0f + s1) + s0; if (t == 0) up = (f32x4){0.f, 0.f, 0.f, 0.f};
                        const f32x4 dx = up - u; u32x2 w2; w2.x = pack2(dx[0], dx[1]); w2.y = pack2(dx[2], dx[3]); *(u32x2*)(U + (size_t)row * ldu + 1024 + c) = w2; } }
            } }
    }
}

__device__ __forceinline__ void final_phase(float* h, const float* g) {
    const int lane = tidx() & 63, wave = tidx() >> 6;
    const int gw = bidx() * 8 + wave, nw = gdim() * 8;
    for (int row0 = gw; row0 < MROWS; row0 += nw * 4) {
        f32x4 x[4][4];
#pragma unroll
        for (int q = 0; q < 4; ++q) { const int row = row0 + q * nw; if (row < MROWS) {
#pragma unroll
            for (int i = 0; i < 4; ++i) x[q][i] = *(const f32x4*)(h + (size_t)row * DM + i * 256 + lane * 4); } }
#pragma unroll
        for (int q = 0; q < 4; ++q) { const int row = row0 + q * nw; if (row < MROWS) {
            float ss = 0.f;
#pragma unroll
            for (int i = 0; i < 4; ++i) ss += x[q][i][0] * x[q][i][0] + x[q][i][1] * x[q][i][1] + x[q][i][2] * x[q][i][2] + x[q][i][3] * x[q][i][3];
            ss = wave_allsum(ss); const float rstd = __builtin_amdgcn_rsqf(ss * (1.0f / 1024.0f) + 1e-6f);
#pragma unroll
            for (int i = 0; i < 4; ++i) { const int c = i * 256 + lane * 4; const f32x4 gg = *(const f32x4*)(g + c);
                *(f32x4*)(h + (size_t)row * DM + c) = x[q][i] * rstd * gg; } } }
    }
}

__device__ __forceinline__ void pre_phase(LAS unsigned char* lds, PPTR p) {
    LAS float* cond = (LAS float*)lds;
    LAS float* red = cond + 4096;
    const int tid = tidx(), lane = tid & 63, wave = tid >> 6;
    float* mod = (float*)(p->ws + WS_MISC); float* lb = mod + 4 * 4 * 6144;
    for (int i = tid; i < 4096; i += 512) cond[i] = siluf_(p->in[1][i]);
    __syncthreads();
    for (int task = bidx(); task < 384; task += gdim()) {
        const int l = task / 96, cb = task % 96, col = cb * 64 + lane;
        float a0 = 0.f, a1 = 0.f, a2 = 0.f, a3 = 0.f;
        const float* wp = p->in[3] + ((size_t)l * 1024 + wave * 128) * 6144 + col;
#pragma unroll 8
        for (int k = 0; k < 128; ++k) { const float wv = wp[(size_t)k * 6144]; const int kk = wave * 128 + k;
            a0 += cond[kk] * wv; a1 += cond[1024 + kk] * wv; a2 += cond[2048 + kk] * wv; a3 += cond[3072 + kk] * wv; }
        red[(wave * 4 + 0) * 64 + lane] = a0; red[(wave * 4 + 1) * 64 + lane] = a1; red[(wave * 4 + 2) * 64 + lane] = a2; red[(wave * 4 + 3) * 64 + lane] = a3;
        __syncthreads();
        if (tid < 256) { const int b = tid >> 6; float s = 0.f;
#pragma unroll
            for (int w = 0; w < 8; ++w) s += red[(w * 4 + b) * 64 + lane];
            mod[((size_t)l * 4 + b) * 6144 + col] = s + p->in[4][(size_t)l * 6144 + col]; }
        __syncthreads();
    }
    for (int c = bidx() * 512 + tid; c < 1024; c += gdim() * 512) {
        const float l0 = p->in[12][c], l1 = p->in[12][1024 + c], l2 = p->in[12][2048 + c], l3 = p->in[12][3072 + c];
        const float mx = fmaxf(fmaxf(l0, l1), fmaxf(l2, l3));
        const float e0 = __expf(l0 - mx), e1 = __expf(l1 - mx), e2 = __expf(l2 - mx), e3 = __expf(l3 - mx);
        lb[c] = e1 / (e0 + e1 + e2 + e3);
    }
}

__device__ __forceinline__ void convglu_phase(const bf16_t* HID, bf16_t* ACT, int g, const float* cw, const float* cb) {
    const int nch = g ? 1280 : 1536, ch0 = g ? 1536 : 0, ld = 2 * nch, ncg = nch / 8;
    const int total = (MROWS / 16) * ncg;
    for (int task = bidx() * 512 + tidx(); task < total; task += gdim() * 512) {
        const int cgi = task % ncg, run = task / ncg, row0 = run * 16, t0 = row0 & (SEQ - 1), j0 = cgi * 8, ch = ch0 + j0;
        float wv[3][8], wg[3][8], bv[8], bg[8];
#pragma unroll
        for (int k = 0; k < 3; ++k)
#pragma unroll
            for (int e = 0; e < 8; ++e) { wv[k][e] = cw[k * 5632 + ch + e]; wg[k][e] = cw[k * 5632 + 2816 + ch + e]; }
#pragma unroll
        for (int e = 0; e < 8; ++e) { bv[e] = cb[ch + e]; bg[e] = cb[2816 + ch + e]; }
        u32x4 v2 = (u32x4){0, 0, 0, 0}, v1 = v2, g2 = v2, g1 = v2;
        if (t0 >= 2) {
            v2 = *(const u32x4*)(HID + (size_t)(row0 - 2) * ld + j0); g2 = *(const u32x4*)(HID + (size_t)(row0 - 2) * ld + nch + j0);
            v1 = *(const u32x4*)(HID + (size_t)(row0 - 1) * ld + j0); g1 = *(const u32x4*)(HID + (size_t)(row0 - 1) * ld + nch + j0);
        }
        u32x4 va[4], ga[4], vb4[4], gb4[4];
#define CG_LOAD(V, G, r0) do { _Pragma("unroll") for (int q_ = 0; q_ < 4; ++q_) { V[q_] = *(const u32x4*)(HID + (size_t)(row0 + (r0) + q_) * ld + j0); G[q_] = *(const u32x4*)(HID + (size_t)(row0 + (r0) + q_) * ld + nch + j0); } } while (0)
#define CG_ROWS(V, G, r0) do { _Pragma("unroll") for (int q_ = 0; q_ < 4; ++q_) { const u32x4 v0 = V[q_], g0 = G[q_]; u32x4 o; \
            _Pragma("unroll") for (int q = 0; q < 4; ++q) { \
                const float yv0 = wv[0][2 * q] * bflo(v2[q]) + wv[1][2 * q] * bflo(v1[q]) + wv[2][2 * q] * bflo(v0[q]) + bv[2 * q]; \
                const float yv1 = wv[0][2 * q + 1] * bfhi(v2[q]) + wv[1][2 * q + 1] * bfhi(v1[q]) + wv[2][2 * q + 1] * bfhi(v0[q]) + bv[2 * q + 1]; \
                const float yg0 = wg[0][2 * q] * bflo(g2[q]) + wg[1][2 * q] * bflo(g1[q]) + wg[2][2 * q] * bflo(g0[q]) + bg[2 * q]; \
                const float yg1 = wg[0][2 * q + 1] * bfhi(g2[q]) + wg[1][2 * q + 1] * bfhi(g1[q]) + wg[2][2 * q + 1] * bfhi(g0[q]) + bg[2 * q + 1]; \
                o[q] = pack2(yv0 * siluf_(yg0), yv1 * siluf_(yg1)); } \
            *(u32x4*)(ACT + (size_t)(row0 + (r0) + q_) * 2816 + ch) = o; \
            v2 = v1; v1 = v0; g2 = g1; g1 = g0; } } while (0)
        CG_LOAD(va, ga, 0);
        CG_LOAD(vb4, gb4, 4);
        CG_ROWS(va, ga, 0);
        CG_LOAD(va, ga, 8);
        CG_ROWS(vb4, gb4, 4);
        CG_LOAD(vb4, gb4, 12);
        CG_ROWS(va, ga, 8);
        CG_ROWS(vb4, gb4, 12);
#undef CG_LOAD
#undef CG_ROWS
    }
}

template <int KIND>
__device__ __forceinline__ void scan_phase(LAS unsigned char* lds, PPTR p, int j) {
    constexpr int N = (KIND == 2) ? 64 : 128;
    constexpr int NH = (KIND == 2) ? 16 : 8;
    constexpr int RG = N / 16;
    constexpr int STRIDE = (KIND == 0) ? 288 : (KIND == 1 ? 272 : 336);
    constexpr int TC = 32, NC = SEQ / TC;
    constexpr int LDP = (KIND == 0) ? 4352 : (KIND == 1 ? 4096 : 3328);
    LAS float* buf = (LAS float*)lds;
    LAS float* ob = buf + 2 * TC * STRIDE;
    const int tid = tidx(), wave = tid >> 6, lane = tid & 63;
    const bool is_loader = wave >= 4; const int lw = wave - 4;
    const int li = lane & 15, row = (wave & 3) * 4 + (lane >> 4);
    const bf16_t* P = (const bf16_t*)(p->ws + (KIND == 2 ? WS_PROJC : WS_PROJ));
    const bf16_t* L2 = (const bf16_t*)(p->ws + WS_R1);
    bf16_t* O = (bf16_t*)(p->ws + (KIND == 2 ? WS_OC : WS_R1));
    const int G = gdim(); const int vcu = (G % 8 == 0) ? (int)(bidx() % 8) * (G / 8) + (int)(bidx() / 8) : (int)bidx();
    for (int task = vcu; task < 256; task += G) {
        const int bh = task / RG, rg = task % RG, b = bh / NH, h = bh % NH;
        const size_t rbase = (size_t)b * SEQ;
        float cwq[4][2], cwk[4][2], cwv[4]; float expA = 0.f, dtb = 0.f; float lbv[2]; float w0v = 0.f, a0v = 0.f, kkc = 0.f, kac = 0.f;
        if (KIND == 0) { const float* cv = p->in[6] + (size_t)j * 4 * 3072;
#pragma unroll
            for (int jj = 0; jj < 4; ++jj) { cwq[jj][0] = cv[jj * 3072 + h * 128 + 2 * lane]; cwq[jj][1] = cv[jj * 3072 + h * 128 + 2 * lane + 1];
                cwk[jj][0] = cv[jj * 3072 + 1024 + h * 128 + 2 * lane]; cwk[jj][1] = cv[jj * 3072 + 1024 + h * 128 + 2 * lane + 1];
                cwv[jj] = cv[jj * 3072 + 2048 + h * 128 + 16 * rg + (lane & 15)]; }
            expA = __expf(p->in[7][j * 8 + h]); dtb = p->in[8][j * 8 + h]; }
        if (KIND == 1) { const float* lbp = (const float*)(p->ws + WS_MISC) + 4 * 4 * 6144; lbv[0] = lbp[h * 128 + 2 * lane]; lbv[1] = lbp[h * 128 + 2 * lane + 1]; }
        if (KIND == 2) { const int ch = h * 64 + lane; w0v = p->in[17][ch]; a0v = p->in[20][ch]; kkc = p->in[25][ch]; kac = p->in[26][ch]; }
        unsigned x0[11], x1[11], x2[11], x3[8], x4[8];
        f32x2 s[4];
#pragma unroll
        for (int e = 0; e < 4; ++e) s[e] = (f32x2){0.f, 0.f};

#define SCAN_LOAD(cc) do { const int c_ = (cc); \
        if (KIND == 0) { const int tfirst = c_ * TC + 8 * lw - 3; \
            _Pragma("unroll") for (int q = 0; q < 11; ++q) { const int t_ = tfirst + q; const bool valid = t_ >= 0; const bf16_t* rowp = P + (rbase + (valid ? t_ : 0)) * LDP; \
                const unsigned vq = *(const unsigned*)(rowp + h * 128 + 2 * lane), vk = *(const unsigned*)(rowp + 1024 + h * 128 + 2 * lane); \
                const int mcol = lane < 16 ? 2048 + h * 128 + 16 * rg + lane : (lane == 32 ? 4096 + h : (lane == 33 ? 4104 + h : 2048 + h * 128)); \
                const unsigned vm = rowp[mcol]; x0[q] = valid ? vq : 0u; x1[q] = valid ? vk : 0u; x2[q] = valid ? vm : 0u; } } \
        else if (KIND == 1) { const int tfirst = c_ * TC + 8 * lw; \
            _Pragma("unroll") for (int q = 0; q < 8; ++q) { const bf16_t* rowp = P + (rbase + tfirst + q) * LDP; \
                x0[q] = *(const unsigned*)(rowp + h * 128 + 2 * lane); x1[q] = *(const unsigned*)(rowp + 1024 + h * 128 + 2 * lane); \
                x2[q] = rowp[2048 + h * 128 + 16 * rg + (lane & 15)]; } } \
        else { const int tfirst = c_ * TC + 8 * lw; \
            _Pragma("unroll") for (int q = 0; q < 8; ++q) { const bf16_t* rowp = P + (rbase + tfirst + q) * LDP; const bf16_t* l2p = L2 + (rbase + tfirst + q) * 3072; \
                x0[q] = rowp[h * 64 + lane]; x1[q] = rowp[1024 + h * 64 + lane]; x2[q] = rowp[2048 + h * 64 + 16 * rg + (lane & 15)]; \
                x3[q] = l2p[h * 64 + lane]; x4[q] = l2p[1024 + h * 64 + lane]; } } } while (0)

#define SCAN_FLUSH(cc) do { const int c_ = (cc); LAS const float* src = ob + (c_ & 1) * (TC * 16) + (lane >> 1) * 16 + (lane & 1) * 8; \
        u32x4 w; w.x = pack2(src[0], src[1]); w.y = pack2(src[2], src[3]); w.z = pack2(src[4], src[5]); w.w = pack2(src[6], src[7]); \
        *(u32x4*)(O + (rbase + c_ * TC + (lane >> 1)) * DM + h * N + 16 * rg + (lane & 1) * 8) = w; } while (0)

        if (is_loader) SCAN_LOAD(0);
        for (int it = 0; it <= NC; ++it) {
            if (is_loader) {
                if (it < NC) {
                    LAS float* bw = buf + (it & 1) * (TC * STRIDE);
#pragma unroll
                    for (int i = 0; i < 8; ++i) {
                        LAS float* rec = bw + (8 * lw + i) * STRIDE;
                        if (KIND == 0) {
                            float yq0 = 0.f, yq1 = 0.f, yk0 = 0.f, yk1 = 0.f, yv = 0.f;
#pragma unroll
                            for (int jj = 0; jj < 4; ++jj) { yq0 += cwq[jj][0] * bflo(x0[i + jj]); yq1 += cwq[jj][1] * bfhi(x0[i + jj]);
                                yk0 += cwk[jj][0] * bflo(x1[i + jj]); yk1 += cwk[jj][1] * bfhi(x1[i + jj]); yv += cwv[jj] * bf2f(x2[i + jj]); }
                            yq0 = siluf_(yq0); yq1 = siluf_(yq1); yk0 = siluf_(yk0); yk1 = siluf_(yk1);
                            const float ssq = wave_allsum(yq0 * yq0 + yq1 * yq1), ssk = wave_allsum(yk0 * yk0 + yk1 * yk1);
                            const float rq = __builtin_amdgcn_rsqf(ssq + 1e-6f) * 0.08838834764831845f, rk = __builtin_amdgcn_rsqf(ssk + 1e-6f);
                            *(LAS f32x2*)(rec + 2 * lane) = (f32x2){yk0 * rk, yk1 * rk};
                            *(LAS f32x2*)(rec + 128 + 2 * lane) = (f32x2){yq0 * rq, yq1 * rq};
                            const float m3 = bf2f(x2[i + 3]);
                            if (lane < 16) rec[256 + lane] = siluf_(yv);
                            else if (lane == 32) rec[273] = __expf(-expA * softplusf_(m3 + dtb));
                            else if (lane == 33) rec[272] = sigmoidf_(m3);
                        } else if (KIND == 1) {
                            const float q0 = siluf_(bflo(x0[i])), q1 = siluf_(bfhi(x0[i]));
                            const float f0 = lbv[0] + (1.0f - lbv[0]) * sigmoidf_(bflo(x1[i])), f1 = lbv[1] + (1.0f - lbv[1]) * sigmoidf_(bfhi(x1[i]));
                            *(LAS f32x2*)(rec + 2 * lane) = (f32x2){q0, q1};
                            *(LAS f32x2*)(rec + 128 + 2 * lane) = (f32x2){f0, f1};
                            if (lane < 16) rec[256 + lane] = bf2f(x2[i]);
                        } else {
                            const float r = bf2f(x0[i]), kraw = bf2f(x1[i]), whi = bf2f(x3[i]), ahi = bf2f(x4[i]);
                            const float wv = -softplusf_(-(w0v + whi)) - 0.5f; const float d = __expf(-__expf(wv));
                            const float ag = sigmoidf_(a0v + ahi);
                            const float kkx = kraw * kkc; const float ss = wave_allsum(kkx * kkx); const float kk = kkx * __builtin_amdgcn_rsqf(ss + 1e-6f);
                            const float kp = kraw * (1.0f + (ag - 1.0f) * kac);
                            rec[lane] = -kk; rec[64 + lane] = kk * ag; rec[128 + lane] = d; rec[192 + lane] = kp; rec[256 + lane] = r;
                            if (lane < 16) rec[320 + lane] = bf2f(x2[i]);
                        }
                    }
                    if (it + 1 < NC) SCAN_LOAD(it + 1);
                }
                if (it >= 2 && lw == 0) SCAN_FLUSH(it - 2);
            } else if (it >= 1) {
                LAS const float* bc = buf + ((it - 1) & 1) * (TC * STRIDE);
                LAS float* oc = ob + ((it - 1) & 1) * (TC * 16);
                StepRegs R[2][2];
                step_load<KIND>(R[0][0], bc, li, row); step_load<KIND>(R[0][1], bc + STRIDE, li, row);
                float osel = 0.f;
#pragma unroll
                for (int g = 0; g < 16; ++g) {
                    if (g + 1 < 16) { step_load<KIND>(R[(g + 1) & 1][0], bc + (2 * g + 2) * STRIDE, li, row); step_load<KIND>(R[(g + 1) & 1][1], bc + (2 * g + 3) * STRIDE, li, row); }
#pragma unroll
                    for (int u = 0; u < 2; ++u) { const float o = step_compute<KIND>(R[g & 1][u], s); osel = (li == ((2 * g + u) & 15)) ? o : osel; }
                    if (g == 7 || g == 15) oc[((g == 15 ? 16 : 0) + li) * 16 + row] = osel;
                }
            }
            lds_barrier();
        }
        if (is_loader && lw == 0) SCAN_FLUSH(NC - 1);
        lds_barrier();
#undef SCAN_LOAD
#undef SCAN_FLUSH
    }
}


typedef short bf16x4 __attribute__((ext_vector_type(4)));
__device__ __forceinline__ bf16x8 cat4(bf16x4 lo, bf16x4 hi) { return __builtin_shufflevector(lo, hi, 0, 1, 2, 3, 4, 5, 6, 7); }
__device__ __forceinline__ bf16x4 cvt4(f32x4 v) { u32x2 w; w.x = pg8::cvt_pk_bf16(v[0], v[1]); w.y = pg8::cvt_pk_bf16(v[2], v[3]); return __builtin_bit_cast(bf16x4, w); }
constexpr size_t WS_KG = WS_R1 + 64 * MiB;
constexpr size_t WS_AM = 420 * MiB;
constexpr size_t WS_DEC = 428 * MiB;

__device__ __forceinline__ void prep_gla(LAS unsigned char* lds, PPTR p) {
    const int tid = tidx(), w = tid >> 6, lane = tid & 63, n = lane & 15, kg = lane >> 4;
    LAS unsigned char* qs = lds + w * 8704; LAS unsigned char* ks = qs + 4352;
    const bf16_t* P = (const bf16_t*)(p->ws + WS_PROJ);
    bf16_t* Qg = (bf16_t*)(p->ws + WS_R1); bf16_t* Kg = (bf16_t*)(p->ws + WS_KG);
    bf16_t* Amg = (bf16_t*)(p->ws + WS_AM); float* Decg = (float*)(p->ws + WS_DEC);
    const float* lbp = (const float*)(p->ws + WS_MISC) + 4 * 4 * 6144;
    for (int task = bidx() * 8 + w; task < 4 * 512 * 8; task += gdim() * 8) {
        const int h = task & 7, rc = task >> 3; const size_t row0 = (size_t)rc * 16;
        const float lb0 = lbp[h * 128 + 2 * lane], lb1 = lbp[h * 128 + 2 * lane + 1];
        unsigned xq[16], xf[16];
#pragma unroll
        for (int t = 0; t < 16; ++t) { const bf16_t* rowp = P + (row0 + t) * 4096 + h * 128 + 2 * lane; xq[t] = *(const unsigned*)rowp; xf[t] = *(const unsigned*)(rowp + 1024); }
        float bc0 = 0.f, bc1 = 0.f; float kk0[16], kk1[16], bs0[16], bs1[16];
#pragma unroll
        for (int t = 0; t < 16; ++t) {
            const float q0 = siluf_(bflo(xq[t])), q1 = siluf_(bfhi(xq[t]));
            const float f0 = lb0 + (1.0f - lb0) * sigmoidf_(bflo(xf[t])), f1 = lb1 + (1.0f - lb1) * sigmoidf_(bfhi(xf[t]));
            bc0 += __logf(f0); bc1 += __logf(f1);
            kk0[t] = 1.0f - f0; kk1[t] = 1.0f - f1; bs0[t] = bc0; bs1[t] = bc1;
            const unsigned qp = pack2(q0 * __expf(bc0), q1 * __expf(bc1));
            *(unsigned*)(Qg + (row0 + t) * 1024 + h * 128 + 2 * lane) = qp;
            *(LAS unsigned*)(qs + t * 272 + 4 * lane) = qp;
        }
#pragma unroll
        for (int t = 0; t < 16; ++t) {
            *(unsigned*)(Kg + (row0 + t) * 1024 + h * 128 + 2 * lane) = pack2(kk0[t] * __expf(bc0 - bs0[t]), kk1[t] * __expf(bc1 - bs1[t]));
            *(LAS unsigned*)(ks + t * 272 + 4 * lane) = pack2(kk0[t] * __expf(-bs0[t]), kk1[t] * __expf(-bs1[t]));
        }
        *(f32x2*)(Decg + (size_t)task * 128 + 2 * lane) = (f32x2){__expf(bc0), __expf(bc1)};
        asm volatile("s_waitcnt lgkmcnt(0)" ::: "memory");
        f32x4 acc = (f32x4){0.f, 0.f, 0.f, 0.f};
#pragma unroll
        for (int a = 0; a < 4; ++a) {
            const bf16x8 af = *(LAS const bf16x8*)(qs + n * 272 + (32 * a + 8 * kg) * 2);
            const bf16x8 bfr = *(LAS const bf16x8*)(ks + n * 272 + (32 * a + 8 * kg) * 2);
            acc = __builtin_amdgcn_mfma_f32_16x16x32_bf16(af, bfr, acc, 0, 0, 0);
        }
#pragma unroll
        for (int jj = 0; jj < 4; ++jj) { const int t = 4 * kg + jj; Amg[(size_t)task * 256 + t * 16 + n] = (bf16_t)f2bf(n <= t ? acc[jj] : 0.f); }
        asm volatile("s_waitcnt lgkmcnt(0)" ::: "memory");
    }
}

__device__ __forceinline__ void scan_gla(LAS unsigned char* lds, PPTR p) {
    constexpr int QOFF = 0, KTOFF = 4352, VOFF = 9472, AMOFF = 13824, DECOFF = 14336, BUFB = 14848;
    const int tid = tidx(), w = tid >> 6, lane = tid & 63, n = lane & 15, kg = lane >> 4;
    const bf16_t* P = (const bf16_t*)(p->ws + WS_PROJ);
    bf16_t* Qg = (bf16_t*)(p->ws + WS_R1); const bf16_t* Kg = (const bf16_t*)(p->ws + WS_KG);
    const bf16_t* Amg = (const bf16_t*)(p->ws + WS_AM); const float* Decg = (const float*)(p->ws + WS_DEC);
    bf16_t* Og = (bf16_t*)(p->ws + WS_OC);
    const bf16x4 z4 = (bf16x4){0, 0, 0, 0};
    for (int task = bidx(); task < 32; task += gdim()) {
        const int b = task >> 3, h = task & 7; const size_t rowbase = (size_t)b * SEQ;
        f32x4 S[8]; bf16x8 Sb[4];
#pragma unroll
        for (int i = 0; i < 8; ++i) S[i] = (f32x4){0.f, 0.f, 0.f, 0.f};
#pragma unroll
        for (int a = 0; a < 4; ++a) Sb[a] = (bf16x8){0, 0, 0, 0, 0, 0, 0, 0};
        const int lt = (tid & 255) >> 4, pc = tid & 15;
        constexpr int PD = 8;
        u32x4 g0[PD], g1[PD];
#define GLA_LOAD(cc, sl) do { const int c_ = (cc); const size_t r_ = rowbase + (size_t)c_ * 16 + lt; \
            if (tid < 256) { g0[sl] = *(const u32x4*)(Qg + r_ * 1024 + h * 128 + 8 * pc); g1[sl] = *(const u32x4*)(P + r_ * 4096 + 2048 + h * 128 + 8 * pc); } \
            else { g0[sl] = *(const u32x4*)(Kg + r_ * 1024 + h * 128 + 8 * pc); const size_t ch_ = ((size_t)(b * 512 + c_) * 8 + h); \
                if (tid < 288) g1[sl] = *(const u32x4*)(Amg + ch_ * 256 + (tid - 256) * 8); else if (tid < 320) g1[sl] = *(const u32x4*)(Decg + ch_ * 128 + (tid - 288) * 4); } } while (0)
#define GLA_STORE(cc, sl) do { LAS unsigned char* bb_ = lds + ((cc) & 1) * BUFB; \
            if (tid < 256) { *(LAS u32x4*)(bb_ + QOFF + lt * 272 + 16 * pc) = g0[sl]; *(LAS u32x4*)(bb_ + VOFF + lt * 272 + 16 * pc) = g1[sl]; } \
            else { _Pragma("unroll") for (int e = 0; e < 4; ++e) { *(LAS unsigned short*)(bb_ + KTOFF + (8 * pc + 2 * e) * 40 + 2 * lt) = (unsigned short)(g0[sl][e] & 0xffffu); \
                    *(LAS unsigned short*)(bb_ + KTOFF + (8 * pc + 2 * e + 1) * 40 + 2 * lt) = (unsigned short)(g0[sl][e] >> 16); } \
                if (tid < 288) *(LAS u32x4*)(bb_ + AMOFF + (tid - 256) * 16) = g1[sl]; else if (tid < 320) *(LAS u32x4*)(bb_ + DECOFF + (tid - 288) * 16) = g1[sl]; } } while (0)
#pragma unroll
        for (int d = 0; d < PD; ++d) GLA_LOAD(d, d);
        GLA_STORE(0, 0); lds_barrier();
        for (int c0 = 0; c0 < 512; c0 += PD) {
#pragma unroll
          for (int d = 0; d < PD; ++d) {
            const int c = c0 + d;
            if (c + PD < 512) GLA_LOAD(c + PD, d);
            LAS const unsigned char* bb = lds + (c & 1) * BUFB;
            f32x4 Z = (f32x4){0.f, 0.f, 0.f, 0.f};
#pragma unroll
            for (int a = 0; a < 4; ++a) {
                const bf16x4 lo = *(LAS const bf16x4*)(bb + QOFF + n * 272 + (32 * a + 4 * kg) * 2), hi = *(LAS const bf16x4*)(bb + QOFF + n * 272 + (32 * a + 16 + 4 * kg) * 2);
                Z = __builtin_amdgcn_mfma_f32_16x16x32_bf16(cat4(lo, hi), Sb[a], Z, 0, 0, 0);
            }
            bf16x4 vb;
#pragma unroll
            for (int j = 0; j < 4; ++j) vb[j] = *(LAS const short*)(bb + VOFF + (4 * kg + j) * 272 + (16 * w + n) * 2);
            const bf16x8 Vb = cat4(vb, z4);
            const bf16x4 am = *(LAS const bf16x4*)(bb + AMOFF + n * 32 + 8 * kg);
            const f32x4 o = __builtin_amdgcn_mfma_f32_16x16x32_bf16(cat4(am, z4), Vb, Z, 0, 0, 0);
#pragma unroll
            for (int i = 0; i < 8; ++i) {
                const f32x4 d4 = *(LAS const f32x4*)(bb + DECOFF + (16 * i + 4 * kg) * 4);
                const bf16x4 kt = *(LAS const bf16x4*)(bb + KTOFF + (16 * i + n) * 40 + 8 * kg);
                S[i] = __builtin_amdgcn_mfma_f32_16x16x32_bf16(cat4(kt, z4), Vb, S[i] * d4, 0, 0, 0);
            }
#pragma unroll
            for (int a = 0; a < 4; ++a) Sb[a] = cat4(cvt4(S[2 * a]), cvt4(S[2 * a + 1]));
#pragma unroll
            for (int j = 0; j < 4; ++j) Og[(rowbase + (size_t)c * 16 + 4 * kg + j) * 1024 + h * 128 + 16 * w + n] = (bf16_t)f2bf(o[j]);
            if (c + 1 < 512) GLA_STORE(c + 1, (d + 1) % PD);
            lds_barrier();
          }
        }
#undef GLA_LOAD
#undef GLA_STORE
    }
}


template <int SGN>
__device__ __forceinline__ void tri_inv16(LAS const float* Lm, int n, float (&x)[16]) {
    x[0] = (n == 0) ? 1.f : 0.f;
    {
        f32x4 la[12];
#pragma unroll
        for (int t = 1; t <= 4; ++t) la[t - 1] = *(LAS const f32x4*)(Lm + t * 16);
#pragma unroll
        for (int t = 5; t <= 8; ++t) { la[4 + 2 * (t - 5)] = *(LAS const f32x4*)(Lm + t * 16); la[5 + 2 * (t - 5)] = *(LAS const f32x4*)(Lm + t * 16 + 4); }
        __builtin_amdgcn_sched_barrier(0);
#pragma unroll
        for (int t = 1; t <= 8; ++t) { float acc = (n == t) ? 1.f : 0.f;
#pragma unroll
            for (int q = 0; q < (t + 3) / 4; ++q) { const f32x4 l4 = (t <= 4) ? la[t - 1] : la[4 + 2 * (t - 5) + q];
#pragma unroll
                for (int e = 0; e < 4; ++e) if (4 * q + e < t) acc += (float)SGN * l4[e] * x[4 * q + e]; }
            x[t] = acc; }
    }
    __builtin_amdgcn_sched_barrier(0);
    {   f32x4 lb[12];
#pragma unroll
        for (int t = 9; t <= 12; ++t)
#pragma unroll
            for (int q = 0; q < 3; ++q) lb[3 * (t - 9) + q] = *(LAS const f32x4*)(Lm + t * 16 + 4 * q);
        __builtin_amdgcn_sched_barrier(0);
#pragma unroll
        for (int t = 9; t <= 12; ++t) { float acc = (n == t) ? 1.f : 0.f;
#pragma unroll
            for (int q = 0; q < 3; ++q) { const f32x4 l4 = lb[3 * (t - 9) + q];
#pragma unroll
                for (int e = 0; e < 4; ++e) if (4 * q + e < t) acc += (float)SGN * l4[e] * x[4 * q + e]; }
            x[t] = acc; }
    }
    __builtin_amdgcn_sched_barrier(0);
    {   f32x4 lc[12];
#pragma unroll
        for (int t = 13; t <= 15; ++t)
#pragma unroll
            for (int q = 0; q < 4; ++q) lc[4 * (t - 13) + q] = *(LAS const f32x4*)(Lm + t * 16 + 4 * q);
        __builtin_amdgcn_sched_barrier(0);
#pragma unroll
        for (int t = 13; t <= 15; ++t) { float acc = (n == t) ? 1.f : 0.f;
#pragma unroll
            for (int q = 0; q < 4; ++q) { const f32x4 l4 = lc[4 * (t - 13) + q];
#pragma unroll
                for (int e = 0; e < 4; ++e) if (4 * q + e < t) acc += (float)SGN * l4[e] * x[4 * q + e]; }
            x[t] = acc; }
    }
}

constexpr size_t WS_TA = 436 * MiB;
constexpr size_t WS_AMA = 444 * MiB;
constexpr size_t WS_SCA = 452 * MiB;

__device__ __forceinline__ void prep_delta(LAS unsigned char* lds, PPTR p, int j) {
    const int tid = tidx(), w = tid >> 6, lane = tid & 63, n = lane & 15, kg = lane >> 4;
    LAS unsigned char* qs = lds + w * 9984; LAS unsigned char* ks = qs + 4352; LAS float* Lm = (LAS float*)(ks + 4352); LAS float* sc = Lm + 256;
    const bf16_t* P = (const bf16_t*)(p->ws + WS_PROJ);
    bf16_t* Qg = (bf16_t*)(p->ws + WS_R1); bf16_t* Kg = (bf16_t*)(p->ws + WS_KG);
    bf16_t* Tg = (bf16_t*)(p->ws + WS_TA); bf16_t* Amg = (bf16_t*)(p->ws + WS_AMA); float* Scg = (float*)(p->ws + WS_SCA);
    const float* cv = p->in[6] + (size_t)j * 4 * 3072;
    for (int task = bidx() * 8 + w; task < 4 * 512 * 8; task += gdim() * 8) {
        const int h = task & 7, rc = task >> 3; const size_t row0 = (size_t)rc * 16; const int t0 = (rc & 511) * 16;
        float cwq[4][2], cwk[4][2];
#pragma unroll
        for (int jj = 0; jj < 4; ++jj) { cwq[jj][0] = cv[jj * 3072 + h * 128 + 2 * lane]; cwq[jj][1] = cv[jj * 3072 + h * 128 + 2 * lane + 1];
            cwk[jj][0] = cv[jj * 3072 + 1024 + h * 128 + 2 * lane]; cwk[jj][1] = cv[jj * 3072 + 1024 + h * 128 + 2 * lane + 1]; }
        unsigned xq[19], xk[19];
#pragma unroll
        for (int r = 0; r < 19; ++r) { const bool valid = (t0 + r - 3) >= 0; const bf16_t* rowp = P + (row0 + (valid ? r - 3 : 0)) * 4352 + h * 128 + 2 * lane;
            const unsigned vq = *(const unsigned*)rowp, vk = *(const unsigned*)(rowp + 1024); xq[r] = valid ? vq : 0u; xk[r] = valid ? vk : 0u; }
        float beta, G;
        { const bf16_t* rowp = P + (row0 + n) * 4352; const float a_raw = bf2f(rowp[4096 + h]), b_raw = bf2f(rowp[4104 + h]);
          beta = sigmoidf_(b_raw); G = -__expf(p->in[7][j * 8 + h]) * softplusf_(a_raw + p->in[8][j * 8 + h]);
          float tq; tq = __int_as_float(__builtin_amdgcn_update_dpp(0, __float_as_int(G), 0x111, 0xf, 0xf, true)); G += tq;
          tq = __int_as_float(__builtin_amdgcn_update_dpp(0, __float_as_int(G), 0x112, 0xf, 0xf, true)); G += tq;
          tq = __int_as_float(__builtin_amdgcn_update_dpp(0, __float_as_int(G), 0x114, 0xf, 0xf, true)); G += tq;
          tq = __int_as_float(__builtin_amdgcn_update_dpp(0, __float_as_int(G), 0x118, 0xf, 0xf, true)); G += tq; }
        const float G15 = __int_as_float(__builtin_amdgcn_readlane(__float_as_int(G), 15));
        if (lane < 16) { sc[lane] = beta; sc[16 + lane] = G;
            float* so = Scg + (size_t)task * 64; so[lane] = beta; so[16 + lane] = __expf(G); so[32 + lane] = __expf(G15 - G); if (lane == 0) so[48] = __expf(G15); }
#pragma unroll
        for (int t = 0; t < 16; ++t) {
            float yq0 = 0.f, yq1 = 0.f, yk0 = 0.f, yk1 = 0.f;
#pragma unroll
            for (int jj = 0; jj < 4; ++jj) { yq0 += cwq[jj][0] * bflo(xq[t + jj]); yq1 += cwq[jj][1] * bfhi(xq[t + jj]); yk0 += cwk[jj][0] * bflo(xk[t + jj]); yk1 += cwk[jj][1] * bfhi(xk[t + jj]); }
            yq0 = siluf_(yq0); yq1 = siluf_(yq1); yk0 = siluf_(yk0); yk1 = siluf_(yk1);
            const float ssq = wave_allsum(yq0 * yq0 + yq1 * yq1), ssk = wave_allsum(yk0 * yk0 + yk1 * yk1);
            const float rq = __builtin_amdgcn_rsqf(ssq + 1e-6f) * 0.08838834764831845f, rk = __builtin_amdgcn_rsqf(ssk + 1e-6f);
            const unsigned qp = pack2(yq0 * rq, yq1 * rq), kp = pack2(yk0 * rk, yk1 * rk);
            *(unsigned*)(Qg + (row0 + t) * 1024 + h * 128 + 2 * lane) = qp; *(unsigned*)(Kg + (row0 + t) * 1024 + h * 128 + 2 * lane) = kp;
            *(LAS unsigned*)(qs + t * 272 + 4 * lane) = qp; *(LAS unsigned*)(ks + t * 272 + 4 * lane) = kp;
        }
        asm volatile("s_waitcnt lgkmcnt(0)" ::: "memory");
        f32x4 akk = (f32x4){0.f, 0.f, 0.f, 0.f}, aqk = akk;
#pragma unroll
        for (int a = 0; a < 4; ++a) {
            const bf16x8 qf = *(LAS const bf16x8*)(qs + n * 272 + (32 * a + 8 * kg) * 2);
            const bf16x8 kf = *(LAS const bf16x8*)(ks + n * 272 + (32 * a + 8 * kg) * 2);
            akk = __builtin_amdgcn_mfma_f32_16x16x32_bf16(kf, kf, akk, 0, 0, 0);
            aqk = __builtin_amdgcn_mfma_f32_16x16x32_bf16(qf, kf, aqk, 0, 0, 0);
        }
        { const float Gn = sc[16 + n]; const f32x4 bt = *(LAS const f32x4*)(sc + 4 * kg), Gt = *(LAS const f32x4*)(sc + 16 + 4 * kg);
#pragma unroll
          for (int jj = 0; jj < 4; ++jj) { const int t = 4 * kg + jj; const float dec = __expf(Gt[jj] - Gn);
              Lm[t * 16 + n] = (n < t) ? bt[jj] * akk[jj] * dec : 0.f;
              Amg[(size_t)task * 256 + t * 16 + n] = (bf16_t)f2bf(n <= t ? aqk[jj] * dec : 0.f); } }
        asm volatile("s_waitcnt lgkmcnt(0)" ::: "memory");
        float x[16];
        tri_inv16<-1>(Lm, n, x);
#pragma unroll
        for (int jj = 0; jj < 4; ++jj) { const float v = (kg == 0) ? x[jj] : (kg == 1 ? x[4 + jj] : (kg == 2 ? x[8 + jj] : x[12 + jj]));
            Tg[(size_t)task * 256 + (4 * kg + jj) * 16 + n] = (bf16_t)f2bf(v); }
        asm volatile("s_waitcnt lgkmcnt(0)" ::: "memory");
    }
}

__device__ __forceinline__ void scan_delta(LAS unsigned char* lds, PPTR p, int j) {
    constexpr int QOFF = 0, KOFF = 4352, KTOFF = 8704, VOFF = 13824, TOFF = 18992, AMOFF = 19504, SCOFF = 20016, BUFB = 20272;
    const int tid = tidx(), w = tid >> 6, lane = tid & 63, n = lane & 15, kg = lane >> 4;
    const bf16_t* P = (const bf16_t*)(p->ws + WS_PROJ);
    bf16_t* Qg = (bf16_t*)(p->ws + WS_R1); const bf16_t* Kg = (const bf16_t*)(p->ws + WS_KG);
    const bf16_t* Tg = (const bf16_t*)(p->ws + WS_TA); const bf16_t* Amg = (const bf16_t*)(p->ws + WS_AMA); const float* Scg = (const float*)(p->ws + WS_SCA);
    const float* cv = p->in[6] + (size_t)j * 4 * 3072;
    const bf16x4 z4 = (bf16x4){0, 0, 0, 0};
    for (int task = bidx(); task < 32; task += gdim()) {
        const int b = task >> 3, h = task & 7; const size_t rowbase = (size_t)b * SEQ;
        float cwv[4];
#pragma unroll
        for (int jj = 0; jj < 4; ++jj) cwv[jj] = cv[jj * 3072 + 2048 + h * 128 + 16 * w + n];
        f32x4 S[8]; bf16x8 Sb[4];
#pragma unroll
        for (int i = 0; i < 8; ++i) S[i] = (f32x4){0.f, 0.f, 0.f, 0.f};
#pragma unroll
        for (int a = 0; a < 4; ++a) Sb[a] = (bf16x8){0, 0, 0, 0, 0, 0, 0, 0};
        const int lt = (tid & 255) >> 4, pc = tid & 15, vr = tid >> 4;
        constexpr int PD = 8;
        u32x4 g0[PD], g1[PD];
#define DL_LOAD(cc, sl) do { const int c_ = (cc); const size_t r_ = rowbase + (size_t)c_ * 16 + lt; const size_t ch_ = ((size_t)(b * 512 + c_) * 8 + h); \
            if (tid < 256) g0[sl] = *(const u32x4*)(Qg + r_ * 1024 + h * 128 + 8 * pc); else g0[sl] = *(const u32x4*)(Kg + r_ * 1024 + h * 128 + 8 * pc); \
            if (tid < 304) { const int tv_ = c_ * 16 + vr - 3; const u32x4 vv_ = *(const u32x4*)(P + (rowbase + (tv_ >= 0 ? tv_ : 0)) * 4352 + 2048 + h * 128 + 8 * pc); g1[sl] = (tv_ >= 0) ? vv_ : (u32x4){0u, 0u, 0u, 0u}; } \
            else if (tid >= 320 && tid < 352) g1[sl] = *(const u32x4*)(Tg + ch_ * 256 + (tid - 320) * 8); \
            else if (tid >= 352 && tid < 384) g1[sl] = *(const u32x4*)(Amg + ch_ * 256 + (tid - 352) * 8); \
            else if (tid >= 384 && tid < 400) g1[sl] = *(const u32x4*)(Scg + ch_ * 64 + (tid - 384) * 4); } while (0)
#define DL_STORE(cc, sl) do { LAS unsigned char* bb_ = lds + ((cc) & 1) * BUFB; \
            if (tid < 256) *(LAS u32x4*)(bb_ + QOFF + lt * 272 + 16 * pc) = g0[sl]; \
            else { *(LAS u32x4*)(bb_ + KOFF + lt * 272 + 16 * pc) = g0[sl]; \
                _Pragma("unroll") for (int e = 0; e < 4; ++e) { *(LAS unsigned short*)(bb_ + KTOFF + (8 * pc + 2 * e) * 40 + 2 * lt) = (unsigned short)(g0[sl][e] & 0xffffu); \
                    *(LAS unsigned short*)(bb_ + KTOFF + (8 * pc + 2 * e + 1) * 40 + 2 * lt) = (unsigned short)(g0[sl][e] >> 16); } } \
            if (tid < 304) *(LAS u32x4*)(bb_ + VOFF + vr * 272 + 16 * pc) = g1[sl]; \
            else if (tid >= 320 && tid < 352) *(LAS u32x4*)(bb_ + TOFF + (tid - 320) * 16) = g1[sl]; \
            else if (tid >= 352 && tid < 384) *(LAS u32x4*)(bb_ + AMOFF + (tid - 352) * 16) = g1[sl]; \
            else if (tid >= 384 && tid < 400) *(LAS u32x4*)(bb_ + SCOFF + (tid - 384) * 16) = g1[sl]; } while (0)
#pragma unroll
        for (int d = 0; d < PD; ++d) DL_LOAD(d, d);
        DL_STORE(0, 0); lds_barrier();
        for (int c0 = 0; c0 < 512; c0 += PD) {
#pragma unroll
          for (int d = 0; d < PD; ++d) {
            const int c = c0 + d;
            if (c + PD < 512) DL_LOAD(c + PD, d);
            LAS const unsigned char* bb = lds + (c & 1) * BUFB;
            float vraw[7];
#pragma unroll
            for (int r = 0; r < 7; ++r) vraw[r] = bf2f(*(LAS const unsigned short*)(bb + VOFF + (4 * kg + r) * 272 + (16 * w + n) * 2));
            f32x4 v4;
#pragma unroll
            for (int jj = 0; jj < 4; ++jj) v4[jj] = siluf_(cwv[0] * vraw[jj] + cwv[1] * vraw[jj + 1] + cwv[2] * vraw[jj + 2] + cwv[3] * vraw[jj + 3]);
            f32x4 X = (f32x4){0.f, 0.f, 0.f, 0.f}, Z = X;
#pragma unroll
            for (int a = 0; a < 4; ++a) {
                const bf16x4 klo = *(LAS const bf16x4*)(bb + KOFF + n * 272 + (32 * a + 4 * kg) * 2), khi = *(LAS const bf16x4*)(bb + KOFF + n * 272 + (32 * a + 16 + 4 * kg) * 2);
                X = __builtin_amdgcn_mfma_f32_16x16x32_bf16(cat4(klo, khi), Sb[a], X, 0, 0, 0);
                const bf16x4 qlo = *(LAS const bf16x4*)(bb + QOFF + n * 272 + (32 * a + 4 * kg) * 2), qhi = *(LAS const bf16x4*)(bb + QOFF + n * 272 + (32 * a + 16 + 4 * kg) * 2);
                Z = __builtin_amdgcn_mfma_f32_16x16x32_bf16(cat4(qlo, qhi), Sb[a], Z, 0, 0, 0);
            }
            const f32x4 be4 = *(LAS const f32x4*)(bb + SCOFF + (4 * kg) * 4), eg4 = *(LAS const f32x4*)(bb + SCOFF + (16 + 4 * kg) * 4), egl4 = *(LAS const f32x4*)(bb + SCOFF + (32 + 4 * kg) * 4);
            const float glast = *(LAS const float*)(bb + SCOFF + 48 * 4);
            const f32x4 R = be4 * (v4 - eg4 * X);
            const bf16x4 tf = *(LAS const bf16x4*)(bb + TOFF + n * 32 + 8 * kg);
            const f32x4 vnew = __builtin_amdgcn_mfma_f32_16x16x32_bf16(cat4(tf, z4), cat4(cvt4(R), z4), (f32x4){0.f, 0.f, 0.f, 0.f}, 0, 0, 0);
            const bf16x4 am = *(LAS const bf16x4*)(bb + AMOFF + n * 32 + 8 * kg);
            const f32x4 o = __builtin_amdgcn_mfma_f32_16x16x32_bf16(cat4(am, z4), cat4(cvt4(vnew), z4), Z * eg4, 0, 0, 0);
            const bf16x8 B2 = cat4(cvt4(vnew * egl4), z4);
#pragma unroll
            for (int i = 0; i < 8; ++i) {
                const bf16x4 kt = *(LAS const bf16x4*)(bb + KTOFF + (16 * i + n) * 40 + 8 * kg);
                S[i] = __builtin_amdgcn_mfma_f32_16x16x32_bf16(cat4(kt, z4), B2, S[i] * glast, 0, 0, 0);
            }
#pragma unroll
            for (int a = 0; a < 4; ++a) Sb[a] = cat4(cvt4(S[2 * a]), cvt4(S[2 * a + 1]));
#pragma unroll
            for (int jj = 0; jj < 4; ++jj) Qg[(rowbase + (size_t)c * 16 + 4 * kg + jj) * 1024 + h * 128 + 16 * w + n] = (bf16_t)f2bf(o[jj]);
            if (c + 1 < 512) DL_STORE(c + 1, (d + 1) % PD);
            lds_barrier();
          }
        }
#undef DL_LOAD
#undef DL_STORE
    }
}


constexpr size_t WS_GCG = 500 * MiB;
constexpr size_t WS_BNG = 508 * MiB;
__device__ __forceinline__ void prep_rwkv_elem(PPTR p) {
    const int tid = tidx(), w = tid >> 6, lane = tid & 63;
    bf16_t* P = (bf16_t*)(p->ws + WS_PROJC); bf16_t* L2 = (bf16_t*)(p->ws + WS_R1);
    float* GCg = (float*)(p->ws + WS_GCG); float* BNg = (float*)(p->ws + WS_BNG);
    for (int task = bidx() * 8 + w; task < 4 * 512 * 16; task += gdim() * 8) {
        const int h = task & 15, rc = task >> 4; const size_t row0 = (size_t)rc * 16; const int ch = h * 64 + lane;
        const float w0v = p->in[17][ch], a0v = p->in[20][ch], kkc = p->in[25][ch], kac = p->in[26][ch], rkc = p->in[27][ch];
        unsigned xr[16], xk[16], xw[16], xa[16];
#pragma unroll
        for (int t = 0; t < 16; ++t) { const bf16_t* rowp = P + (row0 + t) * 3328 + ch; const bf16_t* l2p = L2 + (row0 + t) * 3072 + ch;
            xr[t] = rowp[0]; xk[t] = rowp[1024]; xw[t] = l2p[0]; xa[t] = l2p[1024]; }
        float lg = 0.f;
#pragma unroll
        for (int t = 0; t < 16; ++t) {
            const float r = bf2f(xr[t]), kraw = bf2f(xk[t]), whi = bf2f(xw[t]), ahi = bf2f(xa[t]);
            const float wv = -softplusf_(-(w0v + whi)) - 0.5f; const float ew = __expf(wv);
            const float lgp = lg; lg -= ew;
            const float ag = sigmoidf_(a0v + ahi);
            const float kkx = kraw * kkc; const float ss = wave_allsum(kkx * kkx); const float kk = kkx * __builtin_amdgcn_rsqf(ss + 1e-6f);
            const float kp = kraw * (1.0f + (ag - 1.0f) * kac);
            const float bonus = wave_allsum(r * kp * rkc);
            const float inv = __expf(-lg);
            bf16_t* rowp = P + (row0 + t) * 3328 + ch; bf16_t* l2p = L2 + (row0 + t) * 3072 + ch;
            rowp[0] = (bf16_t)f2bf(-kk * __expf(lgp)); rowp[1024] = (bf16_t)f2bf(r * __expf(lg));
            l2p[0] = (bf16_t)f2bf(kk * ag * inv); l2p[1024] = (bf16_t)f2bf(kp * inv);
            if (lane == 0) BNg[(row0 + t) * 16 + h] = bonus;
        }
        GCg[(size_t)task * 64 + lane] = __expf(lg);
    }
}

__device__ __forceinline__ void scan_rwkv(LAS unsigned char* lds, PPTR p) {
    constexpr int AH = 0, RH = 2304, BMT = 4608, KMT = 7168, TM = 9728, LAK = 10240, MRB = 10752, MRK = 11264, VV = 11776, GC = 14080, SLOT = 14336;
    constexpr int PRIV = 8 * SLOT, PRIVSZ = 5632;
    const int tid = tidx(), wave = tid >> 6, lane = tid & 63, n = lane & 15, kg = lane >> 4;
    const bf16_t* P = (const bf16_t*)(p->ws + WS_PROJC); const bf16_t* L2 = (const bf16_t*)(p->ws + WS_R1);
    bf16_t* Og = (bf16_t*)(p->ws + WS_OC);
    const int G = gdim(); const int vcu = (G % 8 == 0) ? (int)(bidx() % 8) * (G / 8) + (int)(bidx() / 8) : (int)bidx();
    for (int task = vcu; task < 256; task += G) {
        const int bh = task >> 2, slice = task & 3, b = bh >> 4, h = bh & 15; const size_t rowbase = (size_t)b * SEQ;
        const int pwr = (wave >= 1 && wave <= 3) ? wave - 1 : (wave == 5 ? 3 : -1);
        if (pwr >= 0) {
            const int pw = pwr; const int ch = h * 64 + lane;
            LAS unsigned char* bh = lds + PRIV + pw * PRIVSZ; LAS unsigned char* kh = bh + 2304; LAS float* Lm = (LAS float*)(kh + 2304);
            const float* GCg = (const float*)(p->ws + WS_GCG);
            unsigned xr[16], xk[16], xv[16], xw[16], xa[16]; float gCn;
#define RW_LOAD(cc, T0) do { _Pragma("unroll") for (int t = (T0); t < (T0) + 8; ++t) { const size_t r_ = rowbase + (size_t)(cc) * 16 + t; const bf16_t* rowp = P + r_ * 3328 + ch; const bf16_t* l2p = L2 + r_ * 3072 + ch; \
                xr[t] = rowp[0]; xk[t] = rowp[1024]; xv[t] = rowp[2048]; xw[t] = l2p[0]; xa[t] = l2p[1024]; } \
                if ((T0) == 8) gCn = GCg[((size_t)(b * 512 + (cc)) * 16 + h) * 64 + lane]; } while (0)
            RW_LOAD(pw, 0); RW_LOAD(pw, 8);
            for (int m = -1; m < 128; ++m) {
                const int cc = 4 * (m + 1) + pw;
                if (cc < 512) {
                    LAS unsigned char* sl = lds + (cc & 7) * SLOT;
                    const float gC = gCn; float bhat[16], khat[16];
#pragma unroll
                    for (int t = 0; t < 16; ++t) {
                        bhat[t] = bf2f(xw[t]); khat[t] = bf2f(xa[t]);
                        *(LAS unsigned short*)(sl + AH + t * 144 + 2 * lane) = (unsigned short)xr[t];
                        *(LAS unsigned short*)(sl + RH + t * 144 + 2 * lane) = (unsigned short)xk[t];
                        *(LAS unsigned short*)(bh + t * 144 + 2 * lane) = (unsigned short)xw[t];
                        *(LAS unsigned short*)(kh + t * 144 + 2 * lane) = (unsigned short)xa[t];
                        *(LAS unsigned short*)(sl + VV + t * 144 + 2 * lane) = (unsigned short)xv[t];
                    }
                    if (cc + 4 < 512) { RW_LOAD(cc + 4, 0); RW_LOAD(cc + 4, 8); }
                    *(LAS float*)(sl + GC + 4 * lane) = gC;
#pragma unroll
                    for (int q = 0; q < 4; ++q) {
                        u32x2 wb, wk; wb.x = pack2(bhat[4 * q] * gC, bhat[4 * q + 1] * gC); wb.y = pack2(bhat[4 * q + 2] * gC, bhat[4 * q + 3] * gC);
                        wk.x = pack2(khat[4 * q] * gC, khat[4 * q + 1] * gC); wk.y = pack2(khat[4 * q + 2] * gC, khat[4 * q + 3] * gC);
                        *(LAS u32x2*)(sl + BMT + lane * 40 + 8 * q) = wb; *(LAS u32x2*)(sl + KMT + lane * 40 + 8 * q) = wk;
                    }
                    asm volatile("s_waitcnt lgkmcnt(0)" ::: "memory");
                    f32x4 lab = (f32x4){0.f, 0.f, 0.f, 0.f}, lak = lab, mrb = lab, mrk = lab;
#pragma unroll
                    for (int a = 0; a < 2; ++a) {
                        const bf16x8 af = *(LAS const bf16x8*)(sl + AH + n * 144 + (32 * a + 8 * kg) * 2), rf = *(LAS const bf16x8*)(sl + RH + n * 144 + (32 * a + 8 * kg) * 2);
                        const bf16x8 bf_ = *(LAS const bf16x8*)(bh + n * 144 + (32 * a + 8 * kg) * 2), kf = *(LAS const bf16x8*)(kh + n * 144 + (32 * a + 8 * kg) * 2);
                        lab = __builtin_amdgcn_mfma_f32_16x16x32_bf16(af, bf_, lab, 0, 0, 0); lak = __builtin_amdgcn_mfma_f32_16x16x32_bf16(af, kf, lak, 0, 0, 0);
                        mrb = __builtin_amdgcn_mfma_f32_16x16x32_bf16(rf, bf_, mrb, 0, 0, 0); mrk = __builtin_amdgcn_mfma_f32_16x16x32_bf16(rf, kf, mrk, 0, 0, 0);
                    }
#pragma unroll
                    for (int jj = 0; jj < 4; ++jj) { const int t = 4 * kg + jj;
                        Lm[t * 16 + n] = (n < t) ? lab[jj] : 0.f;
                        *(LAS unsigned short*)(sl + LAK + t * 32 + 2 * n) = (unsigned short)f2bf(n < t ? lak[jj] : 0.f);
                        *(LAS unsigned short*)(sl + MRB + t * 32 + 2 * n) = (unsigned short)f2bf(n <= t ? mrb[jj] : 0.f);
                        *(LAS unsigned short*)(sl + MRK + t * 32 + 2 * n) = (unsigned short)f2bf(n <= t ? mrk[jj] : 0.f); }
                    asm volatile("s_waitcnt lgkmcnt(0)" ::: "memory");
                    float x[16];
                    tri_inv16<1>(Lm, n, x);
#pragma unroll
                    for (int jj = 0; jj < 4; ++jj) { const float v = (kg == 0) ? x[jj] : (kg == 1 ? x[4 + jj] : (kg == 2 ? x[8 + jj] : x[12 + jj]));
                        *(LAS unsigned short*)(sl + TM + (4 * kg + jj) * 32 + 2 * n) = (unsigned short)f2bf(v); }
                }
                lds_barrier();
            }
#undef RW_LOAD
        } else if (wave != 0) {
            for (int m = -1; m < 128; ++m) lds_barrier();
        } else {
            const int w = slice;
            f32x4 Zt[4]; bf16x8 Zb[2];
#pragma unroll
            for (int i = 0; i < 4; ++i) Zt[i] = (f32x4){0.f, 0.f, 0.f, 0.f};
            Zb[0] = (bf16x8){0, 0, 0, 0, 0, 0, 0, 0}; Zb[1] = Zb[0];
            struct RwOps { bf16x4 alo[2], ahi[2], rlo[2], rhi[2], vf, lakf, tf, mb, mk, bt[4], kt[4]; f32x4 g4[4]; };
#define RW_OPLOAD(R, cidx) do { LAS const unsigned char* sl_ = lds + ((cidx) & 7) * SLOT; \
                _Pragma("unroll") for (int a = 0; a < 2; ++a) { \
                    R.alo[a] = *(LAS const bf16x4*)(sl_ + AH + n * 144 + (32 * a + 4 * kg) * 2); R.ahi[a] = *(LAS const bf16x4*)(sl_ + AH + n * 144 + (32 * a + 16 + 4 * kg) * 2); \
                    R.rlo[a] = *(LAS const bf16x4*)(sl_ + RH + n * 144 + (32 * a + 4 * kg) * 2); R.rhi[a] = *(LAS const bf16x4*)(sl_ + RH + n * 144 + (32 * a + 16 + 4 * kg) * 2); } \
                _Pragma("unroll") for (int jj = 0; jj < 4; ++jj) R.vf[jj] = *(LAS const short*)(sl_ + VV + (4 * kg + jj) * 144 + (16 * w + n) * 2); \
                R.lakf = *(LAS const bf16x4*)(sl_ + LAK + n * 32 + 8 * kg); R.tf = *(LAS const bf16x4*)(sl_ + TM + n * 32 + 8 * kg); \
                R.mb = *(LAS const bf16x4*)(sl_ + MRB + n * 32 + 8 * kg); R.mk = *(LAS const bf16x4*)(sl_ + MRK + n * 32 + 8 * kg); \
                _Pragma("unroll") for (int i = 0; i < 4; ++i) { R.g4[i] = *(LAS const f32x4*)(sl_ + GC + (16 * i + 4 * kg) * 4); \
                    R.bt[i] = *(LAS const bf16x4*)(sl_ + BMT + (16 * i + n) * 40 + 8 * kg); R.kt[i] = *(LAS const bf16x4*)(sl_ + KMT + (16 * i + n) * 40 + 8 * kg); } } while (0)
#define RW_COMPUTE(R, cidx) do { \
                f32x4 P1 = (f32x4){0.f, 0.f, 0.f, 0.f}, Oa = P1; \
                _Pragma("unroll") for (int a = 0; a < 2; ++a) { P1 = __builtin_amdgcn_mfma_f32_16x16x32_bf16(cat4(R.alo[a], R.ahi[a]), Zb[a], P1, 0, 0, 0); \
                    Oa = __builtin_amdgcn_mfma_f32_16x16x32_bf16(cat4(R.rlo[a], R.rhi[a]), Zb[a], Oa, 0, 0, 0); } \
                P1 = __builtin_amdgcn_mfma_f32_16x16x32_bf16(cat4(R.lakf, z4), cat4(R.vf, z4), P1, 0, 0, 0); \
                const f32x4 Y = __builtin_amdgcn_mfma_f32_16x16x32_bf16(cat4(R.tf, z4), cat4(cvt4(P1), z4), (f32x4){0.f, 0.f, 0.f, 0.f}, 0, 0, 0); \
                const bf16x8 Byv = cat4(cvt4(Y), R.vf); \
                Oa = __builtin_amdgcn_mfma_f32_16x16x32_bf16(cat4(R.mb, R.mk), Byv, Oa, 0, 0, 0); \
                _Pragma("unroll") for (int i = 0; i < 4; ++i) Zt[i] = __builtin_amdgcn_mfma_f32_16x16x32_bf16(cat4(R.bt[i], R.kt[i]), Byv, Zt[i] * R.g4[i], 0, 0, 0); \
                Zb[0] = cat4(cvt4(Zt[0]), cvt4(Zt[1])); Zb[1] = cat4(cvt4(Zt[2]), cvt4(Zt[3])); \
                _Pragma("unroll") for (int jj = 0; jj < 4; ++jj) Og[(rowbase + (size_t)(cidx) * 16 + 4 * kg + jj) * 1024 + h * 64 + 16 * w + n] = (bf16_t)f2bf(Oa[jj]); } while (0)
            const bf16x4 z4 = (bf16x4){0, 0, 0, 0};
            lds_barrier();
            for (int m = 0; m < 128; ++m) {
                RwOps OA, OB;
                RW_OPLOAD(OA, 4 * m);
                RW_OPLOAD(OB, 4 * m + 1); __builtin_amdgcn_sched_barrier(0);
                RW_COMPUTE(OA, 4 * m); __builtin_amdgcn_sched_barrier(0);
                RW_OPLOAD(OA, 4 * m + 2); __builtin_amdgcn_sched_barrier(0);
                RW_COMPUTE(OB, 4 * m + 1); __builtin_amdgcn_sched_barrier(0);
                RW_OPLOAD(OB, 4 * m + 3); __builtin_amdgcn_sched_barrier(0);
                RW_COMPUTE(OA, 4 * m + 2); __builtin_amdgcn_sched_barrier(0);
                RW_COMPUTE(OB, 4 * m + 3);
                lds_barrier();
            }
#undef RW_OPLOAD
#undef RW_COMPUTE
        }
    }
}


template <int KIND>
__device__ __forceinline__ void scan_chunked(LAS unsigned char* lds, PPTR p, int j) {
    constexpr int QOFF = 0, KOFF = 4352, KTOFF = 8704, VOFF = 13824, TOFF = 14464, AMOFF = 14976, SCOFF = 15488, OBOFF = 16000, BUFB = 17024;
    constexpr int LDP = (KIND == 0) ? 4352 : 4096;
    constexpr int VROWS = (KIND == 0) ? 19 : 16, VEND = 512 + 2 * VROWS;
    constexpr int TEND = (KIND == 0) ? VEND + 32 : VEND, AEND = TEND + 32, SEND = AEND + ((KIND == 0) ? 16 : 32);
    const int tid = tidx(), wave = tid >> 6, lane = tid & 63, n = lane & 15, kg = lane >> 4;
    const bf16_t* P = (const bf16_t*)(p->ws + WS_PROJ);
    const bf16_t* Qg = (const bf16_t*)(p->ws + WS_R1); const bf16_t* Kg = (const bf16_t*)(p->ws + WS_KG);
    const bf16_t* Tg = (const bf16_t*)(p->ws + WS_TA);
    const bf16_t* Amg = (const bf16_t*)(p->ws + (KIND == 0 ? WS_AMA : WS_AM));
    const float* Scg = (const float*)(p->ws + (KIND == 0 ? WS_SCA : WS_DEC));
    bf16_t* Og = (KIND == 0) ? (bf16_t*)(p->ws + WS_PROJ) : (bf16_t*)(p->ws + WS_OC);
    constexpr int LDO = (KIND == 0) ? 4352 : 1024;
    const bf16x4 z4 = (bf16x4){0, 0, 0, 0};
    const int G = gdim(); const int vcu = (G % 8 == 0) ? (int)(bidx() % 8) * (G / 8) + (int)(bidx() / 8) : (int)bidx();
    for (int task = vcu; task < 256; task += G) {
        const int bh = task >> 3, w = task & 7, b = bh >> 3, h = bh & 7; const size_t rowbase = (size_t)b * SEQ;
        if (wave == 0) {
            float cwv[4] = {0.f, 0.f, 0.f, 0.f};
            if (KIND == 0) { const float* cv = p->in[6] + (size_t)j * 4 * 3072;
#pragma unroll
                for (int jj = 0; jj < 4; ++jj) cwv[jj] = cv[jj * 3072 + 2048 + h * 128 + 16 * w + n]; }
            f32x4 S[8]; bf16x8 Sb[4];
#pragma unroll
            for (int i = 0; i < 8; ++i) S[i] = (f32x4){0.f, 0.f, 0.f, 0.f};
#pragma unroll
            for (int a = 0; a < 4; ++a) Sb[a] = (bf16x8){0, 0, 0, 0, 0, 0, 0, 0};
            lds_barrier();
            for (int c2 = 0; c2 < 512; c2 += 4) {
#pragma unroll 1
              for (int u = 0; u < 4; ++u) { const int c = c2 + u;
                LAS unsigned char* bb = lds + (c & 7) * BUFB;
                bf16x4 klo[4], khi[4], qlo[4], qhi[4], kt[8], am, tf = z4; f32x4 be4, eg4, egl4, d4[8]; float glast = 0.f; unsigned vr16[7]; bf16x4 vb = z4;
#pragma unroll
                for (int a = 0; a < 4; ++a) {
                    if (KIND == 0) { klo[a] = *(LAS const bf16x4*)(bb + KOFF + n * 272 + (32 * a + 4 * kg) * 2); khi[a] = *(LAS const bf16x4*)(bb + KOFF + n * 272 + (32 * a + 16 + 4 * kg) * 2); }
                    qlo[a] = *(LAS const bf16x4*)(bb + QOFF + n * 272 + (32 * a + 4 * kg) * 2); qhi[a] = *(LAS const bf16x4*)(bb + QOFF + n * 272 + (32 * a + 16 + 4 * kg) * 2); }
                if (KIND == 0) {
#pragma unroll
                    for (int r = 0; r < 7; ++r) vr16[r] = *(LAS const unsigned short*)(bb + VOFF + (4 * kg + r) * 32 + 2 * n);
                    be4 = *(LAS const f32x4*)(bb + SCOFF + (4 * kg) * 4); eg4 = *(LAS const f32x4*)(bb + SCOFF + (16 + 4 * kg) * 4); egl4 = *(LAS const f32x4*)(bb + SCOFF + (32 + 4 * kg) * 4);
                    glast = *(LAS const float*)(bb + SCOFF + 48 * 4); tf = *(LAS const bf16x4*)(bb + TOFF + n * 32 + 8 * kg);
                } else {
#pragma unroll
                    for (int jj = 0; jj < 4; ++jj) vb[jj] = *(LAS const short*)(bb + VOFF + (4 * kg + jj) * 32 + 2 * n);
#pragma unroll
                    for (int i = 0; i < 8; ++i) d4[i] = *(LAS const f32x4*)(bb + SCOFF + (16 * i + 4 * kg) * 4);
                }
                am = *(LAS const bf16x4*)(bb + AMOFF + n * 32 + 8 * kg);
#pragma unroll
                for (int i = 0; i < 8; ++i) kt[i] = *(LAS const bf16x4*)(bb + KTOFF + (16 * i + n) * 40 + 8 * kg);
                __builtin_amdgcn_sched_barrier(0);
                asm volatile("s_waitcnt lgkmcnt(0)" ::: "memory");
                __builtin_amdgcn_sched_barrier(0);
                f32x4 v4 = (f32x4){0.f, 0.f, 0.f, 0.f};
                if (KIND == 0) {
#pragma unroll
                    for (int jj = 0; jj < 4; ++jj) v4[jj] = siluf_(cwv[0] * bf2f(vr16[jj]) + cwv[1] * bf2f(vr16[jj + 1]) + cwv[2] * bf2f(vr16[jj + 2]) + cwv[3] * bf2f(vr16[jj + 3]));
                }
                f32x4 X = (f32x4){0.f, 0.f, 0.f, 0.f}, Z = X;
#pragma unroll
                for (int a = 0; a < 4; ++a) {
                    if (KIND == 0) X = __builtin_amdgcn_mfma_f32_16x16x32_bf16(cat4(klo[a], khi[a]), Sb[a], X, 0, 0, 0);
                    Z = __builtin_amdgcn_mfma_f32_16x16x32_bf16(cat4(qlo[a], qhi[a]), Sb[a], Z, 0, 0, 0);
                }
                f32x4 o; bf16x8 B2;
                if (KIND == 0) {
                    const f32x4 R = be4 * (v4 - eg4 * X);
                    const f32x4 vnew = __builtin_amdgcn_mfma_f32_16x16x32_bf16(cat4(tf, z4), cat4(cvt4(R), z4), (f32x4){0.f, 0.f, 0.f, 0.f}, 0, 0, 0);
                    o = __builtin_amdgcn_mfma_f32_16x16x32_bf16(cat4(am, z4), cat4(cvt4(vnew), z4), Z * eg4, 0, 0, 0);
                    B2 = cat4(cvt4(vnew * egl4), z4);
#pragma unroll
                    for (int i = 0; i < 8; ++i) S[i] = __builtin_amdgcn_mfma_f32_16x16x32_bf16(cat4(kt[i], z4), B2, S[i] * glast, 0, 0, 0);
                } else {
                    B2 = cat4(vb, z4);
                    o = __builtin_amdgcn_mfma_f32_16x16x32_bf16(cat4(am, z4), B2, Z, 0, 0, 0);
#pragma unroll
                    for (int i = 0; i < 8; ++i) S[i] = __builtin_amdgcn_mfma_f32_16x16x32_bf16(cat4(kt[i], z4), B2, S[i] * d4[i], 0, 0, 0);
                }
                *(LAS f32x4*)(bb + OBOFF + lane * 16) = o;
#pragma unroll
                for (int a = 0; a < 4; ++a) Sb[a] = cat4(cvt4(S[2 * a]), cvt4(S[2 * a + 1]));
              }
                lds_barrier();
            }
            lds_barrier();
        } else {
            const int lt = tid - 64, pb = lt + 448;
            const int arow = (lt & 255) >> 4, apc = lt & 15;
            const bf16_t* srcA = (lt < 256 ? Qg : Kg) + (rowbase + arow) * 1024 + h * 128 + 8 * apc;
            const char* srcB; size_t strideB; int kindB;
            if (pb < 512) { kindB = 0; srcB = (const char*)(Kg + (rowbase + ((pb - 256) >> 4)) * 1024 + h * 128 + 8 * (pb & 15)); strideB = (size_t)16 * 1024 * 2; }
            else if (pb < VEND) { kindB = 1; const int vr_ = (pb - 512) >> 1, hf_ = (pb - 512) & 1; srcB = (const char*)(P + (rowbase + vr_) * LDP + 2048 + h * 128 + 16 * w + 8 * hf_); strideB = (size_t)16 * LDP * 2; }
            else if (pb < TEND) { kindB = 2; srcB = (const char*)(Tg + ((size_t)(b * 512) * 8 + h) * 256 + (pb - VEND) * 8); strideB = (size_t)8 * 256 * 2; }
            else if (pb < AEND) { kindB = 3; srcB = (const char*)(Amg + ((size_t)(b * 512) * 8 + h) * 256 + (pb - TEND) * 8); strideB = (size_t)8 * 256 * 2; }
            else if (pb < SEND) { kindB = 4; srcB = (const char*)(Scg + ((size_t)(b * 512) * 8 + h) * (KIND == 0 ? 64 : 128) + (pb - AEND) * 4); strideB = (size_t)8 * (KIND == 0 ? 64 : 128) * 4; }
            else { kindB = 5; srcB = (const char*)srcA; strideB = (size_t)16 * 1024 * 2; }
            const int vrow = (pb - 512) >> 1;
            const bool doflush = (wave == 2);
            constexpr int PD = 8;
            u32x4 g0[PD], g1[PD];
#define SC_LOAD(cc, sl) do { const int c_ = (cc); g0[sl] = *(const u32x4*)(srcA + (size_t)c_ * 16 * 1024); \
                const int tv_ = c_ * 16 + vrow - 3; const bool vh_ = (KIND == 0) && (kindB == 1); \
                const ptrdiff_t ofs_ = vh_ ? (ptrdiff_t)(tv_ >= 0 ? tv_ - vrow : -vrow) * (LDP * 2) : (ptrdiff_t)((size_t)c_ * strideB); \
                const u32x4 vv_ = *(const u32x4*)(srcB + ofs_); g1[sl] = (vh_ && tv_ < 0) ? (u32x4){0u, 0u, 0u, 0u} : vv_; } while (0)
#define SC_KSTORE(bb_, reg, row, pc) do { if (KIND == 0) *(LAS u32x4*)((bb_) + KOFF + (row) * 272 + 16 * (pc)) = (reg); \
                _Pragma("unroll") for (int e = 0; e < 4; ++e) { *(LAS unsigned short*)((bb_) + KTOFF + (8 * (pc) + 2 * e) * 40 + 2 * (row)) = (unsigned short)((reg)[e] & 0xffffu); \
                    *(LAS unsigned short*)((bb_) + KTOFF + (8 * (pc) + 2 * e + 1) * 40 + 2 * (row)) = (unsigned short)((reg)[e] >> 16); } } while (0)
#define SC_STORE(cc, sl) do { LAS unsigned char* bb_ = lds + ((cc) & 7) * BUFB; \
                if (lt < 256) *(LAS u32x4*)(bb_ + QOFF + arow * 272 + 16 * apc) = g0[sl]; else SC_KSTORE(bb_, g0[sl], arow, apc); \
                if (kindB == 0) SC_KSTORE(bb_, g1[sl], ((pb - 256) >> 4), (pb & 15)); \
                else if (kindB == 1) *(LAS u32x4*)(bb_ + VOFF + vrow * 32 + 16 * ((pb - 512) & 1)) = g1[sl]; \
                else if (kindB == 2) *(LAS u32x4*)(bb_ + TOFF + (pb - VEND) * 16) = g1[sl]; \
                else if (kindB == 3) *(LAS u32x4*)(bb_ + AMOFF + (pb - TEND) * 16) = g1[sl]; \
                else if (kindB == 4) *(LAS u32x4*)(bb_ + SCOFF + (pb - AEND) * 16) = g1[sl]; } while (0)
#define SC_OFLUSH(cc) do { const int c_ = (cc); const f32x4 o_ = *(LAS const f32x4*)(lds + (c_ & 7) * BUFB + OBOFF + lane * 16); \
                _Pragma("unroll") for (int jj = 0; jj < 4; ++jj) Og[(rowbase + (size_t)c_ * 16 + 4 * kg + jj) * LDO + h * 128 + 16 * w + n] = (bf16_t)f2bf(o_[jj]); } while (0)
#define SC_LOADER_LOOP(FLUSH) do { \
                _Pragma("unroll") for (int d = 0; d < PD; ++d) SC_LOAD(d, d); \
                SC_STORE(0, 0); SC_STORE(1, 1); SC_STORE(2, 2); SC_STORE(3, 3); \
                SC_LOAD(8, 0); SC_LOAD(9, 1); SC_LOAD(10, 2); SC_LOAD(11, 3); \
                lds_barrier(); \
                for (int c0 = 0; c0 < 512; c0 += PD) { \
                    _Pragma("unroll") for (int d = 0; d < PD; d += 4) { const int c = c0 + d; \
                        if (c + 4 < 512) { _Pragma("unroll") for (int u = 0; u < 4; ++u) SC_STORE(c + 4 + u, (d + 4 + u) % PD); } \
                        if (c + 12 < 512) { _Pragma("unroll") for (int u = 0; u < 4; ++u) SC_LOAD(c + 12 + u, (d + 4 + u) % PD); } \
                        if (FLUSH) { if (c > 0) { _Pragma("unroll") for (int u = 0; u < 4; ++u) SC_OFLUSH(c - 4 + u); } } \
                        lds_barrier(); } } \
                if (FLUSH) { _Pragma("unroll") for (int u = 0; u < 4; ++u) SC_OFLUSH(508 + u); } \
                lds_barrier(); } while (0)
            if (doflush) SC_LOADER_LOOP(true); else SC_LOADER_LOOP(false);
#undef SC_LOAD
#undef SC_KSTORE
#undef SC_STORE
#undef SC_OFLUSH
#undef SC_LOADER_LOOP
        }
    }
}

template <int KIND>
__device__ __forceinline__ void post_phase(PPTR p, int j) {
    const int lane = tidx() & 63, wave = tidx() >> 6;
    const int gw = bidx() * 8 + wave, nw = gdim() * 8;
    bf16_t* O = (bf16_t*)(p->ws + (KIND != 0 ? WS_OC : WS_PROJ));
    constexpr int LDO = (KIND == 0) ? 4352 : 1024;
    const bf16_t* P = (const bf16_t*)(p->ws + (KIND == 2 ? WS_PROJC : WS_PROJ));
    if (KIND != 2) {
        const float* nwp = (KIND == 0) ? p->in[9] + j * 128 : p->in[13];
        const float n0 = nwp[2 * lane], n1 = nwp[2 * lane + 1];
        constexpr int LDP = (KIND == 0) ? 4352 : 4096; constexpr int ZOFF = 3072;
        for (int row = gw; row < MROWS; row += nw) {
            unsigned ov[8], zv[8];
#pragma unroll
            for (int h = 0; h < 8; ++h) { ov[h] = *(const unsigned*)(O + (size_t)row * LDO + h * 128 + 2 * lane); zv[h] = *(const unsigned*)(P + (size_t)row * LDP + ZOFF + h * 128 + 2 * lane); }
#pragma unroll
            for (int h = 0; h < 8; ++h) {
                const float o0 = bflo(ov[h]), o1 = bfhi(ov[h]);
                const float ss = wave_allsum(o0 * o0 + o1 * o1); const float rstd = __builtin_amdgcn_rsqf(ss * (1.0f / 128.0f) + 1e-6f);
                *(unsigned*)(O + (size_t)row * LDO + h * 128 + 2 * lane) = pack2(o0 * rstd * n0 * siluf_(bflo(zv[h])), o1 * rstd * n1 * siluf_(bfhi(zv[h])));
            }
        }
    } else {
        const bf16_t* L2 = (const bf16_t*)(p->ws + WS_R1); const float* BNg = (const float*)(p->ws + WS_BNG);
        for (int task = gw; task < MROWS * 2; task += nw) {
            const int row = task >> 1, h0 = (task & 1) * 8;
            unsigned xy[8], xv[8], xg[8]; float bn[8];
#pragma unroll
            for (int hh = 0; hh < 8; ++hh) { const int ch = (h0 + hh) * 64 + lane; const bf16_t* rowp = P + (size_t)row * 3328; const bf16_t* l2p = L2 + (size_t)row * 3072;
                xy[hh] = O[(size_t)row * DM + ch]; xv[hh] = rowp[2048 + ch]; xg[hh] = l2p[2048 + ch]; bn[hh] = BNg[(size_t)row * 16 + h0 + hh]; }
#pragma unroll
            for (int hh = 0; hh < 8; ++hh) { const int ch = (h0 + hh) * 64 + lane;
                const float y = bf2f(xy[hh]);
                const float mean = wave_allsum(y) * (1.0f / 64.0f); const float dd = y - mean;
                const float var = wave_allsum(dd * dd) * (1.0f / 64.0f);
                const float gn = dd * __builtin_amdgcn_rsqf(var + 0.04096f) * p->in[28][ch] + p->in[29][ch];
                O[(size_t)row * DM + ch] = (bf16_t)f2bf((gn + bn[hh] * bf2f(xv[hh])) * bf2f(xg[hh]));
            }
        }
    }
}

#define XB_TMO      128
#define XB_XCNT(j)  (256  + 64 * (j))
#define XB_XSUB(j)  (1280 + 64 * (j))
#define XB_XGEN(j)  (2304 + 64 * (j))
#define XB_TOP      3328
#define XB_TOPGEN   3392
#define XCD_BAR_WORDS 3456
#define XB_SPIN_CAP (1u << 18)
constexpr size_t WS_BAR = WS_MISC + 1 * MiB;
__device__ __forceinline__ unsigned xb_ld(unsigned* p)              { return __hip_atomic_load(p, __ATOMIC_RELAXED, __HIP_MEMORY_SCOPE_AGENT); }
__device__ __forceinline__ unsigned xb_add(unsigned* p, unsigned v) { return __hip_atomic_fetch_add(p, v, __ATOMIC_RELAXED, __HIP_MEMORY_SCOPE_AGENT); }
__device__ __forceinline__ unsigned xb_xcc_id() { return (unsigned)__builtin_amdgcn_s_getreg((3 << 11) | 20) & 0xFu; }
#define XB_SPIN(cond, bar) do { unsigned _sp = 0; while (cond) { __builtin_amdgcn_s_sleep(1); \
    if ((++_sp & 255u) == 0u) { if (xb_ld(&(bar)[XB_TMO])) break; if (_sp > XB_SPIN_CAP) { atomicAdd(&(bar)[XB_TMO], 1u); break; } } } } while (0)
struct XcdBarrier { unsigned* bar; unsigned x; volatile LAS unsigned* st; };
__device__ __forceinline__ XcdBarrier xcd_barrier_post(unsigned* bar, volatile LAS unsigned* st) {
    XcdBarrier b; b.bar = bar; b.x = xb_xcc_id(); b.st = st;
    if (threadIdx.x == 0) (void)xb_add(&bar[XB_XCNT(b.x)], 1u);
    return b;
}
__device__ __forceinline__ void xcd_barrier_complete(unsigned* bar, unsigned x, unsigned& nloc, unsigned& nx) {
    const unsigned G = gridDim.x * gridDim.y * gridDim.z;
    unsigned sum, cnt, mine, sp = 0u;
    for (;;) {
        sum = 0u; cnt = 0u; mine = 0u;
#pragma unroll
        for (unsigned j = 0; j < 16; ++j) { const unsigned c = xb_ld(&bar[XB_XCNT(j)]); sum += c; cnt += (c > 0u) ? 1u : 0u; mine = (j == x) ? c : mine; }
        if (sum == G) break;
        __builtin_amdgcn_s_sleep(1);
        if ((++sp & 255u) == 0u) { if (xb_ld(&bar[XB_TMO])) break; if (sp > XB_SPIN_CAP) { atomicAdd(&bar[XB_TMO], 1u); break; } }
    }
    nloc = mine > 0u ? mine : 1u; nx = cnt > 0u ? cnt : 1u;
}
__device__ __forceinline__ void xcd_barrier(const XcdBarrier& b) {
    asm volatile("s_waitcnt vmcnt(0)" ::: "memory");
    __syncthreads();
    if (threadIdx.x == 0) {
        unsigned* bar = b.bar;
        __builtin_amdgcn_s_waitcnt(0);
        unsigned nloc = b.st[0], nx = b.st[1];
        if (nloc == 0u) { xcd_barrier_complete(bar, b.x, nloc, nx); b.st[0] = nloc; b.st[1] = nx; }
        const unsigned old = xb_add(&bar[XB_XSUB(b.x)], 1u);
        const unsigned gen = old / nloc;
        if (old + 1u == (gen + 1u) * nloc) {
            __builtin_amdgcn_fence(__ATOMIC_RELEASE, "agent");
            asm volatile("s_waitcnt vmcnt(0)" ::: "memory");
            const unsigned og = xb_add(&bar[XB_TOP], 1u);
            const unsigned tg = og / nx;
            if (og + 1u == (tg + 1u) * nx) xb_add(&bar[XB_TOPGEN], 1u);
            else XB_SPIN(xb_ld(&bar[XB_TOPGEN]) == tg, bar);
            __builtin_amdgcn_fence(__ATOMIC_ACQUIRE, "agent");
            xb_add(&bar[XB_XGEN(b.x)], 1u);
            asm volatile("s_waitcnt vmcnt(0)" ::: "memory");
        } else {
            XB_SPIN(xb_ld(&bar[XB_XGEN(b.x)]) == gen, bar);
            __builtin_amdgcn_fence(__ATOMIC_ACQUIRE, "agent");
            asm volatile("s_waitcnt vmcnt(0)" ::: "memory");
        }
    }
    __syncthreads();
}

constexpr int NPH = 54;
__host__ __device__ inline int step_of(int ph) { const int si = (ph - 1) % 13; return si < 3 ? si : (si == 3 ? 12 : si - 1); }
__host__ __device__ inline bool phase_is_noop(int ph) {
    if (ph == 0 || ph == NPH - 1) return false;
    const int l = (ph - 1) / 13, st = step_of(ph);
    return st == 12 && (l % 3) != 2;
}

__global__ void __launch_bounds__(512, 2) mega(const Params pv) {
    extern __shared__ __attribute__((aligned(16))) unsigned char shm[];
    PPTR p = &pv;
    LAS unsigned char* lds = (LAS unsigned char*)shm;
    cg::grid_group grid = cg::this_grid();
    volatile LAS unsigned* xb_st = (volatile LAS unsigned*)(lds + 147440);
    if (threadIdx.x == 0) { xb_st[0] = 0u; xb_st[1] = 0u; }
    __syncthreads();
    const XcdBarrier xb = xcd_barrier_post((unsigned*)(pv.ws + WS_BAR), xb_st);
    const int ph_lo = p->ph_lo, ph_hi = p->ph_hi;
    for (int ph = ph_lo; ph < ph_hi; ++ph) {
        if (phase_is_noop(ph)) continue;
        float* mod = (float*)(p->ws + WS_MISC);
        bf16_t* W = (bf16_t*)(p->ws + WS_W);
        if (ph == 0) { pre_phase(lds, p); __syncthreads(); cvt_layer(lds, p, 0); }
        else if (ph == NPH - 1) { if (PHMASK & 2) final_phase(p->out, p->in[35]); }
        else {
            const int l = (ph - 1) / 13, st = step_of(ph), kind = l % 3, j = l / 3;
            const float* hin = (l == 0) ? p->in[0] : p->out;
            const float* modl = mod + (size_t)l * 4 * 6144;
            bf16_t* R1 = (bf16_t*)(p->ws + WS_R1);
            for (int rep = 0; rep < 1 + (((REPMASK >> st) & 1) & ((REPL >> l) & 1)); ++rep) {
            if (rep) grid.sync();
            if (!(PHMASK & (4 << st))) {} else if (st == 0) {
                if (l > 0) cvt_layer(lds, p, l);
                if (kind == 2) norm_phase<true>(hin, p->in[2] + (size_t)(l * 2 + 0) * 1024, modl, 0, R1, 2048);
                else norm_phase<false>(hin, p->in[2] + (size_t)(l * 2 + 0) * 1024, modl, 0, R1, 1024);
            } else if (st == 12) {
                prep_rwkv_elem(p);
            } else if (st == 2 && kind == 1) {
                prep_gla(lds, p);
            } else if (st == 2 && kind == 0) {
                prep_delta(lds, p, j);
            } else if (st == 1 || st == 2 || st == 7 || st == 9) {
                pg8::EpiBf16S E; E.act = 0; const bf16_t* A; const bf16_t* Bt; int lda, N, K;
                if (st == 1) {
                    A = R1; Bt = W + W_IN / 2;
                    if (kind == 0) { E.O = (bf16_t*)(p->ws + WS_PROJ); E.ldc = 4352; lda = 1024; N = 4352; K = 1024; }
                    else if (kind == 1) { E.O = (bf16_t*)(p->ws + WS_PROJ); E.ldc = 4096; lda = 1024; N = 4096; K = 1024; }
                    else { E.O = (bf16_t*)(p->ws + WS_PROJC); E.ldc = 3328; E.act = 1; lda = 2048; N = 3328; K = 2048; }
                } else if (st == 2) {
                    A = (const bf16_t*)(p->ws + WS_PROJC) + 3072; Bt = W + W_L2 / 2; E.O = R1; E.ldc = 3072; lda = 3328; N = 3072; K = 256;
                } else {
                    const int g = (st == 9);
                    A = R1; Bt = W + W_UP / 2 + (size_t)(g ? 3072 : 0) * 1024; N = g ? 2560 : 3072; E.O = (bf16_t*)(p->ws + WS_HID); E.ldc = N; lda = 1024; K = 1024;
                }
                run_gemm(lds, A, lda, Bt, N, K, E);
            } else if (st == 5 || st == 11) {
                pg8::EpiRes E; const bf16_t* A; const bf16_t* Bt; int lda, K;
                if (st == 5) { E.res = hin; E.out = p->out; E.gate = modl + 2 * 1024; A = (const bf16_t*)(p->ws + (kind != 0 ? WS_OC : WS_PROJ)); lda = (kind == 0) ? 4352 : 1024; Bt = W + W_OUT / 2; K = 1024; }
                else { E.res = p->out; E.out = p->out; E.gate = modl + 5 * 1024; A = (const bf16_t*)(p->ws + WS_ACT); lda = 2816; Bt = W + W_DN / 2; K = 2816; }
                run_gemm(lds, A, lda, Bt, 1024, K, E);
            } else if (st == 3) {
                if (kind == 0) scan_chunked<0>(lds, p, j); else if (kind == 1) scan_chunked<1>(lds, p, j); else scan_rwkv(lds, p);
            } else if (st == 4) {
                if (kind == 0) post_phase<0>(p, j); else if (kind == 1) post_phase<1>(p, j); else post_phase<2>(p, j);
            } else if (st == 6) {
                norm_phase<false>(p->out, p->in[2] + (size_t)(l * 2 + 1) * 1024, modl, 3, R1, 1024);
            } else if (st == 8 || st == 10) {
                const int g = (st == 10);
                convglu_phase((const bf16_t*)(p->ws + WS_HID), (bf16_t*)(p->ws + WS_ACT), g, p->in[32] + (size_t)l * 3 * 5632, p->in[33] + (size_t)l * 5632);
            }
            }
        }
        if (ph + 1 < ph_hi) { if (ph == ph_lo) grid.sync(); else xcd_barrier(xb); }
    }
}

extern "C" void kernel_launch(void* const* d_in, const int* in_sizes, int n_in, void* d_out, int out_size, void* d_ws, size_t ws_size, hipStream_t stream) {
    constexpr int LDS_BYTES = 144 * 1024;
    static int grid_blocks = 0;
    if (!grid_blocks) {
        int dev = 0, cus = 0, per_cu = 0;
        hipGetDevice(&dev);
        hipDeviceGetAttribute(&cus, hipDeviceAttributeMultiprocessorCount, dev);
        if (hipFuncSetAttribute((const void*)mega, hipFuncAttributeMaxDynamicSharedMemorySize, LDS_BYTES) != hipSuccess) fprintf(stderr, "hipFuncSetAttribute failed\n");
        hipOccupancyMaxActiveBlocksPerMultiprocessor(&per_cu, (const void*)mega, 512, LDS_BYTES);
        if (per_cu < 1) per_cu = 1;
        if (per_cu > 1) per_cu = 1;
        grid_blocks = cus * per_cu;
        if (ws_size < 512 * MiB) fprintf(stderr, "workspace too small: %zu\n", ws_size);
    }
    (void)hipMemsetAsync((char*)d_ws + WS_BAR, 0, XCD_BAR_WORDS * sizeof(unsigned), stream);
    Params p{};
    for (int i = 0; i < 36; ++i) p.in[i] = (const float*)d_in[i];
    p.out = (float*)d_out; p.ws = (unsigned char*)d_ws;
#if SINGLE_LAUNCH
    p.ph_lo = 0; p.ph_hi = NPH;
    void* args[] = {&p};
    hipError_t e = hipLaunchCooperativeKernel((const void*)mega, dim3(grid_blocks), dim3(512), args, LDS_BYTES, stream);
    if (e != hipSuccess) fprintf(stderr, "cooperative launch failed: %s (grid %d)\n", hipGetErrorString(e), grid_blocks);
#else
    for (int ph = 0; ph < NPH; ++ph) {
        if (phase_is_noop(ph)) continue;
        p.ph_lo = ph; p.ph_hi = ph + 1;
        hipLaunchKernelGGL(mega, dim3(grid_blocks), dim3(512), LDS_BYTES, stream, p);
    }
#endif
}
```

```cpp
#include <hip/hip_runtime.h>
#include <hip/hip_cooperative_groups.h>
#include <cstdio>
namespace cg = cooperative_groups;

#ifndef PHMASK
#define PHMASK 0xFFFFFF
#endif
#ifndef REPMASK
#define REPMASK 0
#endif
#ifndef REPL
#define REPL 0xF
#endif
#ifndef SINGLE_LAUNCH
#define SINGLE_LAUNCH 1
#endif

#define LAS __attribute__((address_space(3)))
typedef unsigned short bf16_t;
typedef short bf16x8 __attribute__((ext_vector_type(8)));
typedef float f32x4 __attribute__((ext_vector_type(4)));
typedef float f32x2 __attribute__((ext_vector_type(2)));
typedef unsigned u32x4 __attribute__((ext_vector_type(4)));
typedef unsigned u32x2 __attribute__((ext_vector_type(2)));

constexpr int MROWS = 32768, SEQ = 8192, DM = 1024;
constexpr size_t MiB = 1ull << 20;
constexpr size_t WS_W = 0;
constexpr size_t W_IN = 0, W_L2 = 13 * MiB, W_OUT = 15 * MiB, W_UP = 17 * MiB, W_DN = 28 * MiB;
constexpr size_t WS_MISC = 34 * MiB;
constexpr size_t WS_R1 = 36 * MiB;
constexpr size_t WS_PROJ = 164 * MiB;
constexpr size_t WS_PROJC = 228 * MiB;
constexpr size_t WS_OC = 436 * MiB;
constexpr size_t WS_HID = 100 * MiB;
constexpr size_t WS_ACT = 292 * MiB;

struct Params {
    const float* in[36];
    float* out;
    unsigned char* ws;
    int ph_lo, ph_hi;
};
typedef const Params* PPTR;

__device__ __forceinline__ float bf2f(unsigned v) { return __uint_as_float(v << 16); }
__device__ __forceinline__ float bflo(unsigned v) { return __uint_as_float(v << 16); }
__device__ __forceinline__ float bfhi(unsigned v) { return __uint_as_float(v & 0xffff0000u); }
typedef __bf16 bf16v2 __attribute__((ext_vector_type(2)));
__device__ __forceinline__ unsigned pack2(float lo, float hi) { const f32x2 v = {lo, hi}; const bf16v2 r = __builtin_convertvector(v, bf16v2); return __builtin_bit_cast(unsigned, r); }
__device__ __forceinline__ unsigned f2bf(float f) { return pack2(f, 0.f) & 0xffffu; }
__device__ __forceinline__ float sigmoidf_(float x) { return __builtin_amdgcn_rcpf(1.0f + __expf(-x)); }
__device__ __forceinline__ float siluf_(float x) { return x * __builtin_amdgcn_rcpf(1.0f + __expf(-x)); }
__device__ __forceinline__ float softplusf_(float x) { return x > 15.0f ? x : __logf(1.0f + __expf(x)); }
template <int CTRL> __device__ __forceinline__ float dpp_f(float x) { return __int_as_float(__builtin_amdgcn_update_dpp(0, __float_as_int(x), CTRL, 0xf, 0xf, false)); }
__device__ __forceinline__ float rowred16(float x) { x += dpp_f<0x128>(x); x += dpp_f<0x124>(x); x += dpp_f<0x122>(x); x += dpp_f<0x121>(x); return x; }
__device__ __forceinline__ float wave_allsum(float v) {
    float r = rowred16(v);
    r += __int_as_float(__builtin_amdgcn_update_dpp(0, __float_as_int(r), 0x142, 0xa, 0xf, false));
    r += __int_as_float(__builtin_amdgcn_update_dpp(0, __float_as_int(r), 0x143, 0xc, 0xf, false));
    return __int_as_float(__builtin_amdgcn_readlane(__float_as_int(r), 63));
}
struct StepRegs { f32x4 a, b, c, d, e; float vr, x0, x1; };
template <int KIND> __device__ __forceinline__ void step_load(StepRegs& r, LAS const float* rec, int li, int row) {
    r.a = *(LAS const f32x4*)(rec + 4 * li); r.b = *(LAS const f32x4*)(rec + 64 + 4 * li); r.c = *(LAS const f32x4*)(rec + 128 + 4 * li); r.d = *(LAS const f32x4*)(rec + 192 + 4 * li);
    if (KIND == 0) { r.vr = rec[256 + row]; r.x0 = rec[272]; r.x1 = rec[273]; }
    else if (KIND == 1) { r.vr = rec[256 + row]; }
    else { r.e = *(LAS const f32x4*)(rec + 256 + 4 * li); r.vr = rec[320 + row]; }
}
template <int KIND> __device__ __forceinline__ float step_compute(const StepRegs& r, f32x2 (&s)[4]) {
    if (KIND == 0) {
        const f32x2 k[4] = {{r.a[0], r.a[1]}, {r.a[2], r.a[3]}, {r.b[0], r.b[1]}, {r.b[2], r.b[3]}};
        const f32x2 q[4] = {{r.c[0], r.c[1]}, {r.c[2], r.c[3]}, {r.d[0], r.d[1]}, {r.d[2], r.d[3]}};
        f32x2 pa = s[0] * k[0] + s[1] * k[1]; const f32x2 pb = s[2] * k[2] + s[3] * k[3]; pa += pb;
        const float pp = rowred16(pa.x + pa.y);
        const float cc = r.x0 * (r.vr - r.x1 * pp);
        const f32x2 eg2 = {r.x1, r.x1}, cc2 = {cc, cc};
#pragma unroll
        for (int i = 0; i < 4; ++i) s[i] = s[i] * eg2 + cc2 * k[i];
        f32x2 oa = s[0] * q[0] + s[1] * q[1]; const f32x2 ob = s[2] * q[2] + s[3] * q[3]; oa += ob;
        return rowred16(oa.x + oa.y);
    } else if (KIND == 1) {
        const f32x2 q[4] = {{r.a[0], r.a[1]}, {r.a[2], r.a[3]}, {r.b[0], r.b[1]}, {r.b[2], r.b[3]}};
        const f32x2 f[4] = {{r.c[0], r.c[1]}, {r.c[2], r.c[3]}, {r.d[0], r.d[1]}, {r.d[2], r.d[3]}};
        const f32x2 v2 = {r.vr, r.vr};
#pragma unroll
        for (int i = 0; i < 4; ++i) s[i] = s[i] * f[i] + v2 * (1.0f - f[i]);
        f32x2 oa = s[0] * q[0] + s[1] * q[1]; const f32x2 ob = s[2] * q[2] + s[3] * q[3]; oa += ob;
        return rowred16(oa.x + oa.y);
    } else {
        const f32x2 a2[2] = {{r.a[0], r.a[1]}, {r.a[2], r.a[3]}}, b2[2] = {{r.b[0], r.b[1]}, {r.b[2], r.b[3]}}, d2[2] = {{r.c[0], r.c[1]}, {r.c[2], r.c[3]}};
        const f32x2 k2[2] = {{r.d[0], r.d[1]}, {r.d[2], r.d[3]}}, r2[2] = {{r.e[0], r.e[1]}, {r.e[2], r.e[3]}};
        const f32x2 pa = s[0] * a2[0] + s[1] * a2[1];
        const float sa = rowred16(pa.x + pa.y);
        const f32x2 sa2 = {sa, sa}, v2 = {r.vr, r.vr};
        s[0] = s[0] * d2[0] + sa2 * b2[0] + v2 * k2[0]; s[1] = s[1] * d2[1] + sa2 * b2[1] + v2 * k2[1];
        const f32x2 oa = s[0] * r2[0] + s[1] * r2[1];
        return rowred16(oa.x + oa.y);
    }
}
__device__ __forceinline__ int tidx() { int t = threadIdx.x; asm volatile("" : "+v"(t)); return t; }
__device__ __forceinline__ int bidx() { int t = blockIdx.x; asm volatile("" : "+s"(t)); return t; }
__device__ __forceinline__ int gdim() { int t = gridDim.x; asm volatile("" : "+s"(t)); return t; }
__device__ __forceinline__ void lds_barrier() { asm volatile("s_waitcnt lgkmcnt(0)" ::: "memory"); __builtin_amdgcn_s_barrier(); asm volatile("" ::: "memory"); }

namespace pg8 {
constexpr int BM = 256, BK = 64, HALF = 128, HTB = HALF * BK * 2, STAGE_BYTES = 8 * HTB, NXCD = 8, WGM = 8;
__device__ __forceinline__ int lds_byte(int r, int c) { const int st = (r >> 4) * 2 + (c >> 5), rr = r & 15, cc = c & 31, ob = rr * 64 + cc * 2; return st * 1024 + (ob ^ (((ob >> 9) & 1) << 5)); }
__device__ __forceinline__ void stage_rc(int b, int& R, int& C) { const int st = b / 1024, sb = b % 1024, swz = sb ^ (((sb >> 9) & 1) << 5); R = (st >> 1) * 16 + swz / 64; C = (st & 1) * 32 + (swz % 64) / 2; }
__device__ __forceinline__ int perm32(int rho) { const int n = rho >> 4, i = rho & 15; return 8 * (i >> 2) + 4 * n + (i & 3); }
struct Unit { int pm, pn; };
struct Gemm { const bf16_t* A; const bf16_t* Bt; int M, N, K, lda; };
struct StaticOrder {
    int nM, nN, nwg, G, c;
    __device__ void init(int M, int N, int G_, int c_) { nM = M / BM; nN = N / BM; nwg = nM * nN; G = G_; c = c_; }
    __device__ bool next(int i, Unit& u) const {
        const long L = (long)i * G + c; if (L >= nwg) return false;
        int wgid = (int)L; { const int q = nwg / NXCD, r = nwg % NXCD, xcd = wgid % NXCD, off = wgid / NXCD; wgid = (xcd < r ? xcd * (q + 1) : r * (q + 1) + (xcd - r) * q) + off; }
        const int nig = WGM * nN, gid = wgid / nig, fm = gid * WGM, gsz = (nM - fm) < WGM ? (nM - fm) : WGM;
        u.pm = fm + ((wgid % nig) % gsz); u.pn = (wgid % nig) / gsz; return true;
    }
};
__device__ __forceinline__ unsigned cvt_pk_bf16(float lo, float hi) { return pack2(lo, hi); }

struct EpiBf16S {
    static constexpr bool PERM = true;
    bf16_t* O; int ldc; int act;
    __device__ __forceinline__ void operator()(const f32x4 (&acc)[2][2][4][2], const Unit& u, int wr, int wc, int fr, int fq) const {
        const int row0 = u.pm * BM + wr * 64 + fr; const int col0 = u.pn * BM + wc * 32 + 8 * fq;
#pragma unroll
        for (int ai = 0; ai < 2; ++ai)
#pragma unroll
            for (int m = 0; m < 4; ++m) { bf16_t* rowp = O + (size_t)(row0 + ai * HALF + m * 16) * ldc + col0;
#pragma unroll
                for (int bj = 0; bj < 2; ++bj) { f32x4 v0 = acc[ai][bj][m][0], v1 = acc[ai][bj][m][1];
                    if (act) { const int c = col0 + bj * HALF;
                        if (c >= 3072 && c < 3136) {
#pragma unroll
                            for (int j = 0; j < 4; ++j) { v0[j] = 1.0f - 2.0f * __builtin_amdgcn_rcpf(1.0f + __expf(2.0f * v0[j])); v1[j] = 1.0f - 2.0f * __builtin_amdgcn_rcpf(1.0f + __expf(2.0f * v1[j])); } }
                        else if (c >= 3200) {
#pragma unroll
                            for (int j = 0; j < 4; ++j) { v0[j] = sigmoidf_(v0[j]); v1[j] = sigmoidf_(v1[j]); } } }
                    u32x4 w; w.x = cvt_pk_bf16(v0[0], v0[1]); w.y = cvt_pk_bf16(v0[2], v0[3]); w.z = cvt_pk_bf16(v1[0], v1[1]); w.w = cvt_pk_bf16(v1[2], v1[3]);
                    *(u32x4*)(rowp + bj * HALF) = w; } }
    }
};
struct EpiRes {
    static constexpr bool PERM = false;
    const float* res; float* out; const float* gate;
    __device__ __forceinline__ void operator()(const f32x4 (&acc)[2][2][4][2], const Unit& u, int wr, int wc, int fr, int fq) const {
        const int row0 = u.pm * BM + wr * 64 + fr, col0 = u.pn * BM + wc * 32 + 4 * fq; const int b = (u.pm * BM) / SEQ;
        f32x4 gv[2][2];
#pragma unroll
        for (int bj = 0; bj < 2; ++bj)
#pragma unroll
            for (int n = 0; n < 2; ++n) gv[bj][n] = *(const f32x4*)(gate + (size_t)b * 6144 + col0 + bj * HALF + n * 16);
#pragma unroll
        for (int ai = 0; ai < 2; ++ai)
#pragma unroll
            for (int mp = 0; mp < 2; ++mp) {
                f32x4 r[2][2][2];
#pragma unroll
                for (int mm = 0; mm < 2; ++mm) { const size_t off = (size_t)(row0 + ai * HALF + (2 * mp + mm) * 16) * DM + col0;
#pragma unroll
                    for (int bj = 0; bj < 2; ++bj)
#pragma unroll
                        for (int n = 0; n < 2; ++n) r[mm][bj][n] = *(const f32x4*)(res + off + bj * HALF + n * 16); }
                __builtin_amdgcn_sched_barrier(0);
#pragma unroll
                for (int mm = 0; mm < 2; ++mm) { const size_t off = (size_t)(row0 + ai * HALF + (2 * mp + mm) * 16) * DM + col0;
#pragma unroll
                    for (int bj = 0; bj < 2; ++bj)
#pragma unroll
                        for (int n = 0; n < 2; ++n) *(f32x4*)(out + off + bj * HALF + n * 16) = r[mm][bj][n] + gv[bj][n] * acc[ai][bj][2 * mp + mm][n]; }
            }
    }
};

template <class Epi>
__device__ __forceinline__ void gemm_phase(LAS unsigned char* lds, const Gemm g, const StaticOrder& S, const Epi& E) {
    const int tid = tidx(), wid = __builtin_amdgcn_readfirstlane(tid >> 6), lane = tid & 63, wr = wid >> 2, wc = wid & 3, fr = lane & 15, fq = lane >> 4;
    const int K = g.K, nt = K / BK, lda = g.lda;
    unsigned voffA[2], voffB[2];
#pragma unroll
    for (int i = 0; i < 2; ++i) { int R, C; stage_rc(tid * 16 + i * 8192, R, C); const int Rb = Epi::PERM ? ((R & ~31) + perm32(R & 31)) : R;
        voffA[i] = (unsigned)(R * lda + C) * 2u; voffB[i] = (unsigned)(Rb * K + C) * 2u; }
    const size_t kstep = (size_t)(BK * 2);
    const size_t hstepA = (size_t)HALF * lda * 2, hstepB = (size_t)HALF * K * 2;
    const size_t tstepA = 2 * hstepA, tstepB = 2 * hstepB;
    const unsigned ldsw = (unsigned)wid * 1024u;
    const int aoff = lds_byte(wr * 64 + fr, fq * 8), boff = lds_byte(wc * 32 + fr, fq * 8);
#define PG8_SA(b, h) (((b) * 2 + (h)) * HTB)
#define PG8_SB(b, h) ((4 + (b) * 2 + (h)) * HTB)
#define PG8_STAGE(bufoff, gbase, voff) do { _Pragma("unroll") for (int _i = 0; _i < 2; ++_i) \
        __builtin_amdgcn_global_load_lds((const unsigned*)((const char*)(gbase) + (voff)[_i]), (LAS unsigned*)(lds + (bufoff) + ldsw + _i * 8192), 16, 0, 0); } while (0)
#define PG8_LDA(dst, b, h) do { _Pragma("unroll") for (int m = 0; m < 4; ++m) _Pragma("unroll") for (int k = 0; k < 2; ++k) dst[m][k] = *(const LAS bf16x8*)(lds + PG8_SA(b, h) + aoff + m * 2048 + k * 1024); } while (0)
#define PG8_LDB(dst, b, h) do { _Pragma("unroll") for (int n = 0; n < 2; ++n) _Pragma("unroll") for (int k = 0; k < 2; ++k) dst[n][k] = *(const LAS bf16x8*)(lds + PG8_SB(b, h) + boff + n * 2048 + k * 1024); } while (0)
#define PG8_MMA(ai, bj, At, Bt) do { __builtin_amdgcn_s_setprio(1); _Pragma("unroll") for (int m = 0; m < 4; ++m) _Pragma("unroll") for (int n = 0; n < 2; ++n) _Pragma("unroll") for (int k = 0; k < 2; ++k) \
        acc[ai][bj][m][n] = __builtin_amdgcn_mfma_f32_16x16x32_bf16(Bt[n][k], At[m][k], acc[ai][bj][m][n], 0, 0, 0); __builtin_amdgcn_s_setprio(0); } while (0)
#define PG8_WAIT_V(n) asm volatile("s_waitcnt vmcnt(" #n ")" ::: "memory")
#define PG8_WAIT_L(n) asm volatile("s_waitcnt lgkmcnt(" #n ")" ::: "memory")
#define PG8_BAR __builtin_amdgcn_s_barrier()
#define PG8_SCHED __builtin_amdgcn_sched_barrier(0)
    Unit cur, nxt; int ui = 0;
    if (!S.next(0, cur)) return;
    f32x4 acc[2][2][4][2];
#pragma unroll
    for (int a = 0; a < 2; ++a)
#pragma unroll
        for (int b = 0; b < 2; ++b)
#pragma unroll
            for (int m = 0; m < 4; ++m)
#pragma unroll
                for (int n = 0; n < 2; ++n) acc[a][b][m][n] = (f32x4){0.f, 0.f, 0.f, 0.f};
    bf16x8 At[4][2], B0[2][2], B1[2][2];
    const char* cA = (const char*)g.A + (size_t)cur.pm * tstepA; const char* cB = (const char*)g.Bt + (size_t)cur.pn * tstepB;
    PG8_STAGE(PG8_SB(0, 0), cB, voffB); PG8_STAGE(PG8_SA(0, 0), cA, voffA); PG8_STAGE(PG8_SB(0, 1), cB + hstepB, voffB); PG8_STAGE(PG8_SA(0, 1), cA + hstepA, voffA);
    if (wr == 1) PG8_BAR;
    PG8_WAIT_V(4); PG8_BAR;
    PG8_STAGE(PG8_SB(1, 0), cB + kstep, voffB); PG8_STAGE(PG8_SA(1, 0), cA + kstep, voffA); PG8_STAGE(PG8_SB(1, 1), cB + hstepB + kstep, voffB);
    PG8_WAIT_V(6); PG8_BAR;
    for (;;) {
        const bool has_next = S.next(ui + 1, nxt);
        const char* nA = has_next ? (const char*)g.A + (size_t)nxt.pm * tstepA : cA; const char* nB = has_next ? (const char*)g.Bt + (size_t)nxt.pn * tstepB : cB;
        for (int t = 0; t < nt; t += 2) {
            const bool last = (t == nt - 2);
            const char* a1 = cA + (size_t)(t + 1) * kstep;
            const char* a2 = last ? nA : cA + (size_t)(t + 2) * kstep; const char* b2 = last ? nB : cB + (size_t)(t + 2) * kstep;
            const char* a3 = a2 + kstep; const char* b3 = b2 + kstep;
            PG8_LDB(B0, 0, 0); PG8_SCHED; PG8_LDA(At, 0, 0); PG8_STAGE(PG8_SA(1, 1), a1 + hstepA, voffA);
            PG8_WAIT_L(8); PG8_BAR; PG8_WAIT_L(0); PG8_MMA(0, 0, At, B0); PG8_BAR; PG8_SCHED;
            PG8_LDB(B1, 0, 1); PG8_STAGE(PG8_SB(0, 0), b2, voffB);
            PG8_BAR; PG8_WAIT_L(0); PG8_MMA(0, 1, At, B1); PG8_BAR;
            PG8_LDA(At, 0, 1); PG8_STAGE(PG8_SA(0, 0), a2, voffA);
            PG8_BAR; PG8_WAIT_L(0); PG8_MMA(1, 0, At, B0); PG8_BAR; PG8_SCHED;
            PG8_STAGE(PG8_SB(0, 1), b2 + hstepB, voffB);
            PG8_WAIT_V(6); PG8_BAR; PG8_MMA(1, 1, At, B1); PG8_BAR;
            PG8_LDB(B0, 1, 0); PG8_SCHED; PG8_LDA(At, 1, 0); PG8_STAGE(PG8_SA(0, 1), a2 + hstepA, voffA);
            PG8_WAIT_L(8); PG8_BAR; PG8_WAIT_L(0); PG8_MMA(0, 0, At, B0); PG8_BAR; PG8_SCHED;
            PG8_LDB(B1, 1, 1); PG8_STAGE(PG8_SB(1, 0), b3, voffB);
            PG8_BAR; PG8_WAIT_L(0); PG8_MMA(0, 1, At, B1); PG8_BAR;
            PG8_LDA(At, 1, 1); PG8_STAGE(PG8_SA(1, 0), a3, voffA);
            PG8_BAR; PG8_WAIT_L(0); PG8_MMA(1, 0, At, B0); PG8_BAR; PG8_SCHED;
            PG8_STAGE(PG8_SB(1, 1), b3 + hstepB, voffB);
            PG8_WAIT_V(6); PG8_BAR; PG8_MMA(1, 1, At, B1); PG8_BAR;
        }
        E(acc, cur, wr, wc, fr, fq);
        if (!has_next) break;
#pragma unroll
        for (int a = 0; a < 2; ++a)
#pragma unroll
            for (int b = 0; b < 2; ++b)
#pragma unroll
                for (int m = 0; m < 4; ++m)
#pragma unroll
                    for (int n = 0; n < 2; ++n) acc[a][b][m][n] = (f32x4){0.f, 0.f, 0.f, 0.f};
        cur = nxt; cA = nA; cB = nB; ++ui;
    }
    PG8_WAIT_V(0);
    if (wr == 0) PG8_BAR;
    PG8_BAR;
#undef PG8_SA
#undef PG8_SB
#undef PG8_STAGE
#undef PG8_LDA
#undef PG8_LDB
#undef PG8_MMA
#undef PG8_WAIT_V
#undef PG8_WAIT_L
#undef PG8_BAR
#undef PG8_SCHED
}
}

template <class Epi>
__device__ __forceinline__ void run_gemm(LAS unsigned char* lds, const bf16_t* A, int lda, const bf16_t* Bt, int N, int K, const Epi& E) {
    pg8::Gemm g; g.A = A; g.Bt = Bt; g.M = MROWS; g.N = N; g.K = K; g.lda = lda;
    pg8::StaticOrder S; S.init(MROWS, N, (int)gdim(), (int)bidx());
    pg8::gemm_phase<Epi>(lds, g, S, E);
}

__device__ __forceinline__ void cvt_job(LAS float* tile, bf16_t* dst, int ldd, const float* src, int srcN, int nK, int nNdst, int nNsrc, const float* scale, int noff) {
    const int tid = tidx(); const int tilesK = nK / 64, tilesN = nNdst / 64, ntl = tilesK * tilesN, G = gdim();
    const int kr = tid >> 6, nn = tid & 63;
    for (int tl0 = bidx(); tl0 < ntl; tl0 += 2 * G) {
        float v[2][8];
#pragma unroll
        for (int u = 0; u < 2; ++u) { const int tl = tl0 + u * G; const bool tv = tl < ntl; const int tk = tv ? tl % tilesK : 0, tn = tv ? tl / tilesK : 0, k0 = tk * 64, n = tn * 64 + nn;
            const bool ld_ = tv && src && n < nNsrc;
#pragma unroll
            for (int ps = 0; ps < 8; ++ps) { const int kk = ps * 8 + kr; float x = 0.f;
                if (ld_) { x = src[(size_t)(k0 + kk) * srcN + noff + n]; if (scale) x *= scale[k0 + kk]; }
                v[u][ps] = x; } }
#pragma unroll
        for (int u = 0; u < 2; ++u)
#pragma unroll
            for (int ps = 0; ps < 8; ++ps) tile[u * 4160 + (ps * 8 + kr) * 65 + nn] = v[u][ps];
        __syncthreads();
#pragma unroll
        for (int u = 0; u < 2; ++u) { const int tl = tl0 + u * G;
            if (tl < ntl) { const int tk = tl % tilesK, tn = tl / tilesK, k0 = tk * 64, n0 = tn * 64;
#pragma unroll
                for (int ps = 0; ps < 4; ++ps) { const int kk2 = tid & 31, n2 = (tid >> 5) + 16 * ps;
                    const unsigned w = pack2(tile[u * 4160 + (2 * kk2) * 65 + n2], tile[u * 4160 + (2 * kk2 + 1) * 65 + n2]);
                    *(unsigned*)(dst + (size_t)(n0 + n2) * ldd + k0 + 2 * kk2) = w; } } }
        __syncthreads();
    }
}

__device__ __forceinline__ void cvt_layer(LAS unsigned char* lds, PPTR p, int layer) {
    LAS float* tile = (LAS float*)lds;
    bf16_t* W = (bf16_t*)(p->ws + WS_W);
    bf16_t* w_in = W + W_IN / 2; bf16_t* w_l2 = W + W_L2 / 2; bf16_t* w_out = W + W_OUT / 2; bf16_t* w_up = W + W_UP / 2; bf16_t* w_dn = W + W_DN / 2;
    const int kind = layer % 3, j = layer / 3;
    const int nmix = (kind == 2) ? 20 : 2;
    for (int jb = 0; jb < nmix + 5; ++jb) {
        bf16_t* dst = w_in; int ldd = 1024; const float* src = nullptr; int srcN = 1024, nK = 1024, nNdst = 1024, nNsrc = 1024, noff = 0; const float* scale = nullptr;
        if (jb >= nmix) {
            const int f = jb - nmix;
            if (f < 4) { const int g = f >> 1, gate = f & 1; const int nch = g ? 1280 : 1536, ch0 = g ? 1536 : 0;
                dst = w_up + (size_t)((g ? 3072 : 0) + nch * gate) * 1024; src = p->in[31] + (size_t)layer * 1024 * 5632; srcN = 5632; nNdst = nch; nNsrc = nch; noff = 2816 * gate + ch0; }
            else { dst = w_dn; ldd = 2816; src = p->in[34] + (size_t)layer * 2816 * 1024; nK = 2816; }
        } else if (kind == 0) {
            if (jb == 0) { src = p->in[5] + (size_t)j * 1024 * 4112; srcN = 4112; nNdst = 4352; nNsrc = 4112; }
            else { dst = w_out; src = p->in[10] + (size_t)j * 1024 * 1024; }
        } else if (kind == 1) {
            if (jb == 0) { src = p->in[11]; srcN = 4096; nNdst = 4096; nNsrc = 4096; }
            else { dst = w_out; src = p->in[14]; }
        } else {
            const float* mu = p->in[15];
            if (jb < 6) { const int sI = jb >> 1, hi = jb & 1; const int mi = (sI == 0) ? 0 : (sI == 1 ? 2 : 3);
                dst = w_in + (size_t)sI * 1024 * 2048 + hi * 1024; ldd = 2048; src = p->in[16] + (size_t)sI * 1024 * 1024; if (hi) scale = mu + mi * 1024; }
            else if (jb < 12) { const int q = (jb - 6) >> 1, hi = jb & 1;
                const int rowo = (q == 0) ? 3072 : (q == 1 ? 3136 : 3200); const int nc = (q == 2) ? 128 : 64; const int mi = (q == 0) ? 1 : (q == 1 ? 4 : 5);
                dst = w_in + (size_t)rowo * 2048 + hi * 1024; ldd = 2048; src = (q == 0) ? p->in[18] : (q == 1 ? p->in[21] : p->in[23]); srcN = nc; nNdst = nc; nNsrc = nc; if (hi) scale = mu + mi * 1024; }
            else if (jb < 19) { ldd = 256; nNdst = 1024; nNsrc = 1024;
                const int q = jb - 12;
                if (q == 0) { dst = w_l2; src = p->in[19]; nK = 64; }
                else if (q == 1) { dst = w_l2 + 64; nK = 192; }
                else if (q == 2) { dst = w_l2 + (size_t)1024 * 256; nK = 64; }
                else if (q == 3) { dst = w_l2 + (size_t)1024 * 256 + 64; src = p->in[22]; nK = 64; }
                else if (q == 4) { dst = w_l2 + (size_t)1024 * 256 + 128; nK = 128; }
                else if (q == 5) { dst = w_l2 + (size_t)2048 * 256; nK = 128; }
                else { dst = w_l2 + (size_t)2048 * 256 + 128; src = p->in[24]; nK = 128; } }
            else { dst = w_out; src = p->in[30]; }
        }
        cvt_job(tile, dst, ldd, src, srcN, nK, nNdst, nNsrc, scale, noff);
    }
}

template <bool SHIFT>
__device__ __forceinline__ void norm_phase(const float* h, const float* g, const float* modl, int s_shift, bf16_t* U, int ldu) {
    const int lane = tidx() & 63, wave = tidx() >> 6;
    const int gw = bidx() * 8 + wave, nw = gdim() * 8;
    constexpr int RU = SHIFT ? 2 : 4;
    f32x4 gg4[4];
#pragma unroll
    for (int i = 0; i < 4; ++i) gg4[i] = *(const f32x4*)(g + i * 256 + lane * 4);
    for (int row0 = gw; row0 < MROWS; row0 += nw * RU) {
        const int b0 = row0 >> 13;
        f32x4 gs0[4], sh0[4];
#pragma unroll
        for (int i = 0; i < 4; ++i) { const int c = i * 256 + lane * 4; const float* shp = modl + (size_t)b0 * 6144 + s_shift * 1024;
            gs0[i] = gg4[i] * (1.0f + *(const f32x4*)(shp + 1024 + c)); sh0[i] = *(const f32x4*)(shp + c); }
        f32x4 x[RU][4], xp[RU][4];
#pragma unroll
        for (int q = 0; q < RU; ++q) { const int row = row0 + q * nw;
            if (row < MROWS) {
#pragma unroll
                for (int i = 0; i < 4; ++i) x[q][i] = *(const f32x4*)(h + (size_t)row * DM + i * 256 + lane * 4);
                if (SHIFT) { const size_t prow = ((row & (SEQ - 1)) > 0) ? (size_t)(row - 1) : (size_t)row;
#pragma unroll
                    for (int i = 0; i < 4; ++i) xp[q][i] = *(const f32x4*)(h + prow * DM + i * 256 + lane * 4); } } }
#pragma unroll
        for (int q = 0; q < RU; ++q) { const int row = row0 + q * nw;
            if (row < MROWS) {
                const int b = row >> 13, t = row & (SEQ - 1);
                const float* sh = modl + (size_t)b * 6144 + s_shift * 1024; const float* sc = sh + 1024;
                float ss = 0.f;
#pragma unroll
                for (int i = 0; i < 4; ++i) ss += x[q][i][0] * x[q][i][0] + x[q][i][1] * x[q][i][1] + x[q][i][2] * x[q][i][2] + x[q][i][3] * x[q][i][3];
                ss = wave_allsum(ss); const float rstd = __builtin_amdgcn_rsqf(ss * (1.0f / 1024.0f) + 1e-6f);
                float rstdp = 0.f;
                if (SHIFT) { float ssp = 0.f;
#pragma unroll
                    for (int i = 0; i < 4; ++i) ssp += xp[q][i][0] * xp[q][i][0] + xp[q][i][1] * xp[q][i][1] + xp[q][i][2] * xp[q][i][2] + xp[q][i][3] * xp[q][i][3];
                    ssp = wave_allsum(ssp); rstdp = __builtin_amdgcn_rsqf(ssp * (1.0f / 1024.0f) + 1e-6f); }
#pragma unroll
                for (int i = 0; i < 4; ++i) { const int c = i * 256 + lane * 4; f32x4 gs = gs0[i], s0 = sh0[i];
                    if (b != b0) { gs = gg4[i] * (1.0f + *(const f32x4*)(sc + c)); s0 = *(const f32x4*)(sh + c); }
                    const f32x4 u = x[q][i] * rstd * gs + s0;
                    u32x2 w; w.x = pack2(u[0], u[1]); w.y = pack2(u[2], u[3]); *(u32x2*)(U + (size_t)row * ldu + c) = w;
                    if (SHIFT) { f32x4 up = xp[q][i] * rstdp * gs + s0; if (t == 0) up = (f32x4){0.f, 0.f, 0.f, 0.f};
                        const f32x4 dx = up - u; u32x2 w2; w2.x = pack2(dx[0], dx[1]); w2.y = pack2(dx[2], dx[3]); *(u32x2*)(U + (size_t)row * ldu + 1024 + c) = w2; } }
            } }
    }
}

__device__ __forceinline__ void final_phase(float* h, const float* g) {
    const int lane = tidx() & 63, wave = tidx() >> 6;
    const int gw = bidx() * 8 + wave, nw = gdim() * 8;
    f32x4 gg4[4];
#pragma unroll
    for (int i = 0; i < 4; ++i) gg4[i] = *(const f32x4*)(g + i * 256 + lane * 4);
    for (int row0 = gw; row0 < MROWS; row0 += nw * 4) {
        f32x4 x[4][4];
#pragma unroll
        for (int q = 0; q < 4; ++q) { const int row = row0 + q * nw; if (row < MROWS) {
#pragma unroll
            for (int i = 0; i < 4; ++i) x[q][i] = *(const f32x4*)(h + (size_t)row * DM + i * 256 + lane * 4); } }
#pragma unroll
        for (int q = 0; q < 4; ++q) { const int row = row0 + q * nw; if (row < MROWS) {
            float ss = 0.f;
#pragma unroll
            for (int i = 0; i < 4; ++i) ss += x[q][i][0] * x[q][i][0] + x[q][i][1] * x[q][i][1] + x[q][i][2] * x[q][i][2] + x[q][i][3] * x[q][i][3];
            ss = wave_allsum(ss); const float rstd = __builtin_amdgcn_rsqf(ss * (1.0f / 1024.0f) + 1e-6f);
#pragma unroll
            for (int i = 0; i < 4; ++i) { const int c = i * 256 + lane * 4;
                *(f32x4*)(h + (size_t)row * DM + c) = x[q][i] * rstd * gg4[i]; } } }
    }
}

__device__ __forceinline__ void pre_phase(LAS unsigned char* lds, PPTR p) {
    LAS float* cond = (LAS float*)lds;
    LAS float* red = cond + 4096;
    const int tid = tidx(), lane = tid & 63, wave = tid >> 6;
    float* mod = (float*)(p->ws + WS_MISC); float* lb = mod + 4 * 4 * 6144;
    for (int i = tid; i < 4096; i += 512) cond[i] = siluf_(p->in[1][i]);
    __syncthreads();
    for (int task = bidx(); task < 384; task += gdim()) {
        const int l = task / 96, cb = task % 96, col = cb * 64 + lane;
        float a0 = 0.f, a1 = 0.f, a2 = 0.f, a3 = 0.f;
        const float* wp = p->in[3] + ((size_t)l * 1024 + wave * 128) * 6144 + col;
#pragma unroll 8
        for (int k = 0; k < 128; ++k) { const float wv = wp[(size_t)k * 6144]; const int kk = wave * 128 + k;
            a0 += cond[kk] * wv; a1 += cond[1024 + kk] * wv; a2 += cond[2048 + kk] * wv; a3 += cond[3072 + kk] * wv; }
        red[(wave * 4 + 0) * 64 + lane] = a0; red[(wave * 4 + 1) * 64 + lane] = a1; red[(wave * 4 + 2) * 64 + lane] = a2; red[(wave * 4 + 3) * 64 + lane] = a3;
        __syncthreads();
        if (tid < 256) { const int b = tid >> 6; float s = 0.f;
#pragma unroll
            for (int w = 0; w < 8; ++w) s += red[(w * 4 + b) * 64 + lane];
            mod[((size_t)l * 4 + b) * 6144 + col] = s + p->in[4][(size_t)l * 6144 + col]; }
        __syncthreads();
    }
    for (int c = bidx() * 512 + tid; c < 1024; c += gdim() * 512) {
        const float l0 = p->in[12][c], l1 = p->in[12][1024 + c], l2 = p->in[12][2048 + c], l3 = p->in[12][3072 + c];
        const float mx = fmaxf(fmaxf(l0, l1), fmaxf(l2, l3));
        const float e0 = __expf(l0 - mx), e1 = __expf(l1 - mx), e2 = __expf(l2 - mx), e3 = __expf(l3 - mx);
        lb[c] = e1 / (e0 + e1 + e2 + e3);
    }
}

__device__ __forceinline__ void convglu_phase(const bf16_t* HID, bf16_t* ACT, int g, const float* cw, const float* cb) {
    const int nch = g ? 1280 : 1536, ch0 = g ? 1536 : 0, ld = 2 * nch, ncg = nch / 8;
    const int total = (MROWS / 16) * ncg;
    for (int task = bidx() * 512 + tidx(); task < total; task += gdim() * 512) {
        const int cgi = task % ncg, run = task / ncg, row0 = run * 16, t0 = row0 & (SEQ - 1), j0 = cgi * 8, ch = ch0 + j0;
        float wv[3][8], wg[3][8], bv[8], bg[8];
#pragma unroll
        for (int k = 0; k < 3; ++k)
#pragma unroll
            for (int e = 0; e < 8; ++e) { wv[k][e] = cw[k * 5632 + ch + e]; wg[k][e] = cw[k * 5632 + 2816 + ch + e]; }
#pragma unroll
        for (int e = 0; e < 8; ++e) { bv[e] = cb[ch + e]; bg[e] = cb[2816 + ch + e]; }
        u32x4 v2 = (u32x4){0, 0, 0, 0}, v1 = v2, g2 = v2, g1 = v2;
        if (t0 >= 2) {
            v2 = *(const u32x4*)(HID + (size_t)(row0 - 2) * ld + j0); g2 = *(const u32x4*)(HID + (size_t)(row0 - 2) * ld + nch + j0);
            v1 = *(const u32x4*)(HID + (size_t)(row0 - 1) * ld + j0); g1 = *(const u32x4*)(HID + (size_t)(row0 - 1) * ld + nch + j0);
        }
        u32x4 va[4], ga[4], vb4[4], gb4[4];
#define CG_LOAD(V, G, r0) do { _Pragma("unroll") for (int q_ = 0; q_ < 4; ++q_) { V[q_] = *(const u32x4*)(HID + (size_t)(row0 + (r0) + q_) * ld + j0); G[q_] = *(const u32x4*)(HID + (size_t)(row0 + (r0) + q_) * ld + nch + j0); } } while (0)
#define CG_ROWS(V, G, r0) do { _Pragma("unroll") for (int q_ = 0; q_ < 4; ++q_) { const u32x4 v0 = V[q_], g0 = G[q_]; u32x4 o; \
            _Pragma("unroll") for (int q = 0; q < 4; ++q) { \
                const float yv0 = wv[0][2 * q] * bflo(v2[q]) + wv[1][2 * q] * bflo(v1[q]) + wv[2][2 * q] * bflo(v0[q]) + bv[2 * q]; \
                const float yv1 = wv[0][2 * q + 1] * bfhi(v2[q]) + wv[1][2 * q + 1] * bfhi(v1[q]) + wv[2][2 * q + 1] * bfhi(v0[q]) + bv[2 * q + 1]; \
                const float yg0 = wg[0][2 * q] * bflo(g2[q]) + wg[1][2 * q] * bflo(g1[q]) + wg[2][2 * q] * bflo(g0[q]) + bg[2 * q]; \
                const float yg1 = wg[0][2 * q + 1] * bfhi(g2[q]) + wg[1][2 * q + 1] * bfhi(g1[q]) + wg[2][2 * q + 1] * bfhi(g0[q]) + bg[2 * q + 1]; \
                o[q] = pack2(yv0 * siluf_(yg0), yv1 * siluf_(yg1)); } \
            *(u32x4*)(ACT + (size_t)(row0 + (r0) + q_) * 2816 + ch) = o; \
            v2 = v1; v1 = v0; g2 = g1; g1 = g0; } } while (0)
        CG_LOAD(va, ga, 0);
        CG_LOAD(vb4, gb4, 4);
        CG_ROWS(va, ga, 0);
        CG_LOAD(va, ga, 8);
        CG_ROWS(vb4, gb4, 4);
        CG_LOAD(vb4, gb4, 12);
        CG_ROWS(va, ga, 8);
        CG_ROWS(vb4, gb4, 12);
#undef CG_LOAD
#undef CG_ROWS
    }
}

template <int KIND>
__device__ __forceinline__ void scan_phase(LAS unsigned char* lds, PPTR p, int j) {
    constexpr int N = (KIND == 2) ? 64 : 128;
    constexpr int NH = (KIND == 2) ? 16 : 8;
    constexpr int RG = N / 16;
    constexpr int STRIDE = (KIND == 0) ? 288 : (KIND == 1 ? 272 : 336);
    constexpr int TC = 32, NC = SEQ / TC;
    constexpr int LDP = (KIND == 0) ? 4352 : (KIND == 1 ? 4096 : 3328);
    LAS float* buf = (LAS float*)lds;
    LAS float* ob = buf + 2 * TC * STRIDE;
    const int tid = tidx(), wave = tid >> 6, lane = tid & 63;
    const bool is_loader = wave >= 4; const int lw = wave - 4;
    const int li = lane & 15, row = (wave & 3) * 4 + (lane >> 4);
    const bf16_t* P = (const bf16_t*)(p->ws + (KIND == 2 ? WS_PROJC : WS_PROJ));
    const bf16_t* L2 = (const bf16_t*)(p->ws + WS_R1);
    bf16_t* O = (bf16_t*)(p->ws + (KIND == 2 ? WS_OC : WS_R1));
    const int G = gdim(); const int vcu = (G % 8 == 0) ? (int)(bidx() % 8) * (G / 8) + (int)(bidx() / 8) : (int)bidx();
    for (int task = vcu; task < 256; task += G) {
        const int bh = task / RG, rg = task % RG, b = bh / NH, h = bh % NH;
        const size_t rbase = (size_t)b * SEQ;
        float cwq[4][2], cwk[4][2], cwv[4]; float expA = 0.f, dtb = 0.f; float lbv[2]; float w0v = 0.f, a0v = 0.f, kkc = 0.f, kac = 0.f;
        if (KIND == 0) { const float* cv = p->in[6] + (size_t)j * 4 * 3072;
#pragma unroll
            for (int jj = 0; jj < 4; ++jj) { cwq[jj][0] = cv[jj * 3072 + h * 128 + 2 * lane]; cwq[jj][1] = cv[jj * 3072 + h * 128 + 2 * lane + 1];
                cwk[jj][0] = cv[jj * 3072 + 1024 + h * 128 + 2 * lane]; cwk[jj][1] = cv[jj * 3072 + 1024 + h * 128 + 2 * lane + 1];
                cwv[jj] = cv[jj * 3072 + 2048 + h * 128 + 16 * rg + (lane & 15)]; }
            expA = __expf(p->in[7][j * 8 + h]); dtb = p->in[8][j * 8 + h]; }
        if (KIND == 1) { const float* lbp = (const float*)(p->ws + WS_MISC) + 4 * 4 * 6144; lbv[0] = lbp[h * 128 + 2 * lane]; lbv[1] = lbp[h * 128 + 2 * lane + 1]; }
        if (KIND == 2) { const int ch = h * 64 + lane; w0v = p->in[17][ch]; a0v = p->in[20][ch]; kkc = p->in[25][ch]; kac = p->in[26][ch]; }
        unsigned x0[11], x1[11], x2[11], x3[8], x4[8];
        f32x2 s[4];
#pragma unroll
        for (int e = 0; e < 4; ++e) s[e] = (f32x2){0.f, 0.f};

#define SCAN_LOAD(cc) do { const int c_ = (cc); \
        if (KIND == 0) { const int tfirst = c_ * TC + 8 * lw - 3; \
            _Pragma("unroll") for (int q = 0; q < 11; ++q) { const int t_ = tfirst + q; const bool valid = t_ >= 0; const bf16_t* rowp = P + (rbase + (valid ? t_ : 0)) * LDP; \
                const unsigned vq = *(const unsigned*)(rowp + h * 128 + 2 * lane), vk = *(const unsigned*)(rowp + 1024 + h * 128 + 2 * lane); \
                const int mcol = lane < 16 ? 2048 + h * 128 + 16 * rg + lane : (lane == 32 ? 4096 + h : (lane == 33 ? 4104 + h : 2048 + h * 128)); \
                const unsigned vm = rowp[mcol]; x0[q] = valid ? vq : 0u; x1[q] = valid ? vk : 0u; x2[q] = valid ? vm : 0u; } } \
        else if (KIND == 1) { const int tfirst = c_ * TC + 8 * lw; \
            _Pragma("unroll") for (int q = 0; q < 8; ++q) { const bf16_t* rowp = P + (rbase + tfirst + q) * LDP; \
                x0[q] = *(const unsigned*)(rowp + h * 128 + 2 * lane); x1[q] = *(const unsigned*)(rowp + 1024 + h * 128 + 2 * lane); \
                x2[q] = rowp[2048 + h * 128 + 16 * rg + (lane & 15)]; } } \
        else { const int tfirst = c_ * TC + 8 * lw; \
            _Pragma("unroll") for (int q = 0; q < 8; ++q) { const bf16_t* rowp = P + (rbase + tfirst + q) * LDP; const bf16_t* l2p = L2 + (rbase + tfirst + q) * 3072; \
                x0[q] = rowp[h * 64 + lane]; x1[q] = rowp[1024 + h * 64 + lane]; x2[q] = rowp[2048 + h * 64 + 16 * rg + (lane & 15)]; \
                x3[q] = l2p[h * 64 + lane]; x4[q] = l2p[1024 + h * 64 + lane]; } } } while (0)

#define SCAN_FLUSH(cc) do { const int c_ = (cc); LAS const float* src = ob + (c_ & 1) * (TC * 16) + (lane >> 1) * 16 + (lane & 1) * 8; \
        u32x4 w; w.x = pack2(src[0], src[1]); w.y = pack2(src[2], src[3]); w.z = pack2(src[4], src[5]); w.w = pack2(src[6], src[7]); \
        *(u32x4*)(O + (rbase + c_ * TC + (lane >> 1)) * DM + h * N + 16 * rg + (lane & 1) * 8) = w; } while (0)

        if (is_loader) SCAN_LOAD(0);
        for (int it = 0; it <= NC; ++it) {
            if (is_loader) {
                if (it < NC) {
                    LAS float* bw = buf + (it & 1) * (TC * STRIDE);
#pragma unroll
                    for (int i = 0; i < 8; ++i) {
                        LAS float* rec = bw + (8 * lw + i) * STRIDE;
                        if (KIND == 0) {
                            float yq0 = 0.f, yq1 = 0.f, yk0 = 0.f, yk1 = 0.f, yv = 0.f;
#pragma unroll
                            for (int jj = 0; jj < 4; ++jj) { yq0 += cwq[jj][0] * bflo(x0[i + jj]); yq1 += cwq[jj][1] * bfhi(x0[i + jj]);
                                yk0 += cwk[jj][0] * bflo(x1[i + jj]); yk1 += cwk[jj][1] * bfhi(x1[i + jj]); yv += cwv[jj] * bf2f(x2[i + jj]); }
                            yq0 = siluf_(yq0); yq1 = siluf_(yq1); yk0 = siluf_(yk0); yk1 = siluf_(yk1);
                            const float ssq = wave_allsum(yq0 * yq0 + yq1 * yq1), ssk = wave_allsum(yk0 * yk0 + yk1 * yk1);
                            const float rq = __builtin_amdgcn_rsqf(ssq + 1e-6f) * 0.08838834764831845f, rk = __builtin_amdgcn_rsqf(ssk + 1e-6f);
                            *(LAS f32x2*)(rec + 2 * lane) = (f32x2){yk0 * rk, yk1 * rk};
                            *(LAS f32x2*)(rec + 128 + 2 * lane) = (f32x2){yq0 * rq, yq1 * rq};
                            const float m3 = bf2f(x2[i + 3]);
                            if (lane < 16) rec[256 + lane] = siluf_(yv);
                            else if (lane == 32) rec[273] = __expf(-expA * softplusf_(m3 + dtb));
                            else if (lane == 33) rec[272] = sigmoidf_(m3);
                        } else if (KIND == 1) {
                            const float q0 = siluf_(bflo(x0[i])), q1 = siluf_(bfhi(x0[i]));
                            const float f0 = lbv[0] + (1.0f - lbv[0]) * sigmoidf_(bflo(x1[i])), f1 = lbv[1] + (1.0f - lbv[1]) * sigmoidf_(bfhi(x1[i]));
                            *(LAS f32x2*)(rec + 2 * lane) = (f32x2){q0, q1};
                            *(LAS f32x2*)(rec + 128 + 2 * lane) = (f32x2){f0, f1};
                            if (lane < 16) rec[256 + lane] = bf2f(x2[i]);
                        } else {
                            const float r = bf2f(x0[i]), kraw = bf2f(x1[i]), whi = bf2f(x3[i]), ahi = bf2f(x4[i]);
                            const float wv = -softplusf_(-(w0v + whi)) - 0.5f; const float d = __expf(-__expf(wv));
                            const float ag = sigmoidf_(a0v + ahi);
                            const float kkx = kraw * kkc; const float ss = wave_allsum(kkx * kkx); const float kk = kkx * __builtin_amdgcn_rsqf(ss + 1e-6f);
                            const float kp = kraw * (1.0f + (ag - 1.0f) * kac);
                            rec[lane] = -kk; rec[64 + lane] = kk * ag; rec[128 + lane] = d; rec[192 + lane] = kp; rec[256 + lane] = r;
                            if (lane < 16) rec[320 + lane] = bf2f(x2[i]);
                        }
                    }
                    if (it + 1 < NC) SCAN_LOAD(it + 1);
                }
                if (it >= 2 && lw == 0) SCAN_FLUSH(it - 2);
            } else if (it >= 1) {
                LAS const float* bc = buf + ((it - 1) & 1) * (TC * STRIDE);
                LAS float* oc = ob + ((it - 1) & 1) * (TC * 16);
                StepRegs R[2][2];
                step_load<KIND>(R[0][0], bc, li, row); step_load<KIND>(R[0][1], bc + STRIDE, li, row);
                float osel = 0.f;
#pragma unroll
                for (int g = 0; g < 16; ++g) {
                    if (g + 1 < 16) { step_load<KIND>(R[(g + 1) & 1][0], bc + (2 * g + 2) * STRIDE, li, row); step_load<KIND>(R[(g + 1) & 1][1], bc + (2 * g + 3) * STRIDE, li, row); }
#pragma unroll
                    for (int u = 0; u < 2; ++u) { const float o = step_compute<KIND>(R[g & 1][u], s); osel = (li == ((2 * g + u) & 15)) ? o : osel; }
                    if (g == 7 || g == 15) oc[((g == 15 ? 16 : 0) + li) * 16 + row] = osel;
                }
            }
            lds_barrier();
        }
        if (is_loader && lw == 0) SCAN_FLUSH(NC - 1);
        lds_barrier();
#undef SCAN_LOAD
#undef SCAN_FLUSH
    }
}


typedef short bf16x4 __attribute__((ext_vector_type(4)));
__device__ __forceinline__ bf16x8 cat4(bf16x4 lo, bf16x4 hi) { return __builtin_shufflevector(lo, hi, 0, 1, 2, 3, 4, 5, 6, 7); }
__device__ __forceinline__ bf16x4 cvt4(f32x4 v) { u32x2 w; w.x = pg8::cvt_pk_bf16(v[0], v[1]); w.y = pg8::cvt_pk_bf16(v[2], v[3]); return __builtin_bit_cast(bf16x4, w); }
constexpr size_t WS_KG = WS_R1 + 64 * MiB;
constexpr size_t WS_AM = 420 * MiB;
constexpr size_t WS_DEC = 428 * MiB;

__device__ __forceinline__ void prep_gla(LAS unsigned char* lds, PPTR p) {
    const int tid = tidx(), w = tid >> 6, lane = tid & 63, n = lane & 15, kg = lane >> 4;
    LAS unsigned char* qs = lds + w * 8704; LAS unsigned char* ks = qs + 4352;
    const bf16_t* P = (const bf16_t*)(p->ws + WS_PROJ);
    bf16_t* Qg = (bf16_t*)(p->ws + WS_R1); bf16_t* Kg = (bf16_t*)(p->ws + WS_KG);
    bf16_t* Amg = (bf16_t*)(p->ws + WS_AM); float* Decg = (float*)(p->ws + WS_DEC);
    const float* lbp = (const float*)(p->ws + WS_MISC) + 4 * 4 * 6144;
    for (int task = bidx() * 8 + w; task < 4 * 512 * 8; task += gdim() * 8) {
        const int h = task & 7, rc = task >> 3; const size_t row0 = (size_t)rc * 16;
        const float lb0 = lbp[h * 128 + 2 * lane], lb1 = lbp[h * 128 + 2 * lane + 1];
        unsigned xq[16], xf[16];
#pragma unroll
        for (int t = 0; t < 16; ++t) { const bf16_t* rowp = P + (row0 + t) * 4096 + h * 128 + 2 * lane; xq[t] = *(const unsigned*)rowp; xf[t] = *(const unsigned*)(rowp + 1024); }
        float bc0 = 0.f, bc1 = 0.f; float kk0[16], kk1[16], bs0[16], bs1[16];
#pragma unroll
        for (int t = 0; t < 16; ++t) {
            const float q0 = siluf_(bflo(xq[t])), q1 = siluf_(bfhi(xq[t]));
            const float f0 = lb0 + (1.0f - lb0) * sigmoidf_(bflo(xf[t])), f1 = lb1 + (1.0f - lb1) * sigmoidf_(bfhi(xf[t]));
            bc0 += __logf(f0); bc1 += __logf(f1);
            kk0[t] = 1.0f - f0; kk1[t] = 1.0f - f1; bs0[t] = bc0; bs1[t] = bc1;
            const unsigned qp = pack2(q0 * __expf(bc0), q1 * __expf(bc1));
            *(unsigned*)(Qg + (row0 + t) * 1024 + h * 128 + 2 * lane) = qp;
            *(LAS unsigned*)(qs + t * 272 + 4 * lane) = qp;
        }
#pragma unroll
        for (int t = 0; t < 16; ++t) {
            *(unsigned*)(Kg + (row0 + t) * 1024 + h * 128 + 2 * lane) = pack2(kk0[t] * __expf(bc0 - bs0[t]), kk1[t] * __expf(bc1 - bs1[t]));
            *(LAS unsigned*)(ks + t * 272 + 4 * lane) = pack2(kk0[t] * __expf(-bs0[t]), kk1[t] * __expf(-bs1[t]));
        }
        *(f32x2*)(Decg + (size_t)task * 128 + 2 * lane) = (f32x2){__expf(bc0), __expf(bc1)};
        asm volatile("s_waitcnt lgkmcnt(0)" ::: "memory");
        f32x4 acc = (f32x4){0.f, 0.f, 0.f, 0.f};
#pragma unroll
        for (int a = 0; a < 4; ++a) {
            const bf16x8 af = *(LAS const bf16x8*)(qs + n * 272 + (32 * a + 8 * kg) * 2);
            const bf16x8 bfr = *(LAS const bf16x8*)(ks + n * 272 + (32 * a + 8 * kg) * 2);
            acc = __builtin_amdgcn_mfma_f32_16x16x32_bf16(af, bfr, acc, 0, 0, 0);
        }
#pragma unroll
        for (int jj = 0; jj < 4; ++jj) { const int t = 4 * kg + jj; Amg[(size_t)task * 256 + t * 16 + n] = (bf16_t)f2bf(n <= t ? acc[jj] : 0.f); }
        asm volatile("s_waitcnt lgkmcnt(0)" ::: "memory");
    }
}

__device__ __forceinline__ void scan_gla(LAS unsigned char* lds, PPTR p) {
    constexpr int QOFF = 0, KTOFF = 4352, VOFF = 9472, AMOFF = 13824, DECOFF = 14336, BUFB = 14848;
    const int tid = tidx(), w = tid >> 6, lane = tid & 63, n = lane & 15, kg = lane >> 4;
    const bf16_t* P = (const bf16_t*)(p->ws + WS_PROJ);
    bf16_t* Qg = (bf16_t*)(p->ws + WS_R1); const bf16_t* Kg = (const bf16_t*)(p->ws + WS_KG);
    const bf16_t* Amg = (const bf16_t*)(p->ws + WS_AM); const float* Decg = (const float*)(p->ws + WS_DEC);
    bf16_t* Og = (bf16_t*)(p->ws + WS_OC);
    const bf16x4 z4 = (bf16x4){0, 0, 0, 0};
    for (int task = bidx(); task < 32; task += gdim()) {
        const int b = task >> 3, h = task & 7; const size_t rowbase = (size_t)b * SEQ;
        f32x4 S[8]; bf16x8 Sb[4];
#pragma unroll
        for (int i = 0; i < 8; ++i) S[i] = (f32x4){0.f, 0.f, 0.f, 0.f};
#pragma unroll
        for (int a = 0; a < 4; ++a) Sb[a] = (bf16x8){0, 0, 0, 0, 0, 0, 0, 0};
        const int lt = (tid & 255) >> 4, pc = tid & 15;
        constexpr int PD = 8;
        u32x4 g0[PD], g1[PD];
#define GLA_LOAD(cc, sl) do { const int c_ = (cc); const size_t r_ = rowbase + (size_t)c_ * 16 + lt; \
            if (tid < 256) { g0[sl] = *(const u32x4*)(Qg + r_ * 1024 + h * 128 + 8 * pc); g1[sl] = *(const u32x4*)(P + r_ * 4096 + 2048 + h * 128 + 8 * pc); } \
            else { g0[sl] = *(const u32x4*)(Kg + r_ * 1024 + h * 128 + 8 * pc); const size_t ch_ = ((size_t)(b * 512 + c_) * 8 + h); \
                if (tid < 288) g1[sl] = *(const u32x4*)(Amg + ch_ * 256 + (tid - 256) * 8); else if (tid < 320) g1[sl] = *(const u32x4*)(Decg + ch_ * 128 + (tid - 288) * 4); } } while (0)
#define GLA_STORE(cc, sl) do { LAS unsigned char* bb_ = lds + ((cc) & 1) * BUFB; \
            if (tid < 256) { *(LAS u32x4*)(bb_ + QOFF + lt * 272 + 16 * pc) = g0[sl]; *(LAS u32x4*)(bb_ + VOFF + lt * 272 + 16 * pc) = g1[sl]; } \
            else { _Pragma("unroll") for (int e = 0; e < 4; ++e) { *(LAS unsigned short*)(bb_ + KTOFF + (8 * pc + 2 * e) * 40 + 2 * lt) = (unsigned short)(g0[sl][e] & 0xffffu); \
                    *(LAS unsigned short*)(bb_ + KTOFF + (8 * pc + 2 * e + 1) * 40 + 2 * lt) = (unsigned short)(g0[sl][e] >> 16); } \
                if (tid < 288) *(LAS u32x4*)(bb_ + AMOFF + (tid - 256) * 16) = g1[sl]; else if (tid < 320) *(LAS u32x4*)(bb_ + DECOFF + (tid - 288) * 16) = g1[sl]; } } while (0)
#pragma unroll
        for (int d = 0; d < PD; ++d) GLA_LOAD(d, d);
        GLA_STORE(0, 0); lds_barrier();
        for (int c0 = 0; c0 < 512; c0 += PD) {
#pragma unroll
          for (int d = 0; d < PD; ++d) {
            const int c = c0 + d;
            if (c + PD < 512) GLA_LOAD(c + PD, d);
            LAS const unsigned char* bb = lds + (c & 1) * BUFB;
            f32x4 Z = (f32x4){0.f, 0.f, 0.f, 0.f};
#pragma unroll
            for (int a = 0; a < 4; ++a) {
                const bf16x4 lo = *(LAS const bf16x4*)(bb + QOFF + n * 272 + (32 * a + 4 * kg) * 2), hi = *(LAS const bf16x4*)(bb + QOFF + n * 272 + (32 * a + 16 + 4 * kg) * 2);
                Z = __builtin_amdgcn_mfma_f32_16x16x32_bf16(cat4(lo, hi), Sb[a], Z, 0, 0, 0);
            }
            bf16x4 vb;
#pragma unroll
            for (int j = 0; j < 4; ++j) vb[j] = *(LAS const short*)(bb + VOFF + (4 * kg + j) * 272 + (16 * w + n) * 2);
            const bf16x8 Vb = cat4(vb, z4);
            const bf16x4 am = *(LAS const bf16x4*)(bb + AMOFF + n * 32 + 8 * kg);
            const f32x4 o = __builtin_amdgcn_mfma_f32_16x16x32_bf16(cat4(am, z4), Vb, Z, 0, 0, 0);
#pragma unroll
            for (int i = 0; i < 8; ++i) {
                const f32x4 d4 = *(LAS const f32x4*)(bb + DECOFF + (16 * i + 4 * kg) * 4);
                const bf16x4 kt = *(LAS const bf16x4*)(bb + KTOFF + (16 * i + n) * 40 + 8 * kg);
                S[i] = __builtin_amdgcn_mfma_f32_16x16x32_bf16(cat4(kt, z4), Vb, S[i] * d4, 0, 0, 0);
            }
#pragma unroll
            for (int a = 0; a < 4; ++a) Sb[a] = cat4(cvt4(S[2 * a]), cvt4(S[2 * a + 1]));
#pragma unroll
            for (int j = 0; j < 4; ++j) Og[(rowbase + (size_t)c * 16 + 4 * kg + j) * 1024 + h * 128 + 16 * w + n] = (bf16_t)f2bf(o[j]);
            if (c + 1 < 512) GLA_STORE(c + 1, (d + 1) % PD);
            lds_barrier();
          }
        }
#undef GLA_LOAD
#undef GLA_STORE
    }
}


template <int SGN>
__device__ __forceinline__ void tri_inv16(LAS const float* Lm, int n, float (&x)[16]) {
    x[0] = (n == 0) ? 1.f : 0.f;
    {
        f32x4 la[12];
#pragma unroll
        for (int t = 1; t <= 4; ++t) la[t - 1] = *(LAS const f32x4*)(Lm + t * 16);
#pragma unroll
        for (int t = 5; t <= 8; ++t) { la[4 + 2 * (t - 5)] = *(LAS const f32x4*)(Lm + t * 16); la[5 + 2 * (t - 5)] = *(LAS const f32x4*)(Lm + t * 16 + 4); }
        __builtin_amdgcn_sched_barrier(0);
#pragma unroll
        for (int t = 1; t <= 8; ++t) { float acc = (n == t) ? 1.f : 0.f;
#pragma unroll
            for (int q = 0; q < (t + 3) / 4; ++q) { const f32x4 l4 = (t <= 4) ? la[t - 1] : la[4 + 2 * (t - 5) + q];
#pragma unroll
                for (int e = 0; e < 4; ++e) if (4 * q + e < t) acc += (float)SGN * l4[e] * x[4 * q + e]; }
            x[t] = acc; }
    }
    __builtin_amdgcn_sched_barrier(0);
    {   f32x4 lb[12];
#pragma unroll
        for (int t = 9; t <= 12; ++t)
#pragma unroll
            for (int q = 0; q < 3; ++q) lb[3 * (t - 9) + q] = *(LAS const f32x4*)(Lm + t * 16 + 4 * q);
        __builtin_amdgcn_sched_barrier(0);
#pragma unroll
        for (int t = 9; t <= 12; ++t) { float acc = (n == t) ? 1.f : 0.f;
#pragma unroll
            for (int q = 0; q < 3; ++q) { const f32x4 l4 = lb[3 * (t - 9) + q];
#pragma unroll
                for (int e = 0; e < 4; ++e) if (4 * q + e < t) acc += (float)SGN * l4[e] * x[4 * q + e]; }
            x[t] = acc; }
    }
    __builtin_amdgcn_sched_barrier(0);
    {   f32x4 lc[12];
#pragma unroll
        for (int t = 13; t <= 15; ++t)
#pragma unroll
            for (int q = 0; q < 4; ++q) lc[4 * (t - 13) + q] = *(LAS const f32x4*)(Lm + t * 16 + 4 * q);
        __builtin_amdgcn_sched_barrier(0);
#pragma unroll
        for (int t = 13; t <= 15; ++t) { float acc = (n == t) ? 1.f : 0.f;
#pragma unroll
            for (int q = 0; q < 4; ++q) { const f32x4 l4 = lc[4 * (t - 13) + q];
#pragma unroll
                for (int e = 0; e < 4; ++e) if (4 * q + e < t) acc += (float)SGN * l4[e] * x[4 * q + e]; }
            x[t] = acc; }
    }
}

constexpr size_t WS_TA = 436 * MiB;
constexpr size_t WS_AMA = 444 * MiB;
constexpr size_t WS_SCA = 452 * MiB;

__device__ __forceinline__ void prep_delta(LAS unsigned char* lds, PPTR p, int j) {
    const int tid = tidx(), w = tid >> 6, lane = tid & 63, n = lane & 15, kg = lane >> 4;
    LAS unsigned char* qs = lds + w * 9984; LAS unsigned char* ks = qs + 4352; LAS float* Lm = (LAS float*)(ks + 4352); LAS float* sc = Lm + 256;
    const bf16_t* P = (const bf16_t*)(p->ws + WS_PROJ);
    bf16_t* Qg = (bf16_t*)(p->ws + WS_R1); bf16_t* Kg = (bf16_t*)(p->ws + WS_KG);
    bf16_t* Tg = (bf16_t*)(p->ws + WS_TA); bf16_t* Amg = (bf16_t*)(p->ws + WS_AMA); float* Scg = (float*)(p->ws + WS_SCA);
    const float* cv = p->in[6] + (size_t)j * 4 * 3072;
    for (int task = bidx() * 8 + w; task < 4 * 512 * 8; task += gdim() * 8) {
        const int h = task & 7, rc = task >> 3; const size_t row0 = (size_t)rc * 16; const int t0 = (rc & 511) * 16;
        float cwq[4][2], cwk[4][2];
#pragma unroll
        for (int jj = 0; jj < 4; ++jj) { cwq[jj][0] = cv[jj * 3072 + h * 128 + 2 * lane]; cwq[jj][1] = cv[jj * 3072 + h * 128 + 2 * lane + 1];
            cwk[jj][0] = cv[jj * 3072 + 1024 + h * 128 + 2 * lane]; cwk[jj][1] = cv[jj * 3072 + 1024 + h * 128 + 2 * lane + 1]; }
        unsigned xq[19], xk[19];
#pragma unroll
        for (int r = 0; r < 19; ++r) { const bool valid = (t0 + r - 3) >= 0; const bf16_t* rowp = P + (row0 + (valid ? r - 3 : 0)) * 4352 + h * 128 + 2 * lane;
            const unsigned vq = *(const unsigned*)rowp, vk = *(const unsigned*)(rowp + 1024); xq[r] = valid ? vq : 0u; xk[r] = valid ? vk : 0u; }
        float beta, G;
        { const bf16_t* rowp = P + (row0 + n) * 4352; const float a_raw = bf2f(rowp[4096 + h]), b_raw = bf2f(rowp[4104 + h]);
          beta = sigmoidf_(b_raw); G = -__expf(p->in[7][j * 8 + h]) * softplusf_(a_raw + p->in[8][j * 8 + h]);
          float tq; tq = __int_as_float(__builtin_amdgcn_update_dpp(0, __float_as_int(G), 0x111, 0xf, 0xf, true)); G += tq;
          tq = __int_as_float(__builtin_amdgcn_update_dpp(0, __float_as_int(G), 0x112, 0xf, 0xf, true)); G += tq;
          tq = __int_as_float(__builtin_amdgcn_update_dpp(0, __float_as_int(G), 0x114, 0xf, 0xf, true)); G += tq;
          tq = __int_as_float(__builtin_amdgcn_update_dpp(0, __float_as_int(G), 0x118, 0xf, 0xf, true)); G += tq; }
        const float G15 = __int_as_float(__builtin_amdgcn_readlane(__float_as_int(G), 15));
        if (lane < 16) { sc[lane] = beta; sc[16 + lane] = G;
            float* so = Scg + (size_t)task * 64; so[lane] = beta; so[16 + lane] = __expf(G); so[32 + lane] = __expf(G15 - G); if (lane == 0) so[48] = __expf(G15); }
#pragma unroll
        for (int t = 0; t < 16; ++t) {
            float yq0 = 0.f, yq1 = 0.f, yk0 = 0.f, yk1 = 0.f;
#pragma unroll
            for (int jj = 0; jj < 4; ++jj) { yq0 += cwq[jj][0] * bflo(xq[t + jj]); yq1 += cwq[jj][1] * bfhi(xq[t + jj]); yk0 += cwk[jj][0] * bflo(xk[t + jj]); yk1 += cwk[jj][1] * bfhi(xk[t + jj]); }
            yq0 = siluf_(yq0); yq1 = siluf_(yq1); yk0 = siluf_(yk0); yk1 = siluf_(yk1);
            const float ssq = wave_allsum(yq0 * yq0 + yq1 * yq1), ssk = wave_allsum(yk0 * yk0 + yk1 * yk1);
            const float rq = __builtin_amdgcn_rsqf(ssq + 1e-6f) * 0.08838834764831845f, rk = __builtin_amdgcn_rsqf(ssk + 1e-6f);
            const unsigned qp = pack2(yq0 * rq, yq1 * rq), kp = pack2(yk0 * rk, yk1 * rk);
            *(unsigned*)(Qg + (row0 + t) * 1024 + h * 128 + 2 * lane) = qp; *(unsigned*)(Kg + (row0 + t) * 1024 + h * 128 + 2 * lane) = kp;
            *(LAS unsigned*)(qs + t * 272 + 4 * lane) = qp; *(LAS unsigned*)(ks + t * 272 + 4 * lane) = kp;
        }
        asm volatile("s_waitcnt lgkmcnt(0)" ::: "memory");
        f32x4 akk = (f32x4){0.f, 0.f, 0.f, 0.f}, aqk = akk;
#pragma unroll
        for (int a = 0; a < 4; ++a) {
            const bf16x8 qf = *(LAS const bf16x8*)(qs + n * 272 + (32 * a + 8 * kg) * 2);
            const bf16x8 kf = *(LAS const bf16x8*)(ks + n * 272 + (32 * a + 8 * kg) * 2);
            akk = __builtin_amdgcn_mfma_f32_16x16x32_bf16(kf, kf, akk, 0, 0, 0);
            aqk = __builtin_amdgcn_mfma_f32_16x16x32_bf16(qf, kf, aqk, 0, 0, 0);
        }
        { const float Gn = sc[16 + n]; const f32x4 bt = *(LAS const f32x4*)(sc + 4 * kg), Gt = *(LAS const f32x4*)(sc + 16 + 4 * kg);
#pragma unroll
          for (int jj = 0; jj < 4; ++jj) { const int t = 4 * kg + jj; const float dec = __expf(Gt[jj] - Gn);
              Lm[t * 16 + n] = (n < t) ? bt[jj] * akk[jj] * dec : 0.f;
              Amg[(size_t)task * 256 + t * 16 + n] = (bf16_t)f2bf(n <= t ? aqk[jj] * dec : 0.f); } }
        asm volatile("s_waitcnt lgkmcnt(0)" ::: "memory");
        float x[16];
        tri_inv16<-1>(Lm, n, x);
#pragma unroll
        for (int jj = 0; jj < 4; ++jj) { const float v = (kg == 0) ? x[jj] : (kg == 1 ? x[4 + jj] : (kg == 2 ? x[8 + jj] : x[12 + jj]));
            Tg[(size_t)task * 256 + (4 * kg + jj) * 16 + n] = (bf16_t)f2bf(v); }
        asm volatile("s_waitcnt lgkmcnt(0)" ::: "memory");
    }
}

__device__ __forceinline__ void scan_delta(LAS unsigned char* lds, PPTR p, int j) {
    constexpr int QOFF = 0, KOFF = 4352, KTOFF = 8704, VOFF = 13824, TOFF = 18992, AMOFF = 19504, SCOFF = 20016, BUFB = 20272;
    const int tid = tidx(), w = tid >> 6, lane = tid & 63, n = lane & 15, kg = lane >> 4;
    const bf16_t* P = (const bf16_t*)(p->ws + WS_PROJ);
    bf16_t* Qg = (bf16_t*)(p->ws + WS_R1); const bf16_t* Kg = (const bf16_t*)(p->ws + WS_KG);
    const bf16_t* Tg = (const bf16_t*)(p->ws + WS_TA); const bf16_t* Amg = (const bf16_t*)(p->ws + WS_AMA); const float* Scg = (const float*)(p->ws + WS_SCA);
    const float* cv = p->in[6] + (size_t)j * 4 * 3072;
    const bf16x4 z4 = (bf16x4){0, 0, 0, 0};
    for (int task = bidx(); task < 32; task += gdim()) {
        const int b = task >> 3, h = task & 7; const size_t rowbase = (size_t)b * SEQ;
        float cwv[4];
#pragma unroll
        for (int jj = 0; jj < 4; ++jj) cwv[jj] = cv[jj * 3072 + 2048 + h * 128 + 16 * w + n];
        f32x4 S[8]; bf16x8 Sb[4];
#pragma unroll
        for (int i = 0; i < 8; ++i) S[i] = (f32x4){0.f, 0.f, 0.f, 0.f};
#pragma unroll
        for (int a = 0; a < 4; ++a) Sb[a] = (bf16x8){0, 0, 0, 0, 0, 0, 0, 0};
        const int lt = (tid & 255) >> 4, pc = tid & 15, vr = tid >> 4;
        constexpr int PD = 8;
        u32x4 g0[PD], g1[PD];
#define DL_LOAD(cc, sl) do { const int c_ = (cc); const size_t r_ = rowbase + (size_t)c_ * 16 + lt; const size_t ch_ = ((size_t)(b * 512 + c_) * 8 + h); \
            if (tid < 256) g0[sl] = *(const u32x4*)(Qg + r_ * 1024 + h * 128 + 8 * pc); else g0[sl] = *(const u32x4*)(Kg + r_ * 1024 + h * 128 + 8 * pc); \
            if (tid < 304) { const int tv_ = c_ * 16 + vr - 3; const u32x4 vv_ = *(const u32x4*)(P + (rowbase + (tv_ >= 0 ? tv_ : 0)) * 4352 + 2048 + h * 128 + 8 * pc); g1[sl] = (tv_ >= 0) ? vv_ : (u32x4){0u, 0u, 0u, 0u}; } \
            else if (tid >= 320 && tid < 352) g1[sl] = *(const u32x4*)(Tg + ch_ * 256 + (tid - 320) * 8); \
            else if (tid >= 352 && tid < 384) g1[sl] = *(const u32x4*)(Amg + ch_ * 256 + (tid - 352) * 8); \
            else if (tid >= 384 && tid < 400) g1[sl] = *(const u32x4*)(Scg + ch_ * 64 + (tid - 384) * 4); } while (0)
#define DL_STORE(cc, sl) do { LAS unsigned char* bb_ = lds + ((cc) & 1) * BUFB; \
            if (tid < 256) *(LAS u32x4*)(bb_ + QOFF + lt * 272 + 16 * pc) = g0[sl]; \
            else { *(LAS u32x4*)(bb_ + KOFF + lt * 272 + 16 * pc) = g0[sl]; \
                _Pragma("unroll") for (int e = 0; e < 4; ++e) { *(LAS unsigned short*)(bb_ + KTOFF + (8 * pc + 2 * e) * 40 + 2 * lt) = (unsigned short)(g0[sl][e] & 0xffffu); \
                    *(LAS unsigned short*)(bb_ + KTOFF + (8 * pc + 2 * e + 1) * 40 + 2 * lt) = (unsigned short)(g0[sl][e] >> 16); } } \
            if (tid < 304) *(LAS u32x4*)(bb_ + VOFF + vr * 272 + 16 * pc) = g1[sl]; \
            else if (tid >= 320 && tid < 352) *(LAS u32x4*)(bb_ + TOFF + (tid - 320) * 16) = g1[sl]; \
            else if (tid >= 352 && tid < 384) *(LAS u32x4*)(bb_ + AMOFF + (tid - 352) * 16) = g1[sl]; \
            else if (tid >= 384 && tid < 400) *(LAS u32x4*)(bb_ + SCOFF + (tid - 384) * 16) = g1[sl]; } while (0)
#pragma unroll
        for (int d = 0; d < PD; ++d) DL_LOAD(d, d);
        DL_STORE(0, 0); lds_barrier();
        for (int c0 = 0; c0 < 512; c0 += PD) {
#pragma unroll
          for (int d = 0; d < PD; ++d) {
            const int c = c0 + d;
            if (c + PD < 512) DL_LOAD(c + PD, d);
            LAS const unsigned char* bb = lds + (c & 1) * BUFB;
            float vraw[7];
#pragma unroll
            for (int r = 0; r < 7; ++r) vraw[r] = bf2f(*(LAS const unsigned short*)(bb + VOFF + (4 * kg + r) * 272 + (16 * w + n) * 2));
            f32x4 v4;
#pragma unroll
            for (int jj = 0; jj < 4; ++jj) v4[jj] = siluf_(cwv[0] * vraw[jj] + cwv[1] * vraw[jj + 1] + cwv[2] * vraw[jj + 2] + cwv[3] * vraw[jj + 3]);
            f32x4 X = (f32x4){0.f, 0.f, 0.f, 0.f}, Z = X;
#pragma unroll
            for (int a = 0; a < 4; ++a) {
                const bf16x4 klo = *(LAS const bf16x4*)(bb + KOFF + n * 272 + (32 * a + 4 * kg) * 2), khi = *(LAS const bf16x4*)(bb + KOFF + n * 272 + (32 * a + 16 + 4 * kg) * 2);
                X = __builtin_amdgcn_mfma_f32_16x16x32_bf16(cat4(klo, khi), Sb[a], X, 0, 0, 0);
                const bf16x4 qlo = *(LAS const bf16x4*)(bb + QOFF + n * 272 + (32 * a + 4 * kg) * 2), qhi = *(LAS const bf16x4*)(bb + QOFF + n * 272 + (32 * a + 16 + 4 * kg) * 2);
                Z = __builtin_amdgcn_mfma_f32_16x16x32_bf16(cat4(qlo, qhi), Sb[a], Z, 0, 0, 0);
            }
            const f32x4 be4 = *(LAS const f32x4*)(bb + SCOFF + (4 * kg) * 4), eg4 = *(LAS const f32x4*)(bb + SCOFF + (16 + 4 * kg) * 4), egl4 = *(LAS const f32x4*)(bb + SCOFF + (32 + 4 * kg) * 4);
            const float glast = *(LAS const float*)(bb + SCOFF + 48 * 4);
            const f32x4 R = be4 * (v4 - eg4 * X);
            const bf16x4 tf = *(LAS const bf16x4*)(bb + TOFF + n * 32 + 8 * kg);
            const f32x4 vnew = __builtin_amdgcn_mfma_f32_16x16x32_bf16(cat4(tf, z4), cat4(cvt4(R), z4), (f32x4){0.f, 0.f, 0.f, 0.f}, 0, 0, 0);
            const bf16x4 am = *(LAS const bf16x4*)(bb + AMOFF + n * 32 + 8 * kg);
            const f32x4 o = __builtin_amdgcn_mfma_f32_16x16x32_bf16(cat4(am, z4), cat4(cvt4(vnew), z4), Z * eg4, 0, 0, 0);
            const bf16x8 B2 = cat4(cvt4(vnew * egl4), z4);
#pragma unroll
            for (int i = 0; i < 8; ++i) {
                const bf16x4 kt = *(LAS const bf16x4*)(bb + KTOFF + (16 * i + n) * 40 + 8 * kg);
                S[i] = __builtin_amdgcn_mfma_f32_16x16x32_bf16(cat4(kt, z4), B2, S[i] * glast, 0, 0, 0);
            }
#pragma unroll
            for (int a = 0; a < 4; ++a) Sb[a] = cat4(cvt4(S[2 * a]), cvt4(S[2 * a + 1]));
#pragma unroll
            for (int jj = 0; jj < 4; ++jj) Qg[(rowbase + (size_t)c * 16 + 4 * kg + jj) * 1024 + h * 128 + 16 * w + n] = (bf16_t)f2bf(o[jj]);
            if (c + 1 < 512) DL_STORE(c + 1, (d + 1) % PD);
            lds_barrier();
          }
        }
#undef DL_LOAD
#undef DL_STORE
    }
}


constexpr size_t WS_GCG = 500 * MiB;
constexpr size_t WS_BNG = 508 * MiB;
__device__ __forceinline__ void prep_rwkv_elem(PPTR p) {
    const int tid = tidx(), w = tid >> 6, lane = tid & 63;
    bf16_t* P = (bf16_t*)(p->ws + WS_PROJC); bf16_t* L2 = (bf16_t*)(p->ws + WS_R1);
    float* GCg = (float*)(p->ws + WS_GCG); float* BNg = (float*)(p->ws + WS_BNG);
    for (int task = bidx() * 8 + w; task < 4 * 512 * 16; task += gdim() * 8) {
        const int h = task & 15, rc = task >> 4; const size_t row0 = (size_t)rc * 16; const int ch = h * 64 + lane;
        const float w0v = p->in[17][ch], a0v = p->in[20][ch], kkc = p->in[25][ch], kac = p->in[26][ch], rkc = p->in[27][ch];
        unsigned xr[16], xk[16], xw[16], xa[16];
#pragma unroll
        for (int t = 0; t < 16; ++t) { const bf16_t* rowp = P + (row0 + t) * 3328 + ch; const bf16_t* l2p = L2 + (row0 + t) * 3072 + ch;
            xr[t] = rowp[0]; xk[t] = rowp[1024]; xw[t] = l2p[0]; xa[t] = l2p[1024]; }
        float lg = 0.f;
#pragma unroll
        for (int t = 0; t < 16; ++t) {
            const float r = bf2f(xr[t]), kraw = bf2f(xk[t]), whi = bf2f(xw[t]), ahi = bf2f(xa[t]);
            const float wv = -softplusf_(-(w0v + whi)) - 0.5f; const float ew = __expf(wv);
            const float lgp = lg; lg -= ew;
            const float ag = sigmoidf_(a0v + ahi);
            const float kkx = kraw * kkc; const float ss = wave_allsum(kkx * kkx); const float kk = kkx * __builtin_amdgcn_rsqf(ss + 1e-6f);
            const float kp = kraw * (1.0f + (ag - 1.0f) * kac);
            const float bonus = wave_allsum(r * kp * rkc);
            const float inv = __expf(-lg);
            bf16_t* rowp = P + (row0 + t) * 3328 + ch; bf16_t* l2p = L2 + (row0 + t) * 3072 + ch;
            rowp[0] = (bf16_t)f2bf(-kk * __expf(lgp)); rowp[1024] = (bf16_t)f2bf(r * __expf(lg));
            l2p[0] = (bf16_t)f2bf(kk * ag * inv); l2p[1024] = (bf16_t)f2bf(kp * inv);
            if (lane == 0) BNg[(row0 + t) * 16 + h] = bonus;
        }
        GCg[(size_t)task * 64 + lane] = __expf(lg);
    }
}

__device__ __forceinline__ void scan_rwkv(LAS unsigned char* lds, PPTR p) {
    constexpr int AH = 0, RH = 2304, BMT = 4608, KMT = 7168, TM = 9728, LAK = 10240, MRB = 10752, MRK = 11264, VV = 11776, GC = 14080, SLOT = 14336;
    constexpr int PRIV = 8 * SLOT, PRIVSZ = 5632;
    const int tid = tidx(), wave = tid >> 6, lane = tid & 63, n = lane & 15, kg = lane >> 4;
    const bf16_t* P = (const bf16_t*)(p->ws + WS_PROJC); const bf16_t* L2 = (const bf16_t*)(p->ws + WS_R1);
    bf16_t* Og = (bf16_t*)(p->ws + WS_OC);
    const int G = gdim(); const int vcu = (G % 8 == 0) ? (int)(bidx() % 8) * (G / 8) + (int)(bidx() / 8) : (int)bidx();
    for (int task = vcu; task < 256; task += G) {
        const int bh = task >> 2, slice = task & 3, b = bh >> 4, h = bh & 15; const size_t rowbase = (size_t)b * SEQ;
        const int pwr = (wave >= 1 && wave <= 3) ? wave - 1 : (wave == 5 ? 3 : -1);
        if (pwr >= 0) {
            const int pw = pwr; const int ch = h * 64 + lane;
            LAS unsigned char* bh = lds + PRIV + pw * PRIVSZ; LAS unsigned char* kh = bh + 2304; LAS float* Lm = (LAS float*)(kh + 2304);
            const float* GCg = (const float*)(p->ws + WS_GCG);
            unsigned xr[16], xk[16], xv[16], xw[16], xa[16]; float gCn;
#define RW_LOAD(cc, T0) do { _Pragma("unroll") for (int t = (T0); t < (T0) + 8; ++t) { const size_t r_ = rowbase + (size_t)(cc) * 16 + t; const bf16_t* rowp = P + r_ * 3328 + ch; const bf16_t* l2p = L2 + r_ * 3072 + ch; \
                xr[t] = rowp[0]; xk[t] = rowp[1024]; xv[t] = rowp[2048]; xw[t] = l2p[0]; xa[t] = l2p[1024]; } \
                if ((T0) == 8) gCn = GCg[((size_t)(b * 512 + (cc)) * 16 + h) * 64 + lane]; } while (0)
            RW_LOAD(pw, 0); RW_LOAD(pw, 8);
            for (int m = -1; m < 128; ++m) {
                const int cc = 4 * (m + 1) + pw;
                if (cc < 512) {
                    LAS unsigned char* sl = lds + (cc & 7) * SLOT;
                    const float gC = gCn; float bhat[16], khat[16];
#pragma unroll
                    for (int t = 0; t < 16; ++t) {
                        bhat[t] = bf2f(xw[t]); khat[t] = bf2f(xa[t]);
                        *(LAS unsigned short*)(sl + AH + t * 144 + 2 * lane) = (unsigned short)xr[t];
                        *(LAS unsigned short*)(sl + RH + t * 144 + 2 * lane) = (unsigned short)xk[t];
                        *(LAS unsigned short*)(bh + t * 144 + 2 * lane) = (unsigned short)xw[t];
                        *(LAS unsigned short*)(kh + t * 144 + 2 * lane) = (unsigned short)xa[t];
                        *(LAS unsigned short*)(sl + VV + t * 144 + 2 * lane) = (unsigned short)xv[t];
                    }
                    if (cc + 4 < 512) { RW_LOAD(cc + 4, 0); RW_LOAD(cc + 4, 8); }
                    *(LAS float*)(sl + GC + 4 * lane) = gC;
#pragma unroll
                    for (int q = 0; q < 4; ++q) {
                        u32x2 wb, wk; wb.x = pack2(bhat[4 * q] * gC, bhat[4 * q + 1] * gC); wb.y = pack2(bhat[4 * q + 2] * gC, bhat[4 * q + 3] * gC);
                        wk.x = pack2(khat[4 * q] * gC, khat[4 * q + 1] * gC); wk.y = pack2(khat[4 * q + 2] * gC, khat[4 * q + 3] * gC);
                        *(LAS u32x2*)(sl + BMT + lane * 40 + 8 * q) = wb; *(LAS u32x2*)(sl + KMT + lane * 40 + 8 * q) = wk;
                    }
                    asm volatile("s_waitcnt lgkmcnt(0)" ::: "memory");
                    f32x4 lab = (f32x4){0.f, 0.f, 0.f, 0.f}, lak = lab, mrb = lab, mrk = lab;
#pragma unroll
                    for (int a = 0; a < 2; ++a) {
                        const bf16x8 af = *(LAS const bf16x8*)(sl + AH + n * 144 + (32 * a + 8 * kg) * 2), rf = *(LAS const bf16x8*)(sl + RH + n * 144 + (32 * a + 8 * kg) * 2);
                        const bf16x8 bf_ = *(LAS const bf16x8*)(bh + n * 144 + (32 * a + 8 * kg) * 2), kf = *(LAS const bf16x8*)(kh + n * 144 + (32 * a + 8 * kg) * 2);
                        lab = __builtin_amdgcn_mfma_f32_16x16x32_bf16(af, bf_, lab, 0, 0, 0); lak = __builtin_amdgcn_mfma_f32_16x16x32_bf16(af, kf, lak, 0, 0, 0);
                        mrb = __builtin_amdgcn_mfma_f32_16x16x32_bf16(rf, bf_, mrb, 0, 0, 0); mrk = __builtin_amdgcn_mfma_f32_16x16x32_bf16(rf, kf, mrk, 0, 0, 0);
                    }
#pragma unroll
                    for (int jj = 0; jj < 4; ++jj) { const int t = 4 * kg + jj;
                        Lm[t * 16 + n] = (n < t) ? lab[jj] : 0.f;
                        *(LAS unsigned short*)(sl + LAK + t * 32 + 2 * n) = (unsigned short)f2bf(n < t ? lak[jj] : 0.f);
                        *(LAS unsigned short*)(sl + MRB + t * 32 + 2 * n) = (unsigned short)f2bf(n <= t ? mrb[jj] : 0.f);
                        *(LAS unsigned short*)(sl + MRK + t * 32 + 2 * n) = (unsigned short)f2bf(n <= t ? mrk[jj] : 0.f); }
                    asm volatile("s_waitcnt lgkmcnt(0)" ::: "memory");
                    float x[16];
                    tri_inv16<1>(Lm, n, x);
#pragma unroll
                    for (int jj = 0; jj < 4; ++jj) { const float v = (kg == 0) ? x[jj] : (kg == 1 ? x[4 + jj] : (kg == 2 ? x[8 + jj] : x[12 + jj]));
                        *(LAS unsigned short*)(sl + TM + (4 * kg + jj) * 32 + 2 * n) = (unsigned short)f2bf(v); }
                }
                lds_barrier();
            }
#undef RW_LOAD
        } else if (wave != 0) {
            for (int m = -1; m < 128; ++m) lds_barrier();
        } else {
            const int w = slice;
            f32x4 Zt[4]; bf16x8 Zb[2];
#pragma unroll
            for (int i = 0; i < 4; ++i) Zt[i] = (f32x4){0.f, 0.f, 0.f, 0.f};
            Zb[0] = (bf16x8){0, 0, 0, 0, 0, 0, 0, 0}; Zb[1] = Zb[0];
            struct RwOps { bf16x4 alo[2], ahi[2], rlo[2], rhi[2], vf, lakf, tf, mb, mk, bt[4], kt[4]; f32x4 g4[4]; };
#define RW_OPLOAD(R, cidx) do { LAS const unsigned char* sl_ = lds + ((cidx) & 7) * SLOT; \
                _Pragma("unroll") for (int a = 0; a < 2; ++a) { \
                    R.alo[a] = *(LAS const bf16x4*)(sl_ + AH + n * 144 + (32 * a + 4 * kg) * 2); R.ahi[a] = *(LAS const bf16x4*)(sl_ + AH + n * 144 + (32 * a + 16 + 4 * kg) * 2); \
                    R.rlo[a] = *(LAS const bf16x4*)(sl_ + RH + n * 144 + (32 * a + 4 * kg) * 2); R.rhi[a] = *(LAS const bf16x4*)(sl_ + RH + n * 144 + (32 * a + 16 + 4 * kg) * 2); } \
                _Pragma("unroll") for (int jj = 0; jj < 4; ++jj) R.vf[jj] = *(LAS const short*)(sl_ + VV + (4 * kg + jj) * 144 + (16 * w + n) * 2); \
                R.lakf = *(LAS const bf16x4*)(sl_ + LAK + n * 32 + 8 * kg); R.tf = *(LAS const bf16x4*)(sl_ + TM + n * 32 + 8 * kg); \
                R.mb = *(LAS const bf16x4*)(sl_ + MRB + n * 32 + 8 * kg); R.mk = *(LAS const bf16x4*)(sl_ + MRK + n * 32 + 8 * kg); \
                _Pragma("unroll") for (int i = 0; i < 4; ++i) { R.g4[i] = *(LAS const f32x4*)(sl_ + GC + (16 * i + 4 * kg) * 4); \
                    R.bt[i] = *(LAS const bf16x4*)(sl_ + BMT + (16 * i + n) * 40 + 8 * kg); R.kt[i] = *(LAS const bf16x4*)(sl_ + KMT + (16 * i + n) * 40 + 8 * kg); } } while (0)
#define RW_COMPUTE(R, cidx) do { \
                f32x4 P1 = (f32x4){0.f, 0.f, 0.f, 0.f}, Oa = P1; \
                _Pragma("unroll") for (int a = 0; a < 2; ++a) { P1 = __builtin_amdgcn_mfma_f32_16x16x32_bf16(cat4(R.alo[a], R.ahi[a]), Zb[a], P1, 0, 0, 0); \
                    Oa = __builtin_amdgcn_mfma_f32_16x16x32_bf16(cat4(R.rlo[a], R.rhi[a]), Zb[a], Oa, 0, 0, 0); } \
                P1 = __builtin_amdgcn_mfma_f32_16x16x32_bf16(cat4(R.lakf, z4), cat4(R.vf, z4), P1, 0, 0, 0); \
                const f32x4 Y = __builtin_amdgcn_mfma_f32_16x16x32_bf16(cat4(R.tf, z4), cat4(cvt4(P1), z4), (f32x4){0.f, 0.f, 0.f, 0.f}, 0, 0, 0); \
                const bf16x8 Byv = cat4(cvt4(Y), R.vf); \
                Oa = __builtin_amdgcn_mfma_f32_16x16x32_bf16(cat4(R.mb, R.mk), Byv, Oa, 0, 0, 0); \
                _Pragma("unroll") for (int i = 0; i < 4; ++i) Zt[i] = __builtin_amdgcn_mfma_f32_16x16x32_bf16(cat4(R.bt[i], R.kt[i]), Byv, Zt[i] * R.g4[i], 0, 0, 0); \
                Zb[0] = cat4(cvt4(Zt[0]), cvt4(Zt[1])); Zb[1] = cat4(cvt4(Zt[2]), cvt4(Zt[3])); \
                _Pragma("unroll") for (int jj = 0; jj < 4; ++jj) Og[(rowbase + (size_t)(cidx) * 16 + 4 * kg + jj) * 1024 + h * 64 + 16 * w + n] = (bf16_t)f2bf(Oa[jj]); } while (0)
            const bf16x4 z4 = (bf16x4){0, 0, 0, 0};
            lds_barrier();
            for (int m = 0; m < 128; ++m) {
                RwOps OA, OB;
                RW_OPLOAD(OA, 4 * m);
                RW_OPLOAD(OB, 4 * m + 1); __builtin_amdgcn_sched_barrier(0);
                RW_COMPUTE(OA, 4 * m); __builtin_amdgcn_sched_barrier(0);
                RW_OPLOAD(OA, 4 * m + 2); __builtin_amdgcn_sched_barrier(0);
                RW_COMPUTE(OB, 4 * m + 1); __builtin_amdgcn_sched_barrier(0);
                RW_OPLOAD(OB, 4 * m + 3); __builtin_amdgcn_sched_barrier(0);
                RW_COMPUTE(OA, 4 * m + 2); __builtin_amdgcn_sched_barrier(0);
                RW_COMPUTE(OB, 4 * m + 3);
                lds_barrier();
            }
#undef RW_OPLOAD
#undef RW_COMPUTE
        }
    }
}


template <int KIND>
__device__ __forceinline__ void scan_chunked(LAS unsigned char* lds, PPTR p, int j) {
    constexpr int QOFF = 0, KOFF = 4352, KTOFF = 8704, VOFF = 13824, TOFF = 14464, AMOFF = 14976, SCOFF = 15488, OBOFF = 16000, BUFB = 17024;
    constexpr int LDP = (KIND == 0) ? 4352 : 4096;
    constexpr int VROWS = (KIND == 0) ? 19 : 16, VEND = 512 + 2 * VROWS;
    constexpr int TEND = (KIND == 0) ? VEND + 32 : VEND, AEND = TEND + 32, SEND = AEND + ((KIND == 0) ? 16 : 32);
    const int tid = tidx(), wave = tid >> 6, lane = tid & 63, n = lane & 15, kg = lane >> 4;
    const bf16_t* P = (const bf16_t*)(p->ws + WS_PROJ);
    const bf16_t* Qg = (const bf16_t*)(p->ws + WS_R1); const bf16_t* Kg = (const bf16_t*)(p->ws + WS_KG);
    const bf16_t* Tg = (const bf16_t*)(p->ws + WS_TA);
    const bf16_t* Amg = (const bf16_t*)(p->ws + (KIND == 0 ? WS_AMA : WS_AM));
    const float* Scg = (const float*)(p->ws + (KIND == 0 ? WS_SCA : WS_DEC));
    bf16_t* Og = (KIND == 0) ? (bf16_t*)(p->ws + WS_PROJ) : (bf16_t*)(p->ws + WS_OC);
    constexpr int LDO = (KIND == 0) ? 4352 : 1024;
    const bf16x4 z4 = (bf16x4){0, 0, 0, 0};
    const int G = gdim(); const int vcu = (G % 8 == 0) ? (int)(bidx() % 8) * (G / 8) + (int)(bidx() / 8) : (int)bidx();
    for (int task = vcu; task < 256; task += G) {
        const int bh = task >> 3, w = task & 7, b = bh >> 3, h = bh & 7; const size_t rowbase = (size_t)b * SEQ;
        if (wave == 0) {
            float cwv[4] = {0.f, 0.f, 0.f, 0.f};
            if (KIND == 0) { const float* cv = p->in[6] + (size_t)j * 4 * 3072;
#pragma unroll
                for (int jj = 0; jj < 4; ++jj) cwv[jj] = cv[jj * 3072 + 2048 + h * 128 + 16 * w + n]; }
            f32x4 S[8]; bf16x8 Sb[4];
#pragma unroll
            for (int i = 0; i < 8; ++i) S[i] = (f32x4){0.f, 0.f, 0.f, 0.f};
#pragma unroll
            for (int a = 0; a < 4; ++a) Sb[a] = (bf16x8){0, 0, 0, 0, 0, 0, 0, 0};
            lds_barrier();
            for (int c2 = 0; c2 < 512; c2 += 4) {
#pragma unroll 1
              for (int u = 0; u < 4; ++u) { const int c = c2 + u;
                LAS unsigned char* bb = lds + (c & 7) * BUFB;
                bf16x4 klo[4], khi[4], qlo[4], qhi[4], kt[8], am, tf = z4; f32x4 be4, eg4, egl4, d4[8]; float glast = 0.f; unsigned vr16[7]; bf16x4 vb = z4;
#pragma unroll
                for (int a = 0; a < 4; ++a) {
                    if (KIND == 0) { klo[a] = *(LAS const bf16x4*)(bb + KOFF + n * 272 + (32 * a + 4 * kg) * 2); khi[a] = *(LAS const bf16x4*)(bb + KOFF + n * 272 + (32 * a + 16 + 4 * kg) * 2); }
                    qlo[a] = *(LAS const bf16x4*)(bb + QOFF + n * 272 + (32 * a + 4 * kg) * 2); qhi[a] = *(LAS const bf16x4*)(bb + QOFF + n * 272 + (32 * a + 16 + 4 * kg) * 2); }
                if (KIND == 0) {
#pragma unroll
                    for (int r = 0; r < 7; ++r) vr16[r] = *(LAS const unsigned short*)(bb + VOFF + (4 * kg + r) * 32 + 2 * n);
                    be4 = *(LAS const f32x4*)(bb + SCOFF + (4 * kg) * 4); eg4 = *(LAS const f32x4*)(bb + SCOFF + (16 + 4 * kg) * 4); egl4 = *(LAS const f32x4*)(bb + SCOFF + (32 + 4 * kg) * 4);
                    glast = *(LAS const float*)(bb + SCOFF + 48 * 4); tf = *(LAS const bf16x4*)(bb + TOFF + n * 32 + 8 * kg);
                } else {
#pragma unroll
                    for (int jj = 0; jj < 4; ++jj) vb[jj] = *(LAS const short*)(bb + VOFF + (4 * kg + jj) * 32 + 2 * n);
#pragma unroll
                    for (int i = 0; i < 8; ++i) d4[i] = *(LAS const f32x4*)(bb + SCOFF + (16 * i + 4 * kg) * 4);
                }
                am = *(LAS const bf16x4*)(bb + AMOFF + n * 32 + 8 * kg);
#pragma unroll
                for (int i = 0; i < 8; ++i) kt[i] = *(LAS const bf16x4*)(bb + KTOFF + (16 * i + n) * 40 + 8 * kg);
                __builtin_amdgcn_sched_barrier(0);
                asm volatile("s_waitcnt lgkmcnt(0)" ::: "memory");
                __builtin_amdgcn_sched_barrier(0);
                f32x4 v4 = (f32x4){0.f, 0.f, 0.f, 0.f};
                if (KIND == 0) {
#pragma unroll
                    for (int jj = 0; jj < 4; ++jj) v4[jj] = siluf_(cwv[0] * bf2f(vr16[jj]) + cwv[1] * bf2f(vr16[jj + 1]) + cwv[2] * bf2f(vr16[jj + 2]) + cwv[3] * bf2f(vr16[jj + 3]));
                }
                f32x4 X = (f32x4){0.f, 0.f, 0.f, 0.f}, Z = X;
#pragma unroll
                for (int a = 0; a < 4; ++a) {
                    if (KIND == 0) X = __builtin_amdgcn_mfma_f32_16x16x32_bf16(cat4(klo[a], khi[a]), Sb[a], X, 0, 0, 0);
                    Z = __builtin_amdgcn_mfma_f32_16x16x32_bf16(cat4(qlo[a], qhi[a]), Sb[a], Z, 0, 0, 0);
                }
                f32x4 o; bf16x8 B2;
                if (KIND == 0) {
                    const f32x4 R = be4 * (v4 - eg4 * X);
                    const f32x4 vnew = __builtin_amdgcn_mfma_f32_16x16x32_bf16(cat4(tf, z4), cat4(cvt4(R), z4), (f32x4){0.f, 0.f, 0.f, 0.f}, 0, 0, 0);
                    o = __builtin_amdgcn_mfma_f32_16x16x32_bf16(cat4(am, z4), cat4(cvt4(vnew), z4), Z * eg4, 0, 0, 0);
                    B2 = cat4(cvt4(vnew * egl4), z4);
#pragma unroll
                    for (int i = 0; i < 8; ++i) S[i] = __builtin_amdgcn_mfma_f32_16x16x32_bf16(cat4(kt[i], z4), B2, S[i] * glast, 0, 0, 0);
                } else {
                    B2 = cat4(vb, z4);
                    o = __builtin_amdgcn_mfma_f32_16x16x32_bf16(cat4(am, z4), B2, Z, 0, 0, 0);
#pragma unroll
                    for (int i = 0; i < 8; ++i) S[i] = __builtin_amdgcn_mfma_f32_16x16x32_bf16(cat4(kt[i], z4), B2, S[i] * d4[i], 0, 0, 0);
                }
                *(LAS f32x4*)(bb + OBOFF + lane * 16) = o;
#pragma unroll
                for (int a = 0; a < 4; ++a) Sb[a] = cat4(cvt4(S[2 * a]), cvt4(S[2 * a + 1]));
              }
                lds_barrier();
            }
            lds_barrier();
        } else {
            const int lt = tid - 64, pb = lt + 448;
            const int arow = (lt & 255) >> 4, apc = lt & 15;
            const bf16_t* srcA = (lt < 256 ? Qg : Kg) + (rowbase + arow) * 1024 + h * 128 + 8 * apc;
            const char* srcB; size_t strideB; int kindB;
            if (pb < 512) { kindB = 0; srcB = (const char*)(Kg + (rowbase + ((pb - 256) >> 4)) * 1024 + h * 128 + 8 * (pb & 15)); strideB = (size_t)16 * 1024 * 2; }
            else if (pb < VEND) { kindB = 1; const int vr_ = (pb - 512) >> 1, hf_ = (pb - 512) & 1; srcB = (const char*)(P + (rowbase + vr_) * LDP + 2048 + h * 128 + 16 * w + 8 * hf_); strideB = (size_t)16 * LDP * 2; }
            else if (pb < TEND) { kindB = 2; srcB = (const char*)(Tg + ((size_t)(b * 512) * 8 + h) * 256 + (pb - VEND) * 8); strideB = (size_t)8 * 256 * 2; }
            else if (pb < AEND) { kindB = 3; srcB = (const char*)(Amg + ((size_t)(b * 512) * 8 + h) * 256 + (pb - TEND) * 8); strideB = (size_t)8 * 256 * 2; }
            else if (pb < SEND) { kindB = 4; srcB = (const char*)(Scg + ((size_t)(b * 512) * 8 + h) * (KIND == 0 ? 64 : 128) + (pb - AEND) * 4); strideB = (size_t)8 * (KIND == 0 ? 64 : 128) * 4; }
            else { kindB = 5; srcB = (const char*)srcA; strideB = (size_t)16 * 1024 * 2; }
            const int vrow = (pb - 512) >> 1;
            const bool doflush = (wave == 2);
            constexpr int PD = 8;
            u32x4 g0[PD], g1[PD];
#define SC_LOAD(cc, sl) do { const int c_ = (cc); g0[sl] = *(const u32x4*)(srcA + (size_t)c_ * 16 * 1024); \
                const int tv_ = c_ * 16 + vrow - 3; const bool vh_ = (KIND == 0) && (kindB == 1); \
                const ptrdiff_t ofs_ = vh_ ? (ptrdiff_t)(tv_ >= 0 ? tv_ - vrow : -vrow) * (LDP * 2) : (ptrdiff_t)((size_t)c_ * strideB); \
                const u32x4 vv_ = *(const u32x4*)(srcB + ofs_); g1[sl] = (vh_ && tv_ < 0) ? (u32x4){0u, 0u, 0u, 0u} : vv_; } while (0)
#define SC_KSTORE(bb_, reg, row, pc) do { if (KIND == 0) *(LAS u32x4*)((bb_) + KOFF + (row) * 272 + 16 * (pc)) = (reg); \
                _Pragma("unroll") for (int e = 0; e < 4; ++e) { *(LAS unsigned short*)((bb_) + KTOFF + (8 * (pc) + 2 * e) * 40 + 2 * (row)) = (unsigned short)((reg)[e] & 0xffffu); \
                    *(LAS unsigned short*)((bb_) + KTOFF + (8 * (pc) + 2 * e + 1) * 40 + 2 * (row)) = (unsigned short)((reg)[e] >> 16); } } while (0)
#define SC_STORE(cc, sl) do { LAS unsigned char* bb_ = lds + ((cc) & 7) * BUFB; \
                if (lt < 256) *(LAS u32x4*)(bb_ + QOFF + arow * 272 + 16 * apc) = g0[sl]; else SC_KSTORE(bb_, g0[sl], arow, apc); \
                if (kindB == 0) SC_KSTORE(bb_, g1[sl], ((pb - 256) >> 4), (pb & 15)); \
                else if (kindB == 1) *(LAS u32x4*)(bb_ + VOFF + vrow * 32 + 16 * ((pb - 512) & 1)) = g1[sl]; \
                else if (kindB == 2) *(LAS u32x4*)(bb_ + TOFF + (pb - VEND) * 16) = g1[sl]; \
                else if (kindB == 3) *(LAS u32x4*)(bb_ + AMOFF + (pb - TEND) * 16) = g1[sl]; \
                else if (kindB == 4) *(LAS u32x4*)(bb_ + SCOFF + (pb - AEND) * 16) = g1[sl]; } while (0)
#define SC_OFLUSH(cc) do { const int c_ = (cc); const f32x4 o_ = *(LAS const f32x4*)(lds + (c_ & 7) * BUFB + OBOFF + lane * 16); \
                _Pragma("unroll") for (int jj = 0; jj < 4; ++jj) Og[(rowbase + (size_t)c_ * 16 + 4 * kg + jj) * LDO + h * 128 + 16 * w + n] = (bf16_t)f2bf(o_[jj]); } while (0)
#define SC_LOADER_LOOP(FLUSH) do { \
                _Pragma("unroll") for (int d = 0; d < PD; ++d) SC_LOAD(d, d); \
                SC_STORE(0, 0); SC_STORE(1, 1); SC_STORE(2, 2); SC_STORE(3, 3); \
                SC_LOAD(8, 0); SC_LOAD(9, 1); SC_LOAD(10, 2); SC_LOAD(11, 3); \
                lds_barrier(); \
                for (int c0 = 0; c0 < 512; c0 += PD) { \
                    _Pragma("unroll") for (int d = 0; d < PD; d += 4) { const int c = c0 + d; \
                        if (c + 4 < 512) { _Pragma("unroll") for (int u = 0; u < 4; ++u) SC_STORE(c + 4 + u, (d + 4 + u) % PD); } \
                        if (c + 12 < 512) { _Pragma("unroll") for (int u = 0; u < 4; ++u) SC_LOAD(c + 12 + u, (d + 4 + u) % PD); } \
                        if (FLUSH) { if (c > 0) { _Pragma("unroll") for (int u = 0; u < 4; ++u) SC_OFLUSH(c - 4 + u); } } \
                        lds_barrier(); } } \
                if (FLUSH) { _Pragma("unroll") for (int u = 0; u < 4; ++u) SC_OFLUSH(508 + u); } \
                lds_barrier(); } while (0)
            if (doflush) SC_LOADER_LOOP(true); else SC_LOADER_LOOP(false);
#undef SC_LOAD
#undef SC_KSTORE
#undef SC_STORE
#undef SC_OFLUSH
#undef SC_LOADER_LOOP
        }
    }
}

template <int KIND>
__device__ __forceinline__ void post_phase(PPTR p, int j) {
    const int lane = tidx() & 63, wave = tidx() >> 6;
    const int gw = bidx() * 8 + wave, nw = gdim() * 8;
    bf16_t* O = (bf16_t*)(p->ws + (KIND != 0 ? WS_OC : WS_PROJ));
    constexpr int LDO = (KIND == 0) ? 4352 : 1024;
    const bf16_t* P = (const bf16_t*)(p->ws + (KIND == 2 ? WS_PROJC : WS_PROJ));
    if (KIND != 2) {
        const float* nwp = (KIND == 0) ? p->in[9] + j * 128 : p->in[13];
        const float n0 = nwp[2 * lane], n1 = nwp[2 * lane + 1];
        constexpr int LDP = (KIND == 0) ? 4352 : 4096; constexpr int ZOFF = 3072;
        for (int row = gw; row < MROWS; row += nw) {
            unsigned ov[8], zv[8];
#pragma unroll
            for (int h = 0; h < 8; ++h) { ov[h] = *(const unsigned*)(O + (size_t)row * LDO + h * 128 + 2 * lane); zv[h] = *(const unsigned*)(P + (size_t)row * LDP + ZOFF + h * 128 + 2 * lane); }
#pragma unroll
            for (int h = 0; h < 8; ++h) {
                const float o0 = bflo(ov[h]), o1 = bfhi(ov[h]);
                const float ss = wave_allsum(o0 * o0 + o1 * o1); const float rstd = __builtin_amdgcn_rsqf(ss * (1.0f / 128.0f) + 1e-6f);
                *(unsigned*)(O + (size_t)row * LDO + h * 128 + 2 * lane) = pack2(o0 * rstd * n0 * siluf_(bflo(zv[h])), o1 * rstd * n1 * siluf_(bfhi(zv[h])));
            }
        }
    } else {
        const bf16_t* L2 = (const bf16_t*)(p->ws + WS_R1); const float* BNg = (const float*)(p->ws + WS_BNG);
        for (int task = gw; task < MROWS * 2; task += nw) {
            const int row = task >> 1, h0 = (task & 1) * 8;
            unsigned xy[8], xv[8], xg[8]; float bn[8];
#pragma unroll
            for (int hh = 0; hh < 8; ++hh) { const int ch = (h0 + hh) * 64 + lane; const bf16_t* rowp = P + (size_t)row * 3328; const bf16_t* l2p = L2 + (size_t)row * 3072;
                xy[hh] = O[(size_t)row * DM + ch]; xv[hh] = rowp[2048 + ch]; xg[hh] = l2p[2048 + ch]; bn[hh] = BNg[(size_t)row * 16 + h0 + hh]; }
#pragma unroll
            for (int hh = 0; hh < 8; ++hh) { const int ch = (h0 + hh) * 64 + lane;
                const float y = bf2f(xy[hh]);
                const float mean = wave_allsum(y) * (1.0f / 64.0f); const float dd = y - mean;
                const float var = wave_allsum(dd * dd) * (1.0f / 64.0f);
                const float gn = dd * __builtin_amdgcn_rsqf(var + 0.04096f) * p->in[28][ch] + p->in[29][ch];
                O[(size_t)row * DM + ch] = (bf16_t)f2bf((gn + bn[hh] * bf2f(xv[hh])) * bf2f(xg[hh]));
            }
        }
    }
}

#define XB_TMO      128
#define XB_XCNT(j)  (256  + 64 * (j))
#define XB_XSUB(j)  (1280 + 64 * (j))
#define XB_XGEN(j)  (2304 + 64 * (j))
#define XB_TOP      3328
#define XB_TOPGEN   3392
#define XCD_BAR_WORDS 3456
#define XB_SPIN_CAP (1u << 18)
constexpr size_t WS_BAR = WS_MISC + 1 * MiB;
__device__ __forceinline__ unsigned xb_ld(unsigned* p)              { return __hip_atomic_load(p, __ATOMIC_RELAXED, __HIP_MEMORY_SCOPE_AGENT); }
__device__ __forceinline__ unsigned xb_add(unsigned* p, unsigned v) { return __hip_atomic_fetch_add(p, v, __ATOMIC_RELAXED, __HIP_MEMORY_SCOPE_AGENT); }
__device__ __forceinline__ unsigned xb_xcc_id() { return (unsigned)__builtin_amdgcn_s_getreg((3 << 11) | 20) & 0xFu; }
#define XB_SPIN(cond, bar) do { unsigned _sp = 0; while (cond) { __builtin_amdgcn_s_sleep(1); \
    if ((++_sp & 255u) == 0u) { if (xb_ld(&(bar)[XB_TMO])) break; if (_sp > XB_SPIN_CAP) { atomicAdd(&(bar)[XB_TMO], 1u); break; } } } } while (0)
struct XcdBarrier { unsigned* bar; unsigned x; volatile LAS unsigned* st; };
__device__ __forceinline__ XcdBarrier xcd_barrier_post(unsigned* bar, volatile LAS unsigned* st) {
    XcdBarrier b; b.bar = bar; b.x = xb_xcc_id(); b.st = st;
    if (threadIdx.x == 0) (void)xb_add(&bar[XB_XCNT(b.x)], 1u);
    return b;
}
__device__ __forceinline__ void xcd_barrier_complete(unsigned* bar, unsigned x, unsigned& nloc, unsigned& nx) {
    const unsigned G = gridDim.x * gridDim.y * gridDim.z;
    unsigned sum, cnt, mine, sp = 0u;
    for (;;) {
        sum = 0u; cnt = 0u; mine = 0u;
#pragma unroll
        for (unsigned j = 0; j < 16; ++j) { const unsigned c = xb_ld(&bar[XB_XCNT(j)]); sum += c; cnt += (c > 0u) ? 1u : 0u; mine = (j == x) ? c : mine; }
        if (sum == G) break;
        __builtin_amdgcn_s_sleep(1);
        if ((++sp & 255u) == 0u) { if (xb_ld(&bar[XB_TMO])) break; if (sp > XB_SPIN_CAP) { atomicAdd(&bar[XB_TMO], 1u); break; } }
    }
    nloc = mine > 0u ? mine : 1u; nx = cnt > 0u ? cnt : 1u;
}
__device__ __forceinline__ void xcd_barrier(const XcdBarrier& b) {
    asm volatile("s_waitcnt vmcnt(0)" ::: "memory");
    __syncthreads();
    if (threadIdx.x == 0) {
        unsigned* bar = b.bar;
        __builtin_amdgcn_s_waitcnt(0);
        unsigned nloc = b.st[0], nx = b.st[1];
        if (nloc == 0u) { xcd_barrier_complete(bar, b.x, nloc, nx); b.st[0] = nloc; b.st[1] = nx; }
        const unsigned old = xb_add(&bar[XB_XSUB(b.x)], 1u);
        const unsigned gen = old / nloc;
        if (old + 1u == (gen + 1u) * nloc) {
            __builtin_amdgcn_fence(__ATOMIC_RELEASE, "agent");
            asm volatile("s_waitcnt vmcnt(0)" ::: "memory");
            const unsigned og = xb_add(&bar[XB_TOP], 1u);
            const unsigned tg = og / nx;
            if (og + 1u == (tg + 1u) * nx) xb_add(&bar[XB_TOPGEN], 1u);
            else XB_SPIN(xb_ld(&bar[XB_TOPGEN]) == tg, bar);
            __builtin_amdgcn_fence(__ATOMIC_ACQUIRE, "agent");
            xb_add(&bar[XB_XGEN(b.x)], 1u);
            asm volatile("s_waitcnt vmcnt(0)" ::: "memory");
        } else {
            XB_SPIN(xb_ld(&bar[XB_XGEN(b.x)]) == gen, bar);
            __builtin_amdgcn_fence(__ATOMIC_ACQUIRE, "agent");
            asm volatile("s_waitcnt vmcnt(0)" ::: "memory");
        }
    }
    __syncthreads();
}

constexpr int NPH = 54;
__host__ __device__ inline int step_of(int ph) { const int si = (ph - 1) % 13; return si < 3 ? si : (si == 3 ? 12 : si - 1); }
__host__ __device__ inline bool phase_is_noop(int ph) {
    if (ph == 0 || ph == NPH - 1) return false;
    const int l = (ph - 1) / 13, st = step_of(ph);
    return st == 12 && (l % 3) != 2;
}

__global__ void __launch_bounds__(512, 2) mega(const Params pv) {
    extern __shared__ __attribute__((aligned(16))) unsigned char shm[];
    PPTR p = &pv;
    LAS unsigned char* lds = (LAS unsigned char*)shm;
    cg::grid_group grid = cg::this_grid();
    volatile LAS unsigned* xb_st = (volatile LAS unsigned*)(lds + 147440);
    if (threadIdx.x == 0) { xb_st[0] = 0u; xb_st[1] = 0u; }
    __syncthreads();
    const XcdBarrier xb = xcd_barrier_post((unsigned*)(pv.ws + WS_BAR), xb_st);
    const int ph_lo = p->ph_lo, ph_hi = p->ph_hi;
    for (int ph = ph_lo; ph < ph_hi; ++ph) {
        if (phase_is_noop(ph)) continue;
        float* mod = (float*)(p->ws + WS_MISC);
        bf16_t* W = (bf16_t*)(p->ws + WS_W);
        if (ph == 0) { pre_phase(lds, p); __syncthreads(); cvt_layer(lds, p, 0); }
        else if (ph == NPH - 1) { if (PHMASK & 2) final_phase(p->out, p->in[35]); }
        else {
            const int l = (ph - 1) / 13, st = step_of(ph), kind = l % 3, j = l / 3;
            const float* hin = (l == 0) ? p->in[0] : p->out;
            const float* modl = mod + (size_t)l * 4 * 6144;
            bf16_t* R1 = (bf16_t*)(p->ws + WS_R1);
            for (int rep = 0; rep < 1 + (((REPMASK >> st) & 1) & ((REPL >> l) & 1)); ++rep) {
            if (rep) grid.sync();
            if (!(PHMASK & (4 << st))) {} else if (st == 0) {
                if (l > 0) cvt_layer(lds, p, l);
                if (kind == 2) norm_phase<true>(hin, p->in[2] + (size_t)(l * 2 + 0) * 1024, modl, 0, R1, 2048);
                else norm_phase<false>(hin, p->in[2] + (size_t)(l * 2 + 0) * 1024, modl, 0, R1, 1024);
            } else if (st == 12) {
                prep_rwkv_elem(p);
            } else if (st == 2 && kind == 1) {
                prep_gla(lds, p);
            } else if (st == 2 && kind == 0) {
                prep_delta(lds, p, j);
            } else if (st == 1 || st == 2 || st == 7 || st == 9) {
                pg8::EpiBf16S E; E.act = 0; const bf16_t* A; const bf16_t* Bt; int lda, N, K;
                if (st == 1) {
                    A = R1; Bt = W + W_IN / 2;
                    if (kind == 0) { E.O = (bf16_t*)(p->ws + WS_PROJ); E.ldc = 4352; lda = 1024; N = 4352; K = 1024; }
                    else if (kind == 1) { E.O = (bf16_t*)(p->ws + WS_PROJ); E.ldc = 4096; lda = 1024; N = 4096; K = 1024; }
                    else { E.O = (bf16_t*)(p->ws + WS_PROJC); E.ldc = 3328; E.act = 1; lda = 2048; N = 3328; K = 2048; }
                } else if (st == 2) {
                    A = (const bf16_t*)(p->ws + WS_PROJC) + 3072; Bt = W + W_L2 / 2; E.O = R1; E.ldc = 3072; lda = 3328; N = 3072; K = 256;
                } else {
                    const int g = (st == 9);
                    A = R1; Bt = W + W_UP / 2 + (size_t)(g ? 3072 : 0) * 1024; N = g ? 2560 : 3072; E.O = (bf16_t*)(p->ws + WS_HID); E.ldc = N; lda = 1024; K = 1024;
                }
                run_gemm(lds, A, lda, Bt, N, K, E);
            } else if (st == 5 || st == 11) {
                pg8::EpiRes E; const bf16_t* A; const bf16_t* Bt; int lda, K;
                if (st == 5) { E.res = hin; E.out = p->out; E.gate = modl + 2 * 1024; A = (const bf16_t*)(p->ws + (kind != 0 ? WS_OC : WS_PROJ)); lda = (kind == 0) ? 4352 : 1024; Bt = W + W_OUT / 2; K = 1024; }
                else { E.res = p->out; E.out = p->out; E.gate = modl + 5 * 1024; A = (const bf16_t*)(p->ws + WS_ACT); lda = 2816; Bt = W + W_DN / 2; K = 2816; }
                run_gemm(lds, A, lda, Bt, 1024, K, E);
            } else if (st == 3) {
                if (kind == 0) scan_chunked<0>(lds, p, j); else if (kind == 1) scan_chunked<1>(lds, p, j); else scan_rwkv(lds, p);
            } else if (st == 4) {
                if (kind == 0) post_phase<0>(p, j); else if (kind == 1) post_phase<1>(p, j); else post_phase<2>(p, j);
            } else if (st == 6) {
                norm_phase<false>(p->out, p->in[2] + (size_t)(l * 2 + 1) * 1024, modl, 3, R1, 1024);
            } else if (st == 8 || st == 10) {
                const int g = (st == 10);
                convglu_phase((const bf16_t*)(p->ws + WS_HID), (bf16_t*)(p->ws + WS_ACT), g, p->in[32] + (size_t)l * 3 * 5632, p->in[33] + (size_t)l * 5632);
            }
            }
        }
        if (ph + 1 < ph_hi) { if (ph == ph_lo) grid.sync(); else xcd_barrier(xb); }
    }
}

extern "C" void kernel_launch(void* const* d_in, const int* in_sizes, int n_in, void* d_out, int out_size, void* d_ws, size_t ws_size, hipStream_t stream) {
    constexpr int LDS_BYTES = 144 * 1024;
    static int grid_blocks = 0;
    if (!grid_blocks) {
        int dev = 0, cus = 0, per_cu = 0;
        hipGetDevice(&dev);
        hipDeviceGetAttribute(&cus, hipDeviceAttributeMultiprocessorCount, dev);
        if (hipFuncSetAttribute((const void*)mega, hipFuncAttributeMaxDynamicSharedMemorySize, LDS_BYTES) != hipSuccess) fprintf(stderr, "hipFuncSetAttribute failed\n");
        hipOccupancyMaxActiveBlocksPerMultiprocessor(&per_cu, (const void*)mega, 512, LDS_BYTES);
        if (per_cu < 1) per_cu = 1;
        if (per_cu > 1) per_cu = 1;
        grid_blocks = cus * per_cu;
        if (ws_size < 512 * MiB) fprintf(stderr, "workspace too small: %zu\n", ws_size);
    }
    (void)hipMemsetAsync((char*)d_ws + WS_BAR, 0, XCD_BAR_WORDS * sizeof(unsigned), stream);
    Params p{};
    for (int i = 0; i < 36; ++i) p.in[i] = (const float*)d_in[i];
    p.out = (float*)d_out; p.ws = (unsigned char*)d_ws;
#if SINGLE_LAUNCH
    p.ph_lo = 0; p.ph_hi = NPH;
    void* args[] = {&p};
    hipError_t e = hipLaunchCooperativeKernel((const void*)mega, dim3(grid_blocks), dim3(512), args, LDS_BYTES, stream);
    if (e != hipSuccess) fprintf(stderr, "cooperative launch failed: %s (grid %d)\n", hipGetErrorString(e), grid_blocks);
#else
    for (int ph = 0; ph < NPH; ++ph) {
        if (phase_is_noop(ph)) continue;
        p.ph_lo = ph; p.ph_hi = ph + 1;
        hipLaunchKernelGGL(mega, dim3(grid_blocks), dim3(512), LDS_BYTES, stream, p);
    }
#endif
}
```

```cpp
#include <hip/hip_runtime.h>
#include <hip/hip_cooperative_groups.h>
#include <cstdio>
namespace cg = cooperative_groups;

#ifndef PHMASK
#define PHMASK 0xFFFFFF
#endif
#ifndef REPMASK
#define REPMASK 0
#endif
#ifndef REPL
#define REPL 0xF
#endif
#ifndef SINGLE_LAUNCH
#define SINGLE_LAUNCH 1
#endif

#define LAS __attribute__((address_space(3)))
typedef unsigned short bf16_t;
typedef short bf16x8 __attribute__((ext_vector_type(8)));
typedef float f32x4 __attribute__((ext_vector_type(4)));
typedef float f32x2 __attribute__((ext_vector_type(2)));
typedef unsigned u32x4 __attribute__((ext_vector_type(4)));
typedef unsigned u32x2 __attribute__((ext_vector_type(2)));

constexpr int MROWS = 32768, SEQ = 8192, DM = 1024;
constexpr size_t MiB = 1ull << 20;
constexpr size_t WS_W = 0;
constexpr size_t W_IN = 0, W_L2 = 13 * MiB, W_OUT = 15 * MiB, W_UP = 17 * MiB, W_DN = 28 * MiB;
constexpr size_t WS_MISC = 34 * MiB;
constexpr size_t WS_R1 = 36 * MiB;
constexpr size_t WS_PROJ = 164 * MiB;
constexpr size_t WS_PROJC = 228 * MiB;
constexpr size_t WS_OC = 436 * MiB;
constexpr size_t WS_HID = 100 * MiB;
constexpr size_t WS_ACT = 292 * MiB;

struct Params {
    const float* in[36];
    float* out;
    unsigned char* ws;
    int ph_lo, ph_hi;
};
typedef const Params* PPTR;

__device__ __forceinline__ float bf2f(unsigned v) { return __uint_as_float(v << 16); }
__device__ __forceinline__ float bflo(unsigned v) { return __uint_as_float(v << 16); }
__device__ __forceinline__ float bfhi(unsigned v) { return __uint_as_float(v & 0xffff0000u); }
typedef __bf16 bf16v2 __attribute__((ext_vector_type(2)));
__device__ __forceinline__ unsigned pack2(float lo, float hi) { const f32x2 v = {lo, hi}; const bf16v2 r = __builtin_convertvector(v, bf16v2); return __builtin_bit_cast(unsigned, r); }
__device__ __forceinline__ unsigned f2bf(float f) { return pack2(f, 0.f) & 0xffffu; }
__device__ __forceinline__ float sigmoidf_(float x) { return __builtin_amdgcn_rcpf(1.0f + __expf(-x)); }
__device__ __forceinline__ float siluf_(float x) { return x * __builtin_amdgcn_rcpf(1.0f + __expf(-x)); }
__device__ __forceinline__ float softplusf_(float x) { return x > 15.0f ? x : __logf(1.0f + __expf(x)); }
template <int CTRL> __device__ __forceinline__ float dpp_f(float x) { return __int_as_float(__builtin_amdgcn_update_dpp(0, __float_as_int(x), CTRL, 0xf, 0xf, false)); }
__device__ __forceinline__ float rowred16(float x) { x += dpp_f<0x128>(x); x += dpp_f<0x124>(x); x += dpp_f<0x122>(x); x += dpp_f<0x121>(x); return x; }
__device__ __forceinline__ float wave_allsum(float v) {
    float r = rowred16(v);
    r += __int_as_float(__builtin_amdgcn_update_dpp(0, __float_as_int(r), 0x142, 0xa, 0xf, false));
    r += __int_as_float(__builtin_amdgcn_update_dpp(0, __float_as_int(r), 0x143, 0xc, 0xf, false));
    return __int_as_float(__builtin_amdgcn_readlane(__float_as_int(r), 63));
}
struct StepRegs { f32x4 a, b, c, d, e; float vr, x0, x1; };
template <int KIND> __device__ __forceinline__ void step_load(StepRegs& r, LAS const float* rec, int li, int row) {
    r.a = *(LAS const f32x4*)(rec + 4 * li); r.b = *(LAS const f32x4*)(rec + 64 + 4 * li); r.c = *(LAS const f32x4*)(rec + 128 + 4 * li); r.d = *(LAS const f32x4*)(rec + 192 + 4 * li);
    if (KIND == 0) { r.vr = rec[256 + row]; r.x0 = rec[272]; r.x1 = rec[273]; }
    else if (KIND == 1) { r.vr = rec[256 + row]; }
    else { r.e = *(LAS const f32x4*)(rec + 256 + 4 * li); r.vr = rec[320 + row]; }
}
template <int KIND> __device__ __forceinline__ float step_compute(const StepRegs& r, f32x2 (&s)[4]) {
    if (KIND == 0) {
        const f32x2 k[4] = {{r.a[0], r.a[1]}, {r.a[2], r.a[3]}, {r.b[0], r.b[1]}, {r.b[2], r.b[3]}};
        const f32x2 q[4] = {{r.c[0], r.c[1]}, {r.c[2], r.c[3]}, {r.d[0], r.d[1]}, {r.d[2], r.d[3]}};
        f32x2 pa = s[0] * k[0] + s[1] * k[1]; const f32x2 pb = s[2] * k[2] + s[3] * k[3]; pa += pb;
        const float pp = rowred16(pa.x + pa.y);
        const float cc = r.x0 * (r.vr - r.x1 * pp);
        const f32x2 eg2 = {r.x1, r.x1}, cc2 = {cc, cc};
#pragma unroll
        for (int i = 0; i < 4; ++i) s[i] = s[i] * eg2 + cc2 * k[i];
        f32x2 oa = s[0] * q[0] + s[1] * q[1]; const f32x2 ob = s[2] * q[2] + s[3] * q[3]; oa += ob;
        return rowred16(oa.x + oa.y);
    } else if (KIND == 1) {
        const f32x2 q[4] = {{r.a[0], r.a[1]}, {r.a[2], r.a[3]}, {r.b[0], r.b[1]}, {r.b[2], r.b[3]}};
        const f32x2 f[4] = {{r.c[0], r.c[1]}, {r.c[2], r.c[3]}, {r.d[0], r.d[1]}, {r.d[2], r.d[3]}};
        const f32x2 v2 = {r.vr, r.vr};
#pragma unroll
        for (int i = 0; i < 4; ++i) s[i] = s[i] * f[i] + v2 * (1.0f - f[i]);
        f32x2 oa = s[0] * q[0] + s[1] * q[1]; const f32x2 ob = s[2] * q[2] + s[3] * q[3]; oa += ob;
        return rowred16(oa.x + oa.y);
    } else {
        const f32x2 a2[2] = {{r.a[0], r.a[1]}, {r.a[2], r.a[3]}}, b2[2] = {{r.b[0], r.b[1]}, {r.b[2], r.b[3]}}, d2[2] = {{r.c[0], r.c[1]}, {r.c[2], r.c[3]}};
        const f32x2 k2[2] = {{r.d[0], r.d[1]}, {r.d[2], r.d[3]}}, r2[2] = {{r.e[0], r.e[1]}, {r.e[2], r.e[3]}};
        const f32x2 pa = s[0] * a2[0] + s[1] * a2[1];
        const float sa = rowred16(pa.x + pa.y);
        const f32x2 sa2 = {sa, sa}, v2 = {r.vr, r.vr};
        s[0] = s[0] * d2[0] + sa2 * b2[0] + v2 * k2[0]; s[1] = s[1] * d2[1] + sa2 * b2[1] + v2 * k2[1];
        const f32x2 oa = s[0] * r2[0] + s[1] * r2[1];
        return rowred16(oa.x + oa.y);
    }
}
__device__ __forceinline__ int tidx() { int t = threadIdx.x; asm volatile("" : "+v"(t)); return t; }
__device__ __forceinline__ int bidx() { int t = blockIdx.x; asm volatile("" : "+s"(t)); return t; }
__device__ __forceinline__ int gdim() { int t = gridDim.x; asm volatile("" : "+s"(t)); return t; }
__device__ __forceinline__ void lds_barrier() { asm volatile("s_waitcnt lgkmcnt(0)" ::: "memory"); __builtin_amdgcn_s_barrier(); asm volatile("" ::: "memory"); }

namespace pg8 {
constexpr int BM = 256, BK = 64, HALF = 128, HTB = HALF * BK * 2, STAGE_BYTES = 8 * HTB, NXCD = 8, WGM = 8;
__device__ __forceinline__ int lds_byte(int r, int c) { const int st = (r >> 4) * 2 + (c >> 5), rr = r & 15, cc = c & 31, ob = rr * 64 + cc * 2; return st * 1024 + (ob ^ (((ob >> 9) & 1) << 5)); }
__device__ __forceinline__ void stage_rc(int b, int& R, int& C) { const int st = b / 1024, sb = b % 1024, swz = sb ^ (((sb >> 9) & 1) << 5); R = (st >> 1) * 16 + swz / 64; C = (st & 1) * 32 + (swz % 64) / 2; }
__device__ __forceinline__ int perm32(int rho) { const int n = rho >> 4, i = rho & 15; return 8 * (i >> 2) + 4 * n + (i & 3); }
struct Unit { int pm, pn; };
struct Gemm { const bf16_t* A; const bf16_t* Bt; int M, N, K, lda; };
struct StaticOrder {
    int nM, nN, nwg, G, c;
    __device__ void init(int M, int N, int G_, int c_) { nM = M / BM; nN = N / BM; nwg = nM * nN; G = G_; c = c_; }
    __device__ bool next(int i, Unit& u) const {
        const long L = (long)i * G + c; if (L >= nwg) return false;
        int wgid = (int)L; { const int q = nwg / NXCD, r = nwg % NXCD, xcd = wgid % NXCD, off = wgid / NXCD; wgid = (xcd < r ? xcd * (q + 1) : r * (q + 1) + (xcd - r) * q) + off; }
        const int nig = WGM * nN, gid = wgid / nig, fm = gid * WGM, gsz = (nM - fm) < WGM ? (nM - fm) : WGM;
        u.pm = fm + ((wgid % nig) % gsz); u.pn = (wgid % nig) / gsz; return true;
    }
};
__device__ __forceinline__ unsigned cvt_pk_bf16(float lo, float hi) { return pack2(lo, hi); }

struct EpiBf16S {
    static constexpr bool PERM = true;
    bf16_t* O; int ldc; int act;
    __device__ __forceinline__ void operator()(const f32x4 (&acc)[2][2][4][2], const Unit& u, int wr, int wc, int fr, int fq) const {
        const int row0 = u.pm * BM + wr * 64 + fr; const int col0 = u.pn * BM + wc * 32 + 8 * fq;
#pragma unroll
        for (int ai = 0; ai < 2; ++ai)
#pragma unroll
            for (int m = 0; m < 4; ++m) { bf16_t* rowp = O + (size_t)(row0 + ai * HALF + m * 16) * ldc + col0;
#pragma unroll
                for (int bj = 0; bj < 2; ++bj) { f32x4 v0 = acc[ai][bj][m][0], v1 = acc[ai][bj][m][1];
                    if (act) { const int c = col0 + bj * HALF;
                        if (c >= 3072 && c < 3136) {
#pragma unroll
                            for (int j = 0; j < 4; ++j) { v0[j] = 1.0f - 2.0f * __builtin_amdgcn_rcpf(1.0f + __expf(2.0f * v0[j])); v1[j] = 1.0f - 2.0f * __builtin_amdgcn_rcpf(1.0f + __expf(2.0f * v1[j])); } }
                        else if (c >= 3200) {
#pragma unroll
                            for (int j = 0; j < 4; ++j) { v0[j] = sigmoidf_(v0[j]); v1[j] = sigmoidf_(v1[j]); } } }
                    u32x4 w; w.x = cvt_pk_bf16(v0[0], v0[1]); w.y = cvt_pk_bf16(v0[2], v0[3]); w.z = cvt_pk_bf16(v1[0], v1[1]); w.w = cvt_pk_bf16(v1[2], v1[3]);
                    *(u32x4*)(rowp + bj * HALF) = w; } }
    }
};
struct EpiRes {
    static constexpr bool PERM = false;
    const float* res; float* out; const float* gate;
    __device__ __forceinline__ void operator()(const f32x4 (&acc)[2][2][4][2], const Unit& u, int wr, int wc, int fr, int fq) const {
        const int row0 = u.pm * BM + wr * 64 + fr, col0 = u.pn * BM + wc * 32 + 4 * fq; const int b = (u.pm * BM) / SEQ;
        f32x4 gv[2][2];
#pragma unroll
        for (int bj = 0; bj < 2; ++bj)
#pragma unroll
            for (int n = 0; n < 2; ++n) gv[bj][n] = *(const f32x4*)(gate + (size_t)b * 6144 + col0 + bj * HALF + n * 16);
#pragma unroll
        for (int ai = 0; ai < 2; ++ai)
#pragma unroll
            for (int mp = 0; mp < 2; ++mp) {
                f32x4 r[2][2][2];
#pragma unroll
                for (int mm = 0; mm < 2; ++mm) { const size_t off = (size_t)(row0 + ai * HALF + (2 * mp + mm) * 16) * DM + col0;
#pragma unroll
                    for (int bj = 0; bj < 2; ++bj)
#pragma unroll
                        for (int n = 0; n < 2; ++n) r[mm][bj][n] = *(const f32x4*)(res + off + bj * HALF + n * 16); }
                __builtin_amdgcn_sched_barrier(0);
#pragma unroll
                for (int mm = 0; mm < 2; ++mm) { const size_t off = (size_t)(row0 + ai * HALF + (2 * mp + mm) * 16) * DM + col0;
#pragma unroll
                    for (int bj = 0; bj < 2; ++bj)
#pragma unroll
                        for (int n = 0; n < 2; ++n) *(f32x4*)(out + off + bj * HALF + n * 16) = r[mm][bj][n] + gv[bj][n] * acc[ai][bj][2 * mp + mm][n]; }
            }
    }
};

template <class Epi>
__device__ __forceinline__ void gemm_phase(LAS unsigned char* lds, const Gemm g, const StaticOrder& S, const Epi& E) {
    const int tid = tidx(), wid = __builtin_amdgcn_readfirstlane(tid >> 6), lane = tid & 63, wr = wid >> 2, wc = wid & 3, fr = lane & 15, fq = lane >> 4;
    const int K = g.K, nt = K / BK, lda = g.lda;
    unsigned voffA[2], voffB[2];
#pragma unroll
    for (int i = 0; i < 2; ++i) { int R, C; stage_rc(tid * 16 + i * 8192, R, C); const int Rb = Epi::PERM ? ((R & ~31) + perm32(R & 31)) : R;
        voffA[i] = (unsigned)(R * lda + C) * 2u; voffB[i] = (unsigned)(Rb * K + C) * 2u; }
    const size_t kstep = (size_t)(BK * 2);
    const size_t hstepA = (size_t)HALF * lda * 2, hstepB = (size_t)HALF * K * 2;
    const size_t tstepA = 2 * hstepA, tstepB = 2 * hstepB;
    const unsigned ldsw = (unsigned)wid * 1024u;
    const int aoff = lds_byte(wr * 64 + fr, fq * 8), boff = lds_byte(wc * 32 + fr, fq * 8);
#define PG8_SA(b, h) (((b) * 2 + (h)) * HTB)
#define PG8_SB(b, h) ((4 + (b) * 2 + (h)) * HTB)
#define PG8_STAGE(bufoff, gbase, voff) do { _Pragma("unroll") for (int _i = 0; _i < 2; ++_i) \
        __builtin_amdgcn_global_load_lds((const unsigned*)((const char*)(gbase) + (voff)[_i]), (LAS unsigned*)(lds + (bufoff) + ldsw + _i * 8192), 16, 0, 0); } while (0)
#define PG8_LDA(dst, b, h) do { _Pragma("unroll") for (int m = 0; m < 4; ++m) _Pragma("unroll") for (int k = 0; k < 2; ++k) dst[m][k] = *(const LAS bf16x8*)(lds + PG8_SA(b, h) + aoff + m * 2048 + k * 1024); } while (0)
#define PG8_LDB(dst, b, h) do { _Pragma("unroll") for (int n = 0; n < 2; ++n) _Pragma("unroll") for (int k = 0; k < 2; ++k) dst[n][k] = *(const LAS bf16x8*)(lds + PG8_SB(b, h) + boff + n * 2048 + k * 1024); } while (0)
#define PG8_MMA(ai, bj, At, Bt) do { __builtin_amdgcn_s_setprio(1); _Pragma("unroll") for (int m = 0; m < 4; ++m) _Pragma("unroll") for (int n = 0; n < 2; ++n) _Pragma("unroll") for (int k = 0; k < 2; ++k) \
        acc[ai][bj][m][n] = __builtin_amdgcn_mfma_f32_16x16x32_bf16(Bt[n][k], At[m][k], acc[ai][bj][m][n], 0, 0, 0); __builtin_amdgcn_s_setprio(0); } while (0)
#define PG8_WAIT_V(n) asm volatile("s_waitcnt vmcnt(" #n ")" ::: "memory")
#define PG8_WAIT_L(n) asm volatile("s_waitcnt lgkmcnt(" #n ")" ::: "memory")
#define PG8_BAR __builtin_amdgcn_s_barrier()
#define PG8_SCHED __builtin_amdgcn_sched_barrier(0)
    Unit cur, nxt; int ui = 0;
    if (!S.next(0, cur)) return;
    f32x4 acc[2][2][4][2];
#pragma unroll
    for (int a = 0; a < 2; ++a)
#pragma unroll
        for (int b = 0; b < 2; ++b)
#pragma unroll
            for (int m = 0; m < 4; ++m)
#pragma unroll
                for (int n = 0; n < 2; ++n) acc[a][b][m][n] = (f32x4){0.f, 0.f, 0.f, 0.f};
    bf16x8 At[4][2], B0[2][2], B1[2][2];
    const char* cA = (const char*)g.A + (size_t)cur.pm * tstepA; const char* cB = (const char*)g.Bt + (size_t)cur.pn * tstepB;
    PG8_STAGE(PG8_SB(0, 0), cB, voffB); PG8_STAGE(PG8_SA(0, 0), cA, voffA); PG8_STAGE(PG8_SB(0, 1), cB + hstepB, voffB); PG8_STAGE(PG8_SA(0, 1), cA + hstepA, voffA);
    if (wr == 1) PG8_BAR;
    PG8_WAIT_V(4); PG8_BAR;
    PG8_STAGE(PG8_SB(1, 0), cB + kstep, voffB); PG8_STAGE(PG8_SA(1, 0), cA + kstep, voffA); PG8_STAGE(PG8_SB(1, 1), cB + hstepB + kstep, voffB);
    PG8_WAIT_V(6); PG8_BAR;
    for (;;) {
        const bool has_next = S.next(ui + 1, nxt);
        const char* nA = has_next ? (const char*)g.A + (size_t)nxt.pm * tstepA : cA; const char* nB = has_next ? (const char*)g.Bt + (size_t)nxt.pn * tstepB : cB;
        for (int t = 0; t < nt; t += 2) {
            const bool last = (t == nt - 2);
            const char* a1 = cA + (size_t)(t + 1) * kstep;
            const char* a2 = last ? nA : cA + (size_t)(t + 2) * kstep; const char* b2 = last ? nB : cB + (size_t)(t + 2) * kstep;
            const char* a3 = a2 + kstep; const char* b3 = b2 + kstep;
            PG8_LDB(B0, 0, 0); PG8_SCHED; PG8_LDA(At, 0, 0); PG8_STAGE(PG8_SA(1, 1), a1 + hstepA, voffA);
            PG8_WAIT_L(8); PG8_BAR; PG8_WAIT_L(0); PG8_MMA(0, 0, At, B0); PG8_BAR; PG8_SCHED;
            PG8_LDB(B1, 0, 1); PG8_STAGE(PG8_SB(0, 0), b2, voffB);
            PG8_BAR; PG8_WAIT_L(0); PG8_MMA(0, 1, At, B1); PG8_BAR;
            PG8_LDA(At, 0, 1); PG8_STAGE(PG8_SA(0, 0), a2, voffA);
            PG8_BAR; PG8_WAIT_L(0); PG8_MMA(1, 0, At, B0); PG8_BAR; PG8_SCHED;
            PG8_STAGE(PG8_SB(0, 1), b2 + hstepB, voffB);
            PG8_WAIT_V(6); PG8_BAR; PG8_MMA(1, 1, At, B1); PG8_BAR;
            PG8_LDB(B0, 1, 0); PG8_SCHED; PG8_LDA(At, 1, 0); PG8_STAGE(PG8_SA(0, 1), a2 + hstepA, voffA);
            PG8_WAIT_L(8); PG8_BAR; PG8_WAIT_L(0); PG8_MMA(0, 0, At, B0); PG8_BAR; PG8_SCHED;
            PG8_LDB(B1, 1, 1); PG8_STAGE(PG8_SB(1, 0), b3, voffB);
            PG8_BAR; PG8_WAIT_L(0); PG8_MMA(0, 1, At, B1); PG8_BAR;
            PG8_LDA(At, 1, 1); PG8_STAGE(PG8_SA(1, 0), a3, voffA);
            PG8_BAR; PG8_WAIT_L(0); PG8_MMA(1, 0, At, B0); PG8_BAR; PG8_SCHED;
            PG8_STAGE(PG8_SB(1, 1), b3 + hstepB, voffB);
            PG8_WAIT_V(6); PG8_BAR; PG8_MMA(1, 1, At, B1); PG8_BAR;
        }
        E(acc, cur, wr, wc, fr, fq);
        if (!has_next) break;
#pragma unroll
        for (int a = 0; a < 2; ++a)
#pragma unroll
            for (int b = 0; b < 2; ++b)
#pragma unroll
                for (int m = 0; m < 4; ++m)
#pragma unroll
                    for (int n = 0; n < 2; ++n) acc[a][b][m][n] = (f32x4){0.f, 0.f, 0.f, 0.f};
        cur = nxt; cA = nA; cB = nB; ++ui;
    }
    PG8_WAIT_V(0);
    if (wr == 0) PG8_BAR;
    PG8_BAR;
#undef PG8_SA
#undef PG8_SB
#undef PG8_STAGE
#undef PG8_LDA
#undef PG8_LDB
#undef PG8_MMA
#undef PG8_WAIT_V
#undef PG8_WAIT_L
#undef PG8_BAR
#undef PG8_SCHED
}
}

template <class Epi>
__device__ __forceinline__ void run_gemm(LAS unsigned char* lds, const bf16_t* A, int lda, const bf16_t* Bt, int N, int K, const Epi& E) {
    pg8::Gemm g; g.A = A; g.Bt = Bt; g.M = MROWS; g.N = N; g.K = K; g.lda = lda;
    pg8::StaticOrder S; S.init(MROWS, N, (int)gdim(), (int)bidx());
    pg8::gemm_phase<Epi>(lds, g, S, E);
}

__device__ __forceinline__ void cvt_job(LAS float* tile, bf16_t* dst, int ldd, const float* src, int srcN, int nK, int nNdst, int nNsrc, const float* scale, int noff) {
    const int tid = tidx(); const int tilesK = nK / 64, tilesN = nNdst / 64, ntl = tilesK * tilesN, G = gdim();
    const int kr = tid >> 6, nn = tid & 63;
    for (int tl0 = bidx(); tl0 < ntl; tl0 += 2 * G) {
        float v[2][8];
#pragma unroll
        for (int u = 0; u < 2; ++u) { const int tl = tl0 + u * G; const bool tv = tl < ntl; const int tk = tv ? tl % tilesK : 0, tn = tv ? tl / tilesK : 0, k0 = tk * 64, n = tn * 64 + nn;
            const bool ld_ = tv && src && n < nNsrc;
#pragma unroll
            for (int ps = 0; ps < 8; ++ps) { const int kk = ps * 8 + kr; float x = 0.f;
                if (ld_) { x = src[(size_t)(k0 + kk) * srcN + noff + n]; if (scale) x *= scale[k0 + kk]; }
                v[u][ps] = x; } }
#pragma unroll
        for (int u = 0; u < 2; ++u)
#pragma unroll
            for (int ps = 0; ps < 8; ++ps) tile[u * 4160 + (ps * 8 + kr) * 65 + nn] = v[u][ps];
        __syncthreads();
#pragma unroll
        for (int u = 0; u < 2; ++u) { const int tl = tl0 + u * G;
            if (tl < ntl) { const int tk = tl % tilesK, tn = tl / tilesK, k0 = tk * 64, n0 = tn * 64;
#pragma unroll
                for (int ps = 0; ps < 4; ++ps) { const int kk2 = tid & 31, n2 = (tid >> 5) + 16 * ps;
                    const unsigned w = pack2(tile[u * 4160 + (2 * kk2) * 65 + n2], tile[u * 4160 + (2 * kk2 + 1) * 65 + n2]);
                    *(unsigned*)(dst + (size_t)(n0 + n2) * ldd + k0 + 2 * kk2) = w; } } }
        __syncthreads();
    }
}

__device__ __forceinline__ void cvt_layer(LAS unsigned char* lds, PPTR p, int layer) {
    LAS float* tile = (LAS float*)lds;
    bf16_t* W = (bf16_t*)(p->ws + WS_W);
    bf16_t* w_in = W + W_IN / 2; bf16_t* w_l2 = W + W_L2 / 2; bf16_t* w_out = W + W_OUT / 2; bf16_t* w_up = W + W_UP / 2; bf16_t* w_dn = W + W_DN / 2;
    const int kind = layer % 3, j = layer / 3;
    const int nmix = (kind == 2) ? 20 : 2;
    for (int jb = 0; jb < nmix + 5; ++jb) {
        bf16_t* dst = w_in; int ldd = 1024; const float* src = nullptr; int srcN = 1024, nK = 1024, nNdst = 1024, nNsrc = 1024, noff = 0; const float* scale = nullptr;
        if (jb >= nmix) {
            const int f = jb - nmix;
            if (f < 4) { const int g = f >> 1, gate = f & 1; const int nch = g ? 1280 : 1536, ch0 = g ? 1536 : 0;
                dst = w_up + (size_t)((g ? 3072 : 0) + nch * gate) * 1024; src = p->in[31] + (size_t)layer * 1024 * 5632; srcN = 5632; nNdst = nch; nNsrc = nch; noff = 2816 * gate + ch0; }
            else { dst = w_dn; ldd = 2816; src = p->in[34] + (size_t)layer * 2816 * 1024; nK = 2816; }
        } else if (kind == 0) {
            if (jb == 0) { src = p->in[5] + (size_t)j * 1024 * 4112; srcN = 4112; nNdst = 4352; nNsrc = 4112; }
            else { dst = w_out; src = p->in[10] + (size_t)j * 1024 * 1024; }
        } else if (kind == 1) {
            if (jb == 0) { src = p->in[11]; srcN = 4096; nNdst = 4096; nNsrc = 4096; }
            else { dst = w_out; src = p->in[14]; }
        } else {
            const float* mu = p->in[15];
            if (jb < 6) { const int sI = jb >> 1, hi = jb & 1; const int mi = (sI == 0) ? 0 : (sI == 1 ? 2 : 3);
                dst = w_in + (size_t)sI * 1024 * 2048 + hi * 1024; ldd = 2048; src = p->in[16] + (size_t)sI * 1024 * 1024; if (hi) scale = mu + mi * 1024; }
            else if (jb < 12) { const int q = (jb - 6) >> 1, hi = jb & 1;
                const int rowo = (q == 0) ? 3072 : (q == 1 ? 3136 : 3200); const int nc = (q == 2) ? 128 : 64; const int mi = (q == 0) ? 1 : (q == 1 ? 4 : 5);
                dst = w_in + (size_t)rowo * 2048 + hi * 1024; ldd = 2048; src = (q == 0) ? p->in[18] : (q == 1 ? p->in[21] : p->in[23]); srcN = nc; nNdst = nc; nNsrc = nc; if (hi) scale = mu + mi * 1024; }
            else if (jb < 19) { ldd = 256; nNdst = 1024; nNsrc = 1024;
                const int q = jb - 12;
                if (q == 0) { dst = w_l2; src = p->in[19]; nK = 64; }
                else if (q == 1) { dst = w_l2 + 64; nK = 192; }
                else if (q == 2) { dst = w_l2 + (size_t)1024 * 256; nK = 64; }
                else if (q == 3) { dst = w_l2 + (size_t)1024 * 256 + 64; src = p->in[22]; nK = 64; }
                else if (q == 4) { dst = w_l2 + (size_t)1024 * 256 + 128; nK = 128; }
                else if (q == 5) { dst = w_l2 + (size_t)2048 * 256; nK = 128; }
                else { dst = w_l2 + (size_t)2048 * 256 + 128; src = p->in[24]; nK = 128; } }
            else { dst = w_out; src = p->in[30]; }
        }
        cvt_job(tile, dst, ldd, src, srcN, nK, nNdst, nNsrc, scale, noff);
    }
}

template <bool SHIFT>
__device__ __forceinline__ void norm_phase(const float* h, const float* g, const float* modl, int s_shift, bf16_t* U, int ldu) {
    const int lane = tidx() & 63, wave = tidx() >> 6;
    const int gw = bidx() * 8 + wave, nw = gdim() * 8;
    constexpr int RU = SHIFT ? 2 : 4;
    f32x4 gg4[4];
#pragma unroll
    for (int i = 0; i < 4; ++i) gg4[i] = *(const f32x4*)(g + i * 256 + lane * 4);
    for (int row0 = gw; row0 < MROWS; row0 += nw * RU) {
        const int b0 = row0 >> 13;
        f32x4 gs0[4], sh0[4];
#pragma unroll
        for (int i = 0; i < 4; ++i) { const int c = i * 256 + lane * 4; const float* shp = modl + (size_t)b0 * 6144 + s_shift * 1024;
            gs0[i] = gg4[i] * (1.0f + *(const f32x4*)(shp + 1024 + c)); sh0[i] = *(const f32x4*)(shp + c); }
        f32x4 x[RU][4], xp[RU][4];
#pragma unroll
        for (int q = 0; q < RU; ++q) { const int row = row0 + q * nw;
            if (row < MROWS) {
#pragma unroll
                for (int i = 0; i < 4; ++i) x[q][i] = *(const f32x4*)(h + (size_t)row * DM + i * 256 + lane * 4);
                if (SHIFT) { const size_t prow = ((row & (SEQ - 1)) > 0) ? (size_t)(row - 1) : (size_t)row;
#pragma unroll
                    for (int i = 0; i < 4; ++i) xp[q][i] = *(const f32x4*)(h + prow * DM + i * 256 + lane * 4); } } }
#pragma unroll
        for (int q = 0; q < RU; ++q) { const int row = row0 + q * nw;
            if (row < MROWS) {
                const int b = row >> 13, t = row & (SEQ - 1);
                const float* sh = modl + (size_t)b * 6144 + s_shift * 1024; const float* sc = sh + 1024;
                float ss = 0.f;
#pragma unroll
                for (int i = 0; i < 4; ++i) ss += x[q][i][0] * x[q][i][0] + x[q][i][1] * x[q][i][1] + x[q][i][2] * x[q][i][2] + x[q][i][3] * x[q][i][3];
                ss = wave_allsum(ss); const float rstd = __builtin_amdgcn_rsqf(ss * (1.0f / 1024.0f) + 1e-6f);
                float rstdp = 0.f;
                if (SHIFT) { float ssp = 0.f;
#pragma unroll
                    for (int i = 0; i < 4; ++i) ssp += xp[q][i][0] * xp[q][i][0] + xp[q][i][1] * xp[q][i][1] + xp[q][i][2] * xp[q][i][2] + xp[q][i][3] * xp[q][i][3];
                    ssp = wave_allsum(ssp); rstdp = __builtin_amdgcn_rsqf(ssp * (1.0f / 1024.0f) + 1e-6f); }
#pragma unroll
                for (int i = 0; i < 4; ++i) { const int c = i * 256 + lane * 4; f32x4 gs = gs0[i], s0 = sh0[i];
                    if (b != b0) { gs = gg4[i] * (1.0f + *(const f32x4*)(sc + c)); s0 = *(const f32x4*)(sh + c); }
                    const f32x4 u = x[q][i] * rstd * gs + s0;
                    u32x2 w; w.x = pack2(u[0], u[1]); w.y = pack2(u[2], u[3]); *(u32x2*)(U + (size_t)row * ldu + c) = w;
                    if (SHIFT) { f32x4 up = xp[q][i] * rstdp * gs + s0; if (t == 0) up = (f32x4){0.f, 0.f, 0.f, 0.f};
                        const f32x4 dx = up - u; u32x2 w2; w2.x = pack2(dx[0], dx[1]); w2.y = pack2(dx[2], dx[3]); *(u32x2*)(U + (size_t)row * ldu + 1024 + c) = w2; } }
            } }
    }
}

__device__ __forceinline__ void final_phase(float* h, const float* g) {
    const int lane = tidx() & 63, wave = tidx() >> 6;
    const int gw = bidx() * 8 + wave, nw = gdim() * 8;
    f32x4 gg4[4];
#pragma unroll
    for (int i = 0; i < 4; ++i) gg4[i] = *(const f32x4*)(g + i * 256 + lane * 4);
    for (int row0 = gw; row0 < MROWS; row0 += nw * 4) {
        f32x4 x[4][4];
#pragma unroll
        for (int q = 0; q < 4; ++q) { const int row = row0 + q * nw; if (row < MROWS) {
#pragma unroll
            for (int i = 0; i < 4; ++i) x[q][i] = *(const f32x4*)(h + (size_t)row * DM + i * 256 + lane * 4); } }
#pragma unroll
        for (int q = 0; q < 4; ++q) { const int row = row0 + q * nw; if (row < MROWS) {
            float ss = 0.f;
#pragma unroll
            for (int i = 0; i < 4; ++i) ss += x[q][i][0] * x[q][i][0] + x[q][i][1] * x[q][i][1] + x[q][i][2] * x[q][i][2] + x[q][i][3] * x[q][i][3];
            ss = wave_allsum(ss); const float rstd = __builtin_amdgcn_rsqf(ss * (1.0f / 1024.0f) + 1e-6f);
#pragma unroll
            for (int i = 0; i < 4; ++i) { const int c = i * 256 + lane * 4;
                *(f32x4*)(h + (size_t)row * DM + c) = x[q][i] * rstd * gg4[i]; } } }
    }
}

__device__ __forceinline__ void pre_phase(LAS unsigned char* lds, PPTR p) {
    LAS float* cond = (LAS float*)lds;
    LAS float* red = cond + 4096;
    const int tid = tidx(), lane = tid & 63, wave = tid >> 6;
    float* mod = (float*)(p->ws + WS_MISC); float* lb = mod + 4 * 4 * 6144;
    for (int i = tid; i < 4096; i += 512) cond[i] = siluf_(p->in[1][i]);
    __syncthreads();
    for (int task = bidx(); task < 384; task += gdim()) {
        const int l = task / 96, cb = task % 96, col = cb * 64 + lane;
        float a0 = 0.f, a1 = 0.f, a2 = 0.f, a3 = 0.f;
        const float* wp = p->in[3] + ((size_t)l * 1024 + wave * 128) * 6144 + col;
#pragma unroll 8
        for (int k = 0; k < 128; ++k) { const float wv = wp[(size_t)k * 6144]; const int kk = wave * 128 + k;
            a0 += cond[kk] * wv; a1 += cond[1024 + kk] * wv; a2 += cond[2048 + kk] * wv; a3 += cond[3072 + kk] * wv; }
        red[(wave * 4 + 0) * 64 + lane] = a0; red[(wave * 4 + 1) * 64 + lane] = a1; red[(wave * 4 + 2) * 64 + lane] = a2; red[(wave * 4 + 3) * 64 + lane] = a3;
        __syncthreads();
        if (tid < 256) { const int b = tid >> 6; float s = 0.f;
#pragma unroll
            for (int w = 0; w < 8; ++w) s += red[(w * 4 + b) * 64 + lane];
            mod[((size_t)l * 4 + b) * 6144 + col] = s + p->in[4][(size_t)l * 6144 + col]; }
        __syncthreads();
    }
    for (int c = bidx() * 512 + tid; c < 1024; c += gdim() * 512) {
        const float l0 = p->in[12][c], l1 = p->in[12][1024 + c], l2 = p->in[12][2048 + c], l3 = p->in[12][3072 + c];
        const float mx = fmaxf(fmaxf(l0, l1), fmaxf(l2, l3));
        const float e0 = __expf(l0 - mx), e1 = __expf(l1 - mx), e2 = __expf(l2 - mx), e3 = __expf(l3 - mx);
        lb[c] = e1 / (e0 + e1 + e2 + e3);
    }
}

__device__ __forceinline__ void convglu_phase(const bf16_t* HID, bf16_t* ACT, int g, const float* cw, const float* cb) {
    const int nch = g ? 1280 : 1536, ch0 = g ? 1536 : 0, ld = 2 * nch, ncg = nch / 8;
    const int total = (MROWS / 16) * ncg;
    for (int task = bidx() * 512 + tidx(); task < total; task += gdim() * 512) {
        const int cgi = task % ncg, run = task / ncg, row0 = run * 16, t0 = row0 & (SEQ - 1), j0 = cgi * 8, ch = ch0 + j0;
        float wv[3][8], wg[3][8], bv[8], bg[8];
#pragma unroll
        for (int k = 0; k < 3; ++k)
#pragma unroll
            for (int e = 0; e < 8; ++e) { wv[k][e] = cw[k * 5632 + ch + e]; wg[k][e] = cw[k * 5632 + 2816 + ch + e]; }
#pragma unroll
        for (int e = 0; e < 8; ++e) { bv[e] = cb[ch + e]; bg[e] = cb[2816 + ch + e]; }
        u32x4 v2 = (u32x4){0, 0, 0, 0}, v1 = v2, g2 = v2, g1 = v2;
        if (t0 >= 2) {
            v2 = *(const u32x4*)(HID + (size_t)(row0 - 2) * ld + j0); g2 = *(const u32x4*)(HID + (size_t)(row0 - 2) * ld + nch + j0);
            v1 = *(const u32x4*)(HID + (size_t)(row0 - 1) * ld + j0); g1 = *(const u32x4*)(HID + (size_t)(row0 - 1) * ld + nch + j0);
        }
        u32x4 va[4], ga[4], vb4[4], gb4[4];
#define CG_LOAD(V, G, r0) do { _Pragma("unroll") for (int q_ = 0; q_ < 4; ++q_) { V[q_] = *(const u32x4*)(HID + (size_t)(row0 + (r0) + q_) * ld + j0); G[q_] = *(const u32x4*)(HID + (size_t)(row0 + (r0) + q_) * ld + nch + j0); } } while (0)
#define CG_ROWS(V, G, r0) do { _Pragma("unroll") for (int q_ = 0; q_ < 4; ++q_) { const u32x4 v0 = V[q_], g0 = G[q_]; u32x4 o; \
            _Pragma("unroll") for (int q = 0; q < 4; ++q) { \
                const float yv0 = wv[0][2 * q] * bflo(v2[q]) + wv[1][2 * q] * bflo(v1[q]) + wv[2][2 * q] * bflo(v0[q]) + bv[2 * q]; \
                const float yv1 = wv[0][2 * q + 1] * bfhi(v2[q]) + wv[1][2 * q + 1] * bfhi(v1[q]) + wv[2][2 * q + 1] * bfhi(v0[q]) + bv[2 * q + 1]; \
                const float yg0 = wg[0][2 * q] * bflo(g2[q]) + wg[1][2 * q] * bflo(g1[q]) + wg[2][2 * q] * bflo(g0[q]) + bg[2 * q]; \
                const float yg1 = wg[0][2 * q + 1] * bfhi(g2[q]) + wg[1][2 * q + 1] * bfhi(g1[q]) + wg[2][2 * q + 1] * bfhi(g0[q]) + bg[2 * q + 1]; \
                o[q] = pack2(yv0 * siluf_(yg0), yv1 * siluf_(yg1)); } \
            *(u32x4*)(ACT + (size_t)(row0 + (r0) + q_) * 2816 + ch) = o; \
            v2 = v1; v1 = v0; g2 = g1; g1 = g0; } } while (0)
        CG_LOAD(va, ga, 0);
        CG_LOAD(vb4, gb4, 4);
        CG_ROWS(va, ga, 0);
        CG_LOAD(va, ga, 8);
        CG_ROWS(vb4, gb4, 4);
        CG_LOAD(vb4, gb4, 12);
        CG_ROWS(va, ga, 8);
        CG_ROWS(vb4, gb4, 12);
#undef CG_LOAD
#undef CG_ROWS
    }
}

template <int KIND>
__device__ __forceinline__ void scan_phase(LAS unsigned char* lds, PPTR p, int j) {
    constexpr int N = (KIND == 2) ? 64 : 128;
    constexpr int NH = (KIND == 2) ? 16 : 8;
    constexpr int RG = N / 16;
    constexpr int STRIDE = (KIND == 0) ? 288 : (KIND == 1 ? 272 : 336);
    constexpr int TC = 32, NC = SEQ / TC;
    constexpr int LDP = (KIND == 0) ? 4352 : (KIND == 1 ? 4096 : 3328);
    LAS float* buf = (LAS float*)lds;
    LAS float* ob = buf + 2 * TC * STRIDE;
    const int tid = tidx(), wave = tid >> 6, lane = tid & 63;
    const bool is_loader = wave >= 4; const int lw = wave - 4;
    const int li = lane & 15, row = (wave & 3) * 4 + (lane >> 4);
    const bf16_t* P = (const bf16_t*)(p->ws + (KIND == 2 ? WS_PROJC : WS_PROJ));
    const bf16_t* L2 = (const bf16_t*)(p->ws + WS_R1);
    bf16_t* O = (bf16_t*)(p->ws + (KIND == 2 ? WS_OC : WS_R1));
    const int G = gdim(); const int vcu = (G % 8 == 0) ? (int)(bidx() % 8) * (G / 8) + (int)(bidx() / 8) : (int)bidx();
    for (int task = vcu; task < 256; task += G) {
        const int bh = task / RG, rg = task % RG, b = bh / NH, h = bh % NH;
        const size_t rbase = (size_t)b * SEQ;
        float cwq[4][2], cwk[4][2], cwv[4]; float expA = 0.f, dtb = 0.f; float lbv[2]; float w0v = 0.f, a0v = 0.f, kkc = 0.f, kac = 0.f;
        if (KIND == 0) { const float* cv = p->in[6] + (size_t)j * 4 * 3072;
#pragma unroll
            for (int jj = 0; jj < 4; ++jj) { cwq[jj][0] = cv[jj * 3072 + h * 128 + 2 * lane]; cwq[jj][1] = cv[jj * 3072 + h * 128 + 2 * lane + 1];
                cwk[jj][0] = cv[jj * 3072 + 1024 + h * 128 + 2 * lane]; cwk[jj][1] = cv[jj * 3072 + 1024 + h * 128 + 2 * lane + 1];
                cwv[jj] = cv[jj * 3072 + 2048 + h * 128 + 16 * rg + (lane & 15)]; }
            expA = __expf(p->in[7][j * 8 + h]); dtb = p->in[8][j * 8 + h]; }
        if (KIND == 1) { const float* lbp = (const float*)(p->ws + WS_MISC) + 4 * 4 * 6144; lbv[0] = lbp[h * 128 + 2 * lane]; lbv[1] = lbp[h * 128 + 2 * lane + 1]; }
        if (KIND == 2) { const int ch = h * 64 + lane; w0v = p->in[17][ch]; a0v = p->in[20][ch]; kkc = p->in[25][ch]; kac = p->in[26][ch]; }
        unsigned x0[11], x1[11], x2[11], x3[8], x4[8];
        f32x2 s[4];
#pragma unroll
        for (int e = 0; e < 4; ++e) s[e] = (f32x2){0.f, 0.f};

#define SCAN_LOAD(cc) do { const int c_ = (cc); \
        if (KIND == 0) { const int tfirst = c_ * TC + 8 * lw - 3; \
            _Pragma("unroll") for (int q = 0; q < 11; ++q) { const int t_ = tfirst + q; const bool valid = t_ >= 0; const bf16_t* rowp = P + (rbase + (valid ? t_ : 0)) * LDP; \
                const unsigned vq = *(const unsigned*)(rowp + h * 128 + 2 * lane), vk = *(const unsigned*)(rowp + 1024 + h * 128 + 2 * lane); \
                const int mcol = lane < 16 ? 2048 + h * 128 + 16 * rg + lane : (lane == 32 ? 4096 + h : (lane == 33 ? 4104 + h : 2048 + h * 128)); \
                const unsigned vm = rowp[mcol]; x0[q] = valid ? vq : 0u; x1[q] = valid ? vk : 0u; x2[q] = valid ? vm : 0u; } } \
        else if (KIND == 1) { const int tfirst = c_ * TC + 8 * lw; \
            _Pragma("unroll") for (int q = 0; q < 8; ++q) { const bf16_t* rowp = P + (rbase + tfirst + q) * LDP; \
                x0[q] = *(const unsigned*)(rowp + h * 128 + 2 * lane); x1[q] = *(const unsigned*)(rowp + 1024 + h * 128 + 2 * lane); \
                x2[q] = rowp[2048 + h * 128 + 16 * rg + (lane & 15)]; } } \
        else { const int tfirst = c_ * TC + 8 * lw; \
            _Pragma("unroll") for (int q = 0; q < 8; ++q) { const bf16_t* rowp = P + (rbase + tfirst + q) * LDP; const bf16_t* l2p = L2 + (rbase + tfirst + q) * 3072; \
                x0[q] = rowp[h * 64 + lane]; x1[q] = rowp[1024 + h * 64 + lane]; x2[q] = rowp[2048 + h * 64 + 16 * rg + (lane & 15)]; \
                x3[q] = l2p[h * 64 + lane]; x4[q] = l2p[1024 + h * 64 + lane]; } } } while (0)

#define SCAN_FLUSH(cc) do { const int c_ = (cc); LAS const float* src = ob + (c_ & 1) * (TC * 16) + (lane >> 1) * 16 + (lane & 1) * 8; \
        u32x4 w; w.x = pack2(src[0], src[1]); w.y = pack2(src[2], src[3]); w.z = pack2(src[4], src[5]); w.w = pack2(src[6], src[7]); \
        *(u32x4*)(O + (rbase + c_ * TC + (lane >> 1)) * DM + h * N + 16 * rg + (lane & 1) * 8) = w; } while (0)

        if (is_loader) SCAN_LOAD(0);
        for (int it = 0; it <= NC; ++it) {
            if (is_loader) {
                if (it < NC) {
                    LAS float* bw = buf + (it & 1) * (TC * STRIDE);
#pragma unroll
                    for (int i = 0; i < 8; ++i) {
                        LAS float* rec = bw + (8 * lw + i) * STRIDE;
                        if (KIND == 0) {
                            float yq0 = 0.f, yq1 = 0.f, yk0 = 0.f, yk1 = 0.f, yv = 0.f;
#pragma unroll
                            for (int jj = 0; jj < 4; ++jj) { yq0 += cwq[jj][0] * bflo(x0[i + jj]); yq1 += cwq[jj][1] * bfhi(x0[i + jj]);
                                yk0 += cwk[jj][0] * bflo(x1[i + jj]); yk1 += cwk[jj][1] * bfhi(x1[i + jj]); yv += cwv[jj] * bf2f(x2[i + jj]); }
                            yq0 = siluf_(yq0); yq1 = siluf_(yq1); yk0 = siluf_(yk0); yk1 = siluf_(yk1);
                            const float ssq = wave_allsum(yq0 * yq0 + yq1 * yq1), ssk = wave_allsum(yk0 * yk0 + yk1 * yk1);
                            const float rq = __builtin_amdgcn_rsqf(ssq + 1e-6f) * 0.08838834764831845f, rk = __builtin_amdgcn_rsqf(ssk + 1e-6f);
                            *(LAS f32x2*)(rec + 2 * lane) = (f32x2){yk0 * rk, yk1 * rk};
                            *(LAS f32x2*)(rec + 128 + 2 * lane) = (f32x2){yq0 * rq, yq1 * rq};
                            const float m3 = bf2f(x2[i + 3]);
                            if (lane < 16) rec[256 + lane] = siluf_(yv);
                            else if (lane == 32) rec[273] = __expf(-expA * softplusf_(m3 + dtb));
                            else if (lane == 33) rec[272] = sigmoidf_(m3);
                        } else if (KIND == 1) {
                            const float q0 = siluf_(bflo(x0[i])), q1 = siluf_(bfhi(x0[i]));
                            const float f0 = lbv[0] + (1.0f - lbv[0]) * sigmoidf_(bflo(x1[i])), f1 = lbv[1] + (1.0f - lbv[1]) * sigmoidf_(bfhi(x1[i]));
                            *(LAS f32x2*)(rec + 2 * lane) = (f32x2){q0, q1};
                            *(LAS f32x2*)(rec + 128 + 2 * lane) = (f32x2){f0, f1};
                            if (lane < 16) rec[256 + lane] = bf2f(x2[i]);
                        } else {
                            const float r = bf2f(x0[i]), kraw = bf2f(x1[i]), whi = bf2f(x3[i]), ahi = bf2f(x4[i]);
                            const float wv = -softplusf_(-(w0v + whi)) - 0.5f; const float d = __expf(-__expf(wv));
                            const float ag = sigmoidf_(a0v + ahi);
                            const float kkx = kraw * kkc; const float ss = wave_allsum(kkx * kkx); const float kk = kkx * __builtin_amdgcn_rsqf(ss + 1e-6f);
                            const float kp = kraw * (1.0f + (ag - 1.0f) * kac);
                            rec[lane] = -kk; rec[64 + lane] = kk * ag; rec[128 + lane] = d; rec[192 + lane] = kp; rec[256 + lane] = r;
                            if (lane < 16) rec[320 + lane] = bf2f(x2[i]);
                        }
                    }
                    if (it + 1 < NC) SCAN_LOAD(it + 1);
                }
                if (it >= 2 && lw == 0) SCAN_FLUSH(it - 2);
            } else if (it >= 1) {
                LAS const float* bc = buf + ((it - 1) & 1) * (TC * STRIDE);
                LAS float* oc = ob + ((it - 1) & 1) * (TC * 16);
                StepRegs R[2][2];
                step_load<KIND>(R[0][0], bc, li, row); step_load<KIND>(R[0][1], bc + STRIDE, li, row);
                float osel = 0.f;
#pragma unroll
                for (int g = 0; g < 16; ++g) {
                    if (g + 1 < 16) { step_load<KIND>(R[(g + 1) & 1][0], bc + (2 * g + 2) * STRIDE, li, row); step_load<KIND>(R[(g + 1) & 1][1], bc + (2 * g + 3) * STRIDE, li, row); }
#pragma unroll
                    for (int u = 0; u < 2; ++u) { const float o = step_compute<KIND>(R[g & 1][u], s); osel = (li == ((2 * g + u) & 15)) ? o : osel; }
                    if (g == 7 || g == 15) oc[((g == 15 ? 16 : 0) + li) * 16 + row] = osel;
                }
            }
            lds_barrier();
        }
        if (is_loader && lw == 0) SCAN_FLUSH(NC - 1);
        lds_barrier();
#undef SCAN_LOAD
#undef SCAN_FLUSH
    }
}


typedef short bf16x4 __attribute__((ext_vector_type(4)));
__device__ __forceinline__ bf16x8 cat4(bf16x4 lo, bf16x4 hi) { return __builtin_shufflevector(lo, hi, 0, 1, 2, 3, 4, 5, 6, 7); }
__device__ __forceinline__ bf16x4 cvt4(f32x4 v) { u32x2 w; w.x = pg8::cvt_pk_bf16(v[0], v[1]); w.y = pg8::cvt_pk_bf16(v[2], v[3]); return __builtin_bit_cast(bf16x4, w); }
constexpr size_t WS_KG = WS_R1 + 64 * MiB;
constexpr size_t WS_AM = 420 * MiB;
constexpr size_t WS_DEC = 428 * MiB;

__device__ __forceinline__ void prep_gla(LAS unsigned char* lds, PPTR p) {
    const int tid = tidx(), w = tid >> 6, lane = tid & 63, n = lane & 15, kg = lane >> 4;
    LAS unsigned char* qs = lds + w * 8704; LAS unsigned char* ks = qs + 4352;
    const bf16_t* P = (const bf16_t*)(p->ws + WS_PROJ);
    bf16_t* Qg = (bf16_t*)(p->ws + WS_R1); bf16_t* Kg = (bf16_t*)(p->ws + WS_KG);
    bf16_t* Amg = (bf16_t*)(p->ws + WS_AM); float* Decg = (float*)(p->ws + WS_DEC);
    const float* lbp = (const float*)(p->ws + WS_MISC) + 4 * 4 * 6144;
    for (int task = bidx() * 8 + w; task < 4 * 512 * 8; task += gdim() * 8) {
        const int h = task & 7, rc = task >> 3; const size_t row0 = (size_t)rc * 16;
        const float lb0 = lbp[h * 128 + 2 * lane], lb1 = lbp[h * 128 + 2 * lane + 1];
        unsigned xq[16], xf[16];
#pragma unroll
        for (int t = 0; t < 16; ++t) { const bf16_t* rowp = P + (row0 + t) * 4096 + h * 128 + 2 * lane; xq[t] = *(const unsigned*)rowp; xf[t] = *(const unsigned*)(rowp + 1024); }
        float bc0 = 0.f, bc1 = 0.f; float kk0[16], kk1[16], bs0[16], bs1[16];
#pragma unroll
        for (int t = 0; t < 16; ++t) {
            const float q0 = siluf_(bflo(xq[t])), q1 = siluf_(bfhi(xq[t]));
            const float f0 = lb0 + (1.0f - lb0) * sigmoidf_(bflo(xf[t])), f1 = lb1 + (1.0f - lb1) * sigmoidf_(bfhi(xf[t]));
            bc0 += __logf(f0); bc1 += __logf(f1);
            kk0[t] = 1.0f - f0; kk1[t] = 1.0f - f1; bs0[t] = bc0; bs1[t] = bc1;
            const unsigned qp = pack2(q0 * __expf(bc0), q1 * __expf(bc1));
            *(unsigned*)(Qg + (row0 + t) * 1024 + h * 128 + 2 * lane) = qp;
            *(LAS unsigned*)(qs + t * 272 + 4 * lane) = qp;
        }
#pragma unroll
        for (int t = 0; t < 16; ++t) {
            *(unsigned*)(Kg + (row0 + t) * 1024 + h * 128 + 2 * lane) = pack2(kk0[t] * __expf(bc0 - bs0[t]), kk1[t] * __expf(bc1 - bs1[t]));
            *(LAS unsigned*)(ks + t * 272 + 4 * lane) = pack2(kk0[t] * __expf(-bs0[t]), kk1[t] * __expf(-bs1[t]));
        }
        *(f32x2*)(Decg + (size_t)task * 128 + 2 * lane) = (f32x2){__expf(bc0), __expf(bc1)};
        asm volatile("s_waitcnt lgkmcnt(0)" ::: "memory");
        f32x4 acc = (f32x4){0.f, 0.f, 0.f, 0.f};
#pragma unroll
        for (int a = 0; a < 4; ++a) {
            const bf16x8 af = *(LAS const bf16x8*)(qs + n * 272 + (32 * a + 8 * kg) * 2);
            const bf16x8 bfr = *(LAS const bf16x8*)(ks + n * 272 + (32 * a + 8 * kg) * 2);
            acc = __builtin_amdgcn_mfma_f32_16x16x32_bf16(af, bfr, acc, 0, 0, 0);
        }
#pragma unroll
        for (int jj = 0; jj < 4; ++jj) { const int t = 4 * kg + jj; Amg[(size_t)task * 256 + t * 16 + n] = (bf16_t)f2bf(n <= t ? acc[jj] : 0.f); }
        asm volatile("s_waitcnt lgkmcnt(0)" ::: "memory");
    }
}

__device__ __forceinline__ void scan_gla(LAS unsigned char* lds, PPTR p) {
    constexpr int QOFF = 0, KTOFF = 4352, VOFF = 9472, AMOFF = 13824, DECOFF = 14336, BUFB = 14848;
    const int tid = tidx(), w = tid >> 6, lane = tid & 63, n = lane & 15, kg = lane >> 4;
    const bf16_t* P = (const bf16_t*)(p->ws + WS_PROJ);
    bf16_t* Qg = (bf16_t*)(p->ws + WS_R1); const bf16_t* Kg = (const bf16_t*)(p->ws + WS_KG);
    const bf16_t* Amg = (const bf16_t*)(p->ws + WS_AM); const float* Decg = (const float*)(p->ws + WS_DEC);
    bf16_t* Og = (bf16_t*)(p->ws + WS_OC);
    const bf16x4 z4 = (bf16x4){0, 0, 0, 0};
    for (int task = bidx(); task < 32; task += gdim()) {
        const int b = task >> 3, h = task & 7; const size_t rowbase = (size_t)b * SEQ;
        f32x4 S[8]; bf16x8 Sb[4];
#pragma unroll
        for (int i = 0; i < 8; ++i) S[i] = (f32x4){0.f, 0.f, 0.f, 0.f};
#pragma unroll
        for (int a = 0; a < 4; ++a) Sb[a] = (bf16x8){0, 0, 0, 0, 0, 0, 0, 0};
        const int lt = (tid & 255) >> 4, pc = tid & 15;
        constexpr int PD = 8;
        u32x4 g0[PD], g1[PD];
#define GLA_LOAD(cc, sl) do { const int c_ = (cc); const size_t r_ = rowbase + (size_t)c_ * 16 + lt; \
            if (tid < 256) { g0[sl] = *(const u32x4*)(Qg + r_ * 1024 + h * 128 + 8 * pc); g1[sl] = *(const u32x4*)(P + r_ * 4096 + 2048 + h * 128 + 8 * pc); } \
            else { g0[sl] = *(const u32x4*)(Kg + r_ * 1024 + h * 128 + 8 * pc); const size_t ch_ = ((size_t)(b * 512 + c_) * 8 + h); \
                if (tid < 288) g1[sl] = *(const u32x4*)(Amg + ch_ * 256 + (tid - 256) * 8); else if (tid < 320) g1[sl] = *(const u32x4*)(Decg + ch_ * 128 + (tid - 288) * 4); } } while (0)
#define GLA_STORE(cc, sl) do { LAS unsigned char* bb_ = lds + ((cc) & 1) * BUFB; \
            if (tid < 256) { *(LAS u32x4*)(bb_ + QOFF + lt * 272 + 16 * pc) = g0[sl]; *(LAS u32x4*)(bb_ + VOFF + lt * 272 + 16 * pc) = g1[sl]; } \
            else { _Pragma("unroll") for (int e = 0; e < 4; ++e) { *(LAS unsigned short*)(bb_ + KTOFF + (8 * pc + 2 * e) * 40 + 2 * lt) = (unsigned short)(g0[sl][e] & 0xffffu); \
                    *(LAS unsigned short*)(bb_ + KTOFF + (8 * pc + 2 * e + 1) * 40 + 2 * lt) = (unsigned short)(g0[sl][e] >> 16); } \
                if (tid < 288) *(LAS u32x4*)(bb_ + AMOFF + (tid - 256) * 16) = g1[sl]; else if (tid < 320) *(LAS u32x4*)(bb_ + DECOFF + (tid - 288) * 16) = g1[sl]; } } while (0)
#pragma unroll
        for (int d = 0; d < PD; ++d) GLA_LOAD(d, d);
        GLA_STORE(0, 0); lds_barrier();
        for (int c0 = 0; c0 < 512; c0 += PD) {
#pragma unroll
          for (int d = 0; d < PD; ++d) {
            const int c = c0 + d;
            if (c + PD < 512) GLA_LOAD(c + PD, d);
            LAS const unsigned char* bb = lds + (c & 1) * BUFB;
            f32x4 Z = (f32x4){0.f, 0.f, 0.f, 0.f};
#pragma unroll
            for (int a = 0; a < 4; ++a) {
                const bf16x4 lo = *(LAS const bf16x4*)(bb + QOFF + n * 272 + (32 * a + 4 * kg) * 2), hi = *(LAS const bf16x4*)(bb + QOFF + n * 272 + (32 * a + 16 + 4 * kg) * 2);
                Z = __builtin_amdgcn_mfma_f32_16x16x32_bf16(cat4(lo, hi), Sb[a], Z, 0, 0, 0);
            }
            bf16x4 vb;
#pragma unroll
            for (int j = 0; j < 4; ++j) vb[j] = *(LAS const short*)(bb + VOFF + (4 * kg + j) * 272 + (16 * w + n) * 2);
            const bf16x8 Vb = cat4(vb, z4);
            const bf16x4 am = *(LAS const bf16x4*)(bb + AMOFF + n * 32 + 8 * kg);
            const f32x4 o = __builtin_amdgcn_mfma_f32_16x16x32_bf16(cat4(am, z4), Vb, Z, 0, 0, 0);
#pragma unroll
            for (int i = 0; i < 8; ++i) {
                const f32x4 d4 = *(LAS const f32x4*)(bb + DECOFF + (16 * i + 4 * kg) * 4);
                const bf16x4 kt = *(LAS const bf16x4*)(bb + KTOFF + (16 * i + n) * 40 + 8 * kg);
                S[i] = __builtin_amdgcn_mfma_f32_16x16x32_bf16(cat4(kt, z4), Vb, S[i] * d4, 0, 0, 0);
            }
#pragma unroll
            for (int a = 0; a < 4; ++a) Sb[a] = cat4(cvt4(S[2 * a]), cvt4(S[2 * a + 1]));
#pragma unroll
            for (int j = 0; j < 4; ++j) Og[(rowbase + (size_t)c * 16 + 4 * kg + j) * 1024 + h * 128 + 16 * w + n] = (bf16_t)f2bf(o[j]);
            if (c + 1 < 512) GLA_STORE(c + 1, (d + 1) % PD);
            lds_barrier();
          }
        }
#undef GLA_LOAD
#undef GLA_STORE
    }
}


template <int SGN>
__device__ __forceinline__ void tri_inv16(LAS const float* Lm, int n, float (&x)[16]) {
    x[0] = (n == 0) ? 1.f : 0.f;
    {
        f32x4 la[12];
#pragma unroll
        for (int t = 1; t <= 4; ++t) la[t - 1] = *(LAS const f32x4*)(Lm + t * 16);
#pragma unroll
        for (int t = 5; t <= 8; ++t) { la[4 + 2 * (t - 5)] = *(LAS const f32x4*)(Lm + t * 16); la[5 + 2 * (t - 5)] = *(LAS const f32x4*)(Lm + t * 16 + 4); }
        __builtin_amdgcn_sched_barrier(0);
#pragma unroll
        for (int t = 1; t <= 8; ++t) { float acc = (n == t) ? 1.f : 0.f;
#pragma unroll
            for (int q = 0; q < (t + 3) / 4; ++q) { const f32x4 l4 = (t <= 4) ? la[t - 1] : la[4 + 2 * (t - 5) + q];
#pragma unroll
                for (int e = 0; e < 4; ++e) if (4 * q + e < t) acc += (float)SGN * l4[e] * x[4 * q + e]; }
            x[t] = acc; }
    }
    __builtin_amdgcn_sched_barrier(0);
    {   f32x4 lb[12];
#pragma unroll
        for (int t = 9; t <= 12; ++t)
#pragma unroll
            for (int q = 0; q < 3; ++q) lb[3 * (t - 9) + q] = *(LAS const f32x4*)(Lm + t * 16 + 4 * q);
        __builtin_amdgcn_sched_barrier(0);
#pragma unroll
        for (int t = 9; t <= 12; ++t) { float acc = (n == t) ? 1.f : 0.f;
#pragma unroll
            for (int q = 0; q < 3; ++q) { const f32x4 l4 = lb[3 * (t - 9) + q];
#pragma unroll
                for (int e = 0; e < 4; ++e) if (4 * q + e < t) acc += (float)SGN * l4[e] * x[4 * q + e]; }
            x[t] = acc; }
    }
    __builtin_amdgcn_sched_barrier(0);
    {   f32x4 lc[12];
#pragma unroll
        for (int t = 13; t <= 15; ++t)
#pragma unroll
            for (int q = 0; q < 4; ++q) lc[4 * (t - 13) + q] = *(LAS const f32x4*)(Lm + t * 16 + 4 * q);
        __builtin_amdgcn_sched_barrier(0);
#pragma unroll
        for (int t = 13; t <= 15; ++t) { float acc = (n == t) ? 1.f : 0.f;
#pragma unroll
            for (int q = 0; q < 4; ++q) { const f32x4 l4 = lc[4 * (t - 13) + q];
#pragma unroll
                for (int e = 0; e < 4; ++e) if (4 * q + e < t) acc += (float)SGN * l4[e] * x[4 * q + e]; }
            x[t] = acc; }
    }
}

constexpr size_t WS_TA = 436 * MiB;
constexpr size_t WS_AMA = 444 * MiB;
constexpr size_t WS_SCA = 452 * MiB;

__device__ __forceinline__ void prep_delta(LAS unsigned char* lds, PPTR p, int j) {
    const int tid = tidx(), w = tid >> 6, lane = tid & 63, n = lane & 15, kg = lane >> 4;
    LAS unsigned char* qs = lds + w * 9984; LAS unsigned char* ks = qs + 4352; LAS float* Lm = (LAS float*)(ks + 4352); LAS float* sc = Lm + 256;
    const bf16_t* P = (const bf16_t*)(p->ws + WS_PROJ);
    bf16_t* Qg = (bf16_t*)(p->ws + WS_R1); bf16_t* Kg = (bf16_t*)(p->ws + WS_KG);
    bf16_t* Tg = (bf16_t*)(p->ws + WS_TA); bf16_t* Amg = (bf16_t*)(p->ws + WS_AMA); float* Scg = (float*)(p->ws + WS_SCA);
    const float* cv = p->in[6] + (size_t)j * 4 * 3072;
    for (int task = bidx() * 8 + w; task < 4 * 512 * 8; task += gdim() * 8) {
        const int h = task & 7, rc = task >> 3; const size_t row0 = (size_t)rc * 16; const int t0 = (rc & 511) * 16;
        float cwq[4][2], cwk[4][2];
#pragma unroll
        for (int jj = 0; jj < 4; ++jj) { cwq[jj][0] = cv[jj * 3072 + h * 128 + 2 * lane]; cwq[jj][1] = cv[jj * 3072 + h * 128 + 2 * lane + 1];
            cwk[jj][0] = cv[jj * 3072 + 1024 + h * 128 + 2 * lane]; cwk[jj][1] = cv[jj * 3072 + 1024 + h * 128 + 2 * lane + 1]; }
        unsigned xq[19], xk[19];
#pragma unroll
        for (int r = 0; r < 19; ++r) { const bool valid = (t0 + r - 3) >= 0; const bf16_t* rowp = P + (row0 + (valid ? r - 3 : 0)) * 4352 + h * 128 + 2 * lane;
            const unsigned vq = *(const unsigned*)rowp, vk = *(const unsigned*)(rowp + 1024); xq[r] = valid ? vq : 0u; xk[r] = valid ? vk : 0u; }
        float beta, G;
        { const bf16_t* rowp = P + (row0 + n) * 4352; const float a_raw = bf2f(rowp[4096 + h]), b_raw = bf2f(rowp[4104 + h]);
          beta = sigmoidf_(b_raw); G = -__expf(p->in[7][j * 8 + h]) * softplusf_(a_raw + p->in[8][j * 8 + h]);
          float tq; tq = __int_as_float(__builtin_amdgcn_update_dpp(0, __float_as_int(G), 0x111, 0xf, 0xf, true)); G += tq;
          tq = __int_as_float(__builtin_amdgcn_update_dpp(0, __float_as_int(G), 0x112, 0xf, 0xf, true)); G += tq;
          tq = __int_as_float(__builtin_amdgcn_update_dpp(0, __float_as_int(G), 0x114, 0xf, 0xf, true)); G += tq;
          tq = __int_as_float(__builtin_amdgcn_update_dpp(0, __float_as_int(G), 0x118, 0xf, 0xf, true)); G += tq; }
        const float G15 = __int_as_float(__builtin_amdgcn_readlane(__float_as_int(G), 15));
        if (lane < 16) { sc[lane] = beta; sc[16 + lane] = G;
            float* so = Scg + (size_t)task * 64; so[lane] = beta; so[16 + lane] = __expf(G); so[32 + lane] = __expf(G15 - G); if (lane == 0) so[48] = __expf(G15); }
#pragma unroll
        for (int t = 0; t < 16; ++t) {
            float yq0 = 0.f, yq1 = 0.f, yk0 = 0.f, yk1 = 0.f;
#pragma unroll
            for (int jj = 0; jj < 4; ++jj) { yq0 += cwq[jj][0] * bflo(xq[t + jj]); yq1 += cwq[jj][1] * bfhi(xq[t + jj]); yk0 += cwk[jj][0] * bflo(xk[t + jj]); yk1 += cwk[jj][1] * bfhi(xk[t + jj]); }
            yq0 = siluf_(yq0); yq1 = siluf_(yq1); yk0 = siluf_(yk0); yk1 = siluf_(yk1);
            const float ssq = wave_allsum(yq0 * yq0 + yq1 * yq1), ssk = wave_allsum(yk0 * yk0 + yk1 * yk1);
            const float rq = __builtin_amdgcn_rsqf(ssq + 1e-6f) * 0.08838834764831845f, rk = __builtin_amdgcn_rsqf(ssk + 1e-6f);
            const unsigned qp = pack2(yq0 * rq, yq1 * rq), kp = pack2(yk0 * rk, yk1 * rk);
            *(unsigned*)(Qg + (row0 + t) * 1024 + h * 128 + 2 * lane) = qp; *(unsigned*)(Kg + (row0 + t) * 1024 + h * 128 + 2 * lane) = kp;
            *(LAS unsigned*)(qs + t * 272 + 4 * lane) = qp; *(LAS unsigned*)(ks + t * 272 + 4 * lane) = kp;
        }
        asm volatile("s_waitcnt lgkmcnt(0)" ::: "memory");
        f32x4 akk = (f32x4){0.f, 0.f, 0.f, 0.f}, aqk = akk;
#pragma unroll
        for (int a = 0; a < 4; ++a) {
            const bf16x8 qf = *(LAS const bf16x8*)(qs + n * 272 + (32 * a + 8 * kg) * 2);
            const bf16x8 kf = *(LAS const bf16x8*)(ks + n * 272 + (32 * a + 8 * kg) * 2);
            akk = __builtin_amdgcn_mfma_f32_16x16x32_bf16(kf, kf, akk, 0, 0, 0);
            aqk = __builtin_amdgcn_mfma_f32_16x16x32_bf16(qf, kf, aqk, 0, 0, 0);
        }
        { const float Gn = sc[16 + n]; const f32x4 bt = *(LAS const f32x4*)(sc + 4 * kg), Gt = *(LAS const f32x4*)(sc + 16 + 4 * kg);
#pragma unroll
          for (int jj = 0; jj < 4; ++jj) { const int t = 4 * kg + jj; const float dec = __expf(Gt[jj] - Gn);
              Lm[t * 16 + n] = (n < t) ? bt[jj] * akk[jj] * dec : 0.f;
              Amg[(size_t)task * 256 + t * 16 + n] = (bf16_t)f2bf(n <= t ? aqk[jj] * dec : 0.f); } }
        asm volatile("s_waitcnt lgkmcnt(0)" ::: "memory");
        float x[16];
        tri_inv16<-1>(Lm, n, x);
#pragma unroll
        for (int jj = 0; jj < 4; ++jj) { const float v = (kg == 0) ? x[jj] : (kg == 1 ? x[4 + jj] : (kg == 2 ? x[8 + jj] : x[12 + jj]));
            Tg[(size_t)task * 256 + (4 * kg + jj) * 16 + n] = (bf16_t)f2bf(v); }
        asm volatile("s_waitcnt lgkmcnt(0)" ::: "memory");
    }
}

__device__ __forceinline__ void scan_delta(LAS unsigned char* lds, PPTR p, int j) {
    constexpr int QOFF = 0, KOFF = 4352, KTOFF = 8704, VOFF = 13824, TOFF = 18992, AMOFF = 19504, SCOFF = 20016, BUFB = 20272;
    const int tid = tidx(), w = tid >> 6, lane = tid & 63, n = lane & 15, kg = lane >> 4;
    const bf16_t* P = (const bf16_t*)(p->ws + WS_PROJ);
    bf16_t* Qg = (bf16_t*)(p->ws + WS_R1); const bf16_t* Kg = (const bf16_t*)(p->ws + WS_KG);
    const bf16_t* Tg = (const bf16_t*)(p->ws + WS_TA); const bf16_t* Amg = (const bf16_t*)(p->ws + WS_AMA); const float* Scg = (const float*)(p->ws + WS_SCA);
    const float* cv = p->in[6] + (size_t)j * 4 * 3072;
    const bf16x4 z4 = (bf16x4){0, 0, 0, 0};
    for (int task = bidx(); task < 32; task += gdim()) {
        const int b = task >> 3, h = task & 7; const size_t rowbase = (size_t)b * SEQ;
        float cwv[4];
#pragma unroll
        for (int jj = 0; jj < 4; ++jj) cwv[jj] = cv[jj * 3072 + 2048 + h * 128 + 16 * w + n];
        f32x4 S[8]; bf16x8 Sb[4];
#pragma unroll
        for (int i = 0; i < 8; ++i) S[i] = (f32x4){0.f, 0.f, 0.f, 0.f};
#pragma unroll
        for (int a = 0; a < 4; ++a) Sb[a] = (bf16x8){0, 0, 0, 0, 0, 0, 0, 0};
        const int lt = (tid & 255) >> 4, pc = tid & 15, vr = tid >> 4;
        constexpr int PD = 8;
        u32x4 g0[PD], g1[PD];
#define DL_LOAD(cc, sl) do { const int c_ = (cc); const size_t r_ = rowbase + (size_t)c_ * 16 + lt; const size_t ch_ = ((size_t)(b * 512 + c_) * 8 + h); \
            if (tid < 256) g0[sl] = *(const u32x4*)(Qg + r_ * 1024 + h * 128 + 8 * pc); else g0[sl] = *(const u32x4*)(Kg + r_ * 1024 + h * 128 + 8 * pc); \
            if (tid < 304) { const int tv_ = c_ * 16 + vr - 3; const u32x4 vv_ = *(const u32x4*)(P + (rowbase + (tv_ >= 0 ? tv_ : 0)) * 4352 + 2048 + h * 128 + 8 * pc); g1[sl] = (tv_ >= 0) ? vv_ : (u32x4){0u, 0u, 0u, 0u}; } \
            else if (tid >= 320 && tid < 352) g1[sl] = *(const u32x4*)(Tg + ch_ * 256 + (tid - 320) * 8); \
            else if (tid >= 352 && tid < 384) g1[sl] = *(const u32x4*)(Amg + ch_ * 256 + (tid - 352) * 8); \
            else if (tid >= 384 && tid < 400) g1[sl] = *(const u32x4*)(Scg + ch_ * 64 + (tid - 384) * 4); } while (0)
#define DL_STORE(cc, sl) do { LAS unsigned char* bb_ = lds + ((cc) & 1) * BUFB; \
            if (tid < 256) *(LAS u32x4*)(bb_ + QOFF + lt * 272 + 16 * pc) = g0[sl]; \
            else { *(LAS u32x4*)(bb_ + KOFF + lt * 272 + 16 * pc) = g0[sl]; \
                _Pragma("unroll") for (int e = 0; e < 4; ++e) { *(LAS unsigned short*)(bb_ + KTOFF + (8 * pc + 2 * e) * 40 + 2 * lt) = (unsigned short)(g0[sl][e] & 0xffffu); \
                    *(LAS unsigned short*)(bb_ + KTOFF + (8 * pc + 2 * e + 1) * 40 + 2 * lt) = (unsigned short)(g0[sl][e] >> 16); } } \
            if (tid < 304) *(LAS u32x4*)(bb_ + VOFF + vr * 272 + 16 * pc) = g1[sl]; \
            else if (tid >= 320 && tid < 352) *(LAS u32x4*)(bb_ + TOFF + (tid - 320) * 16) = g1[sl]; \
            else if (tid >= 352 && tid < 384) *(LAS u32x4*)(bb_ + AMOFF + (tid - 352) * 16) = g1[sl]; \
            else if (tid >= 384 && tid < 400) *(LAS u32x4*)(bb_ + SCOFF + (tid - 384) * 16) = g1[sl]; } while (0)
#pragma unroll
        for (int d = 0; d < PD; ++d) DL_LOAD(d, d);
        DL_STORE(0, 0); lds_barrier();
        for (int c0 = 0; c0 < 512; c0 += PD) {
#pragma unroll
          for (int d = 0; d < PD; ++d) {
            const int c = c0 + d;
            if (c + PD < 512) DL_LOAD(c + PD, d);
            LAS const unsigned char* bb = lds + (c & 1) * BUFB;
            float vraw[7];
#pragma unroll
            for (int r = 0; r < 7; ++r) vraw[r] = bf2f(*(LAS const unsigned short*)(bb + VOFF + (4 * kg + r) * 272 + (16 * w + n) * 2));
            f32x4 v4;
#pragma unroll
            for (int jj = 0; jj < 4; ++jj) v4[jj] = siluf_(cwv[0] * vraw[jj] + cwv[1] * vraw[jj + 1] + cwv[2] * vraw[jj + 2] + cwv[3] * vraw[jj + 3]);
            f32x4 X = (f32x4){0.f, 0.f, 0.f, 0.f}, Z = X;
#pragma unroll
            for (int a = 0; a < 4; ++a) {
                const bf16x4 klo = *(LAS const bf16x4*)(bb + KOFF + n * 272 + (32 * a + 4 * kg) * 2), khi = *(LAS const bf16x4*)(bb + KOFF + n * 272 + (32 * a + 16 + 4 * kg) * 2);
                X = __builtin_amdgcn_mfma_f32_16x16x32_bf16(cat4(klo, khi), Sb[a], X, 0, 0, 0);
                const bf16x4 qlo = *(LAS const bf16x4*)(bb + QOFF + n * 272 + (32 * a + 4 * kg) * 2), qhi = *(LAS const bf16x4*)(bb + QOFF + n * 272 + (32 * a + 16 + 4 * kg) * 2);
                Z = __builtin_amdgcn_mfma_f32_16x16x32_bf16(cat4(qlo, qhi), Sb[a], Z, 0, 0, 0);
            }
            const f32x4 be4 = *(LAS const f32x4*)(bb + SCOFF + (4 * kg) * 4), eg4 = *(LAS const f32x4*)(bb + SCOFF + (16 + 4 * kg) * 4), egl4 = *(LAS const f32x4*)(bb + SCOFF + (32 + 4 * kg) * 4);
            const float glast = *(LAS const float*)(bb + SCOFF + 48 * 4);
            const f32x4 R = be4 * (v4 - eg4 * X);
            const bf16x4 tf = *(LAS const bf16x4*)(bb + TOFF + n * 32 + 8 * kg);
            const f32x4 vnew = __builtin_amdgcn_mfma_f32_16x16x32_bf16(cat4(tf, z4), cat4(cvt4(R), z4), (f32x4){0.f, 0.f, 0.f, 0.f}, 0, 0, 0);
            const bf16x4 am = *(LAS const bf16x4*)(bb + AMOFF + n * 32 + 8 * kg);
            const f32x4 o = __builtin_amdgcn_mfma_f32_16x16x32_bf16(cat4(am, z4), cat4(cvt4(vnew), z4), Z * eg4, 0, 0, 0);
            const bf16x8 B2 = cat4(cvt4(vnew * egl4), z4);
#pragma unroll
            for (int i = 0; i < 8; ++i) {
                const bf16x4 kt = *(LAS const bf16x4*)(bb + KTOFF + (16 * i + n) * 40 + 8 * kg);
                S[i] = __builtin_amdgcn_mfma_f32_16x16x32_bf16(cat4(kt, z4), B2, S[i] * glast, 0, 0, 0);
            }
#pragma unroll
            for (int a = 0; a < 4; ++a) Sb[a] = cat4(cvt4(S[2 * a]), cvt4(S[2 * a + 1]));
#pragma unroll
            for (int jj = 0; jj < 4; ++jj) Qg[(rowbase + (size_t)c * 16 + 4 * kg + jj) * 1024 + h * 128 + 16 * w + n] = (bf16_t)f2bf(o[jj]);
            if (c + 1 < 512) DL_STORE(c + 1, (d + 1) % PD);
            lds_barrier();
          }
        }
#undef DL_LOAD
#undef DL_STORE
    }
}


constexpr size_t WS_GCG = 500 * MiB;
constexpr size_t WS_BNG = 508 * MiB;
__device__ __forceinline__ void prep_rwkv_elem(PPTR p) {
    const int tid = tidx(), w = tid >> 6, lane = tid & 63;
    bf16_t* P = (bf16_t*)(p->ws + WS_PROJC); bf16_t* L2 = (bf16_t*)(p->ws + WS_R1);
    float* GCg = (float*)(p->ws + WS_GCG); float* BNg = (float*)(p->ws + WS_BNG);
    for (int task = bidx() * 8 + w; task < 4 * 512 * 16; task += gdim() * 8) {
        const int h = task & 15, rc = task >> 4; const size_t row0 = (size_t)rc * 16; const int ch = h * 64 + lane;
        const float w0v = p->in[17][ch], a0v = p->in[20][ch], kkc = p->in[25][ch], kac = p->in[26][ch], rkc = p->in[27][ch];
        unsigned xr[16], xk[16], xw[16], xa[16];
#pragma unroll
        for (int t = 0; t < 16; ++t) { const bf16_t* rowp = P + (row0 + t) * 3328 + ch; const bf16_t* l2p = L2 + (row0 + t) * 3072 + ch;
            xr[t] = rowp[0]; xk[t] = rowp[1024]; xw[t] = l2p[0]; xa[t] = l2p[1024]; }
        float lg = 0.f;
#pragma unroll
        for (int t = 0; t < 16; ++t) {
            const float r = bf2f(xr[t]), kraw = bf2f(xk[t]), whi = bf2f(xw[t]), ahi = bf2f(xa[t]);
            const float wv = -softplusf_(-(w0v + whi)) - 0.5f; const float ew = __expf(wv);
            const float lgp = lg; lg -= ew;
            const float ag = sigmoidf_(a0v + ahi);
            const float kkx = kraw * kkc; const float ss = wave_allsum(kkx * kkx); const float kk = kkx * __builtin_amdgcn_rsqf(ss + 1e-6f);
            const float kp = kraw * (1.0f + (ag - 1.0f) * kac);
            const float bonus = wave_allsum(r * kp * rkc);
            const float inv = __expf(-lg);
            bf16_t* rowp = P + (row0 + t) * 3328 + ch; bf16_t* l2p = L2 + (row0 + t) * 3072 + ch;
            rowp[0] = (bf16_t)f2bf(-kk * __expf(lgp)); rowp[1024] = (bf16_t)f2bf(r * __expf(lg));
            l2p[0] = (bf16_t)f2bf(kk * ag * inv); l2p[1024] = (bf16_t)f2bf(kp * inv);
            if (lane == 0) BNg[(row0 + t) * 16 + h] = bonus;
        }
        GCg[(size_t)task * 64 + lane] = __expf(lg);
    }
}

__device__ __forceinline__ void scan_rwkv(LAS unsigned char* lds, PPTR p) {
    constexpr int AH = 0, RH = 2304, BMT = 4608, KMT = 7168, TM = 9728, LAK = 10240, MRB = 10752, MRK = 11264, VV = 11776, GC = 14080, SLOT = 14336;
    constexpr int PRIV = 8 * SLOT, PRIVSZ = 5632;
    const int tid = tidx(), wave = tid >> 6, lane = tid & 63, n = lane & 15, kg = lane >> 4;
    const bf16_t* P = (const bf16_t*)(p->ws + WS_PROJC); const bf16_t* L2 = (const bf16_t*)(p->ws + WS_R1);
    bf16_t* Og = (bf16_t*)(p->ws + WS_OC);
    const int G = gdim(); const int vcu = (G % 8 == 0) ? (int)(bidx() % 8) * (G / 8) + (int)(bidx() / 8) : (int)bidx();
    for (int task = vcu; task < 256; task += G) {
        const int bh = task >> 2, slice = task & 3, b = bh >> 4, h = bh & 15; const size_t rowbase = (size_t)b * SEQ;
        const int pwr = (wave >= 1 && wave <= 3) ? wave - 1 : (wave == 5 ? 3 : -1);
        if (pwr >= 0) {
            const int pw = pwr; const int ch = h * 64 + lane;
            LAS unsigned char* bh = lds + PRIV + pw * PRIVSZ; LAS unsigned char* kh = bh + 2304; LAS float* Lm = (LAS float*)(kh + 2304);
            const float* GCg = (const float*)(p->ws + WS_GCG);
            unsigned xr[16], xk[16], xv[16], xw[16], xa[16]; float gCn;
#define RW_LOAD(cc, T0) do { _Pragma("unroll") for (int t = (T0); t < (T0) + 8; ++t) { const size_t r_ = rowbase + (size_t)(cc) * 16 + t; const bf16_t* rowp = P + r_ * 3328 + ch; const bf16_t* l2p = L2 + r_ * 3072 + ch; \
                xr[t] = rowp[0]; xk[t] = rowp[1024]; xv[t] = rowp[2048]; xw[t] = l2p[0]; xa[t] = l2p[1024]; } \
                if ((T0) == 8) gCn = GCg[((size_t)(b * 512 + (cc)) * 16 + h) * 64 + lane]; } while (0)
            RW_LOAD(pw, 0); RW_LOAD(pw, 8);
            for (int m = -1; m < 128; ++m) {
                const int cc = 4 * (m + 1) + pw;
                if (cc < 512) {
                    LAS unsigned char* sl = lds + (cc & 7) * SLOT;
                    const float gC = gCn; float bhat[16], khat[16];
#pragma unroll
                    for (int t = 0; t < 16; ++t) {
                        bhat[t] = bf2f(xw[t]); khat[t] = bf2f(xa[t]);
                        *(LAS unsigned short*)(sl + AH + t * 144 + 2 * lane) = (unsigned short)xr[t];
                        *(LAS unsigned short*)(sl + RH + t * 144 + 2 * lane) = (unsigned short)xk[t];
                        *(LAS unsigned short*)(bh + t * 144 + 2 * lane) = (unsigned short)xw[t];
                        *(LAS unsigned short*)(kh + t * 144 + 2 * lane) = (unsigned short)xa[t];
                        *(LAS unsigned short*)(sl + VV + t * 144 + 2 * lane) = (unsigned short)xv[t];
                    }
                    if (cc + 4 < 512) { RW_LOAD(cc + 4, 0); RW_LOAD(cc + 4, 8); }
                    *(LAS float*)(sl + GC + 4 * lane) = gC;
#pragma unroll
                    for (int q = 0; q < 4; ++q) {
                        u32x2 wb, wk; wb.x = pack2(bhat[4 * q] * gC, bhat[4 * q + 1] * gC); wb.y = pack2(bhat[4 * q + 2] * gC, bhat[4 * q + 3] * gC);
                        wk.x = pack2(khat[4 * q] * gC, khat[4 * q + 1] * gC); wk.y = pack2(khat[4 * q + 2] * gC, khat[4 * q + 3] * gC);
                        *(LAS u32x2*)(sl + BMT + lane * 40 + 8 * q) = wb; *(LAS u32x2*)(sl + KMT + lane * 40 + 8 * q) = wk;
                    }
                    asm volatile("s_waitcnt lgkmcnt(0)" ::: "memory");
                    f32x4 lab = (f32x4){0.f, 0.f, 0.f, 0.f}, lak = lab, mrb = lab, mrk = lab;
#pragma unroll
                    for (int a = 0; a < 2; ++a) {
                        const bf16x8 af = *(LAS const bf16x8*)(sl + AH + n * 144 + (32 * a + 8 * kg) * 2), rf = *(LAS const bf16x8*)(sl + RH + n * 144 + (32 * a + 8 * kg) * 2);
                        const bf16x8 bf_ = *(LAS const bf16x8*)(bh + n * 144 + (32 * a + 8 * kg) * 2), kf = *(LAS const bf16x8*)(kh + n * 144 + (32 * a + 8 * kg) * 2);
                        lab = __builtin_amdgcn_mfma_f32_16x16x32_bf16(af, bf_, lab, 0, 0, 0); lak = __builtin_amdgcn_mfma_f32_16x16x32_bf16(af, kf, lak, 0, 0, 0);
                        mrb = __builtin_amdgcn_mfma_f32_16x16x32_bf16(rf, bf_, mrb, 0, 0, 0); mrk = __builtin_amdgcn_mfma_f32_16x16x32_bf16(rf, kf, mrk, 0, 0, 0);
                    }
#pragma unroll
                    for (int jj = 0; jj < 4; ++jj) { const int t = 4 * kg + jj;
                        Lm[t * 16 + n] = (n < t) ? lab[jj] : 0.f;
                        *(LAS unsigned short*)(sl + LAK + t * 32 + 2 * n) = (unsigned short)f2bf(n < t ? lak[jj] : 0.f);
                        *(LAS unsigned short*)(sl + MRB + t * 32 + 2 * n) = (unsigned short)f2bf(n <= t ? mrb[jj] : 0.f);
                        *(LAS unsigned short*)(sl + MRK + t * 32 + 2 * n) = (unsigned short)f2bf(n <= t ? mrk[jj] : 0.f); }
                    asm volatile("s_waitcnt lgkmcnt(0)" ::: "memory");
                    float x[16];
                    tri_inv16<1>(Lm, n, x);
#pragma unroll
                    for (int jj = 0; jj < 4; ++jj) { const float v = (kg == 0) ? x[jj] : (kg == 1 ? x[4 + jj] : (kg == 2 ? x[8 + jj] : x[12 + jj]));
                        *(LAS unsigned short*)(sl + TM + (4 * kg + jj) * 32 + 2 * n) = (unsigned short)f2bf(v); }
                }
                lds_barrier();
            }
#undef RW_LOAD
        } else if (wave != 0) {
            for (int m = -1; m < 128; ++m) lds_barrier();
        } else {
            const int w = slice;
            f32x4 Zt[4]; bf16x8 Zb[2];
#pragma unroll
            for (int i = 0; i < 4; ++i) Zt[i] = (f32x4){0.f, 0.f, 0.f, 0.f};
            Zb[0] = (bf16x8){0, 0, 0, 0, 0, 0, 0, 0}; Zb[1] = Zb[0];
            struct RwOps { bf16x4 alo[2], ahi[2], rlo[2], rhi[2], vf, lakf, tf, mb, mk, bt[4], kt[4]; f32x4 g4[4]; };
#define RW_OPLOAD(R, cidx) do { LAS const unsigned char* sl_ = lds + ((cidx) & 7) * SLOT; \
                _Pragma("unroll") for (int a = 0; a < 2; ++a) { \
                    R.alo[a] = *(LAS const bf16x4*)(sl_ + AH + n * 144 + (32 * a + 4 * kg) * 2); R.ahi[a] = *(LAS const bf16x4*)(sl_ + AH + n * 144 + (32 * a + 16 + 4 * kg) * 2); \
                    R.rlo[a] = *(LAS const bf16x4*)(sl_ + RH + n * 144 + (32 * a + 4 * kg) * 2); R.rhi[a] = *(LAS const bf16x4*)(sl_ + RH + n * 144 + (32 * a + 16 + 4 * kg) * 2); } \
                _Pragma("unroll") for (int jj = 0; jj < 4; ++jj) R.vf[jj] = *(LAS const short*)(sl_ + VV + (4 * kg + jj) * 144 + (16 * w + n) * 2); \
                R.lakf = *(LAS const bf16x4*)(sl_ + LAK + n * 32 + 8 * kg); R.tf = *(LAS const bf16x4*)(sl_ + TM + n * 32 + 8 * kg); \
                R.mb = *(LAS const bf16x4*)(sl_ + MRB + n * 32 + 8 * kg); R.mk = *(LAS const bf16x4*)(sl_ + MRK + n * 32 + 8 * kg); \
                _Pragma("unroll") for (int i = 0; i < 4; ++i) { R.g4[i] = *(LAS const f32x4*)(sl_ + GC + (16 * i + 4 * kg) * 4); \
                    R.bt[i] = *(LAS const bf16x4*)(sl_ + BMT + (16 * i + n) * 40 + 8 * kg); R.kt[i] = *(LAS const bf16x4*)(sl_ + KMT + (16 * i + n) * 40 + 8 * kg); } } while (0)
#define RW_COMPUTE(R, cidx) do { \
                f32x4 P1 = (f32x4){0.f, 0.f, 0.f, 0.f}, Oa = P1; \
                _Pragma("unroll") for (int a = 0; a < 2; ++a) { P1 = __builtin_amdgcn_mfma_f32_16x16x32_bf16(cat4(R.alo[a], R.ahi[a]), Zb[a], P1, 0, 0, 0); \
                    Oa = __builtin_amdgcn_mfma_f32_16x16x32_bf16(cat4(R.rlo[a], R.rhi[a]), Zb[a], Oa, 0, 0, 0); } \
                P1 = __builtin_amdgcn_mfma_f32_16x16x32_bf16(cat4(R.lakf, z4), cat4(R.vf, z4), P1, 0, 0, 0); \
                const f32x4 Y = __builtin_amdgcn_mfma_f32_16x16x32_bf16(cat4(R.tf, z4), cat4(cvt4(P1), z4), (f32x4){0.f, 0.f, 0.f, 0.f}, 0, 0, 0); \
                const bf16x8 Byv = cat4(cvt4(Y), R.vf); \
                Oa = __builtin_amdgcn_mfma_f32_16x16x32_bf16(cat4(R.mb, R.mk), Byv, Oa, 0, 0, 0); \
                _Pragma("unroll") for (int i = 0; i < 4; ++i) Zt[i] = __builtin_amdgcn_mfma_f32_16x16x32_bf16(cat4(R.bt[i], R.kt[i]), Byv, Zt[i] * R.g4[i], 0, 0, 0); \
                Zb[0] = cat4(cvt4(Zt[0]), cvt4(Zt[1])); Zb[1] = cat4(cvt4(Zt[2]), cvt4(Zt[3])); \
                _Pragma("unroll") for (int jj = 0; jj < 4; ++jj) Og[(rowbase + (size_t)(cidx) * 16 + 4 * kg + jj) * 1024 + h * 64 + 16 * w + n] = (bf16_t)f2bf(Oa[jj]); } while (0)
            const bf16x4 z4 = (bf16x4){0, 0, 0, 0};
            lds_barrier();
            for (int m = 0; m < 128; ++m) {
                RwOps OA, OB;
                RW_OPLOAD(OA, 4 * m);
                RW_OPLOAD(OB, 4 * m + 1); __builtin_amdgcn_sched_barrier(0);
                RW_COMPUTE(OA, 4 * m); __builtin_amdgcn_sched_barrier(0);
                RW_OPLOAD(OA, 4 * m + 2); __builtin_amdgcn_sched_barrier(0);
                RW_COMPUTE(OB, 4 * m + 1); __builtin_amdgcn_sched_barrier(0);
                RW_OPLOAD(OB, 4 * m + 3); __builtin_amdgcn_sched_barrier(0);
                RW_COMPUTE(OA, 4 * m + 2); __builtin_amdgcn_sched_barrier(0);
                RW_COMPUTE(OB, 4 * m + 3);
                lds_barrier();
            }
#undef RW_OPLOAD
#undef RW_COMPUTE
        }
    }
}


template <int KIND>
__device__ __forceinline__ void scan_chunked(LAS unsigned char* lds, PPTR p, int j) {
    constexpr int QOFF = 0, KOFF = 4352, KTOFF = 8704, VOFF = 13824, TOFF = 14464, AMOFF = 14976, SCOFF = 15488, OBOFF = 16000, BUFB = 17024;
    constexpr int LDP = (KIND == 0) ? 4352 : 4096;
    constexpr int VROWS = (KIND == 0) ? 19 : 16, VEND = 512 + 2 * VROWS;
    constexpr int TEND = (KIND == 0) ? VEND + 32 : VEND, AEND = TEND + 32, SEND = AEND + ((KIND == 0) ? 16 : 32);
    const int tid = tidx(), wave = tid >> 6, lane = tid & 63, n = lane & 15, kg = lane >> 4;
    const bf16_t* P = (const bf16_t*)(p->ws + WS_PROJ);
    const bf16_t* Qg = (const bf16_t*)(p->ws + WS_R1); const bf16_t* Kg = (const bf16_t*)(p->ws + WS_KG);
    const bf16_t* Tg = (const bf16_t*)(p->ws + WS_TA);
    const bf16_t* Amg = (const bf16_t*)(p->ws + (KIND == 0 ? WS_AMA : WS_AM));
    const float* Scg = (const float*)(p->ws + (KIND == 0 ? WS_SCA : WS_DEC));
    bf16_t* Og = (KIND == 0) ? (bf16_t*)(p->ws + WS_PROJ) : (bf16_t*)(p->ws + WS_OC);
    constexpr int LDO = (KIND == 0) ? 4352 : 1024;
    const bf16x4 z4 = (bf16x4){0, 0, 0, 0};
    const int G = gdim(); const int vcu = (G % 8 == 0) ? (int)(bidx() % 8) * (G / 8) + (int)(bidx() / 8) : (int)bidx();
    for (int task = vcu; task < 256; task += G) {
        const int bh = task >> 3, w = task & 7, b = bh >> 3, h = bh & 7; const size_t rowbase = (size_t)b * SEQ;
        if (wave == 0) {
            float cwv[4] = {0.f, 0.f, 0.f, 0.f};
            if (KIND == 0) { const float* cv = p->in[6] + (size_t)j * 4 * 3072;
#pragma unroll
                for (int jj = 0; jj < 4; ++jj) cwv[jj] = cv[jj * 3072 + 2048 + h * 128 + 16 * w + n]; }
            f32x4 S[8]; bf16x8 Sb[4];
#pragma unroll
            for (int i = 0; i < 8; ++i) S[i] = (f32x4){0.f, 0.f, 0.f, 0.f};
#pragma unroll
            for (int a = 0; a < 4; ++a) Sb[a] = (bf16x8){0, 0, 0, 0, 0, 0, 0, 0};
            lds_barrier();
            for (int c2 = 0; c2 < 512; c2 += 4) {
#pragma unroll 1
              for (int u = 0; u < 4; ++u) { const int c = c2 + u;
                LAS unsigned char* bb = lds + (c & 7) * BUFB;
                bf16x4 klo[4], khi[4], qlo[4], qhi[4], kt[8], am, tf = z4; f32x4 be4, eg4, egl4, d4[8]; float glast = 0.f; unsigned vr16[7]; bf16x4 vb = z4;
#pragma unroll
                for (int a = 0; a < 4; ++a) {
                    if (KIND == 0) { klo[a] = *(LAS const bf16x4*)(bb + KOFF + n * 272 + (32 * a + 4 * kg) * 2); khi[a] = *(LAS const bf16x4*)(bb + KOFF + n * 272 + (32 * a + 16 + 4 * kg) * 2); }
                    qlo[a] = *(LAS const bf16x4*)(bb + QOFF + n * 272 + (32 * a + 4 * kg) * 2); qhi[a] = *(LAS const bf16x4*)(bb + QOFF + n * 272 + (32 * a + 16 + 4 * kg) * 2); }
                if (KIND == 0) {
#pragma unroll
                    for (int r = 0; r < 7; ++r) vr16[r] = *(LAS const unsigned short*)(bb + VOFF + (4 * kg + r) * 32 + 2 * n);
                    be4 = *(LAS const f32x4*)(bb + SCOFF + (4 * kg) * 4); eg4 = *(LAS const f32x4*)(bb + SCOFF + (16 + 4 * kg) * 4); egl4 = *(LAS const f32x4*)(bb + SCOFF + (32 + 4 * kg) * 4);
                    glast = *(LAS const float*)(bb + SCOFF + 48 * 4); tf = *(LAS const bf16x4*)(bb + TOFF + n * 32 + 8 * kg);
                } else {
#pragma unroll
                    for (int jj = 0; jj < 4; ++jj) vb[jj] = *(LAS const short*)(bb + VOFF + (4 * kg + jj) * 32 + 2 * n);
#pragma unroll
                    for (int i = 0; i < 8; ++i) d4[i] = *(LAS const f32x4*)(bb + SCOFF + (16 * i + 4 * kg) * 4);
                }
                am = *(LAS const bf16x4*)(bb + AMOFF + n * 32 + 8 * kg);
#pragma unroll
                for (int i = 0; i < 8; ++i) kt[i] = *(LAS const bf16x4*)(bb + KTOFF + (16 * i + n) * 40 + 8 * kg);
                __builtin_amdgcn_sched_barrier(0);
                asm volatile("s_waitcnt lgkmcnt(0)" ::: "memory");
                __builtin_amdgcn_sched_barrier(0);
                f32x4 v4 = (f32x4){0.f, 0.f, 0.f, 0.f};
                if (KIND == 0) {
#pragma unroll
                    for (int jj = 0; jj < 4; ++jj) v4[jj] = siluf_(cwv[0] * bf2f(vr16[jj]) + cwv[1] * bf2f(vr16[jj + 1]) + cwv[2] * bf2f(vr16[jj + 2]) + cwv[3] * bf2f(vr16[jj + 3]));
                }
                f32x4 X = (f32x4){0.f, 0.f, 0.f, 0.f}, Z = X;
#pragma unroll
                for (int a = 0; a < 4; ++a) {
                    if (KIND == 0) X = __builtin_amdgcn_mfma_f32_16x16x32_bf16(cat4(klo[a], khi[a]), Sb[a], X, 0, 0, 0);
                    Z = __builtin_amdgcn_mfma_f32_16x16x32_bf16(cat4(qlo[a], qhi[a]), Sb[a], Z, 0, 0, 0);
                }
                f32x4 o; bf16x8 B2;
                if (KIND == 0) {
                    const f32x4 R = be4 * (v4 - eg4 * X);
                    const f32x4 vnew = __builtin_amdgcn_mfma_f32_16x16x32_bf16(cat4(tf, z4), cat4(cvt4(R), z4), (f32x4){0.f, 0.f, 0.f, 0.f}, 0, 0, 0);
                    o = __builtin_amdgcn_mfma_f32_16x16x32_bf16(cat4(am, z4), cat4(cvt4(vnew), z4), Z * eg4, 0, 0, 0);
                    B2 = cat4(cvt4(vnew * egl4), z4);
#pragma unroll
                    for (int i = 0; i < 8; ++i) S[i] = __builtin_amdgcn_mfma_f32_16x16x32_bf16(cat4(kt[i], z4), B2, S[i] * glast, 0, 0, 0);
                } else {
                    B2 = cat4(vb, z4);
                    o = __builtin_amdgcn_mfma_f32_16x16x32_bf16(cat4(am, z4), B2, Z, 0, 0, 0);
#pragma unroll
                    for (int i = 0; i < 8; ++i) S[i] = __builtin_amdgcn_mfma_f32_16x16x32_bf16(cat4(kt[i], z4), B2, S[i] * d4[i], 0, 0, 0);
                }
                *(LAS f32x4*)(bb + OBOFF + lane * 16) = o;
#pragma unroll
                for (int a = 0; a < 4; ++a) Sb[a] = cat4(cvt4(S[2 * a]), cvt4(S[2 * a + 1]));
              }
                lds_barrier();
            }
            lds_barrier();
        } else {
            const int lt = tid - 64, pb = lt + 448;
            const int arow = (lt & 255) >> 4, apc = lt & 15;
            const bf16_t* srcA = (lt < 256 ? Qg : Kg) + (rowbase + arow) * 1024 + h * 128 + 8 * apc;
            const char* srcB; size_t strideB; int kindB;
            if (pb < 512) { kindB = 0; srcB = (const char*)(Kg + (rowbase + ((pb - 256) >> 4)) * 1024 + h * 128 + 8 * (pb & 15)); strideB = (size_t)16 * 1024 * 2; }
            else if (pb < VEND) { kindB = 1; const int vr_ = (pb - 512) >> 1, hf_ = (pb - 512) & 1; srcB = (const char*)(P + (rowbase + vr_) * LDP + 2048 + h * 128 + 16 * w + 8 * hf_); strideB = (size_t)16 * LDP * 2; }
            else if (pb < TEND) { kindB = 2; srcB = (const char*)(Tg + ((size_t)(b * 512) * 8 + h) * 256 + (pb - VEND) * 8); strideB = (size_t)8 * 256 * 2; }
            else if (pb < AEND) { kindB = 3; srcB = (const char*)(Amg + ((size_t)(b * 512) * 8 + h) * 256 + (pb - TEND) * 8); strideB = (size_t)8 * 256 * 2; }
            else if (pb < SEND) { kindB = 4; srcB = (const char*)(Scg + ((size_t)(b * 512) * 8 + h) * (KIND == 0 ? 64 : 128) + (pb - AEND) * 4); strideB = (size_t)8 * (KIND == 0 ? 64 : 128) * 4; }
            else { kindB = 5; srcB = (const char*)srcA; strideB = (size_t)16 * 1024 * 2; }
            const int vrow = (pb - 512) >> 1;
            const bool doflush = (wave == 2);
            constexpr int PD = 8;
            u32x4 g0[PD], g1[PD];
#define SC_LOAD(cc, sl) do { const int c_ = (cc); g0[sl] = *(const u32x4*)(srcA + (size_t)c_ * 16 * 1024); \
                const int tv_ = c_ * 16 + vrow - 3; const bool vh_ = (KIND == 0) && (kindB == 1); \
                const ptrdiff_t ofs_ = vh_ ? (ptrdiff_t)(tv_ >= 0 ? tv_ - vrow : -vrow) * (LDP * 2) : (ptrdiff_t)((size_t)c_ * strideB); \
                const u32x4 vv_ = *(const u32x4*)(srcB + ofs_); g1[sl] = (vh_ && tv_ < 0) ? (u32x4){0u, 0u, 0u, 0u} : vv_; } while (0)
#define SC_KSTORE(bb_, reg, row, pc) do { if (KIND == 0) *(LAS u32x4*)((bb_) + KOFF + (row) * 272 + 16 * (pc)) = (reg); \
                _Pragma("unroll") for (int e = 0; e < 4; ++e) { *(LAS unsigned short*)((bb_) + KTOFF + (8 * (pc) + 2 * e) * 40 + 2 * (row)) = (unsigned short)((reg)[e] & 0xffffu); \
                    *(LAS unsigned short*)((bb_) + KTOFF + (8 * (pc) + 2 * e + 1) * 40 + 2 * (row)) = (unsigned short)((reg)[e] >> 16); } } while (0)
#define SC_STORE(cc, sl) do { LAS unsigned char* bb_ = lds + ((cc) & 7) * BUFB; \
                if (lt < 256) *(LAS u32x4*)(bb_ + QOFF + arow * 272 + 16 * apc) = g0[sl]; else SC_KSTORE(bb_, g0[sl], arow, apc); \
                if (kindB == 0) SC_KSTORE(bb_, g1[sl], ((pb - 256) >> 4), (pb & 15)); \
                else if (kindB == 1) *(LAS u32x4*)(bb_ + VOFF + vrow * 32 + 16 * ((pb - 512) & 1)) = g1[sl]; \
                else if (kindB == 2) *(LAS u32x4*)(bb_ + TOFF + (pb - VEND) * 16) = g1[sl]; \
                else if (kindB == 3) *(LAS u32x4*)(bb_ + AMOFF + (pb - TEND) * 16) = g1[sl]; \
                else if (kindB == 4) *(LAS u32x4*)(bb_ + SCOFF + (pb - AEND) * 16) = g1[sl]; } while (0)
#define SC_OFLUSH(cc) do { const int c_ = (cc); const f32x4 o_ = *(LAS const f32x4*)(lds + (c_ & 7) * BUFB + OBOFF + lane * 16); \
                _Pragma("unroll") for (int jj = 0; jj < 4; ++jj) Og[(rowbase + (size_t)c_ * 16 + 4 * kg + jj) * LDO + h * 128 + 16 * w + n] = (bf16_t)f2bf(o_[jj]); } while (0)
#define SC_LOADER_LOOP(FLUSH) do { \
                _Pragma("unroll") for (int d = 0; d < PD; ++d) SC_LOAD(d, d); \
                SC_STORE(0, 0); SC_STORE(1, 1); SC_STORE(2, 2); SC_STORE(3, 3); \
                SC_LOAD(8, 0); SC_LOAD(9, 1); SC_LOAD(10, 2); SC_LOAD(11, 3); \
                lds_barrier(); \
                for (int c0 = 0; c0 < 512; c0 += PD) { \
                    _Pragma("unroll") for (int d = 0; d < PD; d += 4) { const int c = c0 + d; \
                        if (c + 4 < 512) { _Pragma("unroll") for (int u = 0; u < 4; ++u) SC_STORE(c + 4 + u, (d + 4 + u) % PD); } \
                        if (c + 12 < 512) { _Pragma("unroll") for (int u = 0; u < 4; ++u) SC_LOAD(c + 12 + u, (d + 4 + u) % PD); } \
                        if (FLUSH) { if (c > 0) { _Pragma("unroll") for (int u = 0; u < 4; ++u) SC_OFLUSH(c - 4 + u); } } \
                        lds_barrier(); } } \
                if (FLUSH) { _Pragma("unroll") for (int u = 0; u < 4; ++u) SC_OFLUSH(508 + u); } \
                lds_barrier(); } while (0)
            if (doflush) SC_LOADER_LOOP(true); else SC_LOADER_LOOP(false);
#undef SC_LOAD
#undef SC_KSTORE
#undef SC_STORE
#undef SC_OFLUSH
#undef SC_LOADER_LOOP
        }
    }
}

template <int KIND>
__device__ __forceinline__ void post_phase(PPTR p, int j) {
    const int lane = tidx() & 63, wave = tidx() >> 6;
    const int gw = bidx() * 8 + wave, nw = gdim() * 8;
    bf16_t* O = (bf16_t*)(p->ws + (KIND != 0 ? WS_OC : WS_PROJ));
    constexpr int LDO = (KIND == 0) ? 4352 : 1024;
    const bf16_t* P = (const bf16_t*)(p->ws + (KIND == 2 ? WS_PROJC : WS_PROJ));
    if (KIND != 2) {
        const float* nwp = (KIND == 0) ? p->in[9] + j * 128 : p->in[13];
        const float n0 = nwp[2 * lane], n1 = nwp[2 * lane + 1];
        constexpr int LDP = (KIND == 0) ? 4352 : 4096; constexpr int ZOFF = 3072;
        for (int row = gw; row < MROWS; row += nw) {
            unsigned ov[8], zv[8];
#pragma unroll
            for (int h = 0; h < 8; ++h) { ov[h] = *(const unsigned*)(O + (size_t)row * LDO + h * 128 + 2 * lane); zv[h] = *(const unsigned*)(P + (size_t)row * LDP + ZOFF + h * 128 + 2 * lane); }
#pragma unroll
            for (int h = 0; h < 8; ++h) {
                const float o0 = bflo(ov[h]), o1 = bfhi(ov[h]);
                const float ss = wave_allsum(o0 * o0 + o1 * o1); const float rstd = __builtin_amdgcn_rsqf(ss * (1.0f / 128.0f) + 1e-6f);
                *(unsigned*)(O + (size_t)row * LDO + h * 128 + 2 * lane) = pack2(o0 * rstd * n0 * siluf_(bflo(zv[h])), o1 * rstd * n1 * siluf_(bfhi(zv[h])));
            }
        }
    } else {
        const bf16_t* L2 = (const bf16_t*)(p->ws + WS_R1); const float* BNg = (const float*)(p->ws + WS_BNG);
        for (int task = gw; task < MROWS * 2; task += nw) {
            const int row = task >> 1, h0 = (task & 1) * 8;
            unsigned xy[8], xv[8], xg[8]; float bn[8], lw[8], lb_[8];
#pragma unroll
            for (int hh = 0; hh < 8; ++hh) { const int ch = (h0 + hh) * 64 + lane; const bf16_t* rowp = P + (size_t)row * 3328; const bf16_t* l2p = L2 + (size_t)row * 3072;
                xy[hh] = O[(size_t)row * DM + ch]; xv[hh] = rowp[2048 + ch]; xg[hh] = l2p[2048 + ch]; bn[hh] = BNg[(size_t)row * 16 + h0 + hh];
                lw[hh] = p->in[28][ch]; lb_[hh] = p->in[29][ch]; }
#pragma unroll
            for (int hh = 0; hh < 8; ++hh) { const int ch = (h0 + hh) * 64 + lane;
                const float y = bf2f(xy[hh]);
                const float mean = wave_allsum(y) * (1.0f / 64.0f); const float dd = y - mean;
                const float var = wave_allsum(dd * dd) * (1.0f / 64.0f);
                const float gn = dd * __builtin_amdgcn_rsqf(var + 0.04096f) * lw[hh] + lb_[hh];
                O[(size_t)row * DM + ch] = (bf16_t)f2bf((gn + bn[hh] * bf2f(xv[hh])) * bf2f(xg[hh]));
            }
        }
    }
}

#define XB_TMO      128
#define XB_XCNT(j)  (256  + 64 * (j))
#define XB_XSUB(j)  (1280 + 64 * (j))
#define XB_XGEN(j)  (2304 + 64 * (j))
#define XB_TOP      3328
#define XB_TOPGEN   3392
#define XCD_BAR_WORDS 3456
#define XB_SPIN_CAP (1u << 18)
constexpr size_t WS_BAR = WS_MISC + 1 * MiB;
__device__ __forceinline__ unsigned xb_ld(unsigned* p)              { return __hip_atomic_load(p, __ATOMIC_RELAXED, __HIP_MEMORY_SCOPE_AGENT); }
__device__ __forceinline__ unsigned xb_add(unsigned* p, unsigned v) { return __hip_atomic_fetch_add(p, v, __ATOMIC_RELAXED, __HIP_MEMORY_SCOPE_AGENT); }
__device__ __forceinline__ unsigned xb_xcc_id() { return (unsigned)__builtin_amdgcn_s_getreg((3 << 11) | 20) & 0xFu; }
#define XB_SPIN(cond, bar) do { unsigned _sp = 0; while (cond) { __builtin_amdgcn_s_sleep(1); \
    if ((++_sp & 255u) == 0u) { if (xb_ld(&(bar)[XB_TMO])) break; if (_sp > XB_SPIN_CAP) { atomicAdd(&(bar)[XB_TMO], 1u); break; } } } } while (0)
struct XcdBarrier { unsigned* bar; unsigned x; volatile LAS unsigned* st; };
__device__ __forceinline__ XcdBarrier xcd_barrier_post(unsigned* bar, volatile LAS unsigned* st) {
    XcdBarrier b; b.bar = bar; b.x = xb_xcc_id(); b.st = st;
    if (threadIdx.x == 0) (void)xb_add(&bar[XB_XCNT(b.x)], 1u);
    return b;
}
__device__ __forceinline__ void xcd_barrier_complete(unsigned* bar, unsigned x, unsigned& nloc, unsigned& nx) {
    const unsigned G = gridDim.x * gridDim.y * gridDim.z;
    unsigned sum, cnt, mine, sp = 0u;
    for (;;) {
        sum = 0u; cnt = 0u; mine = 0u;
#pragma unroll
        for (unsigned j = 0; j < 16; ++j) { const unsigned c = xb_ld(&bar[XB_XCNT(j)]); sum += c; cnt += (c > 0u) ? 1u : 0u; mine = (j == x) ? c : mine; }
        if (sum == G) break;
        __builtin_amdgcn_s_sleep(1);
        if ((++sp & 255u) == 0u) { if (xb_ld(&bar[XB_TMO])) break; if (sp > XB_SPIN_CAP) { atomicAdd(&bar[XB_TMO], 1u); break; } }
    }
    nloc = mine > 0u ? mine : 1u; nx = cnt > 0u ? cnt : 1u;
}
__device__ __forceinline__ void xcd_barrier(const XcdBarrier& b) {
    asm volatile("s_waitcnt vmcnt(0)" ::: "memory");
    __syncthreads();
    if (threadIdx.x == 0) {
        unsigned* bar = b.bar;
        __builtin_amdgcn_s_waitcnt(0);
        unsigned nloc = b.st[0], nx = b.st[1];
        if (nloc == 0u) { xcd_barrier_complete(bar, b.x, nloc, nx); b.st[0] = nloc; b.st[1] = nx; }
        const unsigned old = xb_add(&bar[XB_XSUB(b.x)], 1u);
        const unsigned gen = old / nloc;
        if (old + 1u == (gen + 1u) * nloc) {
            __builtin_amdgcn_fence(__ATOMIC_RELEASE, "agent");
            asm volatile("s_waitcnt vmcnt(0)" ::: "memory");
            const unsigned og = xb_add(&bar[XB_TOP], 1u);
            const unsigned tg = og / nx;
            if (og + 1u == (tg + 1u) * nx) xb_add(&bar[XB_TOPGEN], 1u);
            else XB_SPIN(xb_ld(&bar[XB_TOPGEN]) == tg, bar);
            __builtin_amdgcn_fence(__ATOMIC_ACQUIRE, "agent");
            xb_add(&bar[XB_XGEN(b.x)], 1u);
            asm volatile("s_waitcnt vmcnt(0)" ::: "memory");
        } else {
            XB_SPIN(xb_ld(&bar[XB_XGEN(b.x)]) == gen, bar);
            __builtin_amdgcn_fence(__ATOMIC_ACQUIRE, "agent");
            asm volatile("s_waitcnt vmcnt(0)" ::: "memory");
        }
    }
    __syncthreads();
}

constexpr int NPH = 54;
__host__ __device__ inline int step_of(int ph) { const int si = (ph - 1) % 13; return si < 3 ? si : (si == 3 ? 12 : si - 1); }
__host__ __device__ inline bool phase_is_noop(int ph) {
    if (ph == 0 || ph == NPH - 1) return false;
    const int l = (ph - 1) / 13, st = step_of(ph);
    return st == 12 && (l % 3) != 2;
}

__global__ void __launch_bounds__(512, 2) mega(const Params pv) {
    extern __shared__ __attribute__((aligned(16))) unsigned char shm[];
    PPTR p = &pv;
    LAS unsigned char* lds = (LAS unsigned char*)shm;
    cg::grid_group grid = cg::this_grid();
    volatile LAS unsigned* xb_st = (volatile LAS unsigned*)(lds + 147440);
    if (threadIdx.x == 0) { xb_st[0] = 0u; xb_st[1] = 0u; }
    __syncthreads();
    const XcdBarrier xb = xcd_barrier_post((unsigned*)(pv.ws + WS_BAR), xb_st);
    const int ph_lo = p->ph_lo, ph_hi = p->ph_hi;
    for (int ph = ph_lo; ph < ph_hi; ++ph) {
        if (phase_is_noop(ph)) continue;
        float* mod = (float*)(p->ws + WS_MISC);
        bf16_t* W = (bf16_t*)(p->ws + WS_W);
        if (ph == 0) { pre_phase(lds, p); __syncthreads(); cvt_layer(lds, p, 0); }
        else if (ph == NPH - 1) { if (PHMASK & 2) final_phase(p->out, p->in[35]); }
        else {
            const int l = (ph - 1) / 13, st = step_of(ph), kind = l % 3, j = l / 3;
            const float* hin = (l == 0) ? p->in[0] : p->out;
            const float* modl = mod + (size_t)l * 4 * 6144;
            bf16_t* R1 = (bf16_t*)(p->ws + WS_R1);
            for (int rep = 0; rep < 1 + (((REPMASK >> st) & 1) & ((REPL >> l) & 1)); ++rep) {
            if (rep) grid.sync();
            if (!(PHMASK & (4 << st))) {} else if (st == 0) {
                if (l > 0) cvt_layer(lds, p, l);
                if (kind == 2) norm_phase<true>(hin, p->in[2] + (size_t)(l * 2 + 0) * 1024, modl, 0, R1, 2048);
                else norm_phase<false>(hin, p->in[2] + (size_t)(l * 2 + 0) * 1024, modl, 0, R1, 1024);
            } else if (st == 12) {
                prep_rwkv_elem(p);
            } else if (st == 2 && kind == 1) {
                prep_gla(lds, p);
            } else if (st == 2 && kind == 0) {
                prep_delta(lds, p, j);
            } else if (st == 1 || st == 2 || st == 7 || st == 9) {
                pg8::EpiBf16S E; E.act = 0; const bf16_t* A; const bf16_t* Bt; int lda, N, K;
                if (st == 1) {
                    A = R1; Bt = W + W_IN / 2;
                    if (kind == 0) { E.O = (bf16_t*)(p->ws + WS_PROJ); E.ldc = 4352; lda = 1024; N = 4352; K = 1024; }
                    else if (kind == 1) { E.O = (bf16_t*)(p->ws + WS_PROJ); E.ldc = 4096; lda = 1024; N = 4096; K = 1024; }
                    else { E.O = (bf16_t*)(p->ws + WS_PROJC); E.ldc = 3328; E.act = 1; lda = 2048; N = 3328; K = 2048; }
                } else if (st == 2) {
                    A = (const bf16_t*)(p->ws + WS_PROJC) + 3072; Bt = W + W_L2 / 2; E.O = R1; E.ldc = 3072; lda = 3328; N = 3072; K = 256;
                } else {
                    const int g = (st == 9);
                    A = R1; Bt = W + W_UP / 2 + (size_t)(g ? 3072 : 0) * 1024; N = g ? 2560 : 3072; E.O = (bf16_t*)(p->ws + WS_HID); E.ldc = N; lda = 1024; K = 1024;
                }
                run_gemm(lds, A, lda, Bt, N, K, E);
            } else if (st == 5 || st == 11) {
                pg8::EpiRes E; const bf16_t* A; const bf16_t* Bt; int lda, K;
                if (st == 5) { E.res = hin; E.out = p->out; E.gate = modl + 2 * 1024; A = (const bf16_t*)(p->ws + (kind != 0 ? WS_OC : WS_PROJ)); lda = (kind == 0) ? 4352 : 1024; Bt = W + W_OUT / 2; K = 1024; }
                else { E.res = p->out; E.out = p->out; E.gate = modl + 5 * 1024; A = (const bf16_t*)(p->ws + WS_ACT); lda = 2816; Bt = W + W_DN / 2; K = 2816; }
                run_gemm(lds, A, lda, Bt, 1024, K, E);
            } else if (st == 3) {
                if (kind == 0) scan_chunked<0>(lds, p, j); else if (kind == 1) scan_chunked<1>(lds, p, j); else scan_rwkv(lds, p);
            } else if (st == 4) {
                if (kind == 0) post_phase<0>(p, j); else if (kind == 1) post_phase<1>(p, j); else post_phase<2>(p, j);
            } else if (st == 6) {
                norm_phase<false>(p->out, p->in[2] + (size_t)(l * 2 + 1) * 1024, modl, 3, R1, 1024);
            } else if (st == 8 || st == 10) {
                const int g = (st == 10);
                convglu_phase((const bf16_t*)(p->ws + WS_HID), (bf16_t*)(p->ws + WS_ACT), g, p->in[32] + (size_t)l * 3 * 5632, p->in[33] + (size_t)l * 5632);
            }
            }
        }
        if (ph + 1 < ph_hi) { if (ph == ph_lo) grid.sync(); else xcd_barrier(xb); }
    }
}

extern "C" void kernel_launch(void* const* d_in, const int* in_sizes, int n_in, void* d_out, int out_size, void* d_ws, size_t ws_size, hipStream_t stream) {
    constexpr int LDS_BYTES = 144 * 1024;
    static int grid_blocks = 0;
    if (!grid_blocks) {
        int dev = 0, cus = 0, per_cu = 0;
        hipGetDevice(&dev);
        hipDeviceGetAttribute(&cus, hipDeviceAttributeMultiprocessorCount, dev);
        if (hipFuncSetAttribute((const void*)mega, hipFuncAttributeMaxDynamicSharedMemorySize, LDS_BYTES) != hipSuccess) fprintf(stderr, "hipFuncSetAttribute failed\n");
        hipOccupancyMaxActiveBlocksPerMultiprocessor(&per_cu, (const void*)mega, 512, LDS_BYTES);
        if (per_cu < 1) per_cu = 1;
        if (per_cu > 1) per_cu = 1;
        grid_blocks = cus * per_cu;
        if (ws_size < 512 * MiB) fprintf(stderr, "workspace too small: %zu\n", ws_size);
    }
    (void)hipMemsetAsync((char*)d_ws + WS_BAR, 0, XCD_BAR_WORDS * sizeof(unsigned), stream);
    Params p{};
    for (int i = 0; i < 36; ++i) p.in[i] = (const float*)d_in[i];
    p.out = (float*)d_out; p.ws = (unsigned char*)d_ws;
#if SINGLE_LAUNCH
    p.ph_lo = 0; p.ph_hi = NPH;
    void* args[] = {&p};
    hipError_t e = hipLaunchCooperativeKernel((const void*)mega, dim3(grid_blocks), dim3(512), args, LDS_BYTES, stream);
    if (e != hipSuccess) fprintf(stderr, "cooperative launch failed: %s (grid %d)\n", hipGetErrorString(e), grid_blocks);
#else
    for (int ph = 0; ph < NPH; ++ph) {
        if (phase_is_noop(ph)) continue;
        p.ph_lo = ph; p.ph_hi = ph + 1;
        hipLaunchKernelGGL(mega, dim3(grid_blocks), dim3(512), LDS_BYTES, stream, p);
    }
#endif
}
```

```cpp
#include <hip/hip_runtime.h>
#include <hip/hip_cooperative_groups.h>
#include <cstdio>
namespace cg = cooperative_groups;

#ifndef PHMASK
#define PHMASK 0xFFFFFF
#endif
#ifndef REPMASK
#define REPMASK 0
#endif
#ifndef REPL
#define REPL 0xF
#endif
#ifndef SINGLE_LAUNCH
#define SINGLE_LAUNCH 1
#endif

#define LAS __attribute__((address_space(3)))
typedef unsigned short bf16_t;
typedef short bf16x8 __attribute__((ext_vector_type(8)));
typedef float f32x4 __attribute__((ext_vector_type(4)));
typedef float f32x2 __attribute__((ext_vector_type(2)));
typedef unsigned u32x4 __attribute__((ext_vector_type(4)));
typedef unsigned u32x2 __attribute__((ext_vector_type(2)));

constexpr int MROWS = 32768, SEQ = 8192, DM = 1024;
constexpr size_t MiB = 1ull << 20;
constexpr size_t WS_W = 0;
constexpr size_t W_IN = 0, W_L2 = 13 * MiB, W_OUT = 15 * MiB, W_UP = 17 * MiB, W_DN = 28 * MiB;
constexpr size_t WS_MISC = 34 * MiB;
constexpr size_t WS_R1 = 36 * MiB;
constexpr size_t WS_PROJ = 164 * MiB;
constexpr size_t WS_PROJC = 228 * MiB;
constexpr size_t WS_OC = 436 * MiB;
constexpr size_t WS_HID = 100 * MiB;
constexpr size_t WS_ACT = 292 * MiB;

struct Params {
    const float* in[36];
    float* out;
    unsigned char* ws;
    int ph_lo, ph_hi;
};
typedef const Params* PPTR;

__device__ __forceinline__ float bf2f(unsigned v) { return __uint_as_float(v << 16); }
__device__ __forceinline__ float bflo(unsigned v) { return __uint_as_float(v << 16); }
__device__ __forceinline__ float bfhi(unsigned v) { return __uint_as_float(v & 0xffff0000u); }
typedef __bf16 bf16v2 __attribute__((ext_vector_type(2)));
__device__ __forceinline__ unsigned pack2(float lo, float hi) { const f32x2 v = {lo, hi}; const bf16v2 r = __builtin_convertvector(v, bf16v2); return __builtin_bit_cast(unsigned, r); }
__device__ __forceinline__ unsigned f2bf(float f) { return pack2(f, 0.f) & 0xffffu; }
__device__ __forceinline__ float sigmoidf_(float x) { return __builtin_amdgcn_rcpf(1.0f + __expf(-x)); }
__device__ __forceinline__ float siluf_(float x) { return x * __builtin_amdgcn_rcpf(1.0f + __expf(-x)); }
__device__ __forceinline__ float softplusf_(float x) { return x > 15.0f ? x : __logf(1.0f + __expf(x)); }
template <int CTRL> __device__ __forceinline__ float dpp_f(float x) { return __int_as_float(__builtin_amdgcn_update_dpp(0, __float_as_int(x), CTRL, 0xf, 0xf, false)); }
__device__ __forceinline__ float rowred16(float x) { x += dpp_f<0x128>(x); x += dpp_f<0x124>(x); x += dpp_f<0x122>(x); x += dpp_f<0x121>(x); return x; }
__device__ __forceinline__ float wave_allsum(float v) {
    float r = rowred16(v);
    r += __int_as_float(__builtin_amdgcn_update_dpp(0, __float_as_int(r), 0x142, 0xa, 0xf, false));
    r += __int_as_float(__builtin_amdgcn_update_dpp(0, __float_as_int(r), 0x143, 0xc, 0xf, false));
    return __int_as_float(__builtin_amdgcn_readlane(__float_as_int(r), 63));
}
struct StepRegs { f32x4 a, b, c, d, e; float vr, x0, x1; };
template <int KIND> __device__ __forceinline__ void step_load(StepRegs& r, LAS const float* rec, int li, int row) {
    r.a = *(LAS const f32x4*)(rec + 4 * li); r.b = *(LAS const f32x4*)(rec + 64 + 4 * li); r.c = *(LAS const f32x4*)(rec + 128 + 4 * li); r.d = *(LAS const f32x4*)(rec + 192 + 4 * li);
    if (KIND == 0) { r.vr = rec[256 + row]; r.x0 = rec[272]; r.x1 = rec[273]; }
    else if (KIND == 1) { r.vr = rec[256 + row]; }
    else { r.e = *(LAS const f32x4*)(rec + 256 + 4 * li); r.vr = rec[320 + row]; }
}
template <int KIND> __device__ __forceinline__ float step_compute(const StepRegs& r, f32x2 (&s)[4]) {
    if (KIND == 0) {
        const f32x2 k[4] = {{r.a[0], r.a[1]}, {r.a[2], r.a[3]}, {r.b[0], r.b[1]}, {r.b[2], r.b[3]}};
        const f32x2 q[4] = {{r.c[0], r.c[1]}, {r.c[2], r.c[3]}, {r.d[0], r.d[1]}, {r.d[2], r.d[3]}};
        f32x2 pa = s[0] * k[0] + s[1] * k[1]; const f32x2 pb = s[2] * k[2] + s[3] * k[3]; pa += pb;
        const float pp = rowred16(pa.x + pa.y);
        const float cc = r.x0 * (r.vr - r.x1 * pp);
        const f32x2 eg2 = {r.x1, r.x1}, cc2 = {cc, cc};
#pragma unroll
        for (int i = 0; i < 4; ++i) s[i] = s[i] * eg2 + cc2 * k[i];
        f32x2 oa = s[0] * q[0] + s[1] * q[1]; const f32x2 ob = s[2] * q[2] + s[3] * q[3]; oa += ob;
        return rowred16(oa.x + oa.y);
    } else if (KIND == 1) {
        const f32x2 q[4] = {{r.a[0], r.a[1]}, {r.a[2], r.a[3]}, {r.b[0], r.b[1]}, {r.b[2], r.b[3]}};
        const f32x2 f[4] = {{r.c[0], r.c[1]}, {r.c[2], r.c[3]}, {r.d[0], r.d[1]}, {r.d[2], r.d[3]}};
        const f32x2 v2 = {r.vr, r.vr};
#pragma unroll
        for (int i = 0; i < 4; ++i) s[i] = s[i] * f[i] + v2 * (1.0f - f[i]);
        f32x2 oa = s[0] * q[0] + s[1] * q[1]; const f32x2 ob = s[2] * q[2] + s[3] * q[3]; oa += ob;
        return rowred16(oa.x + oa.y);
    } else {
        const f32x2 a2[2] = {{r.a[0], r.a[1]}, {r.a[2], r.a[3]}}, b2[2] = {{r.b[0], r.b[1]}, {r.b[2], r.b[3]}}, d2[2] = {{r.c[0], r.c[1]}, {r.c[2], r.c[3]}};
        const f32x2 k2[2] = {{r.d[0], r.d[1]}, {r.d[2], r.d[3]}}, r2[2] = {{r.e[0], r.e[1]}, {r.e[2], r.e[3]}};
        const f32x2 pa = s[0] * a2[0] + s[1] * a2[1];
        const float sa = rowred16(pa.x + pa.y);
        const f32x2 sa2 = {sa, sa}, v2 = {r.vr, r.vr};
        s[0] = s[0] * d2[0] + sa2 * b2[0] + v2 * k2[0]; s[1] = s[1] * d2[1] + sa2 * b2[1] + v2 * k2[1];
        const f32x2 oa = s[0] * r2[0] + s[1] * r2[1];
        return rowred16(oa.x + oa.y);
    }
}
__device__ __forceinline__ int tidx() { int t = threadIdx.x; asm volatile("" : "+v"(t)); return t; }
__device__ __forceinline__ int bidx() { int t = blockIdx.x; asm volatile("" : "+s"(t)); return t; }
__device__ __forceinline__ int gdim() { int t = gridDim.x; asm volatile("" : "+s"(t)); return t; }
__device__ __forceinline__ void lds_barrier() { asm volatile("s_waitcnt lgkmcnt(0)" ::: "memory"); __builtin_amdgcn_s_barrier(); asm volatile("" ::: "memory"); }

namespace pg8 {
constexpr int BM = 256, BK = 64, HALF = 128, HTB = HALF * BK * 2, STAGE_BYTES = 8 * HTB, NXCD = 8, WGM = 8;
__device__ __forceinline__ int lds_byte(int r, int c) { const int st = (r >> 4) * 2 + (c >> 5), rr = r & 15, cc = c & 31, ob = rr * 64 + cc * 2; return st * 1024 + (ob ^ (((ob >> 9) & 1) << 5)); }
__device__ __forceinline__ void stage_rc(int b, int& R, int& C) { const int st = b / 1024, sb = b % 1024, swz = sb ^ (((sb >> 9) & 1) << 5); R = (st >> 1) * 16 + swz / 64; C = (st & 1) * 32 + (swz % 64) / 2; }
__device__ __forceinline__ int perm32(int rho) { const int n = rho >> 4, i = rho & 15; return 8 * (i >> 2) + 4 * n + (i & 3); }
struct Unit { int pm, pn; };
struct Gemm { const bf16_t* A; const bf16_t* Bt; int M, N, K, lda; };
struct StaticOrder {
    int nM, nN, nwg, G, c;
    __device__ void init(int M, int N, int G_, int c_) { nM = M / BM; nN = N / BM; nwg = nM * nN; G = G_; c = c_; }
    __device__ bool next(int i, Unit& u) const {
        const long L = (long)i * G + c; if (L >= nwg) return false;
        int wgid = (int)L; { const int q = nwg / NXCD, r = nwg % NXCD, xcd = wgid % NXCD, off = wgid / NXCD; wgid = (xcd < r ? xcd * (q + 1) : r * (q + 1) + (xcd - r) * q) + off; }
        const int nig = WGM * nN, gid = wgid / nig, fm = gid * WGM, gsz = (nM - fm) < WGM ? (nM - fm) : WGM;
        u.pm = fm + ((wgid % nig) % gsz); u.pn = (wgid % nig) / gsz; return true;
    }
};
__device__ __forceinline__ unsigned cvt_pk_bf16(float lo, float hi) { return pack2(lo, hi); }

struct EpiBf16S {
    static constexpr bool PERM = true;
    bf16_t* O; int ldc; int act;
    __device__ __forceinline__ void operator()(const f32x4 (&acc)[2][2][4][2], const Unit& u, int wr, int wc, int fr, int fq) const {
        const int row0 = u.pm * BM + wr * 64 + fr; const int col0 = u.pn * BM + wc * 32 + 8 * fq;
#pragma unroll
        for (int ai = 0; ai < 2; ++ai)
#pragma unroll
            for (int m = 0; m < 4; ++m) { bf16_t* rowp = O + (size_t)(row0 + ai * HALF + m * 16) * ldc + col0;
#pragma unroll
                for (int bj = 0; bj < 2; ++bj) { f32x4 v0 = acc[ai][bj][m][0], v1 = acc[ai][bj][m][1];
                    if (act) { const int c = col0 + bj * HALF;
                        if (c >= 3072 && c < 3136) {
#pragma unroll
                            for (int j = 0; j < 4; ++j) { v0[j] = 1.0f - 2.0f * __builtin_amdgcn_rcpf(1.0f + __expf(2.0f * v0[j])); v1[j] = 1.0f - 2.0f * __builtin_amdgcn_rcpf(1.0f + __expf(2.0f * v1[j])); } }
                        else if (c >= 3200) {
#pragma unroll
                            for (int j = 0; j < 4; ++j) { v0[j] = sigmoidf_(v0[j]); v1[j] = sigmoidf_(v1[j]); } } }
                    u32x4 w; w.x = cvt_pk_bf16(v0[0], v0[1]); w.y = cvt_pk_bf16(v0[2], v0[3]); w.z = cvt_pk_bf16(v1[0], v1[1]); w.w = cvt_pk_bf16(v1[2], v1[3]);
                    *(u32x4*)(rowp + bj * HALF) = w; } }
    }
};
struct EpiRes {
    static constexpr bool PERM = false;
    const float* res; float* out; const float* gate;
    __device__ __forceinline__ void operator()(const f32x4 (&acc)[2][2][4][2], const Unit& u, int wr, int wc, int fr, int fq) const {
        const int row0 = u.pm * BM + wr * 64 + fr, col0 = u.pn * BM + wc * 32 + 4 * fq; const int b = (u.pm * BM) / SEQ;
        f32x4 gv[2][2];
#pragma unroll
        for (int bj = 0; bj < 2; ++bj)
#pragma unroll
            for (int n = 0; n < 2; ++n) gv[bj][n] = *(const f32x4*)(gate + (size_t)b * 6144 + col0 + bj * HALF + n * 16);
#pragma unroll
        for (int ai = 0; ai < 2; ++ai)
#pragma unroll
            for (int mp = 0; mp < 2; ++mp) {
                f32x4 r[2][2][2];
#pragma unroll
                for (int mm = 0; mm < 2; ++mm) { const size_t off = (size_t)(row0 + ai * HALF + (2 * mp + mm) * 16) * DM + col0;
#pragma unroll
                    for (int bj = 0; bj < 2; ++bj)
#pragma unroll
                        for (int n = 0; n < 2; ++n) r[mm][bj][n] = *(const f32x4*)(res + off + bj * HALF + n * 16); }
                __builtin_amdgcn_sched_barrier(0);
#pragma unroll
                for (int mm = 0; mm < 2; ++mm) { const size_t off = (size_t)(row0 + ai * HALF + (2 * mp + mm) * 16) * DM + col0;
#pragma unroll
                    for (int bj = 0; bj < 2; ++bj)
#pragma unroll
                        for (int n = 0; n < 2; ++n) *(f32x4*)(out + off + bj * HALF + n * 16) = r[mm][bj][n] + gv[bj][n] * acc[ai][bj][2 * mp + mm][n]; }
            }
    }
};

template <class Epi>
__device__ __forceinline__ void gemm_phase(LAS unsigned char* lds, const Gemm g, const StaticOrder& S, const Epi& E) {
    const int tid = tidx(), wid = __builtin_amdgcn_readfirstlane(tid >> 6), lane = tid & 63, wr = wid >> 2, wc = wid & 3, fr = lane & 15, fq = lane >> 4;
    const int K = g.K, nt = K / BK, lda = g.lda;
    unsigned voffA[2], voffB[2];
#pragma unroll
    for (int i = 0; i < 2; ++i) { int R, C; stage_rc(tid * 16 + i * 8192, R, C); const int Rb = Epi::PERM ? ((R & ~31) + perm32(R & 31)) : R;
        voffA[i] = (unsigned)(R * lda + C) * 2u; voffB[i] = (unsigned)(Rb * K + C) * 2u; }
    const size_t kstep = (size_t)(BK * 2);
    const size_t hstepA = (size_t)HALF * lda * 2, hstepB = (size_t)HALF * K * 2;
    const size_t tstepA = 2 * hstepA, tstepB = 2 * hstepB;
    const unsigned ldsw = (unsigned)wid * 1024u;
    const int aoff = lds_byte(wr * 64 + fr, fq * 8), boff = lds_byte(wc * 32 + fr, fq * 8);
#define PG8_SA(b, h) (((b) * 2 + (h)) * HTB)
#define PG8_SB(b, h) ((4 + (b) * 2 + (h)) * HTB)
#define PG8_STAGE(bufoff, gbase, voff) do { _Pragma("unroll") for (int _i = 0; _i < 2; ++_i) \
        __builtin_amdgcn_global_load_lds((const unsigned*)((const char*)(gbase) + (voff)[_i]), (LAS unsigned*)(lds + (bufoff) + ldsw + _i * 8192), 16, 0, 0); } while (0)
#define PG8_LDA(dst, b, h) do { _Pragma("unroll") for (int m = 0; m < 4; ++m) _Pragma("unroll") for (int k = 0; k < 2; ++k) dst[m][k] = *(const LAS bf16x8*)(lds + PG8_SA(b, h) + aoff + m * 2048 + k * 1024); } while (0)
#define PG8_LDB(dst, b, h) do { _Pragma("unroll") for (int n = 0; n < 2; ++n) _Pragma("unroll") for (int k = 0; k < 2; ++k) dst[n][k] = *(const LAS bf16x8*)(lds + PG8_SB(b, h) + boff + n * 2048 + k * 1024); } while (0)
#define PG8_MMA(ai, bj, At, Bt) do { __builtin_amdgcn_s_setprio(1); _Pragma("unroll") for (int m = 0; m < 4; ++m) _Pragma("unroll") for (int n = 0; n < 2; ++n) _Pragma("unroll") for (int k = 0; k < 2; ++k) \
        acc[ai][bj][m][n] = __builtin_amdgcn_mfma_f32_16x16x32_bf16(Bt[n][k], At[m][k], acc[ai][bj][m][n], 0, 0, 0); __builtin_amdgcn_s_setprio(0); } while (0)
#define PG8_WAIT_V(n) asm volatile("s_waitcnt vmcnt(" #n ")" ::: "memory")
#define PG8_WAIT_L(n) asm volatile("s_waitcnt lgkmcnt(" #n ")" ::: "memory")
#define PG8_BAR __builtin_amdgcn_s_barrier()
#define PG8_SCHED __builtin_amdgcn_sched_barrier(0)
    Unit cur, nxt; int ui = 0;
    if (!S.next(0, cur)) return;
    f32x4 acc[2][2][4][2];
#pragma unroll
    for (int a = 0; a < 2; ++a)
#pragma unroll
        for (int b = 0; b < 2; ++b)
#pragma unroll
            for (int m = 0; m < 4; ++m)
#pragma unroll
                for (int n = 0; n < 2; ++n) acc[a][b][m][n] = (f32x4){0.f, 0.f, 0.f, 0.f};
    bf16x8 At[4][2], B0[2][2], B1[2][2];
    const char* cA = (const char*)g.A + (size_t)cur.pm * tstepA; const char* cB = (const char*)g.Bt + (size_t)cur.pn * tstepB;
    PG8_STAGE(PG8_SB(0, 0), cB, voffB); PG8_STAGE(PG8_SA(0, 0), cA, voffA); PG8_STAGE(PG8_SB(0, 1), cB + hstepB, voffB); PG8_STAGE(PG8_SA(0, 1), cA + hstepA, voffA);
    if (wr == 1) PG8_BAR;
    PG8_WAIT_V(4); PG8_BAR;
    PG8_STAGE(PG8_SB(1, 0), cB + kstep, voffB); PG8_STAGE(PG8_SA(1, 0), cA + kstep, voffA); PG8_STAGE(PG8_SB(1, 1), cB + hstepB + kstep, voffB);
    PG8_WAIT_V(6); PG8_BAR;
    for (;;) {
        const bool has_next = S.next(ui + 1, nxt);
        const char* nA = has_next ? (const char*)g.A + (size_t)nxt.pm * tstepA : cA; const char* nB = has_next ? (const char*)g.Bt + (size_t)nxt.pn * tstepB : cB;
        for (int t = 0; t < nt; t += 2) {
            const bool last = (t == nt - 2);
            const char* a1 = cA + (size_t)(t + 1) * kstep;
            const char* a2 = last ? nA : cA + (size_t)(t + 2) * kstep; const char* b2 = last ? nB : cB + (size_t)(t + 2) * kstep;
            const char* a3 = a2 + kstep; const char* b3 = b2 + kstep;
            PG8_LDB(B0, 0, 0); PG8_SCHED; PG8_LDA(At, 0, 0); PG8_STAGE(PG8_SA(1, 1), a1 + hstepA, voffA);
            PG8_WAIT_L(8); PG8_BAR; PG8_WAIT_L(0); PG8_MMA(0, 0, At, B0); PG8_BAR; PG8_SCHED;
            PG8_LDB(B1, 0, 1); PG8_STAGE(PG8_SB(0, 0), b2, voffB);
            PG8_BAR; PG8_WAIT_L(0); PG8_MMA(0, 1, At, B1); PG8_BAR;
            PG8_LDA(At, 0, 1); PG8_STAGE(PG8_SA(0, 0), a2, voffA);
            PG8_BAR; PG8_WAIT_L(0); PG8_MMA(1, 0, At, B0); PG8_BAR; PG8_SCHED;
            PG8_STAGE(PG8_SB(0, 1), b2 + hstepB, voffB);
            PG8_WAIT_V(6); PG8_BAR; PG8_MMA(1, 1, At, B1); PG8_BAR;
            PG8_LDB(B0, 1, 0); PG8_SCHED; PG8_LDA(At, 1, 0); PG8_STAGE(PG8_SA(0, 1), a2 + hstepA, voffA);
            PG8_WAIT_L(8); PG8_BAR; PG8_WAIT_L(0); PG8_MMA(0, 0, At, B0); PG8_BAR; PG8_SCHED;
            PG8_LDB(B1, 1, 1); PG8_STAGE(PG8_SB(1, 0), b3, voffB);
            PG8_BAR; PG8_WAIT_L(0); PG8_MMA(0, 1, At, B1); PG8_BAR;
            PG8_LDA(At, 1, 1); PG8_STAGE(PG8_SA(1, 0), a3, voffA);
            PG8_BAR; PG8_WAIT_L(0); PG8_MMA(1, 0, At, B0); PG8_BAR; PG8_SCHED;
            PG8_STAGE(PG8_SB(1, 1), b3 + hstepB, voffB);
            PG8_WAIT_V(6); PG8_BAR; PG8_MMA(1, 1, At, B1); PG8_BAR;
        }
        E(acc, cur, wr, wc, fr, fq);
        if (!has_next) break;
#pragma unroll
        for (int a = 0; a < 2; ++a)
#pragma unroll
            for (int b = 0; b < 2; ++b)
#pragma unroll
                for (int m = 0; m < 4; ++m)
#pragma unroll
                    for (int n = 0; n < 2; ++n) acc[a][b][m][n] = (f32x4){0.f, 0.f, 0.f, 0.f};
        cur = nxt; cA = nA; cB = nB; ++ui;
    }
    PG8_WAIT_V(0);
    if (wr == 0) PG8_BAR;
    PG8_BAR;
#undef PG8_SA
#undef PG8_SB
#undef PG8_STAGE
#undef PG8_LDA
#undef PG8_LDB
#undef PG8_MMA
#undef PG8_WAIT_V
#undef PG8_WAIT_L
#undef PG8_BAR
#undef PG8_SCHED
}
}

template <class Epi>
__device__ __forceinline__ void run_gemm(LAS unsigned char* lds, const bf16_t* A, int lda, const bf16_t* Bt, int N, int K, const Epi& E) {
    pg8::Gemm g; g.A = A; g.Bt = Bt; g.M = MROWS; g.N = N; g.K = K; g.lda = lda;
    pg8::StaticOrder S; S.init(MROWS, N, (int)gdim(), (int)bidx());
    pg8::gemm_phase<Epi>(lds, g, S, E);
}

__device__ __forceinline__ void cvt_job(LAS float* tile, bf16_t* dst, int ldd, const float* src, int srcN, int nK, int nNdst, int nNsrc, const float* scale, int noff) {
    const int tid = tidx(); const int tilesK = nK / 64, tilesN = nNdst / 64, ntl = tilesK * tilesN, G = gdim();
    const int kr = tid >> 6, nn = tid & 63;
    for (int tl0 = bidx(); tl0 < ntl; tl0 += 2 * G) {
        float v[2][8];
#pragma unroll
        for (int u = 0; u < 2; ++u) { const int tl = tl0 + u * G; const bool tv = tl < ntl; const int tk = tv ? tl % tilesK : 0, tn = tv ? tl / tilesK : 0, k0 = tk * 64, n = tn * 64 + nn;
            const bool ld_ = tv && src && n < nNsrc;
            float scv[8];
#pragma unroll
            for (int ps = 0; ps < 8; ++ps) scv[ps] = (ld_ && scale) ? scale[k0 + ps * 8 + kr] : 1.0f;
#pragma unroll
            for (int ps = 0; ps < 8; ++ps) { const int kk = ps * 8 + kr; v[u][ps] = ld_ ? src[(size_t)(k0 + kk) * srcN + noff + n] : 0.f; }
#pragma unroll
            for (int ps = 0; ps < 8; ++ps) v[u][ps] *= scv[ps]; }
#pragma unroll
        for (int u = 0; u < 2; ++u)
#pragma unroll
            for (int ps = 0; ps < 8; ++ps) tile[u * 4160 + (ps * 8 + kr) * 65 + nn] = v[u][ps];
        __syncthreads();
#pragma unroll
        for (int u = 0; u < 2; ++u) { const int tl = tl0 + u * G;
            if (tl < ntl) { const int tk = tl % tilesK, tn = tl / tilesK, k0 = tk * 64, n0 = tn * 64;
#pragma unroll
                for (int ps = 0; ps < 4; ++ps) { const int kk2 = tid & 31, n2 = (tid >> 5) + 16 * ps;
                    const unsigned w = pack2(tile[u * 4160 + (2 * kk2) * 65 + n2], tile[u * 4160 + (2 * kk2 + 1) * 65 + n2]);
                    *(unsigned*)(dst + (size_t)(n0 + n2) * ldd + k0 + 2 * kk2) = w; } } }
        __syncthreads();
    }
}

__device__ __forceinline__ void cvt_layer(LAS unsigned char* lds, PPTR p, int layer) {
    LAS float* tile = (LAS float*)lds;
    bf16_t* W = (bf16_t*)(p->ws + WS_W);
    bf16_t* w_in = W + W_IN / 2; bf16_t* w_l2 = W + W_L2 / 2; bf16_t* w_out = W + W_OUT / 2; bf16_t* w_up = W + W_UP / 2; bf16_t* w_dn = W + W_DN / 2;
    const int kind = layer % 3, j = layer / 3;
    const int nmix = (kind == 2) ? 20 : 2;
    for (int jb = 0; jb < nmix + 5; ++jb) {
        bf16_t* dst = w_in; int ldd = 1024; const float* src = nullptr; int srcN = 1024, nK = 1024, nNdst = 1024, nNsrc = 1024, noff = 0; const float* scale = nullptr;
        if (jb >= nmix) {
            const int f = jb - nmix;
            if (f < 4) { const int g = f >> 1, gate = f & 1; const int nch = g ? 1280 : 1536, ch0 = g ? 1536 : 0;
                dst = w_up + (size_t)((g ? 3072 : 0) + nch * gate) * 1024; src = p->in[31] + (size_t)layer * 1024 * 5632; srcN = 5632; nNdst = nch; nNsrc = nch; noff = 2816 * gate + ch0; }
            else { dst = w_dn; ldd = 2816; src = p->in[34] + (size_t)layer * 2816 * 1024; nK = 2816; }
        } else if (kind == 0) {
            if (jb == 0) { src = p->in[5] + (size_t)j * 1024 * 4112; srcN = 4112; nNdst = 4352; nNsrc = 4112; }
            else { dst = w_out; src = p->in[10] + (size_t)j * 1024 * 1024; }
        } else if (kind == 1) {
            if (jb == 0) { src = p->in[11]; srcN = 4096; nNdst = 4096; nNsrc = 4096; }
            else { dst = w_out; src = p->in[14]; }
        } else {
            const float* mu = p->in[15];
            if (jb < 6) { const int sI = jb >> 1, hi = jb & 1; const int mi = (sI == 0) ? 0 : (sI == 1 ? 2 : 3);
                dst = w_in + (size_t)sI * 1024 * 2048 + hi * 1024; ldd = 2048; src = p->in[16] + (size_t)sI * 1024 * 1024; if (hi) scale = mu + mi * 1024; }
            else if (jb < 12) { const int q = (jb - 6) >> 1, hi = jb & 1;
                const int rowo = (q == 0) ? 3072 : (q == 1 ? 3136 : 3200); const int nc = (q == 2) ? 128 : 64; const int mi = (q == 0) ? 1 : (q == 1 ? 4 : 5);
                dst = w_in + (size_t)rowo * 2048 + hi * 1024; ldd = 2048; src = (q == 0) ? p->in[18] : (q == 1 ? p->in[21] : p->in[23]); srcN = nc; nNdst = nc; nNsrc = nc; if (hi) scale = mu + mi * 1024; }
            else if (jb < 19) { ldd = 256; nNdst = 1024; nNsrc = 1024;
                const int q = jb - 12;
                if (q == 0) { dst = w_l2; src = p->in[19]; nK = 64; }
                else if (q == 1) { dst = w_l2 + 64; nK = 192; }
                else if (q == 2) { dst = w_l2 + (size_t)1024 * 256; nK = 64; }
                else if (q == 3) { dst = w_l2 + (size_t)1024 * 256 + 64; src = p->in[22]; nK = 64; }
                else if (q == 4) { dst = w_l2 + (size_t)1024 * 256 + 128; nK = 128; }
                else if (q == 5) { dst = w_l2 + (size_t)2048 * 256; nK = 128; }
                else { dst = w_l2 + (size_t)2048 * 256 + 128; src = p->in[24]; nK = 128; } }
            else { dst = w_out; src = p->in[30]; }
        }
        cvt_job(tile, dst, ldd, src, srcN, nK, nNdst, nNsrc, scale, noff);
    }
}

template <bool SHIFT>
__device__ __forceinline__ void norm_phase(const float* h, const float* g, const float* modl, int s_shift, bf16_t* U, int ldu) {
    const int lane = tidx() & 63, wave = tidx() >> 6;
    const int gw = bidx() * 8 + wave, nw = gdim() * 8;
    constexpr int RU = SHIFT ? 2 : 4;
    f32x4 gg4[4];
#pragma unroll
    for (int i = 0; i < 4; ++i) gg4[i] = *(const f32x4*)(g + i * 256 + lane * 4);
    for (int row0 = gw; row0 < MROWS; row0 += nw * RU) {
        const int b0 = row0 >> 13;
        f32x4 gs0[4], sh0[4];
#pragma unroll
        for (int i = 0; i < 4; ++i) { const int c = i * 256 + lane * 4; const float* shp = modl + (size_t)b0 * 6144 + s_shift * 1024;
            gs0[i] = gg4[i] * (1.0f + *(const f32x4*)(shp + 1024 + c)); sh0[i] = *(const f32x4*)(shp + c); }
        f32x4 x[RU][4], xp[RU][4];
#pragma unroll
        for (int q = 0; q < RU; ++q) { const int row = row0 + q * nw;
            if (row < MROWS) {
#pragma unroll
                for (int i = 0; i < 4; ++i) x[q][i] = *(const f32x4*)(h + (size_t)row * DM + i * 256 + lane * 4);
                if (SHIFT) { const size_t prow = ((row & (SEQ - 1)) > 0) ? (size_t)(row - 1) : (size_t)row;
#pragma unroll
                    for (int i = 0; i < 4; ++i) xp[q][i] = *(const f32x4*)(h + prow * DM + i * 256 + lane * 4); } } }
#pragma unroll
        for (int q = 0; q < RU; ++q) { const int row = row0 + q * nw;
            if (row < MROWS) {
                const int b = row >> 13, t = row & (SEQ - 1);
                const float* sh = modl + (size_t)b * 6144 + s_shift * 1024; const float* sc = sh + 1024;
                float ss = 0.f;
#pragma unroll
                for (int i = 0; i < 4; ++i) ss += x[q][i][0] * x[q][i][0] + x[q][i][1] * x[q][i][1] + x[q][i][2] * x[q][i][2] + x[q][i][3] * x[q][i][3];
                ss = wave_allsum(ss); const float rstd = __builtin_amdgcn_rsqf(ss * (1.0f / 1024.0f) + 1e-6f);
                float rstdp = 0.f;
                if (SHIFT) { float ssp = 0.f;
#pragma unroll
                    for (int i = 0; i < 4; ++i) ssp += xp[q][i][0] * xp[q][i][0] + xp[q][i][1] * xp[q][i][1] + xp[q][i][2] * xp[q][i][2] + xp[q][i][3] * xp[q][i][3];
                    ssp = wave_allsum(ssp); rstdp = __builtin_amdgcn_rsqf(ssp * (1.0f / 1024.0f) + 1e-6f); }
#pragma unroll
                for (int i = 0; i < 4; ++i) { const int c = i * 256 + lane * 4; f32x4 gs = gs0[i], s0 = sh0[i];
                    if (b != b0) { gs = gg4[i] * (1.0f + *(const f32x4*)(sc + c)); s0 = *(const f32x4*)(sh + c); }
                    const f32x4 u = x[q][i] * rstd * gs + s0;
                    u32x2 w; w.x = pack2(u[0], u[1]); w.y = pack2(u[2], u[3]); *(u32x2*)(U + (size_t)row * ldu + c) = w;
                    if (SHIFT) { f32x4 up = xp[q][i] * rstdp * gs + s0; if (t == 0) up = (f32x4){0.f, 0.f, 0.f, 0.f};
                        const f32x4 dx = up - u; u32x2 w2; w2.x = pack2(dx[0], dx[1]); w2.y = pack2(dx[2], dx[3]); *(u32x2*)(U + (size_t)row * ldu + 1024 + c) = w2; } }
            } }
    }
}

__device__ __forceinline__ void final_phase(float* h, const float* g) {
    const int lane = tidx() & 63, wave = tidx() >> 6;
    const int gw = bidx() * 8 + wave, nw = gdim() * 8;
    f32x4 gg4[4];
#pragma unroll
    for (int i = 0; i < 4; ++i) gg4[i] = *(const f32x4*)(g + i * 256 + lane * 4);
    for (int row0 = gw; row0 < MROWS; row0 += nw * 4) {
        f32x4 x[4][4];
#pragma unroll
        for (int q = 0; q < 4; ++q) { const int row = row0 + q * nw; if (row < MROWS) {
#pragma unroll
            for (int i = 0; i < 4; ++i) x[q][i] = *(const f32x4*)(h + (size_t)row * DM + i * 256 + lane * 4); } }
#pragma unroll
        for (int q = 0; q < 4; ++q) { const int row = row0 + q * nw; if (row < MROWS) {
            float ss = 0.f;
#pragma unroll
            for (int i = 0; i < 4; ++i) ss += x[q][i][0] * x[q][i][0] + x[q][i][1] * x[q][i][1] + x[q][i][2] * x[q][i][2] + x[q][i][3] * x[q][i][3];
            ss = wave_allsum(ss); const float rstd = __builtin_amdgcn_rsqf(ss * (1.0f / 1024.0f) + 1e-6f);
#pragma unroll
            for (int i = 0; i < 4; ++i) { const int c = i * 256 + lane * 4;
                *(f32x4*)(h + (size_t)row * DM + c) = x[q][i] * rstd * gg4[i]; } } }
    }
}

__device__ __forceinline__ void pre_phase(LAS unsigned char* lds, PPTR p) {
    LAS float* cond = (LAS float*)lds;
    LAS float* red = cond + 4096;
    const int tid = tidx(), lane = tid & 63, wave = tid >> 6;
    float* mod = (float*)(p->ws + WS_MISC); float* lb = mod + 4 * 4 * 6144;
    for (int i = tid; i < 4096; i += 512) cond[i] = siluf_(p->in[1][i]);
    __syncthreads();
    for (int task = bidx(); task < 384; task += gdim()) {
        const int l = task / 96, cb = task % 96, col = cb * 64 + lane;
        float a0 = 0.f, a1 = 0.f, a2 = 0.f, a3 = 0.f;
        const float* wp = p->in[3] + ((size_t)l * 1024 + wave * 128) * 6144 + col;
#pragma unroll 8
        for (int k = 0; k < 128; ++k) { const float wv = wp[(size_t)k * 6144]; const int kk = wave * 128 + k;
            a0 += cond[kk] * wv; a1 += cond[1024 + kk] * wv; a2 += cond[2048 + kk] * wv; a3 += cond[3072 + kk] * wv; }
        red[(wave * 4 + 0) * 64 + lane] = a0; red[(wave * 4 + 1) * 64 + lane] = a1; red[(wave * 4 + 2) * 64 + lane] = a2; red[(wave * 4 + 3) * 64 + lane] = a3;
        __syncthreads();
        if (tid < 256) { const int b = tid >> 6; float s = 0.f;
#pragma unroll
            for (int w = 0; w < 8; ++w) s += red[(w * 4 + b) * 64 + lane];
            mod[((size_t)l * 4 + b) * 6144 + col] = s + p->in[4][(size_t)l * 6144 + col]; }
        __syncthreads();
    }
    for (int c = bidx() * 512 + tid; c < 1024; c += gdim() * 512) {
        const float l0 = p->in[12][c], l1 = p->in[12][1024 + c], l2 = p->in[12][2048 + c], l3 = p->in[12][3072 + c];
        const float mx = fmaxf(fmaxf(l0, l1), fmaxf(l2, l3));
        const float e0 = __expf(l0 - mx), e1 = __expf(l1 - mx), e2 = __expf(l2 - mx), e3 = __expf(l3 - mx);
        lb[c] = e1 / (e0 + e1 + e2 + e3);
    }
}

__device__ __forceinline__ void convglu_phase(const bf16_t* HID, bf16_t* ACT, int g, const float* cw, const float* cb) {
    const int nch = g ? 1280 : 1536, ch0 = g ? 1536 : 0, ld = 2 * nch, ncg = nch / 8;
    const int total = (MROWS / 16) * ncg;
    for (int task = bidx() * 512 + tidx(); task < total; task += gdim() * 512) {
        const int cgi = task % ncg, run = task / ncg, row0 = run * 16, t0 = row0 & (SEQ - 1), j0 = cgi * 8, ch = ch0 + j0;
        float wv[3][8], wg[3][8], bv[8], bg[8];
#pragma unroll
        for (int k = 0; k < 3; ++k)
#pragma unroll
            for (int e = 0; e < 8; ++e) { wv[k][e] = cw[k * 5632 + ch + e]; wg[k][e] = cw[k * 5632 + 2816 + ch + e]; }
#pragma unroll
        for (int e = 0; e < 8; ++e) { bv[e] = cb[ch + e]; bg[e] = cb[2816 + ch + e]; }
        u32x4 v2 = (u32x4){0, 0, 0, 0}, v1 = v2, g2 = v2, g1 = v2;
        if (t0 >= 2) {
            v2 = *(const u32x4*)(HID + (size_t)(row0 - 2) * ld + j0); g2 = *(const u32x4*)(HID + (size_t)(row0 - 2) * ld + nch + j0);
            v1 = *(const u32x4*)(HID + (size_t)(row0 - 1) * ld + j0); g1 = *(const u32x4*)(HID + (size_t)(row0 - 1) * ld + nch + j0);
        }
        u32x4 va[4], ga[4], vb4[4], gb4[4];
#define CG_LOAD(V, G, r0) do { _Pragma("unroll") for (int q_ = 0; q_ < 4; ++q_) { V[q_] = *(const u32x4*)(HID + (size_t)(row0 + (r0) + q_) * ld + j0); G[q_] = *(const u32x4*)(HID + (size_t)(row0 + (r0) + q_) * ld + nch + j0); } } while (0)
#define CG_ROWS(V, G, r0) do { _Pragma("unroll") for (int q_ = 0; q_ < 4; ++q_) { const u32x4 v0 = V[q_], g0 = G[q_]; u32x4 o; \
            _Pragma("unroll") for (int q = 0; q < 4; ++q) { \
                const float yv0 = wv[0][2 * q] * bflo(v2[q]) + wv[1][2 * q] * bflo(v1[q]) + wv[2][2 * q] * bflo(v0[q]) + bv[2 * q]; \
                const float yv1 = wv[0][2 * q + 1] * bfhi(v2[q]) + wv[1][2 * q + 1] * bfhi(v1[q]) + wv[2][2 * q + 1] * bfhi(v0[q]) + bv[2 * q + 1]; \
                const float yg0 = wg[0][2 * q] * bflo(g2[q]) + wg[1][2 * q] * bflo(g1[q]) + wg[2][2 * q] * bflo(g0[q]) + bg[2 * q]; \
                const float yg1 = wg[0][2 * q + 1] * bfhi(g2[q]) + wg[1][2 * q + 1] * bfhi(g1[q]) + wg[2][2 * q + 1] * bfhi(g0[q]) + bg[2 * q + 1]; \
                o[q] = pack2(yv0 * siluf_(yg0), yv1 * siluf_(yg1)); } \
            *(u32x4*)(ACT + (size_t)(row0 + (r0) + q_) * 2816 + ch) = o; \
            v2 = v1; v1 = v0; g2 = g1; g1 = g0; } } while (0)
        CG_LOAD(va, ga, 0);
        CG_LOAD(vb4, gb4, 4);
        CG_ROWS(va, ga, 0);
        CG_LOAD(va, ga, 8);
        CG_ROWS(vb4, gb4, 4);
        CG_LOAD(vb4, gb4, 12);
        CG_ROWS(va, ga, 8);
        CG_ROWS(vb4, gb4, 12);
#undef CG_LOAD
#undef CG_ROWS
    }
}

template <int KIND>
__device__ __forceinline__ void scan_phase(LAS unsigned char* lds, PPTR p, int j) {
    constexpr int N = (KIND == 2) ? 64 : 128;
    constexpr int NH = (KIND == 2) ? 16 : 8;
    constexpr int RG = N / 16;
    constexpr int STRIDE = (KIND == 0) ? 288 : (KIND == 1 ? 272 : 336);
    constexpr int TC = 32, NC = SEQ / TC;
    constexpr int LDP = (KIND == 0) ? 4352 : (KIND == 1 ? 4096 : 3328);
    LAS float* buf = (LAS float*)lds;
    LAS float* ob = buf + 2 * TC * STRIDE;
    const int tid = tidx(), wave = tid >> 6, lane = tid & 63;
    const bool is_loader = wave >= 4; const int lw = wave - 4;
    const int li = lane & 15, row = (wave & 3) * 4 + (lane >> 4);
    const bf16_t* P = (const bf16_t*)(p->ws + (KIND == 2 ? WS_PROJC : WS_PROJ));
    const bf16_t* L2 = (const bf16_t*)(p->ws + WS_R1);
    bf16_t* O = (bf16_t*)(p->ws + (KIND == 2 ? WS_OC : WS_R1));
    const int G = gdim(); const int vcu = (G % 8 == 0) ? (int)(bidx() % 8) * (G / 8) + (int)(bidx() / 8) : (int)bidx();
    for (int task = vcu; task < 256; task += G) {
        const int bh = task / RG, rg = task % RG, b = bh / NH, h = bh % NH;
        const size_t rbase = (size_t)b * SEQ;
        float cwq[4][2], cwk[4][2], cwv[4]; float expA = 0.f, dtb = 0.f; float lbv[2]; float w0v = 0.f, a0v = 0.f, kkc = 0.f, kac = 0.f;
        if (KIND == 0) { const float* cv = p->in[6] + (size_t)j * 4 * 3072;
#pragma unroll
            for (int jj = 0; jj < 4; ++jj) { cwq[jj][0] = cv[jj * 3072 + h * 128 + 2 * lane]; cwq[jj][1] = cv[jj * 3072 + h * 128 + 2 * lane + 1];
                cwk[jj][0] = cv[jj * 3072 + 1024 + h * 128 + 2 * lane]; cwk[jj][1] = cv[jj * 3072 + 1024 + h * 128 + 2 * lane + 1];
                cwv[jj] = cv[jj * 3072 + 2048 + h * 128 + 16 * rg + (lane & 15)]; }
            expA = __expf(p->in[7][j * 8 + h]); dtb = p->in[8][j * 8 + h]; }
        if (KIND == 1) { const float* lbp = (const float*)(p->ws + WS_MISC) + 4 * 4 * 6144; lbv[0] = lbp[h * 128 + 2 * lane]; lbv[1] = lbp[h * 128 + 2 * lane + 1]; }
        if (KIND == 2) { const int ch = h * 64 + lane; w0v = p->in[17][ch]; a0v = p->in[20][ch]; kkc = p->in[25][ch]; kac = p->in[26][ch]; }
        unsigned x0[11], x1[11], x2[11], x3[8], x4[8];
        f32x2 s[4];
#pragma unroll
        for (int e = 0; e < 4; ++e) s[e] = (f32x2){0.f, 0.f};

#define SCAN_LOAD(cc) do { const int c_ = (cc); \
        if (KIND == 0) { const int tfirst = c_ * TC + 8 * lw - 3; \
            _Pragma("unroll") for (int q = 0; q < 11; ++q) { const int t_ = tfirst + q; const bool valid = t_ >= 0; const bf16_t* rowp = P + (rbase + (valid ? t_ : 0)) * LDP; \
                const unsigned vq = *(const unsigned*)(rowp + h * 128 + 2 * lane), vk = *(const unsigned*)(rowp + 1024 + h * 128 + 2 * lane); \
                const int mcol = lane < 16 ? 2048 + h * 128 + 16 * rg + lane : (lane == 32 ? 4096 + h : (lane == 33 ? 4104 + h : 2048 + h * 128)); \
                const unsigned vm = rowp[mcol]; x0[q] = valid ? vq : 0u; x1[q] = valid ? vk : 0u; x2[q] = valid ? vm : 0u; } } \
        else if (KIND == 1) { const int tfirst = c_ * TC + 8 * lw; \
            _Pragma("unroll") for (int q = 0; q < 8; ++q) { const bf16_t* rowp = P + (rbase + tfirst + q) * LDP; \
                x0[q] = *(const unsigned*)(rowp + h * 128 + 2 * lane); x1[q] = *(const unsigned*)(rowp + 1024 + h * 128 + 2 * lane); \
                x2[q] = rowp[2048 + h * 128 + 16 * rg + (lane & 15)]; } } \
        else { const int tfirst = c_ * TC + 8 * lw; \
            _Pragma("unroll") for (int q = 0; q < 8; ++q) { const bf16_t* rowp = P + (rbase + tfirst + q) * LDP; const bf16_t* l2p = L2 + (rbase + tfirst + q) * 3072; \
                x0[q] = rowp[h * 64 + lane]; x1[q] = rowp[1024 + h * 64 + lane]; x2[q] = rowp[2048 + h * 64 + 16 * rg + (lane & 15)]; \
                x3[q] = l2p[h * 64 + lane]; x4[q] = l2p[1024 + h * 64 + lane]; } } } while (0)

#define SCAN_FLUSH(cc) do { const int c_ = (cc); LAS const float* src = ob + (c_ & 1) * (TC * 16) + (lane >> 1) * 16 + (lane & 1) * 8; \
        u32x4 w; w.x = pack2(src[0], src[1]); w.y = pack2(src[2], src[3]); w.z = pack2(src[4], src[5]); w.w = pack2(src[6], src[7]); \
        *(u32x4*)(O + (rbase + c_ * TC + (lane >> 1)) * DM + h * N + 16 * rg + (lane & 1) * 8) = w; } while (0)

        if (is_loader) SCAN_LOAD(0);
        for (int it = 0; it <= NC; ++it) {
            if (is_loader) {
                if (it < NC) {
                    LAS float* bw = buf + (it & 1) * (TC * STRIDE);
#pragma unroll
                    for (int i = 0; i < 8; ++i) {
                        LAS float* rec = bw + (8 * lw + i) * STRIDE;
                        if (KIND == 0) {
                            float yq0 = 0.f, yq1 = 0.f, yk0 = 0.f, yk1 = 0.f, yv = 0.f;
#pragma unroll
                            for (int jj = 0; jj < 4; ++jj) { yq0 += cwq[jj][0] * bflo(x0[i + jj]); yq1 += cwq[jj][1] * bfhi(x0[i + jj]);
                                yk0 += cwk[jj][0] * bflo(x1[i + jj]); yk1 += cwk[jj][1] * bfhi(x1[i + jj]); yv += cwv[jj] * bf2f(x2[i + jj]); }
                            yq0 = siluf_(yq0); yq1 = siluf_(yq1); yk0 = siluf_(yk0); yk1 = siluf_(yk1);
                            const float ssq = wave_allsum(yq0 * yq0 + yq1 * yq1), ssk = wave_allsum(yk0 * yk0 + yk1 * yk1);
                            const float rq = __builtin_amdgcn_rsqf(ssq + 1e-6f) * 0.08838834764831845f, rk = __builtin_amdgcn_rsqf(ssk + 1e-6f);
                            *(LAS f32x2*)(rec + 2 * lane) = (f32x2){yk0 * rk, yk1 * rk};
                            *(LAS f32x2*)(rec + 128 + 2 * lane) = (f32x2){yq0 * rq, yq1 * rq};
                            const float m3 = bf2f(x2[i + 3]);
                            if (lane < 16) rec[256 + lane] = siluf_(yv);
                            else if (lane == 32) rec[273] = __expf(-expA * softplusf_(m3 + dtb));
                            else if (lane == 33) rec[272] = sigmoidf_(m3);
                        } else if (KIND == 1) {
                            const float q0 = siluf_(bflo(x0[i])), q1 = siluf_(bfhi(x0[i]));
                            const float f0 = lbv[0] + (1.0f - lbv[0]) * sigmoidf_(bflo(x1[i])), f1 = lbv[1] + (1.0f - lbv[1]) * sigmoidf_(bfhi(x1[i]));
                            *(LAS f32x2*)(rec + 2 * lane) = (f32x2){q0, q1};
                            *(LAS f32x2*)(rec + 128 + 2 * lane) = (f32x2){f0, f1};
                            if (lane < 16) rec[256 + lane] = bf2f(x2[i]);
                        } else {
                            const float r = bf2f(x0[i]), kraw = bf2f(x1[i]), whi = bf2f(x3[i]), ahi = bf2f(x4[i]);
                            const float wv = -softplusf_(-(w0v + whi)) - 0.5f; const float d = __expf(-__expf(wv));
                            const float ag = sigmoidf_(a0v + ahi);
                            const float kkx = kraw * kkc; const float ss = wave_allsum(kkx * kkx); const float kk = kkx * __builtin_amdgcn_rsqf(ss + 1e-6f);
                            const float kp = kraw * (1.0f + (ag - 1.0f) * kac);
                            rec[lane] = -kk; rec[64 + lane] = kk * ag; rec[128 + lane] = d; rec[192 + lane] = kp; rec[256 + lane] = r;
                            if (lane < 16) rec[320 + lane] = bf2f(x2[i]);
                        }
                    }
                    if (it + 1 < NC) SCAN_LOAD(it + 1);
                }
                if (it >= 2 && lw == 0) SCAN_FLUSH(it - 2);
            } else if (it >= 1) {
                LAS const float* bc = buf + ((it - 1) & 1) * (TC * STRIDE);
                LAS float* oc = ob + ((it - 1) & 1) * (TC * 16);
                StepRegs R[2][2];
                step_load<KIND>(R[0][0], bc, li, row); step_load<KIND>(R[0][1], bc + STRIDE, li, row);
                float osel = 0.f;
#pragma unroll
                for (int g = 0; g < 16; ++g) {
                    if (g + 1 < 16) { step_load<KIND>(R[(g + 1) & 1][0], bc + (2 * g + 2) * STRIDE, li, row); step_load<KIND>(R[(g + 1) & 1][1], bc + (2 * g + 3) * STRIDE, li, row); }
#pragma unroll
                    for (int u = 0; u < 2; ++u) { const float o = step_compute<KIND>(R[g & 1][u], s); osel = (li == ((2 * g + u) & 15)) ? o : osel; }
                    if (g == 7 || g == 15) oc[((g == 15 ? 16 : 0) + li) * 16 + row] = osel;
                }
            }
            lds_barrier();
        }
        if (is_loader && lw == 0) SCAN_FLUSH(NC - 1);
        lds_barrier();
#undef SCAN_LOAD
#undef SCAN_FLUSH
    }
}


typedef short bf16x4 __attribute__((ext_vector_type(4)));
__device__ __forceinline__ bf16x8 cat4(bf16x4 lo, bf16x4 hi) { return __builtin_shufflevector(lo, hi, 0, 1, 2, 3, 4, 5, 6, 7); }
__device__ __forceinline__ bf16x4 cvt4(f32x4 v) { u32x2 w; w.x = pg8::cvt_pk_bf16(v[0], v[1]); w.y = pg8::cvt_pk_bf16(v[2], v[3]); return __builtin_bit_cast(bf16x4, w); }
constexpr size_t WS_KG = WS_R1 + 64 * MiB;
constexpr size_t WS_AM = 420 * MiB;
constexpr size_t WS_DEC = 428 * MiB;

__device__ __forceinline__ void prep_gla(LAS unsigned char* lds, PPTR p) {
    const int tid = tidx(), w = tid >> 6, lane = tid & 63, n = lane & 15, kg = lane >> 4;
    LAS unsigned char* qs = lds + w * 8704; LAS unsigned char* ks = qs + 4352;
    const bf16_t* P = (const bf16_t*)(p->ws + WS_PROJ);
    bf16_t* Qg = (bf16_t*)(p->ws + WS_R1); bf16_t* Kg = (bf16_t*)(p->ws + WS_KG);
    bf16_t* Amg = (bf16_t*)(p->ws + WS_AM); float* Decg = (float*)(p->ws + WS_DEC);
    const float* lbp = (const float*)(p->ws + WS_MISC) + 4 * 4 * 6144;
    for (int task = bidx() * 8 + w; task < 4 * 512 * 8; task += gdim() * 8) {
        const int h = task & 7, rc = task >> 3; const size_t row0 = (size_t)rc * 16;
        const float lb0 = lbp[h * 128 + 2 * lane], lb1 = lbp[h * 128 + 2 * lane + 1];
        unsigned xq[16], xf[16];
#pragma unroll
        for (int t = 0; t < 16; ++t) { const bf16_t* rowp = P + (row0 + t) * 4096 + h * 128 + 2 * lane; xq[t] = *(const unsigned*)rowp; xf[t] = *(const unsigned*)(rowp + 1024); }
        float bc0 = 0.f, bc1 = 0.f; float kk0[16], kk1[16], bs0[16], bs1[16];
#pragma unroll
        for (int t = 0; t < 16; ++t) {
            const float q0 = siluf_(bflo(xq[t])), q1 = siluf_(bfhi(xq[t]));
            const float f0 = lb0 + (1.0f - lb0) * sigmoidf_(bflo(xf[t])), f1 = lb1 + (1.0f - lb1) * sigmoidf_(bfhi(xf[t]));
            bc0 += __logf(f0); bc1 += __logf(f1);
            kk0[t] = 1.0f - f0; kk1[t] = 1.0f - f1; bs0[t] = bc0; bs1[t] = bc1;
            const unsigned qp = pack2(q0 * __expf(bc0), q1 * __expf(bc1));
            *(unsigned*)(Qg + (row0 + t) * 1024 + h * 128 + 2 * lane) = qp;
            *(LAS unsigned*)(qs + t * 272 + 4 * lane) = qp;
        }
#pragma unroll
        for (int t = 0; t < 16; ++t) {
            *(unsigned*)(Kg + (row0 + t) * 1024 + h * 128 + 2 * lane) = pack2(kk0[t] * __expf(bc0 - bs0[t]), kk1[t] * __expf(bc1 - bs1[t]));
            *(LAS unsigned*)(ks + t * 272 + 4 * lane) = pack2(kk0[t] * __expf(-bs0[t]), kk1[t] * __expf(-bs1[t]));
        }
        *(f32x2*)(Decg + (size_t)task * 128 + 2 * lane) = (f32x2){__expf(bc0), __expf(bc1)};
        asm volatile("s_waitcnt lgkmcnt(0)" ::: "memory");
        f32x4 acc = (f32x4){0.f, 0.f, 0.f, 0.f};
#pragma unroll
        for (int a = 0; a < 4; ++a) {
            const bf16x8 af = *(LAS const bf16x8*)(qs + n * 272 + (32 * a + 8 * kg) * 2);
            const bf16x8 bfr = *(LAS const bf16x8*)(ks + n * 272 + (32 * a + 8 * kg) * 2);
            acc = __builtin_amdgcn_mfma_f32_16x16x32_bf16(af, bfr, acc, 0, 0, 0);
        }
#pragma unroll
        for (int jj = 0; jj < 4; ++jj) { const int t = 4 * kg + jj; Amg[(size_t)task * 256 + t * 16 + n] = (bf16_t)f2bf(n <= t ? acc[jj] : 0.f); }
        asm volatile("s_waitcnt lgkmcnt(0)" ::: "memory");
    }
}

__device__ __forceinline__ void scan_gla(LAS unsigned char* lds, PPTR p) {
    constexpr int QOFF = 0, KTOFF = 4352, VOFF = 9472, AMOFF = 13824, DECOFF = 14336, BUFB = 14848;
    const int tid = tidx(), w = tid >> 6, lane = tid & 63, n = lane & 15, kg = lane >> 4;
    const bf16_t* P = (const bf16_t*)(p->ws + WS_PROJ);
    bf16_t* Qg = (bf16_t*)(p->ws + WS_R1); const bf16_t* Kg = (const bf16_t*)(p->ws + WS_KG);
    const bf16_t* Amg = (const bf16_t*)(p->ws + WS_AM); const float* Decg = (const float*)(p->ws + WS_DEC);
    bf16_t* Og = (bf16_t*)(p->ws + WS_OC);
    const bf16x4 z4 = (bf16x4){0, 0, 0, 0};
    for (int task = bidx(); task < 32; task += gdim()) {
        const int b = task >> 3, h = task & 7; const size_t rowbase = (size_t)b * SEQ;
        f32x4 S[8]; bf16x8 Sb[4];
#pragma unroll
        for (int i = 0; i < 8; ++i) S[i] = (f32x4){0.f, 0.f, 0.f, 0.f};
#pragma unroll
        for (int a = 0; a < 4; ++a) Sb[a] = (bf16x8){0, 0, 0, 0, 0, 0, 0, 0};
        const int lt = (tid & 255) >> 4, pc = tid & 15;
        constexpr int PD = 8;
        u32x4 g0[PD], g1[PD];
#define GLA_LOAD(cc, sl) do { const int c_ = (cc); const size_t r_ = rowbase + (size_t)c_ * 16 + lt; \
            if (tid < 256) { g0[sl] = *(const u32x4*)(Qg + r_ * 1024 + h * 128 + 8 * pc); g1[sl] = *(const u32x4*)(P + r_ * 4096 + 2048 + h * 128 + 8 * pc); } \
            else { g0[sl] = *(const u32x4*)(Kg + r_ * 1024 + h * 128 + 8 * pc); const size_t ch_ = ((size_t)(b * 512 + c_) * 8 + h); \
                if (tid < 288) g1[sl] = *(const u32x4*)(Amg + ch_ * 256 + (tid - 256) * 8); else if (tid < 320) g1[sl] = *(const u32x4*)(Decg + ch_ * 128 + (tid - 288) * 4); } } while (0)
#define GLA_STORE(cc, sl) do { LAS unsigned char* bb_ = lds + ((cc) & 1) * BUFB; \
            if (tid < 256) { *(LAS u32x4*)(bb_ + QOFF + lt * 272 + 16 * pc) = g0[sl]; *(LAS u32x4*)(bb_ + VOFF + lt * 272 + 16 * pc) = g1[sl]; } \
            else { _Pragma("unroll") for (int e = 0; e < 4; ++e) { *(LAS unsigned short*)(bb_ + KTOFF + (8 * pc + 2 * e) * 40 + 2 * lt) = (unsigned short)(g0[sl][e] & 0xffffu); \
                    *(LAS unsigned short*)(bb_ + KTOFF + (8 * pc + 2 * e + 1) * 40 + 2 * lt) = (unsigned short)(g0[sl][e] >> 16); } \
                if (tid < 288) *(LAS u32x4*)(bb_ + AMOFF + (tid - 256) * 16) = g1[sl]; else if (tid < 320) *(LAS u32x4*)(bb_ + DECOFF + (tid - 288) * 16) = g1[sl]; } } while (0)
#pragma unroll
        for (int d = 0; d < PD; ++d) GLA_LOAD(d, d);
        GLA_STORE(0, 0); lds_barrier();
        for (int c0 = 0; c0 < 512; c0 += PD) {
#pragma unroll
          for (int d = 0; d < PD; ++d) {
            const int c = c0 + d;
            if (c + PD < 512) GLA_LOAD(c + PD, d);
            LAS const unsigned char* bb = lds + (c & 1) * BUFB;
            f32x4 Z = (f32x4){0.f, 0.f, 0.f, 0.f};
#pragma unroll
            for (int a = 0; a < 4; ++a) {
                const bf16x4 lo = *(LAS const bf16x4*)(bb + QOFF + n * 272 + (32 * a + 4 * kg) * 2), hi = *(LAS const bf16x4*)(bb + QOFF + n * 272 + (32 * a + 16 + 4 * kg) * 2);
                Z = __builtin_amdgcn_mfma_f32_16x16x32_bf16(cat4(lo, hi), Sb[a], Z, 0, 0, 0);
            }
            bf16x4 vb;
#pragma unroll
            for (int j = 0; j < 4; ++j) vb[j] = *(LAS const short*)(bb + VOFF + (4 * kg + j) * 272 + (16 * w + n) * 2);
            const bf16x8 Vb = cat4(vb, z4);
            const bf16x4 am = *(LAS const bf16x4*)(bb + AMOFF + n * 32 + 8 * kg);
            const f32x4 o = __builtin_amdgcn_mfma_f32_16x16x32_bf16(cat4(am, z4), Vb, Z, 0, 0, 0);
#pragma unroll
            for (int i = 0; i < 8; ++i) {
                const f32x4 d4 = *(LAS const f32x4*)(bb + DECOFF + (16 * i + 4 * kg) * 4);
                const bf16x4 kt = *(LAS const bf16x4*)(bb + KTOFF + (16 * i + n) * 40 + 8 * kg);
                S[i] = __builtin_amdgcn_mfma_f32_16x16x32_bf16(cat4(kt, z4), Vb, S[i] * d4, 0, 0, 0);
            }
#pragma unroll
            for (int a = 0; a < 4; ++a) Sb[a] = cat4(cvt4(S[2 * a]), cvt4(S[2 * a + 1]));
#pragma unroll
            for (int j = 0; j < 4; ++j) Og[(rowbase + (size_t)c * 16 + 4 * kg + j) * 1024 + h * 128 + 16 * w + n] = (bf16_t)f2bf(o[j]);
            if (c + 1 < 512) GLA_STORE(c + 1, (d + 1) % PD);
            lds_barrier();
          }
        }
#undef GLA_LOAD
#undef GLA_STORE
    }
}


template <int SGN>
__device__ __forceinline__ void tri_inv16(LAS const float* Lm, int n, float (&x)[16]) {
    x[0] = (n == 0) ? 1.f : 0.f;
    {
        f32x4 la[12];
#pragma unroll
        for (int t = 1; t <= 4; ++t) la[t - 1] = *(LAS const f32x4*)(Lm + t * 16);
#pragma unroll
        for (int t = 5; t <= 8; ++t) { la[4 + 2 * (t - 5)] = *(LAS const f32x4*)(Lm + t * 16); la[5 + 2 * (t - 5)] = *(LAS const f32x4*)(Lm + t * 16 + 4); }
        __builtin_amdgcn_sched_barrier(0);
#pragma unroll
        for (int t = 1; t <= 8; ++t) { float acc = (n == t) ? 1.f : 0.f;
#pragma unroll
            for (int q = 0; q < (t + 3) / 4; ++q) { const f32x4 l4 = (t <= 4) ? la[t - 1] : la[4 + 2 * (t - 5) + q];
#pragma unroll
                for (int e = 0; e < 4; ++e) if (4 * q + e < t) acc += (float)SGN * l4[e] * x[4 * q + e]; }
            x[t] = acc; }
    }
    __builtin_amdgcn_sched_barrier(0);
    {   f32x4 lb[12];
#pragma unroll
        for (int t = 9; t <= 12; ++t)
#pragma unroll
            for (int q = 0; q < 3; ++q) lb[3 * (t - 9) + q] = *(LAS const f32x4*)(Lm + t * 16 + 4 * q);
        __builtin_amdgcn_sched_barrier(0);
#pragma unroll
        for (int t = 9; t <= 12; ++t) { float acc = (n == t) ? 1.f : 0.f;
#pragma unroll
            for (int q = 0; q < 3; ++q) { const f32x4 l4 = lb[3 * (t - 9) + q];
#pragma unroll
                for (int e = 0; e < 4; ++e) if (4 * q + e < t) acc += (float)SGN * l4[e] * x[4 * q + e]; }
            x[t] = acc; }
    }
    __builtin_amdgcn_sched_barrier(0);
    {   f32x4 lc[12];
#pragma unroll
        for (int t = 13; t <= 15; ++t)
#pragma unroll
            for (int q = 0; q < 4; ++q) lc[4 * (t - 13) + q] = *(LAS const f32x4*)(Lm + t * 16 + 4 * q);
        __builtin_amdgcn_sched_barrier(0);
#pragma unroll
        for (int t = 13; t <= 15; ++t) { float acc = (n == t) ? 1.f : 0.f;
#pragma unroll
            for (int q = 0; q < 4; ++q) { const f32x4 l4 = lc[4 * (t - 13) + q];
#pragma unroll
                for (int e = 0; e < 4; ++e) if (4 * q + e < t) acc += (float)SGN * l4[e] * x[4 * q + e]; }
            x[t] = acc; }
    }
}

constexpr size_t WS_TA = 436 * MiB;
constexpr size_t WS_AMA = 444 * MiB;
constexpr size_t WS_SCA = 452 * MiB;

__device__ __forceinline__ void prep_delta(LAS unsigned char* lds, PPTR p, int j) {
    const int tid = tidx(), w = tid >> 6, lane = tid & 63, n = lane & 15, kg = lane >> 4;
    LAS unsigned char* qs = lds + w * 9984; LAS unsigned char* ks = qs + 4352; LAS float* Lm = (LAS float*)(ks + 4352); LAS float* sc = Lm + 256;
    const bf16_t* P = (const bf16_t*)(p->ws + WS_PROJ);
    bf16_t* Qg = (bf16_t*)(p->ws + WS_R1); bf16_t* Kg = (bf16_t*)(p->ws + WS_KG);
    bf16_t* Tg = (bf16_t*)(p->ws + WS_TA); bf16_t* Amg = (bf16_t*)(p->ws + WS_AMA); float* Scg = (float*)(p->ws + WS_SCA);
    const float* cv = p->in[6] + (size_t)j * 4 * 3072;
    for (int task = bidx() * 8 + w; task < 4 * 512 * 8; task += gdim() * 8) {
        const int h = task & 7, rc = task >> 3; const size_t row0 = (size_t)rc * 16; const int t0 = (rc & 511) * 16;
        float cwq[4][2], cwk[4][2];
#pragma unroll
        for (int jj = 0; jj < 4; ++jj) { cwq[jj][0] = cv[jj * 3072 + h * 128 + 2 * lane]; cwq[jj][1] = cv[jj * 3072 + h * 128 + 2 * lane + 1];
            cwk[jj][0] = cv[jj * 3072 + 1024 + h * 128 + 2 * lane]; cwk[jj][1] = cv[jj * 3072 + 1024 + h * 128 + 2 * lane + 1]; }
        unsigned xq[19], xk[19];
#pragma unroll
        for (int r = 0; r < 19; ++r) { const bool valid = (t0 + r - 3) >= 0; const bf16_t* rowp = P + (row0 + (valid ? r - 3 : 0)) * 4352 + h * 128 + 2 * lane;
            const unsigned vq = *(const unsigned*)rowp, vk = *(const unsigned*)(rowp + 1024); xq[r] = valid ? vq : 0u; xk[r] = valid ? vk : 0u; }
        float beta, G;
        { const bf16_t* rowp = P + (row0 + n) * 4352; const float a_raw = bf2f(rowp[4096 + h]), b_raw = bf2f(rowp[4104 + h]);
          beta = sigmoidf_(b_raw); G = -__expf(p->in[7][j * 8 + h]) * softplusf_(a_raw + p->in[8][j * 8 + h]);
          float tq; tq = __int_as_float(__builtin_amdgcn_update_dpp(0, __float_as_int(G), 0x111, 0xf, 0xf, true)); G += tq;
          tq = __int_as_float(__builtin_amdgcn_update_dpp(0, __float_as_int(G), 0x112, 0xf, 0xf, true)); G += tq;
          tq = __int_as_float(__builtin_amdgcn_update_dpp(0, __float_as_int(G), 0x114, 0xf, 0xf, true)); G += tq;
          tq = __int_as_float(__builtin_amdgcn_update_dpp(0, __float_as_int(G), 0x118, 0xf, 0xf, true)); G += tq; }
        const float G15 = __int_as_float(__builtin_amdgcn_readlane(__float_as_int(G), 15));
        if (lane < 16) { sc[lane] = beta; sc[16 + lane] = G;
            float* so = Scg + (size_t)task * 64; so[lane] = beta; so[16 + lane] = __expf(G); so[32 + lane] = __expf(G15 - G); if (lane == 0) so[48] = __expf(G15); }
#pragma unroll
        for (int t = 0; t < 16; ++t) {
            float yq0 = 0.f, yq1 = 0.f, yk0 = 0.f, yk1 = 0.f;
#pragma unroll
            for (int jj = 0; jj < 4; ++jj) { yq0 += cwq[jj][0] * bflo(xq[t + jj]); yq1 += cwq[jj][1] * bfhi(xq[t + jj]); yk0 += cwk[jj][0] * bflo(xk[t + jj]); yk1 += cwk[jj][1] * bfhi(xk[t + jj]); }
            yq0 = siluf_(yq0); yq1 = siluf_(yq1); yk0 = siluf_(yk0); yk1 = siluf_(yk1);
            const float ssq = wave_allsum(yq0 * yq0 + yq1 * yq1), ssk = wave_allsum(yk0 * yk0 + yk1 * yk1);
            const float rq = __builtin_amdgcn_rsqf(ssq + 1e-6f) * 0.08838834764831845f, rk = __builtin_amdgcn_rsqf(ssk + 1e-6f);
            const unsigned qp = pack2(yq0 * rq, yq1 * rq), kp = pack2(yk0 * rk, yk1 * rk);
            *(unsigned*)(Qg + (row0 + t) * 1024 + h * 128 + 2 * lane) = qp; *(unsigned*)(Kg + (row0 + t) * 1024 + h * 128 + 2 * lane) = kp;
            *(LAS unsigned*)(qs + t * 272 + 4 * lane) = qp; *(LAS unsigned*)(ks + t * 272 + 4 * lane) = kp;
        }
        asm volatile("s_waitcnt lgkmcnt(0)" ::: "memory");
        f32x4 akk = (f32x4){0.f, 0.f, 0.f, 0.f}, aqk = akk;
#pragma unroll
        for (int a = 0; a < 4; ++a) {
            const bf16x8 qf = *(LAS const bf16x8*)(qs + n * 272 + (32 * a + 8 * kg) * 2);
            const bf16x8 kf = *(LAS const bf16x8*)(ks + n * 272 + (32 * a + 8 * kg) * 2);
            akk = __builtin_amdgcn_mfma_f32_16x16x32_bf16(kf, kf, akk, 0, 0, 0);
            aqk = __builtin_amdgcn_mfma_f32_16x16x32_bf16(qf, kf, aqk, 0, 0, 0);
        }
        { const float Gn = sc[16 + n]; const f32x4 bt = *(LAS const f32x4*)(sc + 4 * kg), Gt = *(LAS const f32x4*)(sc + 16 + 4 * kg);
#pragma unroll
          for (int jj = 0; jj < 4; ++jj) { const int t = 4 * kg + jj; const float dec = __expf(Gt[jj] - Gn);
              Lm[t * 16 + n] = (n < t) ? bt[jj] * akk[jj] * dec : 0.f;
              Amg[(size_t)task * 256 + t * 16 + n] = (bf16_t)f2bf(n <= t ? aqk[jj] * dec : 0.f); } }
        asm volatile("s_waitcnt lgkmcnt(0)" ::: "memory");
        float x[16];
        tri_inv16<-1>(Lm, n, x);
#pragma unroll
        for (int jj = 0; jj < 4; ++jj) { const float v = (kg == 0) ? x[jj] : (kg == 1 ? x[4 + jj] : (kg == 2 ? x[8 + jj] : x[12 + jj]));
            Tg[(size_t)task * 256 + (4 * kg + jj) * 16 + n] = (bf16_t)f2bf(v); }
        asm volatile("s_waitcnt lgkmcnt(0)" ::: "memory");
    }
}

__device__ __forceinline__ void scan_delta(LAS unsigned char* lds, PPTR p, int j) {
    constexpr int QOFF = 0, KOFF = 4352, KTOFF = 8704, VOFF = 13824, TOFF = 18992, AMOFF = 19504, SCOFF = 20016, BUFB = 20272;
    const int tid = tidx(), w = tid >> 6, lane = tid & 63, n = lane & 15, kg = lane >> 4;
    const bf16_t* P = (const bf16_t*)(p->ws + WS_PROJ);
    bf16_t* Qg = (bf16_t*)(p->ws + WS_R1); const bf16_t* Kg = (const bf16_t*)(p->ws + WS_KG);
    const bf16_t* Tg = (const bf16_t*)(p->ws + WS_TA); const bf16_t* Amg = (const bf16_t*)(p->ws + WS_AMA); const float* Scg = (const float*)(p->ws + WS_SCA);
    const float* cv = p->in[6] + (size_t)j * 4 * 3072;
    const bf16x4 z4 = (bf16x4){0, 0, 0, 0};
    for (int task = bidx(); task < 32; task += gdim()) {
        const int b = task >> 3, h = task & 7; const size_t rowbase = (size_t)b * SEQ;
        float cwv[4];
#pragma unroll
        for (int jj = 0; jj < 4; ++jj) cwv[jj] = cv[jj * 3072 + 2048 + h * 128 + 16 * w + n];
        f32x4 S[8]; bf16x8 Sb[4];
#pragma unroll
        for (int i = 0; i < 8; ++i) S[i] = (f32x4){0.f, 0.f, 0.f, 0.f};
#pragma unroll
        for (int a = 0; a < 4; ++a) Sb[a] = (bf16x8){0, 0, 0, 0, 0, 0, 0, 0};
        const int lt = (tid & 255) >> 4, pc = tid & 15, vr = tid >> 4;
        constexpr int PD = 8;
        u32x4 g0[PD], g1[PD];
#define DL_LOAD(cc, sl) do { const int c_ = (cc); const size_t r_ = rowbase + (size_t)c_ * 16 + lt; const size_t ch_ = ((size_t)(b * 512 + c_) * 8 + h); \
            if (tid < 256) g0[sl] = *(const u32x4*)(Qg + r_ * 1024 + h * 128 + 8 * pc); else g0[sl] = *(const u32x4*)(Kg + r_ * 1024 + h * 128 + 8 * pc); \
            if (tid < 304) { const int tv_ = c_ * 16 + vr - 3; const u32x4 vv_ = *(const u32x4*)(P + (rowbase + (tv_ >= 0 ? tv_ : 0)) * 4352 + 2048 + h * 128 + 8 * pc); g1[sl] = (tv_ >= 0) ? vv_ : (u32x4){0u, 0u, 0u, 0u}; } \
            else if (tid >= 320 && tid < 352) g1[sl] = *(const u32x4*)(Tg + ch_ * 256 + (tid - 320) * 8); \
            else if (tid >= 352 && tid < 384) g1[sl] = *(const u32x4*)(Amg + ch_ * 256 + (tid - 352) * 8); \
            else if (tid >= 384 && tid < 400) g1[sl] = *(const u32x4*)(Scg + ch_ * 64 + (tid - 384) * 4); } while (0)
#define DL_STORE(cc, sl) do { LAS unsigned char* bb_ = lds + ((cc) & 1) * BUFB; \
            if (tid < 256) *(LAS u32x4*)(bb_ + QOFF + lt * 272 + 16 * pc) = g0[sl]; \
            else { *(LAS u32x4*)(bb_ + KOFF + lt * 272 + 16 * pc) = g0[sl]; \
                _Pragma("unroll") for (int e = 0; e < 4; ++e) { *(LAS unsigned short*)(bb_ + KTOFF + (8 * pc + 2 * e) * 40 + 2 * lt) = (unsigned short)(g0[sl][e] & 0xffffu); \
                    *(LAS unsigned short*)(bb_ + KTOFF + (8 * pc + 2 * e + 1) * 40 + 2 * lt) = (unsigned short)(g0[sl][e] >> 16); } } \
            if (tid < 304) *(LAS u32x4*)(bb_ + VOFF + vr * 272 + 16 * pc) = g1[sl]; \
            else if (tid >= 320 && tid < 352) *(LAS u32x4*)(bb_ + TOFF + (tid - 320) * 16) = g1[sl]; \
            else if (tid >= 352 && tid < 384) *(LAS u32x4*)(bb_ + AMOFF + (tid - 352) * 16) = g1[sl]; \
            else if (tid >= 384 && tid < 400) *(LAS u32x4*)(bb_ + SCOFF + (tid - 384) * 16) = g1[sl]; } while (0)
#pragma unroll
        for (int d = 0; d < PD; ++d) DL_LOAD(d, d);
        DL_STORE(0, 0); lds_barrier();
        for (int c0 = 0; c0 < 512; c0 += PD) {
#pragma unroll
          for (int d = 0; d < PD; ++d) {
            const int c = c0 + d;
            if (c + PD < 512) DL_LOAD(c + PD, d);
            LAS const unsigned char* bb = lds + (c & 1) * BUFB;
            float vraw[7];
#pragma unroll
            for (int r = 0; r < 7; ++r) vraw[r] = bf2f(*(LAS const unsigned short*)(bb + VOFF + (4 * kg + r) * 272 + (16 * w + n) * 2));
            f32x4 v4;
#pragma unroll
            for (int jj = 0; jj < 4; ++jj) v4[jj] = siluf_(cwv[0] * vraw[jj] + cwv[1] * vraw[jj + 1] + cwv[2] * vraw[jj + 2] + cwv[3] * vraw[jj + 3]);
            f32x4 X = (f32x4){0.f, 0.f, 0.f, 0.f}, Z = X;
#pragma unroll
            for (int a = 0; a < 4; ++a) {
                const bf16x4 klo = *(LAS const bf16x4*)(bb + KOFF + n * 272 + (32 * a + 4 * kg) * 2), khi = *(LAS const bf16x4*)(bb + KOFF + n * 272 + (32 * a + 16 + 4 * kg) * 2);
                X = __builtin_amdgcn_mfma_f32_16x16x32_bf16(cat4(klo, khi), Sb[a], X, 0, 0, 0);
                const bf16x4 qlo = *(LAS const bf16x4*)(bb + QOFF + n * 272 + (32 * a + 4 * kg) * 2), qhi = *(LAS const bf16x4*)(bb + QOFF + n * 272 + (32 * a + 16 + 4 * kg) * 2);
                Z = __builtin_amdgcn_mfma_f32_16x16x32_bf16(cat4(qlo, qhi), Sb[a], Z, 0, 0, 0);
            }
            const f32x4 be4 = *(LAS const f32x4*)(bb + SCOFF + (4 * kg) * 4), eg4 = *(LAS const f32x4*)(bb + SCOFF + (16 + 4 * kg) * 4), egl4 = *(LAS const f32x4*)(bb + SCOFF + (32 + 4 * kg) * 4);
            const float glast = *(LAS const float*)(bb + SCOFF + 48 * 4);
            const f32x4 R = be4 * (v4 - eg4 * X);
            const bf16x4 tf = *(LAS const bf16x4*)(bb + TOFF + n * 32 + 8 * kg);
            const f32x4 vnew = __builtin_amdgcn_mfma_f32_16x16x32_bf16(cat4(tf, z4), cat4(cvt4(R), z4), (f32x4){0.f, 0.f, 0.f, 0.f}, 0, 0, 0);
            const bf16x4 am = *(LAS const bf16x4*)(bb + AMOFF + n * 32 + 8 * kg);
            const f32x4 o = __builtin_amdgcn_mfma_f32_16x16x32_bf16(cat4(am, z4), cat4(cvt4(vnew), z4), Z * eg4, 0, 0, 0);
            const bf16x8 B2 = cat4(cvt4(vnew * egl4), z4);
#pragma unroll
            for (int i = 0; i < 8; ++i) {
                const bf16x4 kt = *(LAS const bf16x4*)(bb + KTOFF + (16 * i + n) * 40 + 8 * kg);
                S[i] = __builtin_amdgcn_mfma_f32_16x16x32_bf16(cat4(kt, z4), B2, S[i] * glast, 0, 0, 0);
            }
#pragma unroll
            for (int a = 0; a < 4; ++a) Sb[a] = cat4(cvt4(S[2 * a]), cvt4(S[2 * a + 1]));
#pragma unroll
            for (int jj = 0; jj < 4; ++jj) Qg[(rowbase + (size_t)c * 16 + 4 * kg + jj) * 1024 + h * 128 + 16 * w + n] = (bf16_t)f2bf(o[jj]);
            if (c + 1 < 512) DL_STORE(c + 1, (d + 1) % PD);
            lds_barrier();
          }
        }
#undef DL_LOAD
#undef DL_STORE
    }
}


constexpr size_t WS_GCG = 500 * MiB;
constexpr size_t WS_BNG = 508 * MiB;
__device__ __forceinline__ void prep_rwkv_elem(PPTR p) {
    const int tid = tidx(), w = tid >> 6, lane = tid & 63;
    bf16_t* P = (bf16_t*)(p->ws + WS_PROJC); bf16_t* L2 = (bf16_t*)(p->ws + WS_R1);
    float* GCg = (float*)(p->ws + WS_GCG); float* BNg = (float*)(p->ws + WS_BNG);
    for (int task = bidx() * 8 + w; task < 4 * 512 * 16; task += gdim() * 8) {
        const int h = task & 15, rc = task >> 4; const size_t row0 = (size_t)rc * 16; const int ch = h * 64 + lane;
        const float w0v = p->in[17][ch], a0v = p->in[20][ch], kkc = p->in[25][ch], kac = p->in[26][ch], rkc = p->in[27][ch];
        unsigned xr[16], xk[16], xw[16], xa[16];
#pragma unroll
        for (int t = 0; t < 16; ++t) { const bf16_t* rowp = P + (row0 + t) * 3328 + ch; const bf16_t* l2p = L2 + (row0 + t) * 3072 + ch;
            xr[t] = rowp[0]; xk[t] = rowp[1024]; xw[t] = l2p[0]; xa[t] = l2p[1024]; }
        float lg = 0.f;
#pragma unroll
        for (int t = 0; t < 16; ++t) {
            const float r = bf2f(xr[t]), kraw = bf2f(xk[t]), whi = bf2f(xw[t]), ahi = bf2f(xa[t]);
            const float wv = -softplusf_(-(w0v + whi)) - 0.5f; const float ew = __expf(wv);
            const float lgp = lg; lg -= ew;
            const float ag = sigmoidf_(a0v + ahi);
            const float kkx = kraw * kkc; const float ss = wave_allsum(kkx * kkx); const float kk = kkx * __builtin_amdgcn_rsqf(ss + 1e-6f);
            const float kp = kraw * (1.0f + (ag - 1.0f) * kac);
            const float bonus = wave_allsum(r * kp * rkc);
            const float inv = __expf(-lg);
            bf16_t* rowp = P + (row0 + t) * 3328 + ch; bf16_t* l2p = L2 + (row0 + t) * 3072 + ch;
            rowp[0] = (bf16_t)f2bf(-kk * __expf(lgp)); rowp[1024] = (bf16_t)f2bf(r * __expf(lg));
            l2p[0] = (bf16_t)f2bf(kk * ag * inv); l2p[1024] = (bf16_t)f2bf(kp * inv);
            if (lane == 0) BNg[(row0 + t) * 16 + h] = bonus;
        }
        GCg[(size_t)task * 64 + lane] = __expf(lg);
    }
}

__device__ __forceinline__ void scan_rwkv(LAS unsigned char* lds, PPTR p) {
    constexpr int AH = 0, RH = 2304, BMT = 4608, KMT = 7168, TM = 9728, LAK = 10240, MRB = 10752, MRK = 11264, VV = 11776, GC = 14080, SLOT = 14336;
    constexpr int PRIV = 8 * SLOT, PRIVSZ = 5632;
    const int tid = tidx(), wave = tid >> 6, lane = tid & 63, n = lane & 15, kg = lane >> 4;
    const bf16_t* P = (const bf16_t*)(p->ws + WS_PROJC); const bf16_t* L2 = (const bf16_t*)(p->ws + WS_R1);
    bf16_t* Og = (bf16_t*)(p->ws + WS_OC);
    const int G = gdim(); const int vcu = (G % 8 == 0) ? (int)(bidx() % 8) * (G / 8) + (int)(bidx() / 8) : (int)bidx();
    for (int task = vcu; task < 256; task += G) {
        const int bh = task >> 2, slice = task & 3, b = bh >> 4, h = bh & 15; const size_t rowbase = (size_t)b * SEQ;
        const int pwr = (wave >= 1 && wave <= 3) ? wave - 1 : (wave == 5 ? 3 : -1);
        if (pwr >= 0) {
            const int pw = pwr; const int ch = h * 64 + lane;
            LAS unsigned char* bh = lds + PRIV + pw * PRIVSZ; LAS unsigned char* kh = bh + 2304; LAS float* Lm = (LAS float*)(kh + 2304);
            const float* GCg = (const float*)(p->ws + WS_GCG);
            unsigned xr[16], xk[16], xv[16], xw[16], xa[16]; float gCn;
#define RW_LOAD(cc, T0) do { _Pragma("unroll") for (int t = (T0); t < (T0) + 8; ++t) { const size_t r_ = rowbase + (size_t)(cc) * 16 + t; const bf16_t* rowp = P + r_ * 3328 + ch; const bf16_t* l2p = L2 + r_ * 3072 + ch; \
                xr[t] = rowp[0]; xk[t] = rowp[1024]; xv[t] = rowp[2048]; xw[t] = l2p[0]; xa[t] = l2p[1024]; } \
                if ((T0) == 8) gCn = GCg[((size_t)(b * 512 + (cc)) * 16 + h) * 64 + lane]; } while (0)
            RW_LOAD(pw, 0); RW_LOAD(pw, 8);
            for (int m = -1; m < 128; ++m) {
                const int cc = 4 * (m + 1) + pw;
                if (cc < 512) {
                    LAS unsigned char* sl = lds + (cc & 7) * SLOT;
                    const float gC = gCn; float bhat[16], khat[16];
#pragma unroll
                    for (int t = 0; t < 16; ++t) {
                        bhat[t] = bf2f(xw[t]); khat[t] = bf2f(xa[t]);
                        *(LAS unsigned short*)(sl + AH + t * 144 + 2 * lane) = (unsigned short)xr[t];
                        *(LAS unsigned short*)(sl + RH + t * 144 + 2 * lane) = (unsigned short)xk[t];
                        *(LAS unsigned short*)(bh + t * 144 + 2 * lane) = (unsigned short)xw[t];
                        *(LAS unsigned short*)(kh + t * 144 + 2 * lane) = (unsigned short)xa[t];
                        *(LAS unsigned short*)(sl + VV + t * 144 + 2 * lane) = (unsigned short)xv[t];
                    }
                    if (cc + 4 < 512) { RW_LOAD(cc + 4, 0); RW_LOAD(cc + 4, 8); }
                    *(LAS float*)(sl + GC + 4 * lane) = gC;
#pragma unroll
                    for (int q = 0; q < 4; ++q) {
                        u32x2 wb, wk; wb.x = pack2(bhat[4 * q] * gC, bhat[4 * q + 1] * gC); wb.y = pack2(bhat[4 * q + 2] * gC, bhat[4 * q + 3] * gC);
                        wk.x = pack2(khat[4 * q] * gC, khat[4 * q + 1] * gC); wk.y = pack2(khat[4 * q + 2] * gC, khat[4 * q + 3] * gC);
                        *(LAS u32x2*)(sl + BMT + lane * 40 + 8 * q) = wb; *(LAS u32x2*)(sl + KMT + lane * 40 + 8 * q) = wk;
                    }
                    asm volatile("s_waitcnt lgkmcnt(0)" ::: "memory");
                    f32x4 lab = (f32x4){0.f, 0.f, 0.f, 0.f}, lak = lab, mrb = lab, mrk = lab;
#pragma unroll
                    for (int a = 0; a < 2; ++a) {
                        const bf16x8 af = *(LAS const bf16x8*)(sl + AH + n * 144 + (32 * a + 8 * kg) * 2), rf = *(LAS const bf16x8*)(sl + RH + n * 144 + (32 * a + 8 * kg) * 2);
                        const bf16x8 bf_ = *(LAS const bf16x8*)(bh + n * 144 + (32 * a + 8 * kg) * 2), kf = *(LAS const bf16x8*)(kh + n * 144 + (32 * a + 8 * kg) * 2);
                        lab = __builtin_amdgcn_mfma_f32_16x16x32_bf16(af, bf_, lab, 0, 0, 0); lak = __builtin_amdgcn_mfma_f32_16x16x32_bf16(af, kf, lak, 0, 0, 0);
                        mrb = __builtin_amdgcn_mfma_f32_16x16x32_bf16(rf, bf_, mrb, 0, 0, 0); mrk = __builtin_amdgcn_mfma_f32_16x16x32_bf16(rf, kf, mrk, 0, 0, 0);
                    }
#pragma unroll
                    for (int jj = 0; jj < 4; ++jj) { const int t = 4 * kg + jj;
                        Lm[t * 16 + n] = (n < t) ? lab[jj] : 0.f;
                        *(LAS unsigned short*)(sl + LAK + t * 32 + 2 * n) = (unsigned short)f2bf(n < t ? lak[jj] : 0.f);
                        *(LAS unsigned short*)(sl + MRB + t * 32 + 2 * n) = (unsigned short)f2bf(n <= t ? mrb[jj] : 0.f);
                        *(LAS unsigned short*)(sl + MRK + t * 32 + 2 * n) = (unsigned short)f2bf(n <= t ? mrk[jj] : 0.f); }
                    asm volatile("s_waitcnt lgkmcnt(0)" ::: "memory");
                    float x[16];
                    tri_inv16<1>(Lm, n, x);
#pragma unroll
                    for (int jj = 0; jj < 4; ++jj) { const float v = (kg == 0) ? x[jj] : (kg == 1 ? x[4 + jj] : (kg == 2 ? x[8 + jj] : x[12 + jj]));
                        *(LAS unsigned short*)(sl + TM + (4 * kg + jj) * 32 + 2 * n) = (unsigned short)f2bf(v); }
                }
                lds_barrier();
            }
#undef RW_LOAD
        } else if (wave != 0) {
            for (int m = -1; m < 128; ++m) lds_barrier();
        } else {
            const int w = slice;
            f32x4 Zt[4]; bf16x8 Zb[2];
#pragma unroll
            for (int i = 0; i < 4; ++i) Zt[i] = (f32x4){0.f, 0.f, 0.f, 0.f};
            Zb[0] = (bf16x8){0, 0, 0, 0, 0, 0, 0, 0}; Zb[1] = Zb[0];
            struct RwOps { bf16x4 alo[2], ahi[2], rlo[2], rhi[2], vf, lakf, tf, mb, mk, bt[4], kt[4]; f32x4 g4[4]; };
#define RW_OPLOAD(R, cidx) do { LAS const unsigned char* sl_ = lds + ((cidx) & 7) * SLOT; \
                _Pragma("unroll") for (int a = 0; a < 2; ++a) { \
                    R.alo[a] = *(LAS const bf16x4*)(sl_ + AH + n * 144 + (32 * a + 4 * kg) * 2); R.ahi[a] = *(LAS const bf16x4*)(sl_ + AH + n * 144 + (32 * a + 16 + 4 * kg) * 2); \
                    R.rlo[a] = *(LAS const bf16x4*)(sl_ + RH + n * 144 + (32 * a + 4 * kg) * 2); R.rhi[a] = *(LAS const bf16x4*)(sl_ + RH + n * 144 + (32 * a + 16 + 4 * kg) * 2); } \
                _Pragma("unroll") for (int jj = 0; jj < 4; ++jj) R.vf[jj] = *(LAS const short*)(sl_ + VV + (4 * kg + jj) * 144 + (16 * w + n) * 2); \
                R.lakf = *(LAS const bf16x4*)(sl_ + LAK + n * 32 + 8 * kg); R.tf = *(LAS const bf16x4*)(sl_ + TM + n * 32 + 8 * kg); \
                R.mb = *(LAS const bf16x4*)(sl_ + MRB + n * 32 + 8 * kg); R.mk = *(LAS const bf16x4*)(sl_ + MRK + n * 32 + 8 * kg); \
                _Pragma("unroll") for (int i = 0; i < 4; ++i) { R.g4[i] = *(LAS const f32x4*)(sl_ + GC + (16 * i + 4 * kg) * 4); \
                    R.bt[i] = *(LAS const bf16x4*)(sl_ + BMT + (16 * i + n) * 40 + 8 * kg); R.kt[i] = *(LAS const bf16x4*)(sl_ + KMT + (16 * i + n) * 40 + 8 * kg); } } while (0)
#define RW_COMPUTE(R, cidx) do { \
                f32x4 P1 = (f32x4){0.f, 0.f, 0.f, 0.f}, Oa = P1; \
                _Pragma("unroll") for (int a = 0; a < 2; ++a) { P1 = __builtin_amdgcn_mfma_f32_16x16x32_bf16(cat4(R.alo[a], R.ahi[a]), Zb[a], P1, 0, 0, 0); \
                    Oa = __builtin_amdgcn_mfma_f32_16x16x32_bf16(cat4(R.rlo[a], R.rhi[a]), Zb[a], Oa, 0, 0, 0); } \
                P1 = __builtin_amdgcn_mfma_f32_16x16x32_bf16(cat4(R.lakf, z4), cat4(R.vf, z4), P1, 0, 0, 0); \
                const f32x4 Y = __builtin_amdgcn_mfma_f32_16x16x32_bf16(cat4(R.tf, z4), cat4(cvt4(P1), z4), (f32x4){0.f, 0.f, 0.f, 0.f}, 0, 0, 0); \
                const bf16x8 Byv = cat4(cvt4(Y), R.vf); \
                Oa = __builtin_amdgcn_mfma_f32_16x16x32_bf16(cat4(R.mb, R.mk), Byv, Oa, 0, 0, 0); \
                _Pragma("unroll") for (int i = 0; i < 4; ++i) Zt[i] = __builtin_amdgcn_mfma_f32_16x16x32_bf16(cat4(R.bt[i], R.kt[i]), Byv, Zt[i] * R.g4[i], 0, 0, 0); \
                Zb[0] = cat4(cvt4(Zt[0]), cvt4(Zt[1])); Zb[1] = cat4(cvt4(Zt[2]), cvt4(Zt[3])); \
                _Pragma("unroll") for (int jj = 0; jj < 4; ++jj) Og[(rowbase + (size_t)(cidx) * 16 + 4 * kg + jj) * 1024 + h * 64 + 16 * w + n] = (bf16_t)f2bf(Oa[jj]); } while (0)
            const bf16x4 z4 = (bf16x4){0, 0, 0, 0};
            lds_barrier();
            for (int m = 0; m < 128; ++m) {
                RwOps OA, OB;
                RW_OPLOAD(OA, 4 * m);
                RW_OPLOAD(OB, 4 * m + 1); __builtin_amdgcn_sched_barrier(0);
                RW_COMPUTE(OA, 4 * m); __builtin_amdgcn_sched_barrier(0);
                RW_OPLOAD(OA, 4 * m + 2); __builtin_amdgcn_sched_barrier(0);
                RW_COMPUTE(OB, 4 * m + 1); __builtin_amdgcn_sched_barrier(0);
                RW_OPLOAD(OB, 4 * m + 3); __builtin_amdgcn_sched_barrier(0);
                RW_COMPUTE(OA, 4 * m + 2); __builtin_amdgcn_sched_barrier(0);
                RW_COMPUTE(OB, 4 * m + 3);
                lds_barrier();
            }
#undef RW_OPLOAD
#undef RW_COMPUTE
        }
    }
}


template <int KIND>
__device__ __forceinline__ void scan_chunked(LAS unsigned char* lds, PPTR p, int j) {
    constexpr int QOFF = 0, KOFF = 4352, KTOFF = 8704, VOFF = 13824, TOFF = 14464, AMOFF = 14976, SCOFF = 15488, OBOFF = 16000, BUFB = 17024;
    constexpr int LDP = (KIND == 0) ? 4352 : 4096;
    constexpr int VROWS = (KIND == 0) ? 19 : 16, VEND = 512 + 2 * VROWS;
    constexpr int TEND = (KIND == 0) ? VEND + 32 : VEND, AEND = TEND + 32, SEND = AEND + ((KIND == 0) ? 16 : 32);
    const int tid = tidx(), wave = tid >> 6, lane = tid & 63, n = lane & 15, kg = lane >> 4;
    const bf16_t* P = (const bf16_t*)(p->ws + WS_PROJ);
    const bf16_t* Qg = (const bf16_t*)(p->ws + WS_R1); const bf16_t* Kg = (const bf16_t*)(p->ws + WS_KG);
    const bf16_t* Tg = (const bf16_t*)(p->ws + WS_TA);
    const bf16_t* Amg = (const bf16_t*)(p->ws + (KIND == 0 ? WS_AMA : WS_AM));
    const float* Scg = (const float*)(p->ws + (KIND == 0 ? WS_SCA : WS_DEC));
    bf16_t* Og = (KIND == 0) ? (bf16_t*)(p->ws + WS_PROJ) : (bf16_t*)(p->ws + WS_OC);
    constexpr int LDO = (KIND == 0) ? 4352 : 1024;
    const bf16x4 z4 = (bf16x4){0, 0, 0, 0};
    const int G = gdim(); const int vcu = (G % 8 == 0) ? (int)(bidx() % 8) * (G / 8) + (int)(bidx() / 8) : (int)bidx();
    for (int task = vcu; task < 256; task += G) {
        const int bh = task >> 3, w = task & 7, b = bh >> 3, h = bh & 7; const size_t rowbase = (size_t)b * SEQ;
        if (wave == 0) {
            float cwv[4] = {0.f, 0.f, 0.f, 0.f};
            if (KIND == 0) { const float* cv = p->in[6] + (size_t)j * 4 * 3072;
#pragma unroll
                for (int jj = 0; jj < 4; ++jj) cwv[jj] = cv[jj * 3072 + 2048 + h * 128 + 16 * w + n]; }
            f32x4 S[8]; bf16x8 Sb[4];
#pragma unroll
            for (int i = 0; i < 8; ++i) S[i] = (f32x4){0.f, 0.f, 0.f, 0.f};
#pragma unroll
            for (int a = 0; a < 4; ++a) Sb[a] = (bf16x8){0, 0, 0, 0, 0, 0, 0, 0};
            lds_barrier();
            for (int c2 = 0; c2 < 512; c2 += 4) {
#pragma unroll 1
              for (int u = 0; u < 4; ++u) { const int c = c2 + u;
                LAS unsigned char* bb = lds + (c & 7) * BUFB;
                bf16x4 klo[4], khi[4], qlo[4], qhi[4], kt[8], am, tf = z4; f32x4 be4, eg4, egl4, d4[8]; float glast = 0.f; unsigned vr16[7]; bf16x4 vb = z4;
#pragma unroll
                for (int a = 0; a < 4; ++a) {
                    if (KIND == 0) { klo[a] = *(LAS const bf16x4*)(bb + KOFF + n * 272 + (32 * a + 4 * kg) * 2); khi[a] = *(LAS const bf16x4*)(bb + KOFF + n * 272 + (32 * a + 16 + 4 * kg) * 2); }
                    qlo[a] = *(LAS const bf16x4*)(bb + QOFF + n * 272 + (32 * a + 4 * kg) * 2); qhi[a] = *(LAS const bf16x4*)(bb + QOFF + n * 272 + (32 * a + 16 + 4 * kg) * 2); }
                if (KIND == 0) {
#pragma unroll
                    for (int r = 0; r < 7; ++r) vr16[r] = *(LAS const unsigned short*)(bb + VOFF + (4 * kg + r) * 32 + 2 * n);
                    be4 = *(LAS const f32x4*)(bb + SCOFF + (4 * kg) * 4); eg4 = *(LAS const f32x4*)(bb + SCOFF + (16 + 4 * kg) * 4); egl4 = *(LAS const f32x4*)(bb + SCOFF + (32 + 4 * kg) * 4);
                    glast = *(LAS const float*)(bb + SCOFF + 48 * 4); tf = *(LAS const bf16x4*)(bb + TOFF + n * 32 + 8 * kg);
                } else {
#pragma unroll
                    for (int jj = 0; jj < 4; ++jj) vb[jj] = *(LAS const short*)(bb + VOFF + (4 * kg + jj) * 32 + 2 * n);
#pragma unroll
                    for (int i = 0; i < 8; ++i) d4[i] = *(LAS const f32x4*)(bb + SCOFF + (16 * i + 4 * kg) * 4);
                }
                am = *(LAS const bf16x4*)(bb + AMOFF + n * 32 + 8 * kg);
#pragma unroll
                for (int i = 0; i < 8; ++i) kt[i] = *(LAS const bf16x4*)(bb + KTOFF + (16 * i + n) * 40 + 8 * kg);
                __builtin_amdgcn_sched_barrier(0);
                asm volatile("s_waitcnt lgkmcnt(0)" ::: "memory");
                __builtin_amdgcn_sched_barrier(0);
                f32x4 v4 = (f32x4){0.f, 0.f, 0.f, 0.f};
                if (KIND == 0) {
#pragma unroll
                    for (int jj = 0; jj < 4; ++jj) v4[jj] = siluf_(cwv[0] * bf2f(vr16[jj]) + cwv[1] * bf2f(vr16[jj + 1]) + cwv[2] * bf2f(vr16[jj + 2]) + cwv[3] * bf2f(vr16[jj + 3]));
                }
                f32x4 X = (f32x4){0.f, 0.f, 0.f, 0.f}, Z = X;
#pragma unroll
                for (int a = 0; a < 4; ++a) {
                    if (KIND == 0) X = __builtin_amdgcn_mfma_f32_16x16x32_bf16(cat4(klo[a], khi[a]), Sb[a], X, 0, 0, 0);
                    Z = __builtin_amdgcn_mfma_f32_16x16x32_bf16(cat4(qlo[a], qhi[a]), Sb[a], Z, 0, 0, 0);
                }
                f32x4 o; bf16x8 B2;
                if (KIND == 0) {
                    const f32x4 R = be4 * (v4 - eg4 * X);
                    const f32x4 vnew = __builtin_amdgcn_mfma_f32_16x16x32_bf16(cat4(tf, z4), cat4(cvt4(R), z4), (f32x4){0.f, 0.f, 0.f, 0.f}, 0, 0, 0);
                    o = __builtin_amdgcn_mfma_f32_16x16x32_bf16(cat4(am, z4), cat4(cvt4(vnew), z4), Z * eg4, 0, 0, 0);
                    B2 = cat4(cvt4(vnew * egl4), z4);
#pragma unroll
                    for (int i = 0; i < 8; ++i) S[i] = __builtin_amdgcn_mfma_f32_16x16x32_bf16(cat4(kt[i], z4), B2, S[i] * glast, 0, 0, 0);
                } else {
                    B2 = cat4(vb, z4);
                    o = __builtin_amdgcn_mfma_f32_16x16x32_bf16(cat4(am, z4), B2, Z, 0, 0, 0);
#pragma unroll
                    for (int i = 0; i < 8; ++i) S[i] = __builtin_amdgcn_mfma_f32_16x16x32_bf16(cat4(kt[i], z4), B2, S[i] * d4[i], 0, 0, 0);
                }
                *(LAS f32x4*)(bb + OBOFF + lane * 16) = o;
#pragma unroll
                for (int a = 0; a < 4; ++a) Sb[a] = cat4(cvt4(S[2 * a]), cvt4(S[2 * a + 1]));
              }
                lds_barrier();
            }
            lds_barrier();
        } else {
            const int lt = tid - 64, pb = lt + 448;
            const int arow = (lt & 255) >> 4, apc = lt & 15;
            const bf16_t* srcA = (lt < 256 ? Qg : Kg) + (rowbase + arow) * 1024 + h * 128 + 8 * apc;
            const char* srcB; size_t strideB; int kindB;
            if (pb < 512) { kindB = 0; srcB = (const char*)(Kg + (rowbase + ((pb - 256) >> 4)) * 1024 + h * 128 + 8 * (pb & 15)); strideB = (size_t)16 * 1024 * 2; }
            else if (pb < VEND) { kindB = 1; const int vr_ = (pb - 512) >> 1, hf_ = (pb - 512) & 1; srcB = (const char*)(P + (rowbase + vr_) * LDP + 2048 + h * 128 + 16 * w + 8 * hf_); strideB = (size_t)16 * LDP * 2; }
            else if (pb < TEND) { kindB = 2; srcB = (const char*)(Tg + ((size_t)(b * 512) * 8 + h) * 256 + (pb - VEND) * 8); strideB = (size_t)8 * 256 * 2; }
            else if (pb < AEND) { kindB = 3; srcB = (const char*)(Amg + ((size_t)(b * 512) * 8 + h) * 256 + (pb - TEND) * 8); strideB = (size_t)8 * 256 * 2; }
            else if (pb < SEND) { kindB = 4; srcB = (const char*)(Scg + ((size_t)(b * 512) * 8 + h) * (KIND == 0 ? 64 : 128) + (pb - AEND) * 4); strideB = (size_t)8 * (KIND == 0 ? 64 : 128) * 4; }
            else { kindB = 5; srcB = (const char*)srcA; strideB = (size_t)16 * 1024 * 2; }
            const int vrow = (pb - 512) >> 1;
            const bool doflush = (wave == 2);
            constexpr int PD = 8;
            u32x4 g0[PD], g1[PD];
#define SC_LOAD(cc, sl) do { const int c_ = (cc); g0[sl] = *(const u32x4*)(srcA + (size_t)c_ * 16 * 1024); \
                const int tv_ = c_ * 16 + vrow - 3; const bool vh_ = (KIND == 0) && (kindB == 1); \
                const ptrdiff_t ofs_ = vh_ ? (ptrdiff_t)(tv_ >= 0 ? tv_ - vrow : -vrow) * (LDP * 2) : (ptrdiff_t)((size_t)c_ * strideB); \
                const u32x4 vv_ = *(const u32x4*)(srcB + ofs_); g1[sl] = (vh_ && tv_ < 0) ? (u32x4){0u, 0u, 0u, 0u} : vv_; } while (0)
#define SC_KSTORE(bb_, reg, row, pc) do { if (KIND == 0) *(LAS u32x4*)((bb_) + KOFF + (row) * 272 + 16 * (pc)) = (reg); \
                _Pragma("unroll") for (int e = 0; e < 4; ++e) { *(LAS unsigned short*)((bb_) + KTOFF + (8 * (pc) + 2 * e) * 40 + 2 * (row)) = (unsigned short)((reg)[e] & 0xffffu); \
                    *(LAS unsigned short*)((bb_) + KTOFF + (8 * (pc) + 2 * e + 1) * 40 + 2 * (row)) = (unsigned short)((reg)[e] >> 16); } } while (0)
#define SC_STORE(cc, sl) do { LAS unsigned char* bb_ = lds + ((cc) & 7) * BUFB; \
                if (lt < 256) *(LAS u32x4*)(bb_ + QOFF + arow * 272 + 16 * apc) = g0[sl]; else SC_KSTORE(bb_, g0[sl], arow, apc); \
                if (kindB == 0) SC_KSTORE(bb_, g1[sl], ((pb - 256) >> 4), (pb & 15)); \
                else if (kindB == 1) *(LAS u32x4*)(bb_ + VOFF + vrow * 32 + 16 * ((pb - 512) & 1)) = g1[sl]; \
                else if (kindB == 2) *(LAS u32x4*)(bb_ + TOFF + (pb - VEND) * 16) = g1[sl]; \
                else if (kindB == 3) *(LAS u32x4*)(bb_ + AMOFF + (pb - TEND) * 16) = g1[sl]; \
                else if (kindB == 4) *(LAS u32x4*)(bb_ + SCOFF + (pb - AEND) * 16) = g1[sl]; } while (0)
#define SC_OFLUSH(cc) do { const int c_ = (cc); const f32x4 o_ = *(LAS const f32x4*)(lds + (c_ & 7) * BUFB + OBOFF + lane * 16); \
                _Pragma("unroll") for (int jj = 0; jj < 4; ++jj) Og[(rowbase + (size_t)c_ * 16 + 4 * kg + jj) * LDO + h * 128 + 16 * w + n] = (bf16_t)f2bf(o_[jj]); } while (0)
#define SC_LOADER_LOOP(FLUSH) do { \
                _Pragma("unroll") for (int d = 0; d < PD; ++d) SC_LOAD(d, d); \
                SC_STORE(0, 0); SC_STORE(1, 1); SC_STORE(2, 2); SC_STORE(3, 3); \
                SC_LOAD(8, 0); SC_LOAD(9, 1); SC_LOAD(10, 2); SC_LOAD(11, 3); \
                lds_barrier(); \
                for (int c0 = 0; c0 < 512; c0 += PD) { \
                    _Pragma("unroll") for (int d = 0; d < PD; d += 4) { const int c = c0 + d; \
                        if (c + 4 < 512) { _Pragma("unroll") for (int u = 0; u < 4; ++u) SC_STORE(c + 4 + u, (d + 4 + u) % PD); } \
                        if (c + 12 < 512) { _Pragma("unroll") for (int u = 0; u < 4; ++u) SC_LOAD(c + 12 + u, (d + 4 + u) % PD); } \
                        if (FLUSH) { if (c > 0) { _Pragma("unroll") for (int u = 0; u < 4; ++u) SC_OFLUSH(c - 4 + u); } } \
                        lds_barrier(); } } \
                if (FLUSH) { _Pragma("unroll") for (int u = 0; u < 4; ++u) SC_OFLUSH(508 + u); } \
                lds_barrier(); } while (0)
            if (doflush) SC_LOADER_LOOP(true); else SC_LOADER_LOOP(false);
#undef SC_LOAD
#undef SC_KSTORE
#undef SC_STORE
#undef SC_OFLUSH
#undef SC_LOADER_LOOP
        }
    }
}

template <int KIND>
__device__ __forceinline__ void post_phase(PPTR p, int j) {
    const int lane = tidx() & 63, wave = tidx() >> 6;
    const int gw = bidx() * 8 + wave, nw = gdim() * 8;
    bf16_t* O = (bf16_t*)(p->ws + (KIND != 0 ? WS_OC : WS_PROJ));
    constexpr int LDO = (KIND == 0) ? 4352 : 1024;
    const bf16_t* P = (const bf16_t*)(p->ws + (KIND == 2 ? WS_PROJC : WS_PROJ));
    if (KIND != 2) {
        const float* nwp = (KIND == 0) ? p->in[9] + j * 128 : p->in[13];
        const float n0 = nwp[2 * lane], n1 = nwp[2 * lane + 1];
        constexpr int LDP = (KIND == 0) ? 4352 : 4096; constexpr int ZOFF = 3072;
        for (int row = gw; row < MROWS; row += nw) {
            unsigned ov[8], zv[8];
#pragma unroll
            for (int h = 0; h < 8; ++h) { ov[h] = *(const unsigned*)(O + (size_t)row * LDO + h * 128 + 2 * lane); zv[h] = *(const unsigned*)(P + (size_t)row * LDP + ZOFF + h * 128 + 2 * lane); }
#pragma unroll
            for (int h = 0; h < 8; ++h) {
                const float o0 = bflo(ov[h]), o1 = bfhi(ov[h]);
                const float ss = wave_allsum(o0 * o0 + o1 * o1); const float rstd = __builtin_amdgcn_rsqf(ss * (1.0f / 128.0f) + 1e-6f);
                *(unsigned*)(O + (size_t)row * LDO + h * 128 + 2 * lane) = pack2(o0 * rstd * n0 * siluf_(bflo(zv[h])), o1 * rstd * n1 * siluf_(bfhi(zv[h])));
            }
        }
    } else {
        const bf16_t* L2 = (const bf16_t*)(p->ws + WS_R1); const float* BNg = (const float*)(p->ws + WS_BNG);
        for (int task = gw; task < MROWS * 2; task += nw) {
            const int row = task >> 1, h0 = (task & 1) * 8;
            unsigned xy[8], xv[8], xg[8]; float bn[8], lw[8], lb_[8];
#pragma unroll
            for (int hh = 0; hh < 8; ++hh) { const int ch = (h0 + hh) * 64 + lane; const bf16_t* rowp = P + (size_t)row * 3328; const bf16_t* l2p = L2 + (size_t)row * 3072;
                xy[hh] = O[(size_t)row * DM + ch]; xv[hh] = rowp[2048 + ch]; xg[hh] = l2p[2048 + ch]; bn[hh] = BNg[(size_t)row * 16 + h0 + hh];
                lw[hh] = p->in[28][ch]; lb_[hh] = p->in[29][ch]; }
#pragma unroll
            for (int hh = 0; hh < 8; ++hh) { const int ch = (h0 + hh) * 64 + lane;
                const float y = bf2f(xy[hh]);
                const float mean = wave_allsum(y) * (1.0f / 64.0f); const float dd = y - mean;
                const float var = wave_allsum(dd * dd) * (1.0f / 64.0f);
                const float gn = dd * __builtin_amdgcn_rsqf(var + 0.04096f) * lw[hh] + lb_[hh];
                O[(size_t)row * DM + ch] = (bf16_t)f2bf((gn + bn[hh] * bf2f(xv[hh])) * bf2f(xg[hh]));
            }
        }
    }
}

#define XB_TMO      128
#define XB_XCNT(j)  (256  + 64 * (j))
#define XB_XSUB(j)  (1280 + 64 * (j))
#define XB_XGEN(j)  (2304 + 64 * (j))
#define XB_TOP      3328
#define XB_TOPGEN   3392
#define XCD_BAR_WORDS 3456
#define XB_SPIN_CAP (1u << 18)
constexpr size_t WS_BAR = WS_MISC + 1 * MiB;
__device__ __forceinline__ unsigned xb_ld(unsigned* p)              { return __hip_atomic_load(p, __ATOMIC_RELAXED, __HIP_MEMORY_SCOPE_AGENT); }
__device__ __forceinline__ unsigned xb_add(unsigned* p, unsigned v) { return __hip_atomic_fetch_add(p, v, __ATOMIC_RELAXED, __HIP_MEMORY_SCOPE_AGENT); }
__device__ __forceinline__ unsigned xb_xcc_id() { return (unsigned)__builtin_amdgcn_s_getreg((3 << 11) | 20) & 0xFu; }
#define XB_SPIN(cond, bar) do { unsigned _sp = 0; while (cond) { __builtin_amdgcn_s_sleep(1); \
    if ((++_sp & 255u) == 0u) { if (xb_ld(&(bar)[XB_TMO])) break; if (_sp > XB_SPIN_CAP) { atomicAdd(&(bar)[XB_TMO], 1u); break; } } } } while (0)
struct XcdBarrier { unsigned* bar; unsigned x; volatile LAS unsigned* st; };
__device__ __forceinline__ XcdBarrier xcd_barrier_post(unsigned* bar, volatile LAS unsigned* st) {
    XcdBarrier b; b.bar = bar; b.x = xb_xcc_id(); b.st = st;
    if (threadIdx.x == 0) (void)xb_add(&bar[XB_XCNT(b.x)], 1u);
    return b;
}
__device__ __forceinline__ void xcd_barrier_complete(unsigned* bar, unsigned x, unsigned& nloc, unsigned& nx) {
    const unsigned G = gridDim.x * gridDim.y * gridDim.z;
    unsigned sum, cnt, mine, sp = 0u;
    for (;;) {
        sum = 0u; cnt = 0u; mine = 0u;
#pragma unroll
        for (unsigned j = 0; j < 16; ++j) { const unsigned c = xb_ld(&bar[XB_XCNT(j)]); sum += c; cnt += (c > 0u) ? 1u : 0u; mine = (j == x) ? c : mine; }
        if (sum == G) break;
        __builtin_amdgcn_s_sleep(1);
        if ((++sp & 255u) == 0u) { if (xb_ld(&bar[XB_TMO])) break; if (sp > XB_SPIN_CAP) { atomicAdd(&bar[XB_TMO], 1u); break; } }
    }
    nloc = mine > 0u ? mine : 1u; nx = cnt > 0u ? cnt : 1u;
}
__device__ __forceinline__ void xcd_barrier(const XcdBarrier& b) {
    asm volatile("s_waitcnt vmcnt(0)" ::: "memory");
    __syncthreads();
    if (threadIdx.x == 0) {
        unsigned* bar = b.bar;
        __builtin_amdgcn_s_waitcnt(0);
        unsigned nloc = b.st[0], nx = b.st[1];
        if (nloc == 0u) { xcd_barrier_complete(bar, b.x, nloc, nx); b.st[0] = nloc; b.st[1] = nx; }
        const unsigned old = xb_add(&bar[XB_XSUB(b.x)], 1u);
        const unsigned gen = old / nloc;
        if (old + 1u == (gen + 1u) * nloc) {
            __builtin_amdgcn_fence(__ATOMIC_RELEASE, "agent");
            asm volatile("s_waitcnt vmcnt(0)" ::: "memory");
            const unsigned og = xb_add(&bar[XB_TOP], 1u);
            const unsigned tg = og / nx;
            if (og + 1u == (tg + 1u) * nx) xb_add(&bar[XB_TOPGEN], 1u);
            else XB_SPIN(xb_ld(&bar[XB_TOPGEN]) == tg, bar);
            __builtin_amdgcn_fence(__ATOMIC_ACQUIRE, "agent");
            xb_add(&bar[XB_XGEN(b.x)], 1u);
            asm volatile("s_waitcnt vmcnt(0)" ::: "memory");
        } else {
            XB_SPIN(xb_ld(&bar[XB_XGEN(b.x)]) == gen, bar);
            __builtin_amdgcn_fence(__ATOMIC_ACQUIRE, "agent");
            asm volatile("s_waitcnt vmcnt(0)" ::: "memory");
        }
    }
    __syncthreads();
}

constexpr int NPH = 54;
__host__ __device__ inline int step_of(int ph) { const int si = (ph - 1) % 13; return si < 3 ? si : (si == 3 ? 12 : si - 1); }
__host__ __device__ inline bool phase_is_noop(int ph) {
    if (ph == 0 || ph == NPH - 1) return false;
    const int l = (ph - 1) / 13, st = step_of(ph);
    return st == 12 && (l % 3) != 2;
}

__global__ void __launch_bounds__(512, 2) mega(const Params pv) {
    extern __shared__ __attribute__((aligned(16))) unsigned char shm[];
    PPTR p = &pv;
    LAS unsigned char* lds = (LAS unsigned char*)shm;
    cg::grid_group grid = cg::this_grid();
    volatile LAS unsigned* xb_st = (volatile LAS unsigned*)(lds + 147440);
    if (threadIdx.x == 0) { xb_st[0] = 0u; xb_st[1] = 0u; }
    __syncthreads();
    const XcdBarrier xb = xcd_barrier_post((unsigned*)(pv.ws + WS_BAR), xb_st);
    const int ph_lo = p->ph_lo, ph_hi = p->ph_hi;
    for (int ph = ph_lo; ph < ph_hi; ++ph) {
        if (phase_is_noop(ph)) continue;
        float* mod = (float*)(p->ws + WS_MISC);
        bf16_t* W = (bf16_t*)(p->ws + WS_W);
        if (ph == 0) { pre_phase(lds, p); __syncthreads(); cvt_layer(lds, p, 0); }
        else if (ph == NPH - 1) { if (PHMASK & 2) final_phase(p->out, p->in[35]); }
        else {
            const int l = (ph - 1) / 13, st = step_of(ph), kind = l % 3, j = l / 3;
            const float* hin = (l == 0) ? p->in[0] : p->out;
            const float* modl = mod + (size_t)l * 4 * 6144;
            bf16_t* R1 = (bf16_t*)(p->ws + WS_R1);
            for (int rep = 0; rep < 1 + (((REPMASK >> st) & 1) & ((REPL >> l) & 1)); ++rep) {
            if (rep) grid.sync();
            if (!(PHMASK & (4 << st))) {} else if (st == 0) {
                if (l > 0) cvt_layer(lds, p, l);
                if (kind == 2) norm_phase<true>(hin, p->in[2] + (size_t)(l * 2 + 0) * 1024, modl, 0, R1, 2048);
                else norm_phase<false>(hin, p->in[2] + (size_t)(l * 2 + 0) * 1024, modl, 0, R1, 1024);
            } else if (st == 12) {
                prep_rwkv_elem(p);
            } else if (st == 2 && kind == 1) {
                prep_gla(lds, p);
            } else if (st == 2 && kind == 0) {
                prep_delta(lds, p, j);
            } else if (st == 1 || st == 2 || st == 7 || st == 9) {
                pg8::EpiBf16S E; E.act = 0; const bf16_t* A; const bf16_t* Bt; int lda, N, K;
                if (st == 1) {
                    A = R1; Bt = W + W_IN / 2;
                    if (kind == 0) { E.O = (bf16_t*)(p->ws + WS_PROJ); E.ldc = 4352; lda = 1024; N = 4352; K = 1024; }
                    else if (kind == 1) { E.O = (bf16_t*)(p->ws + WS_PROJ); E.ldc = 4096; lda = 1024; N = 4096; K = 1024; }
                    else { E.O = (bf16_t*)(p->ws + WS_PROJC); E.ldc = 3328; E.act = 1; lda = 2048; N = 3328; K = 2048; }
                } else if (st == 2) {
                    A = (const bf16_t*)(p->ws + WS_PROJC) + 3072; Bt = W + W_L2 / 2; E.O = R1; E.ldc = 3072; lda = 3328; N = 3072; K = 256;
                } else {
                    const int g = (st == 9);
                    A = R1; Bt = W + W_UP / 2 + (size_t)(g ? 3072 : 0) * 1024; N = g ? 2560 : 3072; E.O = (bf16_t*)(p->ws + WS_HID); E.ldc = N; lda = 1024; K = 1024;
                }
                run_gemm(lds, A, lda, Bt, N, K, E);
            } else if (st == 5 || st == 11) {
                pg8::EpiRes E; const bf16_t* A; const bf16_t* Bt; int lda, K;
                if (st == 5) { E.res = hin; E.out = p->out; E.gate = modl + 2 * 1024; A = (const bf16_t*)(p->ws + (kind != 0 ? WS_OC : WS_PROJ)); lda = (kind == 0) ? 4352 : 1024; Bt = W + W_OUT / 2; K = 1024; }
                else { E.res = p->out; E.out = p->out; E.gate = modl + 5 * 1024; A = (const bf16_t*)(p->ws + WS_ACT); lda = 2816; Bt = W + W_DN / 2; K = 2816; }
                run_gemm(lds, A, lda, Bt, 1024, K, E);
            } else if (st == 3) {
                if (kind == 0) scan_chunked<0>(lds, p, j); else if (kind == 1) scan_chunked<1>(lds, p, j); else scan_rwkv(lds, p);
            } else if (st == 4) {
                if (kind == 0) post_phase<0>(p, j); else if (kind == 1) post_phase<1>(p, j); else post_phase<2>(p, j);
            } else if (st == 6) {
                norm_phase<false>(p->out, p->in[2] + (size_t)(l * 2 + 1) * 1024, modl, 3, R1, 1024);
            } else if (st == 8 || st == 10) {
                const int g = (st == 10);
                convglu_phase((const bf16_t*)(p->ws + WS_HID), (bf16_t*)(p->ws + WS_ACT), g, p->in[32] + (size_t)l * 3 * 5632, p->in[33] + (size_t)l * 5632);
            }
            }
        }
        if (ph + 1 < ph_hi) { if (ph == ph_lo) grid.sync(); else xcd_barrier(xb); }
    }
}

extern "C" void kernel_launch(void* const* d_in, const int* in_sizes, int n_in, void* d_out, int out_size, void* d_ws, size_t ws_size, hipStream_t stream) {
    constexpr int LDS_BYTES = 144 * 1024;
    static int grid_blocks = 0;
    if (!grid_blocks) {
        int dev = 0, cus = 0, per_cu = 0;
        hipGetDevice(&dev);
        hipDeviceGetAttribute(&cus, hipDeviceAttributeMultiprocessorCount, dev);
        if (hipFuncSetAttribute((const void*)mega, hipFuncAttributeMaxDynamicSharedMemorySize, LDS_BYTES) != hipSuccess) fprintf(stderr, "hipFuncSetAttribute failed\n");
        hipOccupancyMaxActiveBlocksPerMultiprocessor(&per_cu, (const void*)mega, 512, LDS_BYTES);
        if (per_cu < 1) per_cu = 1;
        if (per_cu > 1) per_cu = 1;
        grid_blocks = cus * per_cu;
        if (ws_size < 512 * MiB) fprintf(stderr, "workspace too small: %zu\n", ws_size);
    }
    (void)hipMemsetAsync((char*)d_ws + WS_BAR, 0, XCD_BAR_WORDS * sizeof(unsigned), stream);
    Params p{};
    for (int i = 0; i < 36; ++i) p.in[i] = (const float*)d_in[i];
    p.out = (float*)d_out; p.ws = (unsigned char*)d_ws;
#if SINGLE_LAUNCH
    p.ph_lo = 0; p.ph_hi = NPH;
    void* args[] = {&p};
    hipError_t e = hipLaunchCooperativeKernel((const void*)mega, dim3(grid_blocks), dim3(512), args, LDS_BYTES, stream);
    if (e != hipSuccess) fprintf(stderr, "cooperative launch failed: %s (grid %d)\n", hipGetErrorString(e), grid_blocks);
#else
    for (int ph = 0; ph < NPH; ++ph) {
        if (phase_is_noop(ph)) continue;
        p.ph_lo = ph; p.ph_hi = ph + 1;
        hipLaunchKernelGGL(mega, dim3(grid_blocks), dim3(512), LDS_BYTES, stream, p);
    }
#endif
}
```

```cpp
#include <hip/hip_runtime.h>
#include <hip/hip_cooperative_groups.h>
#include <cstdio>
namespace cg = cooperative_groups;

#ifndef PHMASK
#define PHMASK 0xFFFFFF
#endif
#ifndef REPMASK
#define REPMASK 0
#endif
#ifndef REPL
#define REPL 0xF
#endif
#ifndef SINGLE_LAUNCH
#define SINGLE_LAUNCH 1
#endif

#define LAS __attribute__((address_space(3)))
typedef unsigned short bf16_t;
typedef short bf16x8 __attribute__((ext_vector_type(8)));
typedef float f32x4 __attribute__((ext_vector_type(4)));
typedef float f32x2 __attribute__((ext_vector_type(2)));
typedef unsigned u32x4 __attribute__((ext_vector_type(4)));
typedef unsigned u32x2 __attribute__((ext_vector_type(2)));

constexpr int MROWS = 32768, SEQ = 8192, DM = 1024;
constexpr size_t MiB = 1ull << 20;
constexpr size_t WS_W = 0;
constexpr size_t W_IN = 0, W_L2 = 13 * MiB, W_OUT = 15 * MiB, W_UP = 17 * MiB, W_DN = 28 * MiB;
constexpr size_t WS_MISC = 34 * MiB;
constexpr size_t WS_R1 = 36 * MiB;
constexpr size_t WS_PROJ = 164 * MiB;
constexpr size_t WS_PROJC = 228 * MiB;
constexpr size_t WS_OC = 436 * MiB;
constexpr size_t WS_HID = 100 * MiB;
constexpr size_t WS_ACT = 292 * MiB;

struct Params {
    const float* in[36];
    float* out;
    unsigned char* ws;
    int ph_lo, ph_hi;
};
typedef const Params* PPTR;

__device__ __forceinline__ float bf2f(unsigned v) { return __uint_as_float(v << 16); }
__device__ __forceinline__ float bflo(unsigned v) { return __uint_as_float(v << 16); }
__device__ __forceinline__ float bfhi(unsigned v) { return __uint_as_float(v & 0xffff0000u); }
typedef __bf16 bf16v2 __attribute__((ext_vector_type(2)));
__device__ __forceinline__ unsigned pack2(float lo, float hi) { const f32x2 v = {lo, hi}; const bf16v2 r = __builtin_convertvector(v, bf16v2); return __builtin_bit_cast(unsigned, r); }
__device__ __forceinline__ unsigned f2bf(float f) { return pack2(f, 0.f) & 0xffffu; }
__device__ __forceinline__ float sigmoidf_(float x) { return __builtin_amdgcn_rcpf(1.0f + __expf(-x)); }
__device__ __forceinline__ float siluf_(float x) { return x * __builtin_amdgcn_rcpf(1.0f + __expf(-x)); }
__device__ __forceinline__ float softplusf_(float x) { return x > 15.0f ? x : __logf(1.0f + __expf(x)); }
template <int CTRL> __device__ __forceinline__ float dpp_f(float x) { return __int_as_float(__builtin_amdgcn_update_dpp(0, __float_as_int(x), CTRL, 0xf, 0xf, false)); }
__device__ __forceinline__ float rowred16(float x) { x += dpp_f<0x128>(x); x += dpp_f<0x124>(x); x += dpp_f<0x122>(x); x += dpp_f<0x121>(x); return x; }
__device__ __forceinline__ float wave_allsum(float v) {
    float r = rowred16(v);
    r += __int_as_float(__builtin_amdgcn_update_dpp(0, __float_as_int(r), 0x142, 0xa, 0xf, false));
    r += __int_as_float(__builtin_amdgcn_update_dpp(0, __float_as_int(r), 0x143, 0xc, 0xf, false));
    return __int_as_float(__builtin_amdgcn_readlane(__float_as_int(r), 63));
}
struct StepRegs { f32x4 a, b, c, d, e; float vr, x0, x1; };
template <int KIND> __device__ __forceinline__ void step_load(StepRegs& r, LAS const float* rec, int li, int row) {
    r.a = *(LAS const f32x4*)(rec + 4 * li); r.b = *(LAS const f32x4*)(rec + 64 + 4 * li); r.c = *(LAS const f32x4*)(rec + 128 + 4 * li); r.d = *(LAS const f32x4*)(rec + 192 + 4 * li);
    if (KIND == 0) { r.vr = rec[256 + row]; r.x0 = rec[272]; r.x1 = rec[273]; }
    else if (KIND == 1) { r.vr = rec[256 + row]; }
    else { r.e = *(LAS const f32x4*)(rec + 256 + 4 * li); r.vr = rec[320 + row]; }
}
template <int KIND> __device__ __forceinline__ float step_compute(const StepRegs& r, f32x2 (&s)[4]) {
    if (KIND == 0) {
        const f32x2 k[4] = {{r.a[0], r.a[1]}, {r.a[2], r.a[3]}, {r.b[0], r.b[1]}, {r.b[2], r.b[3]}};
        const f32x2 q[4] = {{r.c[0], r.c[1]}, {r.c[2], r.c[3]}, {r.d[0], r.d[1]}, {r.d[2], r.d[3]}};
        f32x2 pa = s[0] * k[0] + s[1] * k[1]; const f32x2 pb = s[2] * k[2] + s[3] * k[3]; pa += pb;
        const float pp = rowred16(pa.x + pa.y);
        const float cc = r.x0 * (r.vr - r.x1 * pp);
        const f32x2 eg2 = {r.x1, r.x1}, cc2 = {cc, cc};
#pragma unroll
        for (int i = 0; i < 4; ++i) s[i] = s[i] * eg2 + cc2 * k[i];
        f32x2 oa = s[0] * q[0] + s[1] * q[1]; const f32x2 ob = s[2] * q[2] + s[3] * q[3]; oa += ob;
        return rowred16(oa.x + oa.y);
    } else if (KIND == 1) {
        const f32x2 q[4] = {{r.a[0], r.a[1]}, {r.a[2], r.a[3]}, {r.b[0], r.b[1]}, {r.b[2], r.b[3]}};
        const f32x2 f[4] = {{r.c[0], r.c[1]}, {r.c[2], r.c[3]}, {r.d[0], r.d[1]}, {r.d[2], r.d[3]}};
        const f32x2 v2 = {r.vr, r.vr};
#pragma unroll
        for (int i = 0; i < 4; ++i) s[i] = s[i] * f[i] + v2 * (1.0f - f[i]);
        f32x2 oa = s[0] * q[0] + s[1] * q[1]; const f32x2 ob = s[2] * q[2] + s[3] * q[3]; oa += ob;
        return rowred16(oa.x + oa.y);
    } else {
        const f32x2 a2[2] = {{r.a[0], r.a[1]}, {r.a[2], r.a[3]}}, b2[2] = {{r.b[0], r.b[1]}, {r.b[2], r.b[3]}}, d2[2] = {{r.c[0], r.c[1]}, {r.c[2], r.c[3]}};
        const f32x2 k2[2] = {{r.d[0], r.d[1]}, {r.d[2], r.d[3]}}, r2[2] = {{r.e[0], r.e[1]}, {r.e[2], r.e[3]}};
        const f32x2 pa = s[0] * a2[0] + s[1] * a2[1];
        const float sa = rowred16(pa.x + pa.y);
        const f32x2 sa2 = {sa, sa}, v2 = {r.vr, r.vr};
        s[0] = s[0] * d2[0] + sa2 * b2[0] + v2 * k2[0]; s[1] = s[1] * d2[1] + sa2 * b2[1] + v2 * k2[1];
        const f32x2 oa = s[0] * r2[0] + s[1] * r2[1];
        return rowred16(oa.x + oa.y);
    }
}
__device__ __forceinline__ int tidx() { int t = threadIdx.x; asm volatile("" : "+v"(t)); return t; }
__device__ __forceinline__ int bidx() { int t = blockIdx.x; asm volatile("" : "+s"(t)); return t; }
__device__ __forceinline__ int gdim() { int t = gridDim.x; asm volatile("" : "+s"(t)); return t; }
__device__ __forceinline__ void lds_barrier() { asm volatile("s_waitcnt lgkmcnt(0)" ::: "memory"); __builtin_amdgcn_s_barrier(); asm volatile("" ::: "memory"); }

namespace pg8 {
constexpr int BM = 256, BK = 64, HALF = 128, HTB = HALF * BK * 2, STAGE_BYTES = 8 * HTB, NXCD = 8, WGM = 8;
__device__ __forceinline__ int lds_byte(int r, int c) { const int st = (r >> 4) * 2 + (c >> 5), rr = r & 15, cc = c & 31, ob = rr * 64 + cc * 2; return st * 1024 + (ob ^ (((ob >> 9) & 1) << 5)); }
__device__ __forceinline__ void stage_rc(int b, int& R, int& C) { const int st = b / 1024, sb = b % 1024, swz = sb ^ (((sb >> 9) & 1) << 5); R = (st >> 1) * 16 + swz / 64; C = (st & 1) * 32 + (swz % 64) / 2; }
__device__ __forceinline__ int perm32(int rho) { const int n = rho >> 4, i = rho & 15; return 8 * (i >> 2) + 4 * n + (i & 3); }
struct Unit { int pm, pn; };
struct Gemm { const bf16_t* A; const bf16_t* Bt; int M, N, K, lda; };
struct StaticOrder {
    int nM, nN, nwg, G, c;
    __device__ void init(int M, int N, int G_, int c_) { nM = M / BM; nN = N / BM; nwg = nM * nN; G = G_; c = c_; }
    __device__ bool next(int i, Unit& u) const {
        const long L = (long)i * G + c; if (L >= nwg) return false;
        int wgid = (int)L; { const int q = nwg / NXCD, r = nwg % NXCD, xcd = wgid % NXCD, off = wgid / NXCD; wgid = (xcd < r ? xcd * (q + 1) : r * (q + 1) + (xcd - r) * q) + off; }
        const int nig = WGM * nN, gid = wgid / nig, fm = gid * WGM, gsz = (nM - fm) < WGM ? (nM - fm) : WGM;
        u.pm = fm + ((wgid % nig) % gsz); u.pn = (wgid % nig) / gsz; return true;
    }
};
__device__ __forceinline__ unsigned cvt_pk_bf16(float lo, float hi) { return pack2(lo, hi); }

struct EpiBf16S {
    static constexpr bool PERM = true;
    bf16_t* O; int ldc; int act;
    __device__ __forceinline__ void operator()(const f32x4 (&acc)[2][2][4][2], const Unit& u, int wr, int wc, int fr, int fq) const {
        const int row0 = u.pm * BM + wr * 64 + fr; const int col0 = u.pn * BM + wc * 32 + 8 * fq;
#pragma unroll
        for (int ai = 0; ai < 2; ++ai)
#pragma unroll
            for (int m = 0; m < 4; ++m) { bf16_t* rowp = O + (size_t)(row0 + ai * HALF + m * 16) * ldc + col0;
#pragma unroll
                for (int bj = 0; bj < 2; ++bj) { f32x4 v0 = acc[ai][bj][m][0], v1 = acc[ai][bj][m][1];
                    if (act) { const int c = col0 + bj * HALF;
                        if (c >= 3072 && c < 3136) {
#pragma unroll
                            for (int j = 0; j < 4; ++j) { v0[j] = 1.0f - 2.0f * __builtin_amdgcn_rcpf(1.0f + __expf(2.0f * v0[j])); v1[j] = 1.0f - 2.0f * __builtin_amdgcn_rcpf(1.0f + __expf(2.0f * v1[j])); } }
                        else if (c >= 3200) {
#pragma unroll
                            for (int j = 0; j < 4; ++j) { v0[j] = sigmoidf_(v0[j]); v1[j] = sigmoidf_(v1[j]); } } }
                    u32x4 w; w.x = cvt_pk_bf16(v0[0], v0[1]); w.y = cvt_pk_bf16(v0[2], v0[3]); w.z = cvt_pk_bf16(v1[0], v1[1]); w.w = cvt_pk_bf16(v1[2], v1[3]);
                    *(u32x4*)(rowp + bj * HALF) = w; } }
    }
};
struct EpiRes {
    static constexpr bool PERM = false;
    const float* res; float* out; const float* gate;
    __device__ __forceinline__ void operator()(const f32x4 (&acc)[2][2][4][2], const Unit& u, int wr, int wc, int fr, int fq) const {
        const int row0 = u.pm * BM + wr * 64 + fr, col0 = u.pn * BM + wc * 32 + 4 * fq; const int b = (u.pm * BM) / SEQ;
        f32x4 gv[2][2];
#pragma unroll
        for (int bj = 0; bj < 2; ++bj)
#pragma unroll
            for (int n = 0; n < 2; ++n) gv[bj][n] = *(const f32x4*)(gate + (size_t)b * 6144 + col0 + bj * HALF + n * 16);
        f32x4 rA[2][2][2], rB[2][2][2];
#define ER_LOAD(R, k) do { _Pragma("unroll") for (int mm = 0; mm < 2; ++mm) { const size_t off = (size_t)(row0 + ((k) >> 1) * HALF + (2 * ((k) & 1) + mm) * 16) * DM + col0; \
            _Pragma("unroll") for (int bj = 0; bj < 2; ++bj) _Pragma("unroll") for (int n = 0; n < 2; ++n) R[mm][bj][n] = *(const f32x4*)(res + off + bj * HALF + n * 16); } } while (0)
#define ER_STORE(R, k) do { _Pragma("unroll") for (int mm = 0; mm < 2; ++mm) { const size_t off = (size_t)(row0 + ((k) >> 1) * HALF + (2 * ((k) & 1) + mm) * 16) * DM + col0; \
            _Pragma("unroll") for (int bj = 0; bj < 2; ++bj) _Pragma("unroll") for (int n = 0; n < 2; ++n) \
                *(f32x4*)(out + off + bj * HALF + n * 16) = R[mm][bj][n] + gv[bj][n] * acc[(k) >> 1][bj][2 * ((k) & 1) + mm][n]; } } while (0)
        ER_LOAD(rA, 0);
        ER_LOAD(rB, 1); __builtin_amdgcn_sched_barrier(0);
        ER_STORE(rA, 0); __builtin_amdgcn_sched_barrier(0);
        ER_LOAD(rA, 2); __builtin_amdgcn_sched_barrier(0);
        ER_STORE(rB, 1); __builtin_amdgcn_sched_barrier(0);
        ER_LOAD(rB, 3); __builtin_amdgcn_sched_barrier(0);
        ER_STORE(rA, 2); __builtin_amdgcn_sched_barrier(0);
        ER_STORE(rB, 3);
#undef ER_LOAD
#undef ER_STORE
    }
};

template <class Epi>
__device__ __forceinline__ void gemm_phase(LAS unsigned char* lds, const Gemm g, const StaticOrder& S, const Epi& E) {
    const int tid = tidx(), wid = __builtin_amdgcn_readfirstlane(tid >> 6), lane = tid & 63, wr = wid >> 2, wc = wid & 3, fr = lane & 15, fq = lane >> 4;
    const int K = g.K, nt = K / BK, lda = g.lda;
    unsigned voffA[2], voffB[2];
#pragma unroll
    for (int i = 0; i < 2; ++i) { int R, C; stage_rc(tid * 16 + i * 8192, R, C); const int Rb = Epi::PERM ? ((R & ~31) + perm32(R & 31)) : R;
        voffA[i] = (unsigned)(R * lda + C) * 2u; voffB[i] = (unsigned)(Rb * K + C) * 2u; }
    const size_t kstep = (size_t)(BK * 2);
    const size_t hstepA = (size_t)HALF * lda * 2, hstepB = (size_t)HALF * K * 2;
    const size_t tstepA = 2 * hstepA, tstepB = 2 * hstepB;
    const unsigned ldsw = (unsigned)wid * 1024u;
    const int aoff = lds_byte(wr * 64 + fr, fq * 8), boff = lds_byte(wc * 32 + fr, fq * 8);
#define PG8_SA(b, h) (((b) * 2 + (h)) * HTB)
#define PG8_SB(b, h) ((4 + (b) * 2 + (h)) * HTB)
#define PG8_STAGE(bufoff, gbase, voff) do { _Pragma("unroll") for (int _i = 0; _i < 2; ++_i) \
        __builtin_amdgcn_global_load_lds((const unsigned*)((const char*)(gbase) + (voff)[_i]), (LAS unsigned*)(lds + (bufoff) + ldsw + _i * 8192), 16, 0, 0); } while (0)
#define PG8_LDA(dst, b, h) do { _Pragma("unroll") for (int m = 0; m < 4; ++m) _Pragma("unroll") for (int k = 0; k < 2; ++k) dst[m][k] = *(const LAS bf16x8*)(lds + PG8_SA(b, h) + aoff + m * 2048 + k * 1024); } while (0)
#define PG8_LDB(dst, b, h) do { _Pragma("unroll") for (int n = 0; n < 2; ++n) _Pragma("unroll") for (int k = 0; k < 2; ++k) dst[n][k] = *(const LAS bf16x8*)(lds + PG8_SB(b, h) + boff + n * 2048 + k * 1024); } while (0)
#define PG8_MMA(ai, bj, At, Bt) do { __builtin_amdgcn_s_setprio(1); _Pragma("unroll") for (int m = 0; m < 4; ++m) _Pragma("unroll") for (int n = 0; n < 2; ++n) _Pragma("unroll") for (int k = 0; k < 2; ++k) \
        acc[ai][bj][m][n] = __builtin_amdgcn_mfma_f32_16x16x32_bf16(Bt[n][k], At[m][k], acc[ai][bj][m][n], 0, 0, 0); __builtin_amdgcn_s_setprio(0); } while (0)
#define PG8_WAIT_V(n) asm volatile("s_waitcnt vmcnt(" #n ")" ::: "memory")
#define PG8_WAIT_L(n) asm volatile("s_waitcnt lgkmcnt(" #n ")" ::: "memory")
#define PG8_BAR __builtin_amdgcn_s_barrier()
#define PG8_SCHED __builtin_amdgcn_sched_barrier(0)
    Unit cur, nxt; int ui = 0;
    if (!S.next(0, cur)) return;
    f32x4 acc[2][2][4][2];
#pragma unroll
    for (int a = 0; a < 2; ++a)
#pragma unroll
        for (int b = 0; b < 2; ++b)
#pragma unroll
            for (int m = 0; m < 4; ++m)
#pragma unroll
                for (int n = 0; n < 2; ++n) acc[a][b][m][n] = (f32x4){0.f, 0.f, 0.f, 0.f};
    bf16x8 At[4][2], B0[2][2], B1[2][2];
    const char* cA = (const char*)g.A + (size_t)cur.pm * tstepA; const char* cB = (const char*)g.Bt + (size_t)cur.pn * tstepB;
    PG8_STAGE(PG8_SB(0, 0), cB, voffB); PG8_STAGE(PG8_SA(0, 0), cA, voffA); PG8_STAGE(PG8_SB(0, 1), cB + hstepB, voffB); PG8_STAGE(PG8_SA(0, 1), cA + hstepA, voffA);
    if (wr == 1) PG8_BAR;
    PG8_WAIT_V(4); PG8_BAR;
    PG8_STAGE(PG8_SB(1, 0), cB + kstep, voffB); PG8_STAGE(PG8_SA(1, 0), cA + kstep, voffA); PG8_STAGE(PG8_SB(1, 1), cB + hstepB + kstep, voffB);
    PG8_WAIT_V(6); PG8_BAR;
    for (;;) {
        const bool has_next = S.next(ui + 1, nxt);
        const char* nA = has_next ? (const char*)g.A + (size_t)nxt.pm * tstepA : cA; const char* nB = has_next ? (const char*)g.Bt + (size_t)nxt.pn * tstepB : cB;
        for (int t = 0; t < nt; t += 2) {
            const bool last = (t == nt - 2);
            const char* a1 = cA + (size_t)(t + 1) * kstep;
            const char* a2 = last ? nA : cA + (size_t)(t + 2) * kstep; const char* b2 = last ? nB : cB + (size_t)(t + 2) * kstep;
            const char* a3 = a2 + kstep; const char* b3 = b2 + kstep;
            PG8_LDB(B0, 0, 0); PG8_SCHED; PG8_LDA(At, 0, 0); PG8_STAGE(PG8_SA(1, 1), a1 + hstepA, voffA);
            PG8_WAIT_L(8); PG8_BAR; PG8_WAIT_L(0); PG8_MMA(0, 0, At, B0); PG8_BAR; PG8_SCHED;
            PG8_LDB(B1, 0, 1); PG8_STAGE(PG8_SB(0, 0), b2, voffB);
            PG8_BAR; PG8_WAIT_L(0); PG8_MMA(0, 1, At, B1); PG8_BAR;
            PG8_LDA(At, 0, 1); PG8_STAGE(PG8_SA(0, 0), a2, voffA);
            PG8_BAR; PG8_WAIT_L(0); PG8_MMA(1, 0, At, B0); PG8_BAR; PG8_SCHED;
            PG8_STAGE(PG8_SB(0, 1), b2 + hstepB, voffB);
            PG8_WAIT_V(6); PG8_BAR; PG8_MMA(1, 1, At, B1); PG8_BAR;
            PG8_LDB(B0, 1, 0); PG8_SCHED; PG8_LDA(At, 1, 0); PG8_STAGE(PG8_SA(0, 1), a2 + hstepA, voffA);
            PG8_WAIT_L(8); PG8_BAR; PG8_WAIT_L(0); PG8_MMA(0, 0, At, B0); PG8_BAR; PG8_SCHED;
            PG8_LDB(B1, 1, 1); PG8_STAGE(PG8_SB(1, 0), b3, voffB);
            PG8_BAR; PG8_WAIT_L(0); PG8_MMA(0, 1, At, B1); PG8_BAR;
            PG8_LDA(At, 1, 1); PG8_STAGE(PG8_SA(1, 0), a3, voffA);
            PG8_BAR; PG8_WAIT_L(0); PG8_MMA(1, 0, At, B0); PG8_BAR; PG8_SCHED;
            PG8_STAGE(PG8_SB(1, 1), b3 + hstepB, voffB);
            PG8_WAIT_V(6); PG8_BAR; PG8_MMA(1, 1, At, B1); PG8_BAR;
        }
        E(acc, cur, wr, wc, fr, fq);
        if (!has_next) break;
#pragma unroll
        for (int a = 0; a < 2; ++a)
#pragma unroll
            for (int b = 0; b < 2; ++b)
#pragma unroll
                for (int m = 0; m < 4; ++m)
#pragma unroll
                    for (int n = 0; n < 2; ++n) acc[a][b][m][n] = (f32x4){0.f, 0.f, 0.f, 0.f};
        cur = nxt; cA = nA; cB = nB; ++ui;
    }
    PG8_WAIT_V(0);
    if (wr == 0) PG8_BAR;
    PG8_BAR;
#undef PG8_SA
#undef PG8_SB
#undef PG8_STAGE
#undef PG8_LDA
#undef PG8_LDB
#undef PG8_MMA
#undef PG8_WAIT_V
#undef PG8_WAIT_L
#undef PG8_BAR
#undef PG8_SCHED
}
}

template <class Epi>
__device__ __forceinline__ void run_gemm(LAS unsigned char* lds, const bf16_t* A, int lda, const bf16_t* Bt, int N, int K, const Epi& E) {
    pg8::Gemm g; g.A = A; g.Bt = Bt; g.M = MROWS; g.N = N; g.K = K; g.lda = lda;
    pg8::StaticOrder S; S.init(MROWS, N, (int)gdim(), (int)bidx());
    pg8::gemm_phase<Epi>(lds, g, S, E);
}

__device__ __forceinline__ void cvt_job(LAS float* tile, bf16_t* dst, int ldd, const float* src, int srcN, int nK, int nNdst, int nNsrc, const float* scale, int noff) {
    const int tid = tidx(); const int tilesK = nK / 64, tilesN = nNdst / 64, ntl = tilesK * tilesN, G = gdim();
    const int kr = tid >> 6, nn = tid & 63;
    for (int tl0 = bidx(); tl0 < ntl; tl0 += 2 * G) {
        float v[2][8];
#pragma unroll
        for (int u = 0; u < 2; ++u) { const int tl = tl0 + u * G; const bool tv = tl < ntl; const int tk = tv ? tl % tilesK : 0, tn = tv ? tl / tilesK : 0, k0 = tk * 64, n = tn * 64 + nn;
            const bool ld_ = tv && src && n < nNsrc;
            float scv[8];
#pragma unroll
            for (int ps = 0; ps < 8; ++ps) scv[ps] = (ld_ && scale) ? scale[k0 + ps * 8 + kr] : 1.0f;
#pragma unroll
            for (int ps = 0; ps < 8; ++ps) { const int kk = ps * 8 + kr; v[u][ps] = ld_ ? src[(size_t)(k0 + kk) * srcN + noff + n] : 0.f; }
#pragma unroll
            for (int ps = 0; ps < 8; ++ps) v[u][ps] *= scv[ps]; }
#pragma unroll
        for (int u = 0; u < 2; ++u)
#pragma unroll
            for (int ps = 0; ps < 8; ++ps) tile[u * 4160 + (ps * 8 + kr) * 65 + nn] = v[u][ps];
        __syncthreads();
#pragma unroll
        for (int u = 0; u < 2; ++u) { const int tl = tl0 + u * G;
            if (tl < ntl) { const int tk = tl % tilesK, tn = tl / tilesK, k0 = tk * 64, n0 = tn * 64;
#pragma unroll
                for (int ps = 0; ps < 4; ++ps) { const int kk2 = tid & 31, n2 = (tid >> 5) + 16 * ps;
                    const unsigned w = pack2(tile[u * 4160 + (2 * kk2) * 65 + n2], tile[u * 4160 + (2 * kk2 + 1) * 65 + n2]);
                    *(unsigned*)(dst + (size_t)(n0 + n2) * ldd + k0 + 2 * kk2) = w; } } }
        __syncthreads();
    }
}

__device__ __forceinline__ void cvt_layer(LAS unsigned char* lds, PPTR p, int layer) {
    LAS float* tile = (LAS float*)lds;
    bf16_t* W = (bf16_t*)(p->ws + WS_W);
    bf16_t* w_in = W + W_IN / 2; bf16_t* w_l2 = W + W_L2 / 2; bf16_t* w_out = W + W_OUT / 2; bf16_t* w_up = W + W_UP / 2; bf16_t* w_dn = W + W_DN / 2;
    const int kind = layer % 3, j = layer / 3;
    const int nmix = (kind == 2) ? 20 : 2;
    for (int jb = 0; jb < nmix + 5; ++jb) {
        bf16_t* dst = w_in; int ldd = 1024; const float* src = nullptr; int srcN = 1024, nK = 1024, nNdst = 1024, nNsrc = 1024, noff = 0; const float* scale = nullptr;
        if (jb >= nmix) {
            const int f = jb - nmix;
            if (f < 4) { const int g = f >> 1, gate = f & 1; const int nch = g ? 1280 : 1536, ch0 = g ? 1536 : 0;
                dst = w_up + (size_t)((g ? 3072 : 0) + nch * gate) * 1024; src = p->in[31] + (size_t)layer * 1024 * 5632; srcN = 5632; nNdst = nch; nNsrc = nch; noff = 2816 * gate + ch0; }
            else { dst = w_dn; ldd = 2816; src = p->in[34] + (size_t)layer * 2816 * 1024; nK = 2816; }
        } else if (kind == 0) {
            if (jb == 0) { src = p->in[5] + (size_t)j * 1024 * 4112; srcN = 4112; nNdst = 4352; nNsrc = 4112; }
            else { dst = w_out; src = p->in[10] + (size_t)j * 1024 * 1024; }
        } else if (kind == 1) {
            if (jb == 0) { src = p->in[11]; srcN = 4096; nNdst = 4096; nNsrc = 4096; }
            else { dst = w_out; src = p->in[14]; }
        } else {
            const float* mu = p->in[15];
            if (jb < 6) { const int sI = jb >> 1, hi = jb & 1; const int mi = (sI == 0) ? 0 : (sI == 1 ? 2 : 3);
                dst = w_in + (size_t)sI * 1024 * 2048 + hi * 1024; ldd = 2048; src = p->in[16] + (size_t)sI * 1024 * 1024; if (hi) scale = mu + mi * 1024; }
            else if (jb < 12) { const int q = (jb - 6) >> 1, hi = jb & 1;
                const int rowo = (q == 0) ? 3072 : (q == 1 ? 3136 : 3200); const int nc = (q == 2) ? 128 : 64; const int mi = (q == 0) ? 1 : (q == 1 ? 4 : 5);
                dst = w_in + (size_t)rowo * 2048 + hi * 1024; ldd = 2048; src = (q == 0) ? p->in[18] : (q == 1 ? p->in[21] : p->in[23]); srcN = nc; nNdst = nc; nNsrc = nc; if (hi) scale = mu + mi * 1024; }
            else if (jb < 19) { ldd = 256; nNdst = 1024; nNsrc = 1024;
                const int q = jb - 12;
                if (q == 0) { dst = w_l2; src = p->in[19]; nK = 64; }
                else if (q == 1) { dst = w_l2 + 64; nK = 192; }
                else if (q == 2) { dst = w_l2 + (size_t)1024 * 256; nK = 64; }
                else if (q == 3) { dst = w_l2 + (size_t)1024 * 256 + 64; src = p->in[22]; nK = 64; }
                else if (q == 4) { dst = w_l2 + (size_t)1024 * 256 + 128; nK = 128; }
                else if (q == 5) { dst = w_l2 + (size_t)2048 * 256; nK = 128; }
                else { dst = w_l2 + (size_t)2048 * 256 + 128; src = p->in[24]; nK = 128; } }
            else { dst = w_out; src = p->in[30]; }
        }
        cvt_job(tile, dst, ldd, src, srcN, nK, nNdst, nNsrc, scale, noff);
    }
}

template <bool SHIFT>
__device__ __forceinline__ void norm_phase(const float* h, const float* g, const float* modl, int s_shift, bf16_t* U, int ldu) {
    const int lane = tidx() & 63, wave = tidx() >> 6;
    const int gw = bidx() * 8 + wave, nw = gdim() * 8;
    constexpr int RU = SHIFT ? 2 : 4;
    f32x4 gg4[4];
#pragma unroll
    for (int i = 0; i < 4; ++i) gg4[i] = *(const f32x4*)(g + i * 256 + lane * 4);
    for (int row0 = gw; row0 < MROWS; row0 += nw * RU) {
        const int b0 = row0 >> 13;
        f32x4 gs0[4], sh0[4];
#pragma unroll
        for (int i = 0; i < 4; ++i) { const int c = i * 256 + lane * 4; const float* shp = modl + (size_t)b0 * 6144 + s_shift * 1024;
            gs0[i] = gg4[i] * (1.0f + *(const f32x4*)(shp + 1024 + c)); sh0[i] = *(const f32x4*)(shp + c); }
        f32x4 x[RU][4], xp[RU][4];
#pragma unroll
        for (int q = 0; q < RU; ++q) { const int row = row0 + q * nw;
            if (row < MROWS) {
#pragma unroll
                for (int i = 0; i < 4; ++i) x[q][i] = *(const f32x4*)(h + (size_t)row * DM + i * 256 + lane * 4);
                if (SHIFT) { const size_t prow = ((row & (SEQ - 1)) > 0) ? (size_t)(row - 1) : (size_t)row;
#pragma unroll
                    for (int i = 0; i < 4; ++i) xp[q][i] = *(const f32x4*)(h + prow * DM + i * 256 + lane * 4); } } }
#pragma unroll
        for (int q = 0; q < RU; ++q) { const int row = row0 + q * nw;
            if (row < MROWS) {
                const int b = row >> 13, t = row & (SEQ - 1);
                const float* sh = modl + (size_t)b * 6144 + s_shift * 1024; const float* sc = sh + 1024;
                float ss = 0.f;
#pragma unroll
                for (int i = 0; i < 4; ++i) ss += x[q][i][0] * x[q][i][0] + x[q][i][1] * x[q][i][1] + x[q][i][2] * x[q][i][2] + x[q][i][3] * x[q][i][3];
                ss = wave_allsum(ss); const float rstd = __builtin_amdgcn_rsqf(ss * (1.0f / 1024.0f) + 1e-6f);
                float rstdp = 0.f;
                if (SHIFT) { float ssp = 0.f;
#pragma unroll
                    for (int i = 0; i < 4; ++i) ssp += xp[q][i][0] * xp[q][i][0] + xp[q][i][1] * xp[q][i][1] + xp[q][i][2] * xp[q][i][2] + xp[q][i][3] * xp[q][i][3];
                    ssp = wave_allsum(ssp); rstdp = __builtin_amdgcn_rsqf(ssp * (1.0f / 1024.0f) + 1e-6f); }
#pragma unroll
                for (int i = 0; i < 4; ++i) { const int c = i * 256 + lane * 4; f32x4 gs = gs0[i], s0 = sh0[i];
                    if (b != b0) { gs = gg4[i] * (1.0f + *(const f32x4*)(sc + c)); s0 = *(const f32x4*)(sh + c); }
                    const f32x4 u = x[q][i] * rstd * gs + s0;
                    u32x2 w; w.x = pack2(u[0], u[1]); w.y = pack2(u[2], u[3]); *(u32x2*)(U + (size_t)row * ldu + c) = w;
                    if (SHIFT) { f32x4 up = xp[q][i] * rstdp * gs + s0; if (t == 0) up = (f32x4){0.f, 0.f, 0.f, 0.f};
                        const f32x4 dx = up - u; u32x2 w2; w2.x = pack2(dx[0], dx[1]); w2.y = pack2(dx[2], dx[3]); *(u32x2*)(U + (size_t)row * ldu + 1024 + c) = w2; } }
            } }
    }
}

__device__ __forceinline__ void final_phase(float* h, const float* g) {
    const int lane = tidx() & 63, wave = tidx() >> 6;
    const int gw = bidx() * 8 + wave, nw = gdim() * 8;
    f32x4 gg4[4];
#pragma unroll
    for (int i = 0; i < 4; ++i) gg4[i] = *(const f32x4*)(g + i * 256 + lane * 4);
    for (int row0 = gw; row0 < MROWS; row0 += nw * 4) {
        f32x4 x[4][4];
#pragma unroll
        for (int q = 0; q < 4; ++q) { const int row = row0 + q * nw; if (row < MROWS) {
#pragma unroll
            for (int i = 0; i < 4; ++i) x[q][i] = *(const f32x4*)(h + (size_t)row * DM + i * 256 + lane * 4); } }
#pragma unroll
        for (int q = 0; q < 4; ++q) { const int row = row0 + q * nw; if (row < MROWS) {
            float ss = 0.f;
#pragma unroll
            for (int i = 0; i < 4; ++i) ss += x[q][i][0] * x[q][i][0] + x[q][i][1] * x[q][i][1] + x[q][i][2] * x[q][i][2] + x[q][i][3] * x[q][i][3];
            ss = wave_allsum(ss); const float rstd = __builtin_amdgcn_rsqf(ss * (1.0f / 1024.0f) + 1e-6f);
#pragma unroll
            for (int i = 0; i < 4; ++i) { const int c = i * 256 + lane * 4;
                *(f32x4*)(h + (size_t)row * DM + c) = x[q][i] * rstd * gg4[i]; } } }
    }
}

__device__ __forceinline__ void pre_phase(LAS unsigned char* lds, PPTR p) {
    LAS float* cond = (LAS float*)lds;
    LAS float* red = cond + 4096;
    const int tid = tidx(), lane = tid & 63, wave = tid >> 6;
    float* mod = (float*)(p->ws + WS_MISC); float* lb = mod + 4 * 4 * 6144;
    for (int i = tid; i < 4096; i += 512) cond[i] = siluf_(p->in[1][i]);
    __syncthreads();
    for (int task = bidx(); task < 384; task += gdim()) {
        const int l = task / 96, cb = task % 96, col = cb * 64 + lane;
        float a0 = 0.f, a1 = 0.f, a2 = 0.f, a3 = 0.f;
        const float* wp = p->in[3] + ((size_t)l * 1024 + wave * 128) * 6144 + col;
#pragma unroll 16
        for (int k = 0; k < 128; ++k) { const float wv = wp[(size_t)k * 6144]; const int kk = wave * 128 + k;
            a0 += cond[kk] * wv; a1 += cond[1024 + kk] * wv; a2 += cond[2048 + kk] * wv; a3 += cond[3072 + kk] * wv; }
        red[(wave * 4 + 0) * 64 + lane] = a0; red[(wave * 4 + 1) * 64 + lane] = a1; red[(wave * 4 + 2) * 64 + lane] = a2; red[(wave * 4 + 3) * 64 + lane] = a3;
        __syncthreads();
        if (tid < 256) { const int b = tid >> 6; float s = 0.f;
#pragma unroll
            for (int w = 0; w < 8; ++w) s += red[(w * 4 + b) * 64 + lane];
            mod[((size_t)l * 4 + b) * 6144 + col] = s + p->in[4][(size_t)l * 6144 + col]; }
        __syncthreads();
    }
    for (int c = bidx() * 512 + tid; c < 1024; c += gdim() * 512) {
        const float l0 = p->in[12][c], l1 = p->in[12][1024 + c], l2 = p->in[12][2048 + c], l3 = p->in[12][3072 + c];
        const float mx = fmaxf(fmaxf(l0, l1), fmaxf(l2, l3));
        const float e0 = __expf(l0 - mx), e1 = __expf(l1 - mx), e2 = __expf(l2 - mx), e3 = __expf(l3 - mx);
        lb[c] = e1 / (e0 + e1 + e2 + e3);
    }
}

__device__ __forceinline__ void convglu_phase(const bf16_t* HID, bf16_t* ACT, int g, const float* cw, const float* cb) {
    const int nch = g ? 1280 : 1536, ch0 = g ? 1536 : 0, ld = 2 * nch, ncg = nch / 8;
    const int total = (MROWS / 16) * ncg;
    for (int task = bidx() * 512 + tidx(); task < total; task += gdim() * 512) {
        const int cgi = task % ncg, run = task / ncg, row0 = run * 16, t0 = row0 & (SEQ - 1), j0 = cgi * 8, ch = ch0 + j0;
        float wv[3][8], wg[3][8], bv[8], bg[8];
#pragma unroll
        for (int k = 0; k < 3; ++k)
#pragma unroll
            for (int e = 0; e < 8; ++e) { wv[k][e] = cw[k * 5632 + ch + e]; wg[k][e] = cw[k * 5632 + 2816 + ch + e]; }
#pragma unroll
        for (int e = 0; e < 8; ++e) { bv[e] = cb[ch + e]; bg[e] = cb[2816 + ch + e]; }
        u32x4 v2 = (u32x4){0, 0, 0, 0}, v1 = v2, g2 = v2, g1 = v2;
        if (t0 >= 2) {
            v2 = *(const u32x4*)(HID + (size_t)(row0 - 2) * ld + j0); g2 = *(const u32x4*)(HID + (size_t)(row0 - 2) * ld + nch + j0);
            v1 = *(const u32x4*)(HID + (size_t)(row0 - 1) * ld + j0); g1 = *(const u32x4*)(HID + (size_t)(row0 - 1) * ld + nch + j0);
        }
        u32x4 va[4], ga[4], vb4[4], gb4[4];
#define CG_LOAD(V, G, r0) do { _Pragma("unroll") for (int q_ = 0; q_ < 4; ++q_) { V[q_] = *(const u32x4*)(HID + (size_t)(row0 + (r0) + q_) * ld + j0); G[q_] = *(const u32x4*)(HID + (size_t)(row0 + (r0) + q_) * ld + nch + j0); } } while (0)
#define CG_ROWS(V, G, r0) do { _Pragma("unroll") for (int q_ = 0; q_ < 4; ++q_) { const u32x4 v0 = V[q_], g0 = G[q_]; u32x4 o; \
            _Pragma("unroll") for (int q = 0; q < 4; ++q) { \
                const float yv0 = wv[0][2 * q] * bflo(v2[q]) + wv[1][2 * q] * bflo(v1[q]) + wv[2][2 * q] * bflo(v0[q]) + bv[2 * q]; \
                const float yv1 = wv[0][2 * q + 1] * bfhi(v2[q]) + wv[1][2 * q + 1] * bfhi(v1[q]) + wv[2][2 * q + 1] * bfhi(v0[q]) + bv[2 * q + 1]; \
                const float yg0 = wg[0][2 * q] * bflo(g2[q]) + wg[1][2 * q] * bflo(g1[q]) + wg[2][2 * q] * bflo(g0[q]) + bg[2 * q]; \
                const float yg1 = wg[0][2 * q + 1] * bfhi(g2[q]) + wg[1][2 * q + 1] * bfhi(g1[q]) + wg[2][2 * q + 1] * bfhi(g0[q]) + bg[2 * q + 1]; \
                o[q] = pack2(yv0 * siluf_(yg0), yv1 * siluf_(yg1)); } \
            *(u32x4*)(ACT + (size_t)(row0 + (r0) + q_) * 2816 + ch) = o; \
            v2 = v1; v1 = v0; g2 = g1; g1 = g0; } } while (0)
        CG_LOAD(va, ga, 0);
        CG_LOAD(vb4, gb4, 4);
        CG_ROWS(va, ga, 0);
        CG_LOAD(va, ga, 8);
        CG_ROWS(vb4, gb4, 4);
        CG_LOAD(vb4, gb4, 12);
        CG_ROWS(va, ga, 8);
        CG_ROWS(vb4, gb4, 12);
#undef CG_LOAD
#undef CG_ROWS
    }
}

template <int KIND>
__device__ __forceinline__ void scan_phase(LAS unsigned char* lds, PPTR p, int j) {
    constexpr int N = (KIND == 2) ? 64 : 128;
    constexpr int NH = (KIND == 2) ? 16 : 8;
    constexpr int RG = N / 16;
    constexpr int STRIDE = (KIND == 0) ? 288 : (KIND == 1 ? 272 : 336);
    constexpr int TC = 32, NC = SEQ / TC;
    constexpr int LDP = (KIND == 0) ? 4352 : (KIND == 1 ? 4096 : 3328);
    LAS float* buf = (LAS float*)lds;
    LAS float* ob = buf + 2 * TC * STRIDE;
    const int tid = tidx(), wave = tid >> 6, lane = tid & 63;
    const bool is_loader = wave >= 4; const int lw = wave - 4;
    const int li = lane & 15, row = (wave & 3) * 4 + (lane >> 4);
    const bf16_t* P = (const bf16_t*)(p->ws + (KIND == 2 ? WS_PROJC : WS_PROJ));
    const bf16_t* L2 = (const bf16_t*)(p->ws + WS_R1);
    bf16_t* O = (bf16_t*)(p->ws + (KIND == 2 ? WS_OC : WS_R1));
    const int G = gdim(); const int vcu = (G % 8 == 0) ? (int)(bidx() % 8) * (G / 8) + (int)(bidx() / 8) : (int)bidx();
    for (int task = vcu; task < 256; task += G) {
        const int bh = task / RG, rg = task % RG, b = bh / NH, h = bh % NH;
        const size_t rbase = (size_t)b * SEQ;
        float cwq[4][2], cwk[4][2], cwv[4]; float expA = 0.f, dtb = 0.f; float lbv[2]; float w0v = 0.f, a0v = 0.f, kkc = 0.f, kac = 0.f;
        if (KIND == 0) { const float* cv = p->in[6] + (size_t)j * 4 * 3072;
#pragma unroll
            for (int jj = 0; jj < 4; ++jj) { cwq[jj][0] = cv[jj * 3072 + h * 128 + 2 * lane]; cwq[jj][1] = cv[jj * 3072 + h * 128 + 2 * lane + 1];
                cwk[jj][0] = cv[jj * 3072 + 1024 + h * 128 + 2 * lane]; cwk[jj][1] = cv[jj * 3072 + 1024 + h * 128 + 2 * lane + 1];
                cwv[jj] = cv[jj * 3072 + 2048 + h * 128 + 16 * rg + (lane & 15)]; }
            expA = __expf(p->in[7][j * 8 + h]); dtb = p->in[8][j * 8 + h]; }
        if (KIND == 1) { const float* lbp = (const float*)(p->ws + WS_MISC) + 4 * 4 * 6144; lbv[0] = lbp[h * 128 + 2 * lane]; lbv[1] = lbp[h * 128 + 2 * lane + 1]; }
        if (KIND == 2) { const int ch = h * 64 + lane; w0v = p->in[17][ch]; a0v = p->in[20][ch]; kkc = p->in[25][ch]; kac = p->in[26][ch]; }
        unsigned x0[11], x1[11], x2[11], x3[8], x4[8];
        f32x2 s[4];
#pragma unroll
        for (int e = 0; e < 4; ++e) s[e] = (f32x2){0.f, 0.f};

#define SCAN_LOAD(cc) do { const int c_ = (cc); \
        if (KIND == 0) { const int tfirst = c_ * TC + 8 * lw - 3; \
            _Pragma("unroll") for (int q = 0; q < 11; ++q) { const int t_ = tfirst + q; const bool valid = t_ >= 0; const bf16_t* rowp = P + (rbase + (valid ? t_ : 0)) * LDP; \
                const unsigned vq = *(const unsigned*)(rowp + h * 128 + 2 * lane), vk = *(const unsigned*)(rowp + 1024 + h * 128 + 2 * lane); \
                const int mcol = lane < 16 ? 2048 + h * 128 + 16 * rg + lane : (lane == 32 ? 4096 + h : (lane == 33 ? 4104 + h : 2048 + h * 128)); \
                const unsigned vm = rowp[mcol]; x0[q] = valid ? vq : 0u; x1[q] = valid ? vk : 0u; x2[q] = valid ? vm : 0u; } } \
        else if (KIND == 1) { const int tfirst = c_ * TC + 8 * lw; \
            _Pragma("unroll") for (int q = 0; q < 8; ++q) { const bf16_t* rowp = P + (rbase + tfirst + q) * LDP; \
                x0[q] = *(const unsigned*)(rowp + h * 128 + 2 * lane); x1[q] = *(const unsigned*)(rowp + 1024 + h * 128 + 2 * lane); \
                x2[q] = rowp[2048 + h * 128 + 16 * rg + (lane & 15)]; } } \
        else { const int tfirst = c_ * TC + 8 * lw; \
            _Pragma("unroll") for (int q = 0; q < 8; ++q) { const bf16_t* rowp = P + (rbase + tfirst + q) * LDP; const bf16_t* l2p = L2 + (rbase + tfirst + q) * 3072; \
                x0[q] = rowp[h * 64 + lane]; x1[q] = rowp[1024 + h * 64 + lane]; x2[q] = rowp[2048 + h * 64 + 16 * rg + (lane & 15)]; \
                x3[q] = l2p[h * 64 + lane]; x4[q] = l2p[1024 + h * 64 + lane]; } } } while (0)

#define SCAN_FLUSH(cc) do { const int c_ = (cc); LAS const float* src = ob + (c_ & 1) * (TC * 16) + (lane >> 1) * 16 + (lane & 1) * 8; \
        u32x4 w; w.x = pack2(src[0], src[1]); w.y = pack2(src[2], src[3]); w.z = pack2(src[4], src[5]); w.w = pack2(src[6], src[7]); \
        *(u32x4*)(O + (rbase + c_ * TC + (lane >> 1)) * DM + h * N + 16 * rg + (lane & 1) * 8) = w; } while (0)

        if (is_loader) SCAN_LOAD(0);
        for (int it = 0; it <= NC; ++it) {
            if (is_loader) {
                if (it < NC) {
                    LAS float* bw = buf + (it & 1) * (TC * STRIDE);
#pragma unroll
                    for (int i = 0; i < 8; ++i) {
                        LAS float* rec = bw + (8 * lw + i) * STRIDE;
                        if (KIND == 0) {
                            float yq0 = 0.f, yq1 = 0.f, yk0 = 0.f, yk1 = 0.f, yv = 0.f;
#pragma unroll
                            for (int jj = 0; jj < 4; ++jj) { yq0 += cwq[jj][0] * bflo(x0[i + jj]); yq1 += cwq[jj][1] * bfhi(x0[i + jj]);
                                yk0 += cwk[jj][0] * bflo(x1[i + jj]); yk1 += cwk[jj][1] * bfhi(x1[i + jj]); yv += cwv[jj] * bf2f(x2[i + jj]); }
                            yq0 = siluf_(yq0); yq1 = siluf_(yq1); yk0 = siluf_(yk0); yk1 = siluf_(yk1);
                            const float ssq = wave_allsum(yq0 * yq0 + yq1 * yq1), ssk = wave_allsum(yk0 * yk0 + yk1 * yk1);
                            const float rq = __builtin_amdgcn_rsqf(ssq + 1e-6f) * 0.08838834764831845f, rk = __builtin_amdgcn_rsqf(ssk + 1e-6f);
                            *(LAS f32x2*)(rec + 2 * lane) = (f32x2){yk0 * rk, yk1 * rk};
                            *(LAS f32x2*)(rec + 128 + 2 * lane) = (f32x2){yq0 * rq, yq1 * rq};
                            const float m3 = bf2f(x2[i + 3]);
                            if (lane < 16) rec[256 + lane] = siluf_(yv);
                            else if (lane == 32) rec[273] = __expf(-expA * softplusf_(m3 + dtb));
                            else if (lane == 33) rec[272] = sigmoidf_(m3);
                        } else if (KIND == 1) {
                            const float q0 = siluf_(bflo(x0[i])), q1 = siluf_(bfhi(x0[i]));
                            const float f0 = lbv[0] + (1.0f - lbv[0]) * sigmoidf_(bflo(x1[i])), f1 = lbv[1] + (1.0f - lbv[1]) * sigmoidf_(bfhi(x1[i]));
                            *(LAS f32x2*)(rec + 2 * lane) = (f32x2){q0, q1};
                            *(LAS f32x2*)(rec + 128 + 2 * lane) = (f32x2){f0, f1};
                            if (lane < 16) rec[256 + lane] = bf2f(x2[i]);
                        } else {
                            const float r = bf2f(x0[i]), kraw = bf2f(x1[i]), whi = bf2f(x3[i]), ahi = bf2f(x4[i]);
                            const float wv = -softplusf_(-(w0v + whi)) - 0.5f; const float d = __expf(-__expf(wv));
                            const float ag = sigmoidf_(a0v + ahi);
                            const float kkx = kraw * kkc; const float ss = wave_allsum(kkx * kkx); const float kk = kkx * __builtin_amdgcn_rsqf(ss + 1e-6f);
                            const float kp = kraw * (1.0f + (ag - 1.0f) * kac);
                            rec[lane] = -kk; rec[64 + lane] = kk * ag; rec[128 + lane] = d; rec[192 + lane] = kp; rec[256 + lane] = r;
                            if (lane < 16) rec[320 + lane] = bf2f(x2[i]);
                        }
                    }
                    if (it + 1 < NC) SCAN_LOAD(it + 1);
                }
                if (it >= 2 && lw == 0) SCAN_FLUSH(it - 2);
            } else if (it >= 1) {
                LAS const float* bc = buf + ((it - 1) & 1) * (TC * STRIDE);
                LAS float* oc = ob + ((it - 1) & 1) * (TC * 16);
                StepRegs R[2][2];
                step_load<KIND>(R[0][0], bc, li, row); step_load<KIND>(R[0][1], bc + STRIDE, li, row);
                float osel = 0.f;
#pragma unroll
                for (int g = 0; g < 16; ++g) {
                    if (g + 1 < 16) { step_load<KIND>(R[(g + 1) & 1][0], bc + (2 * g + 2) * STRIDE, li, row); step_load<KIND>(R[(g + 1) & 1][1], bc + (2 * g + 3) * STRIDE, li, row); }
#pragma unroll
                    for (int u = 0; u < 2; ++u) { const float o = step_compute<KIND>(R[g & 1][u], s); osel = (li == ((2 * g + u) & 15)) ? o : osel; }
                    if (g == 7 || g == 15) oc[((g == 15 ? 16 : 0) + li) * 16 + row] = osel;
                }
            }
            lds_barrier();
        }
        if (is_loader && lw == 0) SCAN_FLUSH(NC - 1);
        lds_barrier();
#undef SCAN_LOAD
#undef SCAN_FLUSH
    }
}


typedef short bf16x4 __attribute__((ext_vector_type(4)));
__device__ __forceinline__ bf16x8 cat4(bf16x4 lo, bf16x4 hi) { return __builtin_shufflevector(lo, hi, 0, 1, 2, 3, 4, 5, 6, 7); }
__device__ __forceinline__ bf16x4 cvt4(f32x4 v) { u32x2 w; w.x = pg8::cvt_pk_bf16(v[0], v[1]); w.y = pg8::cvt_pk_bf16(v[2], v[3]); return __builtin_bit_cast(bf16x4, w); }
constexpr size_t WS_KG = WS_R1 + 64 * MiB;
constexpr size_t WS_AM = 420 * MiB;
constexpr size_t WS_DEC = 428 * MiB;

__device__ __forceinline__ void prep_gla(LAS unsigned char* lds, PPTR p) {
    const int tid = tidx(), w = tid >> 6, lane = tid & 63, n = lane & 15, kg = lane >> 4;
    LAS unsigned char* qs = lds + w * 8704; LAS unsigned char* ks = qs + 4352;
    const bf16_t* P = (const bf16_t*)(p->ws + WS_PROJ);
    bf16_t* Qg = (bf16_t*)(p->ws + WS_R1); bf16_t* Kg = (bf16_t*)(p->ws + WS_KG);
    bf16_t* Amg = (bf16_t*)(p->ws + WS_AM); float* Decg = (float*)(p->ws + WS_DEC);
    const float* lbp = (const float*)(p->ws + WS_MISC) + 4 * 4 * 6144;
    for (int task = bidx() * 8 + w; task < 4 * 512 * 8; task += gdim() * 8) {
        const int h = task & 7, rc = task >> 3; const size_t row0 = (size_t)rc * 16;
        const float lb0 = lbp[h * 128 + 2 * lane], lb1 = lbp[h * 128 + 2 * lane + 1];
        unsigned xq[16], xf[16];
#pragma unroll
        for (int t = 0; t < 16; ++t) { const bf16_t* rowp = P + (row0 + t) * 4096 + h * 128 + 2 * lane; xq[t] = *(const unsigned*)rowp; xf[t] = *(const unsigned*)(rowp + 1024); }
        float bc0 = 0.f, bc1 = 0.f; float kk0[16], kk1[16], bs0[16], bs1[16];
#pragma unroll
        for (int t = 0; t < 16; ++t) {
            const float q0 = siluf_(bflo(xq[t])), q1 = siluf_(bfhi(xq[t]));
            const float f0 = lb0 + (1.0f - lb0) * sigmoidf_(bflo(xf[t])), f1 = lb1 + (1.0f - lb1) * sigmoidf_(bfhi(xf[t]));
            bc0 += __logf(f0); bc1 += __logf(f1);
            kk0[t] = 1.0f - f0; kk1[t] = 1.0f - f1; bs0[t] = bc0; bs1[t] = bc1;
            const unsigned qp = pack2(q0 * __expf(bc0), q1 * __expf(bc1));
            *(unsigned*)(Qg + (row0 + t) * 1024 + h * 128 + 2 * lane) = qp;
            *(LAS unsigned*)(qs + t * 272 + 4 * lane) = qp;
        }
#pragma unroll
        for (int t = 0; t < 16; ++t) {
            *(unsigned*)(Kg + (row0 + t) * 1024 + h * 128 + 2 * lane) = pack2(kk0[t] * __expf(bc0 - bs0[t]), kk1[t] * __expf(bc1 - bs1[t]));
            *(LAS unsigned*)(ks + t * 272 + 4 * lane) = pack2(kk0[t] * __expf(-bs0[t]), kk1[t] * __expf(-bs1[t]));
        }
        *(f32x2*)(Decg + (size_t)task * 128 + 2 * lane) = (f32x2){__expf(bc0), __expf(bc1)};
        asm volatile("s_waitcnt lgkmcnt(0)" ::: "memory");
        f32x4 acc = (f32x4){0.f, 0.f, 0.f, 0.f};
#pragma unroll
        for (int a = 0; a < 4; ++a) {
            const bf16x8 af = *(LAS const bf16x8*)(qs + n * 272 + (32 * a + 8 * kg) * 2);
            const bf16x8 bfr = *(LAS const bf16x8*)(ks + n * 272 + (32 * a + 8 * kg) * 2);
            acc = __builtin_amdgcn_mfma_f32_16x16x32_bf16(af, bfr, acc, 0, 0, 0);
        }
#pragma unroll
        for (int jj = 0; jj < 4; ++jj) { const int t = 4 * kg + jj; Amg[(size_t)task * 256 + t * 16 + n] = (bf16_t)f2bf(n <= t ? acc[jj] : 0.f); }
        asm volatile("s_waitcnt lgkmcnt(0)" ::: "memory");
    }
}

__device__ __forceinline__ void scan_gla(LAS unsigned char* lds, PPTR p) {
    constexpr int QOFF = 0, KTOFF = 4352, VOFF = 9472, AMOFF = 13824, DECOFF = 14336, BUFB = 14848;
    const int tid = tidx(), w = tid >> 6, lane = tid & 63, n = lane & 15, kg = lane >> 4;
    const bf16_t* P = (const bf16_t*)(p->ws + WS_PROJ);
    bf16_t* Qg = (bf16_t*)(p->ws + WS_R1); const bf16_t* Kg = (const bf16_t*)(p->ws + WS_KG);
    const bf16_t* Amg = (const bf16_t*)(p->ws + WS_AM); const float* Decg = (const float*)(p->ws + WS_DEC);
    bf16_t* Og = (bf16_t*)(p->ws + WS_OC);
    const bf16x4 z4 = (bf16x4){0, 0, 0, 0};
    for (int task = bidx(); task < 32; task += gdim()) {
        const int b = task >> 3, h = task & 7; const size_t rowbase = (size_t)b * SEQ;
        f32x4 S[8]; bf16x8 Sb[4];
#pragma unroll
        for (int i = 0; i < 8; ++i) S[i] = (f32x4){0.f, 0.f, 0.f, 0.f};
#pragma unroll
        for (int a = 0; a < 4; ++a) Sb[a] = (bf16x8){0, 0, 0, 0, 0, 0, 0, 0};
        const int lt = (tid & 255) >> 4, pc = tid & 15;
        constexpr int PD = 8;
        u32x4 g0[PD], g1[PD];
#define GLA_LOAD(cc, sl) do { const int c_ = (cc); const size_t r_ = rowbase + (size_t)c_ * 16 + lt; \
            if (tid < 256) { g0[sl] = *(const u32x4*)(Qg + r_ * 1024 + h * 128 + 8 * pc); g1[sl] = *(const u32x4*)(P + r_ * 4096 + 2048 + h * 128 + 8 * pc); } \
            else { g0[sl] = *(const u32x4*)(Kg + r_ * 1024 + h * 128 + 8 * pc); const size_t ch_ = ((size_t)(b * 512 + c_) * 8 + h); \
                if (tid < 288) g1[sl] = *(const u32x4*)(Amg + ch_ * 256 + (tid - 256) * 8); else if (tid < 320) g1[sl] = *(const u32x4*)(Decg + ch_ * 128 + (tid - 288) * 4); } } while (0)
#define GLA_STORE(cc, sl) do { LAS unsigned char* bb_ = lds + ((cc) & 1) * BUFB; \
            if (tid < 256) { *(LAS u32x4*)(bb_ + QOFF + lt * 272 + 16 * pc) = g0[sl]; *(LAS u32x4*)(bb_ + VOFF + lt * 272 + 16 * pc) = g1[sl]; } \
            else { _Pragma("unroll") for (int e = 0; e < 4; ++e) { *(LAS unsigned short*)(bb_ + KTOFF + (8 * pc + 2 * e) * 40 + 2 * lt) = (unsigned short)(g0[sl][e] & 0xffffu); \
                    *(LAS unsigned short*)(bb_ + KTOFF + (8 * pc + 2 * e + 1) * 40 + 2 * lt) = (unsigned short)(g0[sl][e] >> 16); } \
                if (tid < 288) *(LAS u32x4*)(bb_ + AMOFF + (tid - 256) * 16) = g1[sl]; else if (tid < 320) *(LAS u32x4*)(bb_ + DECOFF + (tid - 288) * 16) = g1[sl]; } } while (0)
#pragma unroll
        for (int d = 0; d < PD; ++d) GLA_LOAD(d, d);
        GLA_STORE(0, 0); lds_barrier();
        for (int c0 = 0; c0 < 512; c0 += PD) {
#pragma unroll
          for (int d = 0; d < PD; ++d) {
            const int c = c0 + d;
            if (c + PD < 512) GLA_LOAD(c + PD, d);
            LAS const unsigned char* bb = lds + (c & 1) * BUFB;
            f32x4 Z = (f32x4){0.f, 0.f, 0.f, 0.f};
#pragma unroll
            for (int a = 0; a < 4; ++a) {
                const bf16x4 lo = *(LAS const bf16x4*)(bb + QOFF + n * 272 + (32 * a + 4 * kg) * 2), hi = *(LAS const bf16x4*)(bb + QOFF + n * 272 + (32 * a + 16 + 4 * kg) * 2);
                Z = __builtin_amdgcn_mfma_f32_16x16x32_bf16(cat4(lo, hi), Sb[a], Z, 0, 0, 0);
            }
            bf16x4 vb;
#pragma unroll
            for (int j = 0; j < 4; ++j) vb[j] = *(LAS const short*)(bb + VOFF + (4 * kg + j) * 272 + (16 * w + n) * 2);
            const bf16x8 Vb = cat4(vb, z4);
            const bf16x4 am = *(LAS const bf16x4*)(bb + AMOFF + n * 32 + 8 * kg);
            const f32x4 o = __builtin_amdgcn_mfma_f32_16x16x32_bf16(cat4(am, z4), Vb, Z, 0, 0, 0);
#pragma unroll
            for (int i = 0; i < 8; ++i) {
                const f32x4 d4 = *(LAS const f32x4*)(bb + DECOFF + (16 * i + 4 * kg) * 4);
                const bf16x4 kt = *(LAS const bf16x4*)(bb + KTOFF + (16 * i + n) * 40 + 8 * kg);
                S[i] = __builtin_amdgcn_mfma_f32_16x16x32_bf16(cat4(kt, z4), Vb, S[i] * d4, 0, 0, 0);
            }
#pragma unroll
            for (int a = 0; a < 4; ++a) Sb[a] = cat4(cvt4(S[2 * a]), cvt4(S[2 * a + 1]));
#pragma unroll
            for (int j = 0; j < 4; ++j) Og[(rowbase + (size_t)c * 16 + 4 * kg + j) * 1024 + h * 128 + 16 * w + n] = (bf16_t)f2bf(o[j]);
            if (c + 1 < 512) GLA_STORE(c + 1, (d + 1) % PD);
            lds_barrier();
          }
        }
#undef GLA_LOAD
#undef GLA_STORE
    }
}


template <int SGN>
__device__ __forceinline__ void tri_inv16(LAS const float* Lm, int n, float (&x)[16]) {
    x[0] = (n == 0) ? 1.f : 0.f;
    {
        f32x4 la[12];
#pragma unroll
        for (int t = 1; t <= 4; ++t) la[t - 1] = *(LAS const f32x4*)(Lm + t * 16);
#pragma unroll
        for (int t = 5; t <= 8; ++t) { la[4 + 2 * (t - 5)] = *(LAS const f32x4*)(Lm + t * 16); la[5 + 2 * (t - 5)] = *(LAS const f32x4*)(Lm + t * 16 + 4); }
        __builtin_amdgcn_sched_barrier(0);
#pragma unroll
        for (int t = 1; t <= 8; ++t) { float acc = (n == t) ? 1.f : 0.f;
#pragma unroll
            for (int q = 0; q < (t + 3) / 4; ++q) { const f32x4 l4 = (t <= 4) ? la[t - 1] : la[4 + 2 * (t - 5) + q];
#pragma unroll
                for (int e = 0; e < 4; ++e) if (4 * q + e < t) acc += (float)SGN * l4[e] * x[4 * q + e]; }
            x[t] = acc; }
    }
    __builtin_amdgcn_sched_barrier(0);
    {   f32x4 lb[12];
#pragma unroll
        for (int t = 9; t <= 12; ++t)
#pragma unroll
            for (int q = 0; q < 3; ++q) lb[3 * (t - 9) + q] = *(LAS const f32x4*)(Lm + t * 16 + 4 * q);
        __builtin_amdgcn_sched_barrier(0);
#pragma unroll
        for (int t = 9; t <= 12; ++t) { float acc = (n == t) ? 1.f : 0.f;
#pragma unroll
            for (int q = 0; q < 3; ++q) { const f32x4 l4 = lb[3 * (t - 9) + q];
#pragma unroll
                for (int e = 0; e < 4; ++e) if (4 * q + e < t) acc += (float)SGN * l4[e] * x[4 * q + e]; }
            x[t] = acc; }
    }
    __builtin_amdgcn_sched_barrier(0);
    {   f32x4 lc[12];
#pragma unroll
        for (int t = 13; t <= 15; ++t)
#pragma unroll
            for (int q = 0; q < 4; ++q) lc[4 * (t - 13) + q] = *(LAS const f32x4*)(Lm + t * 16 + 4 * q);
        __builtin_amdgcn_sched_barrier(0);
#pragma unroll
        for (int t = 13; t <= 15; ++t) { float acc = (n == t) ? 1.f : 0.f;
#pragma unroll
            for (int q = 0; q < 4; ++q) { const f32x4 l4 = lc[4 * (t - 13) + q];
#pragma unroll
                for (int e = 0; e < 4; ++e) if (4 * q + e < t) acc += (float)SGN * l4[e] * x[4 * q + e]; }
            x[t] = acc; }
    }
}

constexpr size_t WS_TA = 436 * MiB;
constexpr size_t WS_AMA = 444 * MiB;
constexpr size_t WS_SCA = 452 * MiB;

__device__ __forceinline__ void prep_delta(LAS unsigned char* lds, PPTR p, int j) {
    const int tid = tidx(), w = tid >> 6, lane = tid & 63, n = lane & 15, kg = lane >> 4;
    LAS unsigned char* qs = lds + w * 9984; LAS unsigned char* ks = qs + 4352; LAS float* Lm = (LAS float*)(ks + 4352); LAS float* sc = Lm + 256;
    const bf16_t* P = (const bf16_t*)(p->ws + WS_PROJ);
    bf16_t* Qg = (bf16_t*)(p->ws + WS_R1); bf16_t* Kg = (bf16_t*)(p->ws + WS_KG);
    bf16_t* Tg = (bf16_t*)(p->ws + WS_TA); bf16_t* Amg = (bf16_t*)(p->ws + WS_AMA); float* Scg = (float*)(p->ws + WS_SCA);
    const float* cv = p->in[6] + (size_t)j * 4 * 3072;
    for (int task = bidx() * 8 + w; task < 4 * 512 * 8; task += gdim() * 8) {
        const int h = task & 7, rc = task >> 3; const size_t row0 = (size_t)rc * 16; const int t0 = (rc & 511) * 16;
        float cwq[4][2], cwk[4][2];
#pragma unroll
        for (int jj = 0; jj < 4; ++jj) { cwq[jj][0] = cv[jj * 3072 + h * 128 + 2 * lane]; cwq[jj][1] = cv[jj * 3072 + h * 128 + 2 * lane + 1];
            cwk[jj][0] = cv[jj * 3072 + 1024 + h * 128 + 2 * lane]; cwk[jj][1] = cv[jj * 3072 + 1024 + h * 128 + 2 * lane + 1]; }
        unsigned xq[19], xk[19];
#pragma unroll
        for (int r = 0; r < 19; ++r) { const bool valid = (t0 + r - 3) >= 0; const bf16_t* rowp = P + (row0 + (valid ? r - 3 : 0)) * 4352 + h * 128 + 2 * lane;
            const unsigned vq = *(const unsigned*)rowp, vk = *(const unsigned*)(rowp + 1024); xq[r] = valid ? vq : 0u; xk[r] = valid ? vk : 0u; }
        float beta, G;
        { const bf16_t* rowp = P + (row0 + n) * 4352; const float a_raw = bf2f(rowp[4096 + h]), b_raw = bf2f(rowp[4104 + h]);
          beta = sigmoidf_(b_raw); G = -__expf(p->in[7][j * 8 + h]) * softplusf_(a_raw + p->in[8][j * 8 + h]);
          float tq; tq = __int_as_float(__builtin_amdgcn_update_dpp(0, __float_as_int(G), 0x111, 0xf, 0xf, true)); G += tq;
          tq = __int_as_float(__builtin_amdgcn_update_dpp(0, __float_as_int(G), 0x112, 0xf, 0xf, true)); G += tq;
          tq = __int_as_float(__builtin_amdgcn_update_dpp(0, __float_as_int(G), 0x114, 0xf, 0xf, true)); G += tq;
          tq = __int_as_float(__builtin_amdgcn_update_dpp(0, __float_as_int(G), 0x118, 0xf, 0xf, true)); G += tq; }
        const float G15 = __int_as_float(__builtin_amdgcn_readlane(__float_as_int(G), 15));
        if (lane < 16) { sc[lane] = beta; sc[16 + lane] = G;
            float* so = Scg + (size_t)task * 64; so[lane] = beta; so[16 + lane] = __expf(G); so[32 + lane] = __expf(G15 - G); if (lane == 0) so[48] = __expf(G15); }
#pragma unroll
        for (int t = 0; t < 16; ++t) {
            float yq0 = 0.f, yq1 = 0.f, yk0 = 0.f, yk1 = 0.f;
#pragma unroll
            for (int jj = 0; jj < 4; ++jj) { yq0 += cwq[jj][0] * bflo(xq[t + jj]); yq1 += cwq[jj][1] * bfhi(xq[t + jj]); yk0 += cwk[jj][0] * bflo(xk[t + jj]); yk1 += cwk[jj][1] * bfhi(xk[t + jj]); }
            yq0 = siluf_(yq0); yq1 = siluf_(yq1); yk0 = siluf_(yk0); yk1 = siluf_(yk1);
            const float ssq = wave_allsum(yq0 * yq0 + yq1 * yq1), ssk = wave_allsum(yk0 * yk0 + yk1 * yk1);
            const float rq = __builtin_amdgcn_rsqf(ssq + 1e-6f) * 0.08838834764831845f, rk = __builtin_amdgcn_rsqf(ssk + 1e-6f);
            const unsigned qp = pack2(yq0 * rq, yq1 * rq), kp = pack2(yk0 * rk, yk1 * rk);
            *(unsigned*)(Qg + (row0 + t) * 1024 + h * 128 + 2 * lane) = qp; *(unsigned*)(Kg + (row0 + t) * 1024 + h * 128 + 2 * lane) = kp;
            *(LAS unsigned*)(qs + t * 272 + 4 * lane) = qp; *(LAS unsigned*)(ks + t * 272 + 4 * lane) = kp;
        }
        asm volatile("s_waitcnt lgkmcnt(0)" ::: "memory");
        f32x4 akk = (f32x4){0.f, 0.f, 0.f, 0.f}, aqk = akk;
#pragma unroll
        for (int a = 0; a < 4; ++a) {
            const bf16x8 qf = *(LAS const bf16x8*)(qs + n * 272 + (32 * a + 8 * kg) * 2);
            const bf16x8 kf = *(LAS const bf16x8*)(ks + n * 272 + (32 * a + 8 * kg) * 2);
            akk = __builtin_amdgcn_mfma_f32_16x16x32_bf16(kf, kf, akk, 0, 0, 0);
            aqk = __builtin_amdgcn_mfma_f32_16x16x32_bf16(qf, kf, aqk, 0, 0, 0);
        }
        { const float Gn = sc[16 + n]; const f32x4 bt = *(LAS const f32x4*)(sc + 4 * kg), Gt = *(LAS const f32x4*)(sc + 16 + 4 * kg);
#pragma unroll
          for (int jj = 0; jj < 4; ++jj) { const int t = 4 * kg + jj; const float dec = __expf(Gt[jj] - Gn);
              Lm[t * 16 + n] = (n < t) ? bt[jj] * akk[jj] * dec : 0.f;
              Amg[(size_t)task * 256 + t * 16 + n] = (bf16_t)f2bf(n <= t ? aqk[jj] * dec : 0.f); } }
        asm volatile("s_waitcnt lgkmcnt(0)" ::: "memory");
        float x[16];
        tri_inv16<-1>(Lm, n, x);
#pragma unroll
        for (int jj = 0; jj < 4; ++jj) { const float v = (kg == 0) ? x[jj] : (kg == 1 ? x[4 + jj] : (kg == 2 ? x[8 + jj] : x[12 + jj]));
            Tg[(size_t)task * 256 + (4 * kg + jj) * 16 + n] = (bf16_t)f2bf(v); }
        asm volatile("s_waitcnt lgkmcnt(0)" ::: "memory");
    }
}

__device__ __forceinline__ void scan_delta(LAS unsigned char* lds, PPTR p, int j) {
    constexpr int QOFF = 0, KOFF = 4352, KTOFF = 8704, VOFF = 13824, TOFF = 18992, AMOFF = 19504, SCOFF = 20016, BUFB = 20272;
    const int tid = tidx(), w = tid >> 6, lane = tid & 63, n = lane & 15, kg = lane >> 4;
    const bf16_t* P = (const bf16_t*)(p->ws + WS_PROJ);
    bf16_t* Qg = (bf16_t*)(p->ws + WS_R1); const bf16_t* Kg = (const bf16_t*)(p->ws + WS_KG);
    const bf16_t* Tg = (const bf16_t*)(p->ws + WS_TA); const bf16_t* Amg = (const bf16_t*)(p->ws + WS_AMA); const float* Scg = (const float*)(p->ws + WS_SCA);
    const float* cv = p->in[6] + (size_t)j * 4 * 3072;
    const bf16x4 z4 = (bf16x4){0, 0, 0, 0};
    for (int task = bidx(); task < 32; task += gdim()) {
        const int b = task >> 3, h = task & 7; const size_t rowbase = (size_t)b * SEQ;
        float cwv[4];
#pragma unroll
        for (int jj = 0; jj < 4; ++jj) cwv[jj] = cv[jj * 3072 + 2048 + h * 128 + 16 * w + n];
        f32x4 S[8]; bf16x8 Sb[4];
#pragma unroll
        for (int i = 0; i < 8; ++i) S[i] = (f32x4){0.f, 0.f, 0.f, 0.f};
#pragma unroll
        for (int a = 0; a < 4; ++a) Sb[a] = (bf16x8){0, 0, 0, 0, 0, 0, 0, 0};
        const int lt = (tid & 255) >> 4, pc = tid & 15, vr = tid >> 4;
        constexpr int PD = 8;
        u32x4 g0[PD], g1[PD];
#define DL_LOAD(cc, sl) do { const int c_ = (cc); const size_t r_ = rowbase + (size_t)c_ * 16 + lt; const size_t ch_ = ((size_t)(b * 512 + c_) * 8 + h); \
            if (tid < 256) g0[sl] = *(const u32x4*)(Qg + r_ * 1024 + h * 128 + 8 * pc); else g0[sl] = *(const u32x4*)(Kg + r_ * 1024 + h * 128 + 8 * pc); \
            if (tid < 304) { const int tv_ = c_ * 16 + vr - 3; const u32x4 vv_ = *(const u32x4*)(P + (rowbase + (tv_ >= 0 ? tv_ : 0)) * 4352 + 2048 + h * 128 + 8 * pc); g1[sl] = (tv_ >= 0) ? vv_ : (u32x4){0u, 0u, 0u, 0u}; } \
            else if (tid >= 320 && tid < 352) g1[sl] = *(const u32x4*)(Tg + ch_ * 256 + (tid - 320) * 8); \
            else if (tid >= 352 && tid < 384) g1[sl] = *(const u32x4*)(Amg + ch_ * 256 + (tid - 352) * 8); \
            else if (tid >= 384 && tid < 400) g1[sl] = *(const u32x4*)(Scg + ch_ * 64 + (tid - 384) * 4); } while (0)
#define DL_STORE(cc, sl) do { LAS unsigned char* bb_ = lds + ((cc) & 1) * BUFB; \
            if (tid < 256) *(LAS u32x4*)(bb_ + QOFF + lt * 272 + 16 * pc) = g0[sl]; \
            else { *(LAS u32x4*)(bb_ + KOFF + lt * 272 + 16 * pc) = g0[sl]; \
                _Pragma("unroll") for (int e = 0; e < 4; ++e) { *(LAS unsigned short*)(bb_ + KTOFF + (8 * pc + 2 * e) * 40 + 2 * lt) = (unsigned short)(g0[sl][e] & 0xffffu); \
                    *(LAS unsigned short*)(bb_ + KTOFF + (8 * pc + 2 * e + 1) * 40 + 2 * lt) = (unsigned short)(g0[sl][e] >> 16); } } \
            if (tid < 304) *(LAS u32x4*)(bb_ + VOFF + vr * 272 + 16 * pc) = g1[sl]; \
            else if (tid >= 320 && tid < 352) *(LAS u32x4*)(bb_ + TOFF + (tid - 320) * 16) = g1[sl]; \
            else if (tid >= 352 && tid < 384) *(LAS u32x4*)(bb_ + AMOFF + (tid - 352) * 16) = g1[sl]; \
            else if (tid >= 384 && tid < 400) *(LAS u32x4*)(bb_ + SCOFF + (tid - 384) * 16) = g1[sl]; } while (0)
#pragma unroll
        for (int d = 0; d < PD; ++d) DL_LOAD(d, d);
        DL_STORE(0, 0); lds_barrier();
        for (int c0 = 0; c0 < 512; c0 += PD) {
#pragma unroll
          for (int d = 0; d < PD; ++d) {
            const int c = c0 + d;
            if (c + PD < 512) DL_LOAD(c + PD, d);
            LAS const unsigned char* bb = lds + (c & 1) * BUFB;
            float vraw[7];
#pragma unroll
            for (int r = 0; r < 7; ++r) vraw[r] = bf2f(*(LAS const unsigned short*)(bb + VOFF + (4 * kg + r) * 272 + (16 * w + n) * 2));
            f32x4 v4;
#pragma unroll
            for (int jj = 0; jj < 4; ++jj) v4[jj] = siluf_(cwv[0] * vraw[jj] + cwv[1] * vraw[jj + 1] + cwv[2] * vraw[jj + 2] + cwv[3] * vraw[jj + 3]);
            f32x4 X = (f32x4){0.f, 0.f, 0.f, 0.f}, Z = X;
#pragma unroll
            for (int a = 0; a < 4; ++a) {
                const bf16x4 klo = *(LAS const bf16x4*)(bb + KOFF + n * 272 + (32 * a + 4 * kg) * 2), khi = *(LAS const bf16x4*)(bb + KOFF + n * 272 + (32 * a + 16 + 4 * kg) * 2);
                X = __builtin_amdgcn_mfma_f32_16x16x32_bf16(cat4(klo, khi), Sb[a], X, 0, 0, 0);
                const bf16x4 qlo = *(LAS const bf16x4*)(bb + QOFF + n * 272 + (32 * a + 4 * kg) * 2), qhi = *(LAS const bf16x4*)(bb + QOFF + n * 272 + (32 * a + 16 + 4 * kg) * 2);
                Z = __builtin_amdgcn_mfma_f32_16x16x32_bf16(cat4(qlo, qhi), Sb[a], Z, 0, 0, 0);
            }
            const f32x4 be4 = *(LAS const f32x4*)(bb + SCOFF + (4 * kg) * 4), eg4 = *(LAS const f32x4*)(bb + SCOFF + (16 + 4 * kg) * 4), egl4 = *(LAS const f32x4*)(bb + SCOFF + (32 + 4 * kg) * 4);
            const float glast = *(LAS const float*)(bb + SCOFF + 48 * 4);
            const f32x4 R = be4 * (v4 - eg4 * X);
            const bf16x4 tf = *(LAS const bf16x4*)(bb + TOFF + n * 32 + 8 * kg);
            const f32x4 vnew = __builtin_amdgcn_mfma_f32_16x16x32_bf16(cat4(tf, z4), cat4(cvt4(R), z4), (f32x4){0.f, 0.f, 0.f, 0.f}, 0, 0, 0);
            const bf16x4 am = *(LAS const bf16x4*)(bb + AMOFF + n * 32 + 8 * kg);
            const f32x4 o = __builtin_amdgcn_mfma_f32_16x16x32_bf16(cat4(am, z4), cat4(cvt4(vnew), z4), Z * eg4, 0, 0, 0);
            const bf16x8 B2 = cat4(cvt4(vnew * egl4), z4);
#pragma unroll
            for (int i = 0; i < 8; ++i) {
                const bf16x4 kt = *(LAS const bf16x4*)(bb + KTOFF + (16 * i + n) * 40 + 8 * kg);
                S[i] = __builtin_amdgcn_mfma_f32_16x16x32_bf16(cat4(kt, z4), B2, S[i] * glast, 0, 0, 0);
            }
#pragma unroll
            for (int a = 0; a < 4; ++a) Sb[a] = cat4(cvt4(S[2 * a]), cvt4(S[2 * a + 1]));
#pragma unroll
            for (int jj = 0; jj < 4; ++jj) Qg[(rowbase + (size_t)c * 16 + 4 * kg + jj) * 1024 + h * 128 + 16 * w + n] = (bf16_t)f2bf(o[jj]);
            if (c + 1 < 512) DL_STORE(c + 1, (d + 1) % PD);
            lds_barrier();
          }
        }
#undef DL_LOAD
#undef DL_STORE
    }
}


constexpr size_t WS_GCG = 500 * MiB;
constexpr size_t WS_BNG = 508 * MiB;
__device__ __forceinline__ void prep_rwkv_elem(PPTR p) {
    const int tid = tidx(), w = tid >> 6, lane = tid & 63;
    bf16_t* P = (bf16_t*)(p->ws + WS_PROJC); bf16_t* L2 = (bf16_t*)(p->ws + WS_R1);
    float* GCg = (float*)(p->ws + WS_GCG); float* BNg = (float*)(p->ws + WS_BNG);
    for (int task = bidx() * 8 + w; task < 4 * 512 * 16; task += gdim() * 8) {
        const int h = task & 15, rc = task >> 4; const size_t row0 = (size_t)rc * 16; const int ch = h * 64 + lane;
        const float w0v = p->in[17][ch], a0v = p->in[20][ch], kkc = p->in[25][ch], kac = p->in[26][ch], rkc = p->in[27][ch];
        unsigned xr[16], xk[16], xw[16], xa[16];
#pragma unroll
        for (int t = 0; t < 16; ++t) { const bf16_t* rowp = P + (row0 + t) * 3328 + ch; const bf16_t* l2p = L2 + (row0 + t) * 3072 + ch;
            xr[t] = rowp[0]; xk[t] = rowp[1024]; xw[t] = l2p[0]; xa[t] = l2p[1024]; }
        float lg = 0.f;
#pragma unroll
        for (int t = 0; t < 16; ++t) {
            const float r = bf2f(xr[t]), kraw = bf2f(xk[t]), whi = bf2f(xw[t]), ahi = bf2f(xa[t]);
            const float wv = -softplusf_(-(w0v + whi)) - 0.5f; const float ew = __expf(wv);
            const float lgp = lg; lg -= ew;
            const float ag = sigmoidf_(a0v + ahi);
            const float kkx = kraw * kkc; const float ss = wave_allsum(kkx * kkx); const float kk = kkx * __builtin_amdgcn_rsqf(ss + 1e-6f);
            const float kp = kraw * (1.0f + (ag - 1.0f) * kac);
            const float bonus = wave_allsum(r * kp * rkc);
            const float inv = __expf(-lg);
            bf16_t* rowp = P + (row0 + t) * 3328 + ch; bf16_t* l2p = L2 + (row0 + t) * 3072 + ch;
            rowp[0] = (bf16_t)f2bf(-kk * __expf(lgp)); rowp[1024] = (bf16_t)f2bf(r * __expf(lg));
            l2p[0] = (bf16_t)f2bf(kk * ag * inv); l2p[1024] = (bf16_t)f2bf(kp * inv);
            if (lane == 0) BNg[(row0 + t) * 16 + h] = bonus;
        }
        GCg[(size_t)task * 64 + lane] = __expf(lg);
    }
}

__device__ __forceinline__ void scan_rwkv(LAS unsigned char* lds, PPTR p) {
    constexpr int AH = 0, RH = 2304, BMT = 4608, KMT = 7168, TM = 9728, LAK = 10240, MRB = 10752, MRK = 11264, VV = 11776, GC = 14080, SLOT = 14336;
    constexpr int PRIV = 8 * SLOT, PRIVSZ = 5632;
    const int tid = tidx(), wave = tid >> 6, lane = tid & 63, n = lane & 15, kg = lane >> 4;
    const bf16_t* P = (const bf16_t*)(p->ws + WS_PROJC); const bf16_t* L2 = (const bf16_t*)(p->ws + WS_R1);
    bf16_t* Og = (bf16_t*)(p->ws + WS_OC);
    const int G = gdim(); const int vcu = (G % 8 == 0) ? (int)(bidx() % 8) * (G / 8) + (int)(bidx() / 8) : (int)bidx();
    for (int task = vcu; task < 256; task += G) {
        const int bh = task >> 2, slice = task & 3, b = bh >> 4, h = bh & 15; const size_t rowbase = (size_t)b * SEQ;
        const int pwr = (wave >= 1 && wave <= 3) ? wave - 1 : (wave == 5 ? 3 : -1);
        if (pwr >= 0) {
            const int pw = pwr; const int ch = h * 64 + lane;
            LAS unsigned char* bh = lds + PRIV + pw * PRIVSZ; LAS unsigned char* kh = bh + 2304; LAS float* Lm = (LAS float*)(kh + 2304);
            const float* GCg = (const float*)(p->ws + WS_GCG);
            unsigned xr[16], xk[16], xv[16], xw[16], xa[16]; float gCn;
#define RW_LOAD(cc, T0) do { _Pragma("unroll") for (int t = (T0); t < (T0) + 8; ++t) { const size_t r_ = rowbase + (size_t)(cc) * 16 + t; const bf16_t* rowp = P + r_ * 3328 + ch; const bf16_t* l2p = L2 + r_ * 3072 + ch; \
                xr[t] = rowp[0]; xk[t] = rowp[1024]; xv[t] = rowp[2048]; xw[t] = l2p[0]; xa[t] = l2p[1024]; } \
                if ((T0) == 8) gCn = GCg[((size_t)(b * 512 + (cc)) * 16 + h) * 64 + lane]; } while (0)
            RW_LOAD(pw, 0); RW_LOAD(pw, 8);
            for (int m = -1; m < 128; ++m) {
                const int cc = 4 * (m + 1) + pw;
                if (cc < 512) {
                    LAS unsigned char* sl = lds + (cc & 7) * SLOT;
                    const float gC = gCn; float bhat[16], khat[16];
#pragma unroll
                    for (int t = 0; t < 16; ++t) {
                        bhat[t] = bf2f(xw[t]); khat[t] = bf2f(xa[t]);
                        *(LAS unsigned short*)(sl + AH + t * 144 + 2 * lane) = (unsigned short)xr[t];
                        *(LAS unsigned short*)(sl + RH + t * 144 + 2 * lane) = (unsigned short)xk[t];
                        *(LAS unsigned short*)(bh + t * 144 + 2 * lane) = (unsigned short)xw[t];
                        *(LAS unsigned short*)(kh + t * 144 + 2 * lane) = (unsigned short)xa[t];
                        *(LAS unsigned short*)(sl + VV + t * 144 + 2 * lane) = (unsigned short)xv[t];
                    }
                    if (cc + 4 < 512) { RW_LOAD(cc + 4, 0); RW_LOAD(cc + 4, 8); }
                    *(LAS float*)(sl + GC + 4 * lane) = gC;
#pragma unroll
                    for (int q = 0; q < 4; ++q) {
                        u32x2 wb, wk; wb.x = pack2(bhat[4 * q] * gC, bhat[4 * q + 1] * gC); wb.y = pack2(bhat[4 * q + 2] * gC, bhat[4 * q + 3] * gC);
                        wk.x = pack2(khat[4 * q] * gC, khat[4 * q + 1] * gC); wk.y = pack2(khat[4 * q + 2] * gC, khat[4 * q + 3] * gC);
                        *(LAS u32x2*)(sl + BMT + lane * 40 + 8 * q) = wb; *(LAS u32x2*)(sl + KMT + lane * 40 + 8 * q) = wk;
                    }
                    asm volatile("s_waitcnt lgkmcnt(0)" ::: "memory");
                    f32x4 lab = (f32x4){0.f, 0.f, 0.f, 0.f}, lak = lab, mrb = lab, mrk = lab;
#pragma unroll
                    for (int a = 0; a < 2; ++a) {
                        const bf16x8 af = *(LAS const bf16x8*)(sl + AH + n * 144 + (32 * a + 8 * kg) * 2), rf = *(LAS const bf16x8*)(sl + RH + n * 144 + (32 * a + 8 * kg) * 2);
                        const bf16x8 bf_ = *(LAS const bf16x8*)(bh + n * 144 + (32 * a + 8 * kg) * 2), kf = *(LAS const bf16x8*)(kh + n * 144 + (32 * a + 8 * kg) * 2);
                        lab = __builtin_amdgcn_mfma_f32_16x16x32_bf16(af, bf_, lab, 0, 0, 0); lak = __builtin_amdgcn_mfma_f32_16x16x32_bf16(af, kf, lak, 0, 0, 0);
                        mrb = __builtin_amdgcn_mfma_f32_16x16x32_bf16(rf, bf_, mrb, 0, 0, 0); mrk = __builtin_amdgcn_mfma_f32_16x16x32_bf16(rf, kf, mrk, 0, 0, 0);
                    }
#pragma unroll
                    for (int jj = 0; jj < 4; ++jj) { const int t = 4 * kg + jj;
                        Lm[t * 16 + n] = (n < t) ? lab[jj] : 0.f;
                        *(LAS unsigned short*)(sl + LAK + t * 32 + 2 * n) = (unsigned short)f2bf(n < t ? lak[jj] : 0.f);
                        *(LAS unsigned short*)(sl + MRB + t * 32 + 2 * n) = (unsigned short)f2bf(n <= t ? mrb[jj] : 0.f);
                        *(LAS unsigned short*)(sl + MRK + t * 32 + 2 * n) = (unsigned short)f2bf(n <= t ? mrk[jj] : 0.f); }
                    asm volatile("s_waitcnt lgkmcnt(0)" ::: "memory");
                    float x[16];
                    tri_inv16<1>(Lm, n, x);
#pragma unroll
                    for (int jj = 0; jj < 4; ++jj) { const float v = (kg == 0) ? x[jj] : (kg == 1 ? x[4 + jj] : (kg == 2 ? x[8 + jj] : x[12 + jj]));
                        *(LAS unsigned short*)(sl + TM + (4 * kg + jj) * 32 + 2 * n) = (unsigned short)f2bf(v); }
                }
                lds_barrier();
            }
#undef RW_LOAD
        } else if (wave != 0) {
            for (int m = -1; m < 128; ++m) lds_barrier();
        } else {
            const int w = slice;
            f32x4 Zt[4]; bf16x8 Zb[2];
#pragma unroll
            for (int i = 0; i < 4; ++i) Zt[i] = (f32x4){0.f, 0.f, 0.f, 0.f};
            Zb[0] = (bf16x8){0, 0, 0, 0, 0, 0, 0, 0}; Zb[1] = Zb[0];
            struct RwOps { bf16x4 alo[2], ahi[2], rlo[2], rhi[2], vf, lakf, tf, mb, mk, bt[4], kt[4]; f32x4 g4[4]; };
#define RW_OPLOAD(R, cidx) do { LAS const unsigned char* sl_ = lds + ((cidx) & 7) * SLOT; \
                _Pragma("unroll") for (int a = 0; a < 2; ++a) { \
                    R.alo[a] = *(LAS const bf16x4*)(sl_ + AH + n * 144 + (32 * a + 4 * kg) * 2); R.ahi[a] = *(LAS const bf16x4*)(sl_ + AH + n * 144 + (32 * a + 16 + 4 * kg) * 2); \
                    R.rlo[a] = *(LAS const bf16x4*)(sl_ + RH + n * 144 + (32 * a + 4 * kg) * 2); R.rhi[a] = *(LAS const bf16x4*)(sl_ + RH + n * 144 + (32 * a + 16 + 4 * kg) * 2); } \
                _Pragma("unroll") for (int jj = 0; jj < 4; ++jj) R.vf[jj] = *(LAS const short*)(sl_ + VV + (4 * kg + jj) * 144 + (16 * w + n) * 2); \
                R.lakf = *(LAS const bf16x4*)(sl_ + LAK + n * 32 + 8 * kg); R.tf = *(LAS const bf16x4*)(sl_ + TM + n * 32 + 8 * kg); \
                R.mb = *(LAS const bf16x4*)(sl_ + MRB + n * 32 + 8 * kg); R.mk = *(LAS const bf16x4*)(sl_ + MRK + n * 32 + 8 * kg); \
                _Pragma("unroll") for (int i = 0; i < 4; ++i) { R.g4[i] = *(LAS const f32x4*)(sl_ + GC + (16 * i + 4 * kg) * 4); \
                    R.bt[i] = *(LAS const bf16x4*)(sl_ + BMT + (16 * i + n) * 40 + 8 * kg); R.kt[i] = *(LAS const bf16x4*)(sl_ + KMT + (16 * i + n) * 40 + 8 * kg); } } while (0)
#define RW_COMPUTE(R, cidx) do { \
                f32x4 P1 = (f32x4){0.f, 0.f, 0.f, 0.f}, Oa = P1; \
                _Pragma("unroll") for (int a = 0; a < 2; ++a) { P1 = __builtin_amdgcn_mfma_f32_16x16x32_bf16(cat4(R.alo[a], R.ahi[a]), Zb[a], P1, 0, 0, 0); \
                    Oa = __builtin_amdgcn_mfma_f32_16x16x32_bf16(cat4(R.rlo[a], R.rhi[a]), Zb[a], Oa, 0, 0, 0); } \
                P1 = __builtin_amdgcn_mfma_f32_16x16x32_bf16(cat4(R.lakf, z4), cat4(R.vf, z4), P1, 0, 0, 0); \
                const f32x4 Y = __builtin_amdgcn_mfma_f32_16x16x32_bf16(cat4(R.tf, z4), cat4(cvt4(P1), z4), (f32x4){0.f, 0.f, 0.f, 0.f}, 0, 0, 0); \
                const bf16x8 Byv = cat4(cvt4(Y), R.vf); \
                Oa = __builtin_amdgcn_mfma_f32_16x16x32_bf16(cat4(R.mb, R.mk), Byv, Oa, 0, 0, 0); \
                _Pragma("unroll") for (int i = 0; i < 4; ++i) Zt[i] = __builtin_amdgcn_mfma_f32_16x16x32_bf16(cat4(R.bt[i], R.kt[i]), Byv, Zt[i] * R.g4[i], 0, 0, 0); \
                Zb[0] = cat4(cvt4(Zt[0]), cvt4(Zt[1])); Zb[1] = cat4(cvt4(Zt[2]), cvt4(Zt[3])); \
                _Pragma("unroll") for (int jj = 0; jj < 4; ++jj) Og[(rowbase + (size_t)(cidx) * 16 + 4 * kg + jj) * 1024 + h * 64 + 16 * w + n] = (bf16_t)f2bf(Oa[jj]); } while (0)
            const bf16x4 z4 = (bf16x4){0, 0, 0, 0};
            lds_barrier();
            for (int m = 0; m < 128; ++m) {
                RwOps OA, OB;
                RW_OPLOAD(OA, 4 * m);
                RW_OPLOAD(OB, 4 * m + 1); __builtin_amdgcn_sched_barrier(0);
                RW_COMPUTE(OA, 4 * m); __builtin_amdgcn_sched_barrier(0);
                RW_OPLOAD(OA, 4 * m + 2); __builtin_amdgcn_sched_barrier(0);
                RW_COMPUTE(OB, 4 * m + 1); __builtin_amdgcn_sched_barrier(0);
                RW_OPLOAD(OB, 4 * m + 3); __builtin_amdgcn_sched_barrier(0);
                RW_COMPUTE(OA, 4 * m + 2); __builtin_amdgcn_sched_barrier(0);
                RW_COMPUTE(OB, 4 * m + 3);
                lds_barrier();
            }
#undef RW_OPLOAD
#undef RW_COMPUTE
        }
    }
}


template <int KIND>
__device__ __forceinline__ void scan_chunked(LAS unsigned char* lds, PPTR p, int j) {
    constexpr int QOFF = 0, KOFF = 4352, KTOFF = 8704, VOFF = 13824, TOFF = 14464, AMOFF = 14976, SCOFF = 15488, OBOFF = 16000, BUFB = 17024;
    constexpr int LDP = (KIND == 0) ? 4352 : 4096;
    constexpr int VROWS = (KIND == 0) ? 19 : 16, VEND = 512 + 2 * VROWS;
    constexpr int TEND = (KIND == 0) ? VEND + 32 : VEND, AEND = TEND + 32, SEND = AEND + ((KIND == 0) ? 16 : 32);
    const int tid = tidx(), wave = tid >> 6, lane = tid & 63, n = lane & 15, kg = lane >> 4;
    const bf16_t* P = (const bf16_t*)(p->ws + WS_PROJ);
    const bf16_t* Qg = (const bf16_t*)(p->ws + WS_R1); const bf16_t* Kg = (const bf16_t*)(p->ws + WS_KG);
    const bf16_t* Tg = (const bf16_t*)(p->ws + WS_TA);
    const bf16_t* Amg = (const bf16_t*)(p->ws + (KIND == 0 ? WS_AMA : WS_AM));
    const float* Scg = (const float*)(p->ws + (KIND == 0 ? WS_SCA : WS_DEC));
    bf16_t* Og = (KIND == 0) ? (bf16_t*)(p->ws + WS_PROJ) : (bf16_t*)(p->ws + WS_OC);
    constexpr int LDO = (KIND == 0) ? 4352 : 1024;
    const bf16x4 z4 = (bf16x4){0, 0, 0, 0};
    const int G = gdim(); const int vcu = (G % 8 == 0) ? (int)(bidx() % 8) * (G / 8) + (int)(bidx() / 8) : (int)bidx();
    for (int task = vcu; task < 256; task += G) {
        const int bh = task >> 3, w = task & 7, b = bh >> 3, h = bh & 7; const size_t rowbase = (size_t)b * SEQ;
        if (wave == 0) {
            float cwv[4] = {0.f, 0.f, 0.f, 0.f};
            if (KIND == 0) { const float* cv = p->in[6] + (size_t)j * 4 * 3072;
#pragma unroll
                for (int jj = 0; jj < 4; ++jj) cwv[jj] = cv[jj * 3072 + 2048 + h * 128 + 16 * w + n]; }
            f32x4 S[8]; bf16x8 Sb[4];
#pragma unroll
            for (int i = 0; i < 8; ++i) S[i] = (f32x4){0.f, 0.f, 0.f, 0.f};
#pragma unroll
            for (int a = 0; a < 4; ++a) Sb[a] = (bf16x8){0, 0, 0, 0, 0, 0, 0, 0};
            lds_barrier();
            for (int c2 = 0; c2 < 512; c2 += 4) {
#pragma unroll 1
              for (int u = 0; u < 4; ++u) { const int c = c2 + u;
                LAS unsigned char* bb = lds + (c & 7) * BUFB;
                bf16x4 klo[4], khi[4], qlo[4], qhi[4], kt[8], am, tf = z4; f32x4 be4, eg4, egl4, d4[8]; float glast = 0.f; unsigned vr16[7]; bf16x4 vb = z4;
#pragma unroll
                for (int a = 0; a < 4; ++a) {
                    if (KIND == 0) { klo[a] = *(LAS const bf16x4*)(bb + KOFF + n * 272 + (32 * a + 4 * kg) * 2); khi[a] = *(LAS const bf16x4*)(bb + KOFF + n * 272 + (32 * a + 16 + 4 * kg) * 2); }
                    qlo[a] = *(LAS const bf16x4*)(bb + QOFF + n * 272 + (32 * a + 4 * kg) * 2); qhi[a] = *(LAS const bf16x4*)(bb + QOFF + n * 272 + (32 * a + 16 + 4 * kg) * 2); }
                if (KIND == 0) {
#pragma unroll
                    for (int r = 0; r < 7; ++r) vr16[r] = *(LAS const unsigned short*)(bb + VOFF + (4 * kg + r) * 32 + 2 * n);
                    be4 = *(LAS const f32x4*)(bb + SCOFF + (4 * kg) * 4); eg4 = *(LAS const f32x4*)(bb + SCOFF + (16 + 4 * kg) * 4); egl4 = *(LAS const f32x4*)(bb + SCOFF + (32 + 4 * kg) * 4);
                    glast = *(LAS const float*)(bb + SCOFF + 48 * 4); tf = *(LAS const bf16x4*)(bb + TOFF + n * 32 + 8 * kg);
                } else {
#pragma unroll
                    for (int jj = 0; jj < 4; ++jj) vb[jj] = *(LAS const short*)(bb + VOFF + (4 * kg + jj) * 32 + 2 * n);
#pragma unroll
                    for (int i = 0; i < 8; ++i) d4[i] = *(LAS const f32x4*)(bb + SCOFF + (16 * i + 4 * kg) * 4);
                }
                am = *(LAS const bf16x4*)(bb + AMOFF + n * 32 + 8 * kg);
#pragma unroll
                for (int i = 0; i < 8; ++i) kt[i] = *(LAS const bf16x4*)(bb + KTOFF + (16 * i + n) * 40 + 8 * kg);
                __builtin_amdgcn_sched_barrier(0);
                asm volatile("s_waitcnt lgkmcnt(0)" ::: "memory");
                __builtin_amdgcn_sched_barrier(0);
                f32x4 v4 = (f32x4){0.f, 0.f, 0.f, 0.f};
                if (KIND == 0) {
#pragma unroll
                    for (int jj = 0; jj < 4; ++jj) v4[jj] = siluf_(cwv[0] * bf2f(vr16[jj]) + cwv[1] * bf2f(vr16[jj + 1]) + cwv[2] * bf2f(vr16[jj + 2]) + cwv[3] * bf2f(vr16[jj + 3]));
                }
                f32x4 X = (f32x4){0.f, 0.f, 0.f, 0.f}, Z = X;
#pragma unroll
                for (int a = 0; a < 4; ++a) {
                    if (KIND == 0) X = __builtin_amdgcn_mfma_f32_16x16x32_bf16(cat4(klo[a], khi[a]), Sb[a], X, 0, 0, 0);
                    Z = __builtin_amdgcn_mfma_f32_16x16x32_bf16(cat4(qlo[a], qhi[a]), Sb[a], Z, 0, 0, 0);
                }
                f32x4 o; bf16x8 B2;
                if (KIND == 0) {
                    const f32x4 R = be4 * (v4 - eg4 * X);
                    const f32x4 vnew = __builtin_amdgcn_mfma_f32_16x16x32_bf16(cat4(tf, z4), cat4(cvt4(R), z4), (f32x4){0.f, 0.f, 0.f, 0.f}, 0, 0, 0);
                    o = __builtin_amdgcn_mfma_f32_16x16x32_bf16(cat4(am, z4), cat4(cvt4(vnew), z4), Z * eg4, 0, 0, 0);
                    B2 = cat4(cvt4(vnew * egl4), z4);
#pragma unroll
                    for (int i = 0; i < 8; ++i) S[i] = __builtin_amdgcn_mfma_f32_16x16x32_bf16(cat4(kt[i], z4), B2, S[i] * glast, 0, 0, 0);
                } else {
                    B2 = cat4(vb, z4);
                    o = __builtin_amdgcn_mfma_f32_16x16x32_bf16(cat4(am, z4), B2, Z, 0, 0, 0);
#pragma unroll
                    for (int i = 0; i < 8; ++i) S[i] = __builtin_amdgcn_mfma_f32_16x16x32_bf16(cat4(kt[i], z4), B2, S[i] * d4[i], 0, 0, 0);
                }
                *(LAS f32x4*)(bb + OBOFF + lane * 16) = o;
#pragma unroll
                for (int a = 0; a < 4; ++a) Sb[a] = cat4(cvt4(S[2 * a]), cvt4(S[2 * a + 1]));
              }
                lds_barrier();
            }
            lds_barrier();
        } else {
            const int lt = tid - 64, pb = lt + 448;
            const int arow = (lt & 255) >> 4, apc = lt & 15;
            const bf16_t* srcA = (lt < 256 ? Qg : Kg) + (rowbase + arow) * 1024 + h * 128 + 8 * apc;
            const char* srcB; size_t strideB; int kindB;
            if (pb < 512) { kindB = 0; srcB = (const char*)(Kg + (rowbase + ((pb - 256) >> 4)) * 1024 + h * 128 + 8 * (pb & 15)); strideB = (size_t)16 * 1024 * 2; }
            else if (pb < VEND) { kindB = 1; const int vr_ = (pb - 512) >> 1, hf_ = (pb - 512) & 1; srcB = (const char*)(P + (rowbase + vr_) * LDP + 2048 + h * 128 + 16 * w + 8 * hf_); strideB = (size_t)16 * LDP * 2; }
            else if (pb < TEND) { kindB = 2; srcB = (const char*)(Tg + ((size_t)(b * 512) * 8 + h) * 256 + (pb - VEND) * 8); strideB = (size_t)8 * 256 * 2; }
            else if (pb < AEND) { kindB = 3; srcB = (const char*)(Amg + ((size_t)(b * 512) * 8 + h) * 256 + (pb - TEND) * 8); strideB = (size_t)8 * 256 * 2; }
            else if (pb < SEND) { kindB = 4; srcB = (const char*)(Scg + ((size_t)(b * 512) * 8 + h) * (KIND == 0 ? 64 : 128) + (pb - AEND) * 4); strideB = (size_t)8 * (KIND == 0 ? 64 : 128) * 4; }
            else { kindB = 5; srcB = (const char*)srcA; strideB = (size_t)16 * 1024 * 2; }
            const int vrow = (pb - 512) >> 1;
            const bool doflush = (wave == 2);
            constexpr int PD = 8;
            u32x4 g0[PD], g1[PD];
#define SC_LOAD(cc, sl) do { const int c_ = (cc); g0[sl] = *(const u32x4*)(srcA + (size_t)c_ * 16 * 1024); \
                const int tv_ = c_ * 16 + vrow - 3; const bool vh_ = (KIND == 0) && (kindB == 1); \
                const ptrdiff_t ofs_ = vh_ ? (ptrdiff_t)(tv_ >= 0 ? tv_ - vrow : -vrow) * (LDP * 2) : (ptrdiff_t)((size_t)c_ * strideB); \
                const u32x4 vv_ = *(const u32x4*)(srcB + ofs_); g1[sl] = (vh_ && tv_ < 0) ? (u32x4){0u, 0u, 0u, 0u} : vv_; } while (0)
#define SC_KSTORE(bb_, reg, row, pc) do { if (KIND == 0) *(LAS u32x4*)((bb_) + KOFF + (row) * 272 + 16 * (pc)) = (reg); \
                _Pragma("unroll") for (int e = 0; e < 4; ++e) { *(LAS unsigned short*)((bb_) + KTOFF + (8 * (pc) + 2 * e) * 40 + 2 * (row)) = (unsigned short)((reg)[e] & 0xffffu); \
                    *(LAS unsigned short*)((bb_) + KTOFF + (8 * (pc) + 2 * e + 1) * 40 + 2 * (row)) = (unsigned short)((reg)[e] >> 16); } } while (0)
#define SC_STORE(cc, sl) do { LAS unsigned char* bb_ = lds + ((cc) & 7) * BUFB; \
                if (lt < 256) *(LAS u32x4*)(bb_ + QOFF + arow * 272 + 16 * apc) = g0[sl]; else SC_KSTORE(bb_, g0[sl], arow, apc); \
                if (kindB == 0) SC_KSTORE(bb_, g1[sl], ((pb - 256) >> 4), (pb & 15)); \
                else if (kindB == 1) *(LAS u32x4*)(bb_ + VOFF + vrow * 32 + 16 * ((pb - 512) & 1)) = g1[sl]; \
                else if (kindB == 2) *(LAS u32x4*)(bb_ + TOFF + (pb - VEND) * 16) = g1[sl]; \
                else if (kindB == 3) *(LAS u32x4*)(bb_ + AMOFF + (pb - TEND) * 16) = g1[sl]; \
                else if (kindB == 4) *(LAS u32x4*)(bb_ + SCOFF + (pb - AEND) * 16) = g1[sl]; } while (0)
#define SC_OFLUSH(cc) do { const int c_ = (cc); const f32x4 o_ = *(LAS const f32x4*)(lds + (c_ & 7) * BUFB + OBOFF + lane * 16); \
                _Pragma("unroll") for (int jj = 0; jj < 4; ++jj) Og[(rowbase + (size_t)c_ * 16 + 4 * kg + jj) * LDO + h * 128 + 16 * w + n] = (bf16_t)f2bf(o_[jj]); } while (0)
#define SC_LOADER_LOOP(FLUSH) do { \
                _Pragma("unroll") for (int d = 0; d < PD; ++d) SC_LOAD(d, d); \
                SC_STORE(0, 0); SC_STORE(1, 1); SC_STORE(2, 2); SC_STORE(3, 3); \
                SC_LOAD(8, 0); SC_LOAD(9, 1); SC_LOAD(10, 2); SC_LOAD(11, 3); \
                lds_barrier(); \
                for (int c0 = 0; c0 < 512; c0 += PD) { \
                    _Pragma("unroll") for (int d = 0; d < PD; d += 4) { const int c = c0 + d; \
                        if (c + 4 < 512) { _Pragma("unroll") for (int u = 0; u < 4; ++u) SC_STORE(c + 4 + u, (d + 4 + u) % PD); } \
                        if (c + 12 < 512) { _Pragma("unroll") for (int u = 0; u < 4; ++u) SC_LOAD(c + 12 + u, (d + 4 + u) % PD); } \
                        if (FLUSH) { if (c > 0) { _Pragma("unroll") for (int u = 0; u < 4; ++u) SC_OFLUSH(c - 4 + u); } } \
                        lds_barrier(); } } \
                if (FLUSH) { _Pragma("unroll") for (int u = 0; u < 4; ++u) SC_OFLUSH(508 + u); } \
                lds_barrier(); } while (0)
            if (doflush) SC_LOADER_LOOP(true); else SC_LOADER_LOOP(false);
#undef SC_LOAD
#undef SC_KSTORE
#undef SC_STORE
#undef SC_OFLUSH
#undef SC_LOADER_LOOP
        }
    }
}

template <int KIND>
__device__ __forceinline__ void post_phase(PPTR p, int j) {
    const int lane = tidx() & 63, wave = tidx() >> 6;
    const int gw = bidx() * 8 + wave, nw = gdim() * 8;
    bf16_t* O = (bf16_t*)(p->ws + (KIND != 0 ? WS_OC : WS_PROJ));
    constexpr int LDO = (KIND == 0) ? 4352 : 1024;
    const bf16_t* P = (const bf16_t*)(p->ws + (KIND == 2 ? WS_PROJC : WS_PROJ));
    if (KIND != 2) {
        const float* nwp = (KIND == 0) ? p->in[9] + j * 128 : p->in[13];
        const float n0 = nwp[2 * lane], n1 = nwp[2 * lane + 1];
        constexpr int LDP = (KIND == 0) ? 4352 : 4096; constexpr int ZOFF = 3072;
        for (int row = gw; row < MROWS; row += nw) {
            unsigned ov[8], zv[8];
#pragma unroll
            for (int h = 0; h < 8; ++h) { ov[h] = *(const unsigned*)(O + (size_t)row * LDO + h * 128 + 2 * lane); zv[h] = *(const unsigned*)(P + (size_t)row * LDP + ZOFF + h * 128 + 2 * lane); }
#pragma unroll
            for (int h = 0; h < 8; ++h) {
                const float o0 = bflo(ov[h]), o1 = bfhi(ov[h]);
                const float ss = wave_allsum(o0 * o0 + o1 * o1); const float rstd = __builtin_amdgcn_rsqf(ss * (1.0f / 128.0f) + 1e-6f);
                *(unsigned*)(O + (size_t)row * LDO + h * 128 + 2 * lane) = pack2(o0 * rstd * n0 * siluf_(bflo(zv[h])), o1 * rstd * n1 * siluf_(bfhi(zv[h])));
            }
        }
    } else {
        const bf16_t* L2 = (const bf16_t*)(p->ws + WS_R1); const float* BNg = (const float*)(p->ws + WS_BNG);
        for (int task = gw; task < MROWS * 2; task += nw) {
            const int row = task >> 1, h0 = (task & 1) * 8;
            unsigned xy[8], xv[8], xg[8]; float bn[8], lw[8], lb_[8];
#pragma unroll
            for (int hh = 0; hh < 8; ++hh) { const int ch = (h0 + hh) * 64 + lane; const bf16_t* rowp = P + (size_t)row * 3328; const bf16_t* l2p = L2 + (size_t)row * 3072;
                xy[hh] = O[(size_t)row * DM + ch]; xv[hh] = rowp[2048 + ch]; xg[hh] = l2p[2048 + ch]; bn[hh] = BNg[(size_t)row * 16 + h0 + hh];
                lw[hh] = p->in[28][ch]; lb_[hh] = p->in[29][ch]; }
#pragma unroll
            for (int hh = 0; hh < 8; ++hh) { const int ch = (h0 + hh) * 64 + lane;
                const float y = bf2f(xy[hh]);
                const float mean = wave_allsum(y) * (1.0f / 64.0f); const float dd = y - mean;
                const float var = wave_allsum(dd * dd) * (1.0f / 64.0f);
                const float gn = dd * __builtin_amdgcn_rsqf(var + 0.04096f) * lw[hh] + lb_[hh];
                O[(size_t)row * DM + ch] = (bf16_t)f2bf((gn + bn[hh] * bf2f(xv[hh])) * bf2f(xg[hh]));
            }
        }
    }
}

#define XB_TMO      128
#define XB_XCNT(j)  (256  + 64 * (j))
#define XB_XSUB(j)  (1280 + 64 * (j))
#define XB_XGEN(j)  (2304 + 64 * (j))
#define XB_TOP      3328
#define XB_TOPGEN   3392
#define XCD_BAR_WORDS 3456
#define XB_SPIN_CAP (1u << 18)
constexpr size_t WS_BAR = WS_MISC + 1 * MiB;
__device__ __forceinline__ unsigned xb_ld(unsigned* p)              { return __hip_atomic_load(p, __ATOMIC_RELAXED, __HIP_MEMORY_SCOPE_AGENT); }
__device__ __forceinline__ unsigned xb_add(unsigned* p, unsigned v) { return __hip_atomic_fetch_add(p, v, __ATOMIC_RELAXED, __HIP_MEMORY_SCOPE_AGENT); }
__device__ __forceinline__ unsigned xb_xcc_id() { return (unsigned)__builtin_amdgcn_s_getreg((3 << 11) | 20) & 0xFu; }
#define XB_SPIN(cond, bar) do { unsigned _sp = 0; while (cond) { __builtin_amdgcn_s_sleep(1); \
    if ((++_sp & 255u) == 0u) { if (xb_ld(&(bar)[XB_TMO])) break; if (_sp > XB_SPIN_CAP) { atomicAdd(&(bar)[XB_TMO], 1u); break; } } } } while (0)
struct XcdBarrier { unsigned* bar; unsigned x; volatile LAS unsigned* st; };
__device__ __forceinline__ XcdBarrier xcd_barrier_post(unsigned* bar, volatile LAS unsigned* st) {
    XcdBarrier b; b.bar = bar; b.x = xb_xcc_id(); b.st = st;
    if (threadIdx.x == 0) (void)xb_add(&bar[XB_XCNT(b.x)], 1u);
    return b;
}
__device__ __forceinline__ void xcd_barrier_complete(unsigned* bar, unsigned x, unsigned& nloc, unsigned& nx) {
    const unsigned G = gridDim.x * gridDim.y * gridDim.z;
    unsigned sum, cnt, mine, sp = 0u;
    for (;;) {
        sum = 0u; cnt = 0u; mine = 0u;
#pragma unroll
        for (unsigned j = 0; j < 16; ++j) { const unsigned c = xb_ld(&bar[XB_XCNT(j)]); sum += c; cnt += (c > 0u) ? 1u : 0u; mine = (j == x) ? c : mine; }
        if (sum == G) break;
        __builtin_amdgcn_s_sleep(1);
        if ((++sp & 255u) == 0u) { if (xb_ld(&bar[XB_TMO])) break; if (sp > XB_SPIN_CAP) { atomicAdd(&bar[XB_TMO], 1u); break; } }
    }
    nloc = mine > 0u ? mine : 1u; nx = cnt > 0u ? cnt : 1u;
}
__device__ __forceinline__ void xcd_barrier(const XcdBarrier& b) {
    asm volatile("s_waitcnt vmcnt(0)" ::: "memory");
    __syncthreads();
    if (threadIdx.x == 0) {
        unsigned* bar = b.bar;
        __builtin_amdgcn_s_waitcnt(0);
        unsigned nloc = b.st[0], nx = b.st[1];
        if (nloc == 0u) { xcd_barrier_complete(bar, b.x, nloc, nx); b.st[0] = nloc; b.st[1] = nx; }
        const unsigned old = xb_add(&bar[XB_XSUB(b.x)], 1u);
        const unsigned gen = old / nloc;
        if (old + 1u == (gen + 1u) * nloc) {
            __builtin_amdgcn_fence(__ATOMIC_RELEASE, "agent");
            asm volatile("s_waitcnt vmcnt(0)" ::: "memory");
            const unsigned og = xb_add(&bar[XB_TOP], 1u);
            const unsigned tg = og / nx;
            if (og + 1u == (tg + 1u) * nx) xb_add(&bar[XB_TOPGEN], 1u);
            else XB_SPIN(xb_ld(&bar[XB_TOPGEN]) == tg, bar);
            __builtin_amdgcn_fence(__ATOMIC_ACQUIRE, "agent");
            xb_add(&bar[XB_XGEN(b.x)], 1u);
            asm volatile("s_waitcnt vmcnt(0)" ::: "memory");
        } else {
            XB_SPIN(xb_ld(&bar[XB_XGEN(b.x)]) == gen, bar);
            __builtin_amdgcn_fence(__ATOMIC_ACQUIRE, "agent");
            asm volatile("s_waitcnt vmcnt(0)" ::: "memory");
        }
    }
    __syncthreads();
}

constexpr int NPH = 54;
__host__ __device__ inline int step_of(int ph) { const int si = (ph - 1) % 13; return si < 3 ? si : (si == 3 ? 12 : si - 1); }
__host__ __device__ inline bool phase_is_noop(int ph) {
    if (ph == 0 || ph == NPH - 1) return false;
    const int l = (ph - 1) / 13, st = step_of(ph);
    return st == 12 && (l % 3) != 2;
}

__global__ void __launch_bounds__(512, 2) mega(const Params pv) {
    extern __shared__ __attribute__((aligned(16))) unsigned char shm[];
    PPTR p = &pv;
    LAS unsigned char* lds = (LAS unsigned char*)shm;
    cg::grid_group grid = cg::this_grid();
    volatile LAS unsigned* xb_st = (volatile LAS unsigned*)(lds + 147440);
    if (threadIdx.x == 0) { xb_st[0] = 0u; xb_st[1] = 0u; }
    __syncthreads();
    const XcdBarrier xb = xcd_barrier_post((unsigned*)(pv.ws + WS_BAR), xb_st);
    const int ph_lo = p->ph_lo, ph_hi = p->ph_hi;
    for (int ph = ph_lo; ph < ph_hi; ++ph) {
        if (phase_is_noop(ph)) continue;
        float* mod = (float*)(p->ws + WS_MISC);
        bf16_t* W = (bf16_t*)(p->ws + WS_W);
        if (ph == 0) { pre_phase(lds, p); __syncthreads(); cvt_layer(lds, p, 0); }
        else if (ph == NPH - 1) { if (PHMASK & 2) final_phase(p->out, p->in[35]); }
        else {
            const int l = (ph - 1) / 13, st = step_of(ph), kind = l % 3, j = l / 3;
            const float* hin = (l == 0) ? p->in[0] : p->out;
            const float* modl = mod + (size_t)l * 4 * 6144;
            bf16_t* R1 = (bf16_t*)(p->ws + WS_R1);
            for (int rep = 0; rep < 1 + (((REPMASK >> st) & 1) & ((REPL >> l) & 1)); ++rep) {
            if (rep) grid.sync();
            if (!(PHMASK & (4 << st))) {} else if (st == 0) {
                if (l > 0) cvt_layer(lds, p, l);
                if (kind == 2) norm_phase<true>(hin, p->in[2] + (size_t)(l * 2 + 0) * 1024, modl, 0, R1, 2048);
                else norm_phase<false>(hin, p->in[2] + (size_t)(l * 2 + 0) * 1024, modl, 0, R1, 1024);
            } else if (st == 12) {
                prep_rwkv_elem(p);
            } else if (st == 2 && kind == 1) {
                prep_gla(lds, p);
            } else if (st == 2 && kind == 0) {
                prep_delta(lds, p, j);
            } else if (st == 1 || st == 2 || st == 7 || st == 9) {
                pg8::EpiBf16S E; E.act = 0; const bf16_t* A; const bf16_t* Bt; int lda, N, K;
                if (st == 1) {
                    A = R1; Bt = W + W_IN / 2;
                    if (kind == 0) { E.O = (bf16_t*)(p->ws + WS_PROJ); E.ldc = 4352; lda = 1024; N = 4352; K = 1024; }
                    else if (kind == 1) { E.O = (bf16_t*)(p->ws + WS_PROJ); E.ldc = 4096; lda = 1024; N = 4096; K = 1024; }
                    else { E.O = (bf16_t*)(p->ws + WS_PROJC); E.ldc = 3328; E.act = 1; lda = 2048; N = 3328; K = 2048; }
                } else if (st == 2) {
                    A = (const bf16_t*)(p->ws + WS_PROJC) + 3072; Bt = W + W_L2 / 2; E.O = R1; E.ldc = 3072; lda = 3328; N = 3072; K = 256;
                } else {
                    const int g = (st == 9);
                    A = R1; Bt = W + W_UP / 2 + (size_t)(g ? 3072 : 0) * 1024; N = g ? 2560 : 3072; E.O = (bf16_t*)(p->ws + WS_HID); E.ldc = N; lda = 1024; K = 1024;
                }
                run_gemm(lds, A, lda, Bt, N, K, E);
            } else if (st == 5 || st == 11) {
                pg8::EpiRes E; const bf16_t* A; const bf16_t* Bt; int lda, K;
                if (st == 5) { E.res = hin; E.out = p->out; E.gate = modl + 2 * 1024; A = (const bf16_t*)(p->ws + (kind != 0 ? WS_OC : WS_PROJ)); lda = (kind == 0) ? 4352 : 1024; Bt = W + W_OUT / 2; K = 1024; }
                else { E.res = p->out; E.out = p->out; E.gate = modl + 5 * 1024; A = (const bf16_t*)(p->ws + WS_ACT); lda = 2816; Bt = W + W_DN / 2; K = 2816; }
                run_gemm(lds, A, lda, Bt, 1024, K, E);
            } else if (st == 3) {
                if (kind == 0) scan_chunked<0>(lds, p, j); else if (kind == 1) scan_chunked<1>(lds, p, j); else scan_rwkv(lds, p);
            } else if (st == 4) {
                if (kind == 0) post_phase<0>(p, j); else if (kind == 1) post_phase<1>(p, j); else post_phase<2>(p, j);
            } else if (st == 6) {
                norm_phase<false>(p->out, p->in[2] + (size_t)(l * 2 + 1) * 1024, modl, 3, R1, 1024);
            } else if (st == 8 || st == 10) {
                const int g = (st == 10);
                convglu_phase((const bf16_t*)(p->ws + WS_HID), (bf16_t*)(p->ws + WS_ACT), g, p->in[32] + (size_t)l * 3 * 5632, p->in[33] + (size_t)l * 5632);
            }
            }
        }
        if (ph + 1 < ph_hi) { if (ph == ph_lo) grid.sync(); else xcd_barrier(xb); }
    }
}

extern "C" void kernel_launch(void* const* d_in, const int* in_sizes, int n_in, void* d_out, int out_size, void* d_ws, size_t ws_size, hipStream_t stream) {
    constexpr int LDS_BYTES = 144 * 1024;
    static int grid_blocks = 0;
    if (!grid_blocks) {
        int dev = 0, cus = 0, per_cu = 0;
        hipGetDevice(&dev);
        hipDeviceGetAttribute(&cus, hipDeviceAttributeMultiprocessorCount, dev);
        if (hipFuncSetAttribute((const void*)mega, hipFuncAttributeMaxDynamicSharedMemorySize, LDS_BYTES) != hipSuccess) fprintf(stderr, "hipFuncSetAttribute failed\n");
        hipOccupancyMaxActiveBlocksPerMultiprocessor(&per_cu, (const void*)mega, 512, LDS_BYTES);
        if (per_cu < 1) per_cu = 1;
        if (per_cu > 1) per_cu = 1;
        grid_blocks = cus * per_cu;
        if (ws_size < 512 * MiB) fprintf(stderr, "workspace too small: %zu\n", ws_size);
    }
    (void)hipMemsetAsync((char*)d_ws + WS_BAR, 0, XCD_BAR_WORDS * sizeof(unsigned), stream);
    Params p{};
    for (int i = 0; i < 36; ++i) p.in[i] = (const float*)d_in[i];
    p.out = (float*)d_out; p.ws = (unsigned char*)d_ws;
#if SINGLE_LAUNCH
    p.ph_lo = 0; p.ph_hi = NPH;
    void* args[] = {&p};
    hipError_t e = hipLaunchCooperativeKernel((const void*)mega, dim3(grid_blocks), dim3(512), args, LDS_BYTES, stream);
    if (e != hipSuccess) fprintf(stderr, "cooperative launch failed: %s (grid %d)\n", hipGetErrorString(e), grid_blocks);
#else
    for (int ph = 0; ph < NPH; ++ph) {
        if (phase_is_noop(ph)) continue;
        p.ph_lo = ph; p.ph_hi = ph + 1;
        hipLaunchKernelGGL(mega, dim3(grid_blocks), dim3(512), LDS_BYTES, stream, p);
    }
#endif
}
```

```cpp
#include <hip/hip_runtime.h>
#include <hip/hip_cooperative_groups.h>
#include <cstdio>
namespace cg = cooperative_groups;

#ifndef PHMASK
#define PHMASK 0xFFFFFF
#endif
#ifndef REPMASK
#define REPMASK 0
#endif
#ifndef REPL
#define REPL 0xF
#endif
#ifndef SINGLE_LAUNCH
#define SINGLE_LAUNCH 1
#endif

#define LAS __attribute__((address_space(3)))
typedef unsigned short bf16_t;
typedef short bf16x8 __attribute__((ext_vector_type(8)));
typedef float f32x4 __attribute__((ext_vector_type(4)));
typedef float f32x2 __attribute__((ext_vector_type(2)));
typedef unsigned u32x4 __attribute__((ext_vector_type(4)));
typedef unsigned u32x2 __attribute__((ext_vector_type(2)));

constexpr int MROWS = 32768, SEQ = 8192, DM = 1024;
constexpr size_t MiB = 1ull << 20;
constexpr size_t WS_W = 0;
constexpr size_t W_IN = 0, W_L2 = 13 * MiB, W_OUT = 15 * MiB, W_UP = 17 * MiB, W_DN = 28 * MiB;
constexpr size_t WS_MISC = 34 * MiB;
constexpr size_t WS_R1 = 36 * MiB;
constexpr size_t WS_PROJ = 164 * MiB;
constexpr size_t WS_PROJC = 228 * MiB;
constexpr size_t WS_OC = 436 * MiB;
constexpr size_t WS_HID = 100 * MiB;
constexpr size_t WS_ACT = 292 * MiB;

struct Params {
    const float* in[36];
    float* out;
    unsigned char* ws;
    int ph_lo, ph_hi;
};
typedef const Params* PPTR;

__device__ __forceinline__ float bf2f(unsigned v) { return __uint_as_float(v << 16); }
__device__ __forceinline__ float bflo(unsigned v) { return __uint_as_float(v << 16); }
__device__ __forceinline__ float bfhi(unsigned v) { return __uint_as_float(v & 0xffff0000u); }
typedef __bf16 bf16v2 __attribute__((ext_vector_type(2)));
__device__ __forceinline__ unsigned pack2(float lo, float hi) { const f32x2 v = {lo, hi}; const bf16v2 r = __builtin_convertvector(v, bf16v2); return __builtin_bit_cast(unsigned, r); }
__device__ __forceinline__ unsigned f2bf(float f) { return pack2(f, 0.f) & 0xffffu; }
__device__ __forceinline__ float sigmoidf_(float x) { return __builtin_amdgcn_rcpf(1.0f + __expf(-x)); }
__device__ __forceinline__ float siluf_(float x) { return x * __builtin_amdgcn_rcpf(1.0f + __expf(-x)); }
__device__ __forceinline__ float softplusf_(float x) { return x > 15.0f ? x : __logf(1.0f + __expf(x)); }
template <int CTRL> __device__ __forceinline__ float dpp_f(float x) { return __int_as_float(__builtin_amdgcn_update_dpp(0, __float_as_int(x), CTRL, 0xf, 0xf, false)); }
__device__ __forceinline__ float rowred16(float x) { x += dpp_f<0x128>(x); x += dpp_f<0x124>(x); x += dpp_f<0x122>(x); x += dpp_f<0x121>(x); return x; }
__device__ __forceinline__ float wave_allsum(float v) {
    float r = rowred16(v);
    r += __int_as_float(__builtin_amdgcn_update_dpp(0, __float_as_int(r), 0x142, 0xa, 0xf, false));
    r += __int_as_float(__builtin_amdgcn_update_dpp(0, __float_as_int(r), 0x143, 0xc, 0xf, false));
    return __int_as_float(__builtin_amdgcn_readlane(__float_as_int(r), 63));
}
struct StepRegs { f32x4 a, b, c, d, e; float vr, x0, x1; };
template <int KIND> __device__ __forceinline__ void step_load(StepRegs& r, LAS const float* rec, int li, int row) {
    r.a = *(LAS const f32x4*)(rec + 4 * li); r.b = *(LAS const f32x4*)(rec + 64 + 4 * li); r.c = *(LAS const f32x4*)(rec + 128 + 4 * li); r.d = *(LAS const f32x4*)(rec + 192 + 4 * li);
    if (KIND == 0) { r.vr = rec[256 + row]; r.x0 = rec[272]; r.x1 = rec[273]; }
    else if (KIND == 1) { r.vr = rec[256 + row]; }
    else { r.e = *(LAS const f32x4*)(rec + 256 + 4 * li); r.vr = rec[320 + row]; }
}
template <int KIND> __device__ __forceinline__ float step_compute(const StepRegs& r, f32x2 (&s)[4]) {
    if (KIND == 0) {
        const f32x2 k[4] = {{r.a[0], r.a[1]}, {r.a[2], r.a[3]}, {r.b[0], r.b[1]}, {r.b[2], r.b[3]}};
        const f32x2 q[4] = {{r.c[0], r.c[1]}, {r.c[2], r.c[3]}, {r.d[0], r.d[1]}, {r.d[2], r.d[3]}};
        f32x2 pa = s[0] * k[0] + s[1] * k[1]; const f32x2 pb = s[2] * k[2] + s[3] * k[3]; pa += pb;
        const float pp = rowred16(pa.x + pa.y);
        const float cc = r.x0 * (r.vr - r.x1 * pp);
        const f32x2 eg2 = {r.x1, r.x1}, cc2 = {cc, cc};
#pragma unroll
        for (int i = 0; i < 4; ++i) s[i] = s[i] * eg2 + cc2 * k[i];
        f32x2 oa = s[0] * q[0] + s[1] * q[1]; const f32x2 ob = s[2] * q[2] + s[3] * q[3]; oa += ob;
        return rowred16(oa.x + oa.y);
    } else if (KIND == 1) {
        const f32x2 q[4] = {{r.a[0], r.a[1]}, {r.a[2], r.a[3]}, {r.b[0], r.b[1]}, {r.b[2], r.b[3]}};
        const f32x2 f[4] = {{r.c[0], r.c[1]}, {r.c[2], r.c[3]}, {r.d[0], r.d[1]}, {r.d[2], r.d[3]}};
        const f32x2 v2 = {r.vr, r.vr};
#pragma unroll
        for (int i = 0; i < 4; ++i) s[i] = s[i] * f[i] + v2 * (1.0f - f[i]);
        f32x2 oa = s[0] * q[0] + s[1] * q[1]; const f32x2 ob = s[2] * q[2] + s[3] * q[3]; oa += ob;
        return rowred16(oa.x + oa.y);
    } else {
        const f32x2 a2[2] = {{r.a[0], r.a[1]}, {r.a[2], r.a[3]}}, b2[2] = {{r.b[0], r.b[1]}, {r.b[2], r.b[3]}}, d2[2] = {{r.c[0], r.c[1]}, {r.c[2], r.c[3]}};
        const f32x2 k2[2] = {{r.d[0], r.d[1]}, {r.d[2], r.d[3]}}, r2[2] = {{r.e[0], r.e[1]}, {r.e[2], r.e[3]}};
        const f32x2 pa = s[0] * a2[0] + s[1] * a2[1];
        const float sa = rowred16(pa.x + pa.y);
        const f32x2 sa2 = {sa, sa}, v2 = {r.vr, r.vr};
        s[0] = s[0] * d2[0] + sa2 * b2[0] + v2 * k2[0]; s[1] = s[1] * d2[1] + sa2 * b2[1] + v2 * k2[1];
        const f32x2 oa = s[0] * r2[0] + s[1] * r2[1];
        return rowred16(oa.x + oa.y);
    }
}
__device__ __forceinline__ int tidx() { int t = threadIdx.x; asm volatile("" : "+v"(t)); return t; }
__device__ __forceinline__ int bidx() { int t = blockIdx.x; asm volatile("" : "+s"(t)); return t; }
__device__ __forceinline__ int gdim() { int t = gridDim.x; asm volatile("" : "+s"(t)); return t; }
__device__ __forceinline__ void lds_barrier() { asm volatile("s_waitcnt lgkmcnt(0)" ::: "memory"); __builtin_amdgcn_s_barrier(); asm volatile("" ::: "memory"); }

namespace pg8 {
constexpr int BM = 256, BK = 64, HALF = 128, HTB = HALF * BK * 2, STAGE_BYTES = 8 * HTB, NXCD = 8, WGM = 8;
__device__ __forceinline__ int lds_byte(int r, int c) { const int st = (r >> 4) * 2 + (c >> 5), rr = r & 15, cc = c & 31, ob = rr * 64 + cc * 2; return st * 1024 + (ob ^ (((ob >> 9) & 1) << 5)); }
__device__ __forceinline__ void stage_rc(int b, int& R, int& C) { const int st = b / 1024, sb = b % 1024, swz = sb ^ (((sb >> 9) & 1) << 5); R = (st >> 1) * 16 + swz / 64; C = (st & 1) * 32 + (swz % 64) / 2; }
__device__ __forceinline__ int perm32(int rho) { const int n = rho >> 4, i = rho & 15; return 8 * (i >> 2) + 4 * n + (i & 3); }
struct Unit { int pm, pn; };
struct Gemm { const bf16_t* A; const bf16_t* Bt; int M, N, K, lda; };
struct StaticOrder {
    int nM, nN, nwg, G, c;
    __device__ void init(int M, int N, int G_, int c_) { nM = M / BM; nN = N / BM; nwg = nM * nN; G = G_; c = c_; }
    __device__ bool next(int i, Unit& u) const {
        const long L = (long)i * G + c; if (L >= nwg) return false;
        int wgid = (int)L; { const int q = nwg / NXCD, r = nwg % NXCD, xcd = wgid % NXCD, off = wgid / NXCD; wgid = (xcd < r ? xcd * (q + 1) : r * (q + 1) + (xcd - r) * q) + off; }
        const int nig = WGM * nN, gid = wgid / nig, fm = gid * WGM, gsz = (nM - fm) < WGM ? (nM - fm) : WGM;
        u.pm = fm + ((wgid % nig) % gsz); u.pn = (wgid % nig) / gsz; return true;
    }
};
__device__ __forceinline__ unsigned cvt_pk_bf16(float lo, float hi) { return pack2(lo, hi); }

struct EpiBf16S {
    static constexpr bool PERM = true;
    bf16_t* O; int ldc; int act;
    __device__ __forceinline__ void operator()(const f32x4 (&acc)[2][2][4][2], const Unit& u, int wr, int wc, int fr, int fq) const {
        const int row0 = u.pm * BM + wr * 64 + fr; const int col0 = u.pn * BM + wc * 32 + 8 * fq;
#pragma unroll
        for (int ai = 0; ai < 2; ++ai)
#pragma unroll
            for (int m = 0; m < 4; ++m) { bf16_t* rowp = O + (size_t)(row0 + ai * HALF + m * 16) * ldc + col0;
#pragma unroll
                for (int bj = 0; bj < 2; ++bj) { f32x4 v0 = acc[ai][bj][m][0], v1 = acc[ai][bj][m][1];
                    if (act) { const int c = col0 + bj * HALF;
                        if (c >= 3072 && c < 3136) {
#pragma unroll
                            for (int j = 0; j < 4; ++j) { v0[j] = 1.0f - 2.0f * __builtin_amdgcn_rcpf(1.0f + __expf(2.0f * v0[j])); v1[j] = 1.0f - 2.0f * __builtin_amdgcn_rcpf(1.0f + __expf(2.0f * v1[j])); } }
                        else if (c >= 3200) {
#pragma unroll
                            for (int j = 0; j < 4; ++j) { v0[j] = sigmoidf_(v0[j]); v1[j] = sigmoidf_(v1[j]); } } }
                    u32x4 w; w.x = cvt_pk_bf16(v0[0], v0[1]); w.y = cvt_pk_bf16(v0[2], v0[3]); w.z = cvt_pk_bf16(v1[0], v1[1]); w.w = cvt_pk_bf16(v1[2], v1[3]);
                    *(u32x4*)(rowp + bj * HALF) = w; } }
    }
};
struct EpiRes {
    static constexpr bool PERM = false;
    const float* res; float* out; const float* gate;
    __device__ __forceinline__ void operator()(const f32x4 (&acc)[2][2][4][2], const Unit& u, int wr, int wc, int fr, int fq) const {
        const int row0 = u.pm * BM + wr * 64 + fr, col0 = u.pn * BM + wc * 32 + 4 * fq; const int b = (u.pm * BM) / SEQ;
        f32x4 gv[2][2];
#pragma unroll
        for (int bj = 0; bj < 2; ++bj)
#pragma unroll
            for (int n = 0; n < 2; ++n) gv[bj][n] = *(const f32x4*)(gate + (size_t)b * 6144 + col0 + bj * HALF + n * 16);
        f32x4 rA[2][2][2], rB[2][2][2];
#define ER_LOAD(R, k) do { _Pragma("unroll") for (int mm = 0; mm < 2; ++mm) { const size_t off = (size_t)(row0 + ((k) >> 1) * HALF + (2 * ((k) & 1) + mm) * 16) * DM + col0; \
            _Pragma("unroll") for (int bj = 0; bj < 2; ++bj) _Pragma("unroll") for (int n = 0; n < 2; ++n) R[mm][bj][n] = *(const f32x4*)(res + off + bj * HALF + n * 16); } } while (0)
#define ER_STORE(R, k) do { _Pragma("unroll") for (int mm = 0; mm < 2; ++mm) { const size_t off = (size_t)(row0 + ((k) >> 1) * HALF + (2 * ((k) & 1) + mm) * 16) * DM + col0; \
            _Pragma("unroll") for (int bj = 0; bj < 2; ++bj) _Pragma("unroll") for (int n = 0; n < 2; ++n) \
                *(f32x4*)(out + off + bj * HALF + n * 16) = R[mm][bj][n] + gv[bj][n] * acc[(k) >> 1][bj][2 * ((k) & 1) + mm][n]; } } while (0)
        ER_LOAD(rA, 0);
        ER_LOAD(rB, 1); __builtin_amdgcn_sched_barrier(0);
        ER_STORE(rA, 0); __builtin_amdgcn_sched_barrier(0);
        ER_LOAD(rA, 2); __builtin_amdgcn_sched_barrier(0);
        ER_STORE(rB, 1); __builtin_amdgcn_sched_barrier(0);
        ER_LOAD(rB, 3); __builtin_amdgcn_sched_barrier(0);
        ER_STORE(rA, 2); __builtin_amdgcn_sched_barrier(0);
        ER_STORE(rB, 3);
#undef ER_LOAD
#undef ER_STORE
    }
};

template <class Epi>
__device__ __forceinline__ void gemm_phase(LAS unsigned char* lds, const Gemm g, const StaticOrder& S, const Epi& E) {
    const int tid = tidx(), wid = __builtin_amdgcn_readfirstlane(tid >> 6), lane = tid & 63, wr = wid >> 2, wc = wid & 3, fr = lane & 15, fq = lane >> 4;
    const int K = g.K, nt = K / BK, lda = g.lda;
    unsigned voffA[2], voffB[2];
#pragma unroll
    for (int i = 0; i < 2; ++i) { int R, C; stage_rc(tid * 16 + i * 8192, R, C); const int Rb = Epi::PERM ? ((R & ~31) + perm32(R & 31)) : R;
        voffA[i] = (unsigned)(R * lda + C) * 2u; voffB[i] = (unsigned)(Rb * K + C) * 2u; }
    const size_t kstep = (size_t)(BK * 2);
    const size_t hstepA = (size_t)HALF * lda * 2, hstepB = (size_t)HALF * K * 2;
    const size_t tstepA = 2 * hstepA, tstepB = 2 * hstepB;
    const unsigned ldsw = (unsigned)wid * 1024u;
    const int aoff = lds_byte(wr * 64 + fr, fq * 8), boff = lds_byte(wc * 32 + fr, fq * 8);
#define PG8_SA(b, h) (((b) * 2 + (h)) * HTB)
#define PG8_SB(b, h) ((4 + (b) * 2 + (h)) * HTB)
#define PG8_STAGE(bufoff, gbase, voff) do { _Pragma("unroll") for (int _i = 0; _i < 2; ++_i) \
        __builtin_amdgcn_global_load_lds((const unsigned*)((const char*)(gbase) + (voff)[_i]), (LAS unsigned*)(lds + (bufoff) + ldsw + _i * 8192), 16, 0, 0); } while (0)
#define PG8_LDA(dst, b, h) do { _Pragma("unroll") for (int m = 0; m < 4; ++m) _Pragma("unroll") for (int k = 0; k < 2; ++k) dst[m][k] = *(const LAS bf16x8*)(lds + PG8_SA(b, h) + aoff + m * 2048 + k * 1024); } while (0)
#define PG8_LDB(dst, b, h) do { _Pragma("unroll") for (int n = 0; n < 2; ++n) _Pragma("unroll") for (int k = 0; k < 2; ++k) dst[n][k] = *(const LAS bf16x8*)(lds + PG8_SB(b, h) + boff + n * 2048 + k * 1024); } while (0)
#define PG8_MMA(ai, bj, At, Bt) do { __builtin_amdgcn_s_setprio(1); _Pragma("unroll") for (int m = 0; m < 4; ++m) _Pragma("unroll") for (int n = 0; n < 2; ++n) _Pragma("unroll") for (int k = 0; k < 2; ++k) \
        acc[ai][bj][m][n] = __builtin_amdgcn_mfma_f32_16x16x32_bf16(Bt[n][k], At[m][k], acc[ai][bj][m][n], 0, 0, 0); __builtin_amdgcn_s_setprio(0); } while (0)
#define PG8_WAIT_V(n) asm volatile("s_waitcnt vmcnt(" #n ")" ::: "memory")
#define PG8_WAIT_L(n) asm volatile("s_waitcnt lgkmcnt(" #n ")" ::: "memory")
#define PG8_BAR __builtin_amdgcn_s_barrier()
#define PG8_SCHED __builtin_amdgcn_sched_barrier(0)
    Unit cur, nxt; int ui = 0;
    if (!S.next(0, cur)) return;
    f32x4 acc[2][2][4][2];
#pragma unroll
    for (int a = 0; a < 2; ++a)
#pragma unroll
        for (int b = 0; b < 2; ++b)
#pragma unroll
            for (int m = 0; m < 4; ++m)
#pragma unroll
                for (int n = 0; n < 2; ++n) acc[a][b][m][n] = (f32x4){0.f, 0.f, 0.f, 0.f};
    bf16x8 At[4][2], B0[2][2], B1[2][2];
    const char* cA = (const char*)g.A + (size_t)cur.pm * tstepA; const char* cB = (const char*)g.Bt + (size_t)cur.pn * tstepB;
    PG8_STAGE(PG8_SB(0, 0), cB, voffB); PG8_STAGE(PG8_SA(0, 0), cA, voffA); PG8_STAGE(PG8_SB(0, 1), cB + hstepB, voffB); PG8_STAGE(PG8_SA(0, 1), cA + hstepA, voffA);
    if (wr == 1) PG8_BAR;
    PG8_WAIT_V(4); PG8_BAR;
    PG8_STAGE(PG8_SB(1, 0), cB + kstep, voffB); PG8_STAGE(PG8_SA(1, 0), cA + kstep, voffA); PG8_STAGE(PG8_SB(1, 1), cB + hstepB + kstep, voffB);
    PG8_WAIT_V(6); PG8_BAR;
    for (;;) {
        const bool has_next = S.next(ui + 1, nxt);
        const char* nA = has_next ? (const char*)g.A + (size_t)nxt.pm * tstepA : cA; const char* nB = has_next ? (const char*)g.Bt + (size_t)nxt.pn * tstepB : cB;
        for (int t = 0; t < nt; t += 2) {
            const bool last = (t == nt - 2);
            const char* a1 = cA + (size_t)(t + 1) * kstep;
            const char* a2 = last ? nA : cA + (size_t)(t + 2) * kstep; const char* b2 = last ? nB : cB + (size_t)(t + 2) * kstep;
            const char* a3 = a2 + kstep; const char* b3 = b2 + kstep;
            PG8_LDB(B0, 0, 0); PG8_SCHED; PG8_LDA(At, 0, 0); PG8_STAGE(PG8_SA(1, 1), a1 + hstepA, voffA);
            PG8_WAIT_L(8); PG8_BAR; PG8_WAIT_L(0); PG8_MMA(0, 0, At, B0); PG8_BAR; PG8_SCHED;
            PG8_LDB(B1, 0, 1); PG8_STAGE(PG8_SB(0, 0), b2, voffB);
            PG8_BAR; PG8_WAIT_L(0); PG8_MMA(0, 1, At, B1); PG8_BAR;
            PG8_LDA(At, 0, 1); PG8_STAGE(PG8_SA(0, 0), a2, voffA);
            PG8_BAR; PG8_WAIT_L(0); PG8_MMA(1, 0, At, B0); PG8_BAR; PG8_SCHED;
            PG8_STAGE(PG8_SB(0, 1), b2 + hstepB, voffB);
            PG8_WAIT_V(6); PG8_BAR; PG8_MMA(1, 1, At, B1); PG8_BAR;
            PG8_LDB(B0, 1, 0); PG8_SCHED; PG8_LDA(At, 1, 0); PG8_STAGE(PG8_SA(0, 1), a2 + hstepA, voffA);
            PG8_WAIT_L(8); PG8_BAR; PG8_WAIT_L(0); PG8_MMA(0, 0, At, B0); PG8_BAR; PG8_SCHED;
            PG8_LDB(B1, 1, 1); PG8_STAGE(PG8_SB(1, 0), b3, voffB);
            PG8_BAR; PG8_WAIT_L(0); PG8_MMA(0, 1, At, B1); PG8_BAR;
            PG8_LDA(At, 1, 1); PG8_STAGE(PG8_SA(1, 0), a3, voffA);
            PG8_BAR; PG8_WAIT_L(0); PG8_MMA(1, 0, At, B0); PG8_BAR; PG8_SCHED;
            PG8_STAGE(PG8_SB(1, 1), b3 + hstepB, voffB);
            PG8_WAIT_V(6); PG8_BAR; PG8_MMA(1, 1, At, B1); PG8_BAR;
        }
        E(acc, cur, wr, wc, fr, fq);
        if (!has_next) break;
#pragma unroll
        for (int a = 0; a < 2; ++a)
#pragma unroll
            for (int b = 0; b < 2; ++b)
#pragma unroll
                for (int m = 0; m < 4; ++m)
#pragma unroll
                    for (int n = 0; n < 2; ++n) acc[a][b][m][n] = (f32x4){0.f, 0.f, 0.f, 0.f};
        cur = nxt; cA = nA; cB = nB; ++ui;
    }
    PG8_WAIT_V(0);
    if (wr == 0) PG8_BAR;
    PG8_BAR;
#undef PG8_SA
#undef PG8_SB
#undef PG8_STAGE
#undef PG8_LDA
#undef PG8_LDB
#undef PG8_MMA
#undef PG8_WAIT_V
#undef PG8_WAIT_L
#undef PG8_BAR
#undef PG8_SCHED
}
}

template <class Epi>
__device__ __forceinline__ void run_gemm(LAS unsigned char* lds, const bf16_t* A, int lda, const bf16_t* Bt, int N, int K, const Epi& E) {
    pg8::Gemm g; g.A = A; g.Bt = Bt; g.M = MROWS; g.N = N; g.K = K; g.lda = lda;
    pg8::StaticOrder S; S.init(MROWS, N, (int)gdim(), (int)bidx());
    pg8::gemm_phase<Epi>(lds, g, S, E);
}

__device__ __forceinline__ void cvt_job(LAS float* tile, bf16_t* dst, int ldd, const float* src, int srcN, int nK, int nNdst, int nNsrc, const float* scale, int noff) {
    const int tid = tidx(); const int tilesK = nK / 64, tilesN = nNdst / 64, ntl = tilesK * tilesN, G = gdim();
    const int kr = tid >> 6, nn = tid & 63;
    for (int tl0 = bidx(); tl0 < ntl; tl0 += 2 * G) {
        float v[2][8];
#pragma unroll
        for (int u = 0; u < 2; ++u) { const int tl = tl0 + u * G; const bool tv = tl < ntl; const int tk = tv ? tl % tilesK : 0, tn = tv ? tl / tilesK : 0, k0 = tk * 64, n = tn * 64 + nn;
            const bool ld_ = tv && src && n < nNsrc;
            float scv[8];
#pragma unroll
            for (int ps = 0; ps < 8; ++ps) scv[ps] = (ld_ && scale) ? scale[k0 + ps * 8 + kr] : 1.0f;
#pragma unroll
            for (int ps = 0; ps < 8; ++ps) { const int kk = ps * 8 + kr; v[u][ps] = ld_ ? src[(size_t)(k0 + kk) * srcN + noff + n] : 0.f; }
#pragma unroll
            for (int ps = 0; ps < 8; ++ps) v[u][ps] *= scv[ps]; }
#pragma unroll
        for (int u = 0; u < 2; ++u)
#pragma unroll
            for (int ps = 0; ps < 8; ++ps) tile[u * 4160 + (ps * 8 + kr) * 65 + nn] = v[u][ps];
        __syncthreads();
#pragma unroll
        for (int u = 0; u < 2; ++u) { const int tl = tl0 + u * G;
            if (tl < ntl) { const int tk = tl % tilesK, tn = tl / tilesK, k0 = tk * 64, n0 = tn * 64;
#pragma unroll
                for (int ps = 0; ps < 4; ++ps) { const int kk2 = tid & 31, n2 = (tid >> 5) + 16 * ps;
                    const unsigned w = pack2(tile[u * 4160 + (2 * kk2) * 65 + n2], tile[u * 4160 + (2 * kk2 + 1) * 65 + n2]);
                    *(unsigned*)(dst + (size_t)(n0 + n2) * ldd + k0 + 2 * kk2) = w; } } }
        __syncthreads();
    }
}

__device__ __forceinline__ void cvt_layer(LAS unsigned char* lds, PPTR p, int layer) {
    LAS float* tile = (LAS float*)lds;
    bf16_t* W = (bf16_t*)(p->ws + WS_W);
    bf16_t* w_in = W + W_IN / 2; bf16_t* w_l2 = W + W_L2 / 2; bf16_t* w_out = W + W_OUT / 2; bf16_t* w_up = W + W_UP / 2; bf16_t* w_dn = W + W_DN / 2;
    const int kind = layer % 3, j = layer / 3;
    const int nmix = (kind == 2) ? 20 : 2;
    for (int jb = 0; jb < nmix + 5; ++jb) {
        bf16_t* dst = w_in; int ldd = 1024; const float* src = nullptr; int srcN = 1024, nK = 1024, nNdst = 1024, nNsrc = 1024, noff = 0; const float* scale = nullptr;
        if (jb >= nmix) {
            const int f = jb - nmix;
            if (f < 4) { const int g = f >> 1, gate = f & 1; const int nch = g ? 1280 : 1536, ch0 = g ? 1536 : 0;
                dst = w_up + (size_t)((g ? 3072 : 0) + nch * gate) * 1024; src = p->in[31] + (size_t)layer * 1024 * 5632; srcN = 5632; nNdst = nch; nNsrc = nch; noff = 2816 * gate + ch0; }
            else { dst = w_dn; ldd = 2816; src = p->in[34] + (size_t)layer * 2816 * 1024; nK = 2816; }
        } else if (kind == 0) {
            if (jb == 0) { src = p->in[5] + (size_t)j * 1024 * 4112; srcN = 4112; nNdst = 4352; nNsrc = 4112; }
            else { dst = w_out; src = p->in[10] + (size_t)j * 1024 * 1024; }
        } else if (kind == 1) {
            if (jb == 0) { src = p->in[11]; srcN = 4096; nNdst = 4096; nNsrc = 4096; }
            else { dst = w_out; src = p->in[14]; }
        } else {
            const float* mu = p->in[15];
            if (jb < 6) { const int sI = jb >> 1, hi = jb & 1; const int mi = (sI == 0) ? 0 : (sI == 1 ? 2 : 3);
                dst = w_in + (size_t)sI * 1024 * 2048 + hi * 1024; ldd = 2048; src = p->in[16] + (size_t)sI * 1024 * 1024; if (hi) scale = mu + mi * 1024; }
            else if (jb < 12) { const int q = (jb - 6) >> 1, hi = jb & 1;
                const int rowo = (q == 0) ? 3072 : (q == 1 ? 3136 : 3200); const int nc = (q == 2) ? 128 : 64; const int mi = (q == 0) ? 1 : (q == 1 ? 4 : 5);
                dst = w_in + (size_t)rowo * 2048 + hi * 1024; ldd = 2048; src = (q == 0) ? p->in[18] : (q == 1 ? p->in[21] : p->in[23]); srcN = nc; nNdst = nc; nNsrc = nc; if (hi) scale = mu + mi * 1024; }
            else if (jb < 19) { ldd = 256; nNdst = 1024; nNsrc = 1024;
                const int q = jb - 12;
                if (q == 0) { dst = w_l2; src = p->in[19]; nK = 64; }
                else if (q == 1) { dst = w_l2 + 64; nK = 192; }
                else if (q == 2) { dst = w_l2 + (size_t)1024 * 256; nK = 64; }
                else if (q == 3) { dst = w_l2 + (size_t)1024 * 256 + 64; src = p->in[22]; nK = 64; }
                else if (q == 4) { dst = w_l2 + (size_t)1024 * 256 + 128; nK = 128; }
                else if (q == 5) { dst = w_l2 + (size_t)2048 * 256; nK = 128; }
                else { dst = w_l2 + (size_t)2048 * 256 + 128; src = p->in[24]; nK = 128; } }
            else { dst = w_out; src = p->in[30]; }
        }
        cvt_job(tile, dst, ldd, src, srcN, nK, nNdst, nNsrc, scale, noff);
    }
}

template <bool SHIFT>
__device__ __forceinline__ void norm_phase(const float* h, const float* g, const float* modl, int s_shift, bf16_t* U, int ldu) {
    const int lane = tidx() & 63, wave = tidx() >> 6;
    const int gw = bidx() * 8 + wave, nw = gdim() * 8;
    constexpr int RU = SHIFT ? 2 : 4;
    f32x4 gg4[4];
#pragma unroll
    for (int i = 0; i < 4; ++i) gg4[i] = *(const f32x4*)(g + i * 256 + lane * 4);
    for (int row0 = gw; row0 < MROWS; row0 += nw * RU) {
        const int b0 = row0 >> 13;
        f32x4 gs0[4], sh0[4];
#pragma unroll
        for (int i = 0; i < 4; ++i) { const int c = i * 256 + lane * 4; const float* shp = modl + (size_t)b0 * 6144 + s_shift * 1024;
            gs0[i] = gg4[i] * (1.0f + *(const f32x4*)(shp + 1024 + c)); sh0[i] = *(const f32x4*)(shp + c); }
        f32x4 x[RU][4], xp[RU][4];
#pragma unroll
        for (int q = 0; q < RU; ++q) { const int row = row0 + q * nw;
            if (row < MROWS) {
#pragma unroll
                for (int i = 0; i < 4; ++i) x[q][i] = *(const f32x4*)(h + (size_t)row * DM + i * 256 + lane * 4);
                if (SHIFT) { const size_t prow = ((row & (SEQ - 1)) > 0) ? (size_t)(row - 1) : (size_t)row;
#pragma unroll
                    for (int i = 0; i < 4; ++i) xp[q][i] = *(const f32x4*)(h + prow * DM + i * 256 + lane * 4); } } }
#pragma unroll
        for (int q = 0; q < RU; ++q) { const int row = row0 + q * nw;
            if (row < MROWS) {
                const int b = row >> 13, t = row & (SEQ - 1);
                const float* sh = modl + (size_t)b * 6144 + s_shift * 1024; const float* sc = sh + 1024;
                float ss = 0.f;
#pragma unroll
                for (int i = 0; i < 4; ++i) ss += x[q][i][0] * x[q][i][0] + x[q][i][1] * x[q][i][1] + x[q][i][2] * x[q][i][2] + x[q][i][3] * x[q][i][3];
                ss = wave_allsum(ss); const float rstd = __builtin_amdgcn_rsqf(ss * (1.0f / 1024.0f) + 1e-6f);
                float rstdp = 0.f;
                if (SHIFT) { float ssp = 0.f;
#pragma unroll
                    for (int i = 0; i < 4; ++i) ssp += xp[q][i][0] * xp[q][i][0] + xp[q][i][1] * xp[q][i][1] + xp[q][i][2] * xp[q][i][2] + xp[q][i][3] * xp[q][i][3];
                    ssp = wave_allsum(ssp); rstdp = __builtin_amdgcn_rsqf(ssp * (1.0f / 1024.0f) + 1e-6f); }
#pragma unroll
                for (int i = 0; i < 4; ++i) { const int c = i * 256 + lane * 4; f32x4 gs = gs0[i], s0 = sh0[i];
                    if (b != b0) { gs = gg4[i] * (1.0f + *(const f32x4*)(sc + c)); s0 = *(const f32x4*)(sh + c); }
                    const f32x4 u = x[q][i] * rstd * gs + s0;
                    u32x2 w; w.x = pack2(u[0], u[1]); w.y = pack2(u[2], u[3]); *(u32x2*)(U + (size_t)row * ldu + c) = w;
                    if (SHIFT) { f32x4 up = xp[q][i] * rstdp * gs + s0; if (t == 0) up = (f32x4){0.f, 0.f, 0.f, 0.f};
                        const f32x4 dx = up - u; u32x2 w2; w2.x = pack2(dx[0], dx[1]); w2.y = pack2(dx[2], dx[3]); *(u32x2*)(U + (size_t)row * ldu + 1024 + c) = w2; } }
            } }
    }
}

__device__ __forceinline__ void final_phase(float* h, const float* g) {
    const int lane = tidx() & 63, wave = tidx() >> 6;
    const int gw = bidx() * 8 + wave, nw = gdim() * 8;
    f32x4 gg4[4];
#pragma unroll
    for (int i = 0; i < 4; ++i) gg4[i] = *(const f32x4*)(g + i * 256 + lane * 4);
    for (int row0 = gw; row0 < MROWS; row0 += nw * 4) {
        f32x4 x[4][4];
#pragma unroll
        for (int q = 0; q < 4; ++q) { const int row = row0 + q * nw; if (row < MROWS) {
#pragma unroll
            for (int i = 0; i < 4; ++i) x[q][i] = *(const f32x4*)(h + (size_t)row * DM + i * 256 + lane * 4); } }
#pragma unroll
        for (int q = 0; q < 4; ++q) { const int row = row0 + q * nw; if (row < MROWS) {
            float ss = 0.f;
#pragma unroll
            for (int i = 0; i < 4; ++i) ss += x[q][i][0] * x[q][i][0] + x[q][i][1] * x[q][i][1] + x[q][i][2] * x[q][i][2] + x[q][i][3] * x[q][i][3];
            ss = wave_allsum(ss); const float rstd = __builtin_amdgcn_rsqf(ss * (1.0f / 1024.0f) + 1e-6f);
#pragma unroll
            for (int i = 0; i < 4; ++i) { const int c = i * 256 + lane * 4;
                *(f32x4*)(h + (size_t)row * DM + c) = x[q][i] * rstd * gg4[i]; } } }
    }
}

__device__ __forceinline__ void pre_phase(LAS unsigned char* lds, PPTR p) {
    LAS float* cond = (LAS float*)lds;
    LAS float* red = cond + 4096;
    const int tid = tidx(), lane = tid & 63, wave = tid >> 6;
    float* mod = (float*)(p->ws + WS_MISC); float* lb = mod + 4 * 4 * 6144;
    for (int i = tid; i < 4096; i += 512) cond[i] = siluf_(p->in[1][i]);
    __syncthreads();
    for (int task = bidx(); task < 384; task += gdim()) {
        const int l = task / 96, cb = task % 96, col = cb * 64 + lane;
        float a0 = 0.f, a1 = 0.f, a2 = 0.f, a3 = 0.f;
        const float* wp = p->in[3] + ((size_t)l * 1024 + wave * 128) * 6144 + col;
#pragma unroll 16
        for (int k = 0; k < 128; ++k) { const float wv = wp[(size_t)k * 6144]; const int kk = wave * 128 + k;
            a0 += cond[kk] * wv; a1 += cond[1024 + kk] * wv; a2 += cond[2048 + kk] * wv; a3 += cond[3072 + kk] * wv; }
        red[(wave * 4 + 0) * 64 + lane] = a0; red[(wave * 4 + 1) * 64 + lane] = a1; red[(wave * 4 + 2) * 64 + lane] = a2; red[(wave * 4 + 3) * 64 + lane] = a3;
        __syncthreads();
        if (tid < 256) { const int b = tid >> 6; float s = 0.f;
#pragma unroll
            for (int w = 0; w < 8; ++w) s += red[(w * 4 + b) * 64 + lane];
            mod[((size_t)l * 4 + b) * 6144 + col] = s + p->in[4][(size_t)l * 6144 + col]; }
        __syncthreads();
    }
    for (int c = bidx() * 512 + tid; c < 1024; c += gdim() * 512) {
        const float l0 = p->in[12][c], l1 = p->in[12][1024 + c], l2 = p->in[12][2048 + c], l3 = p->in[12][3072 + c];
        const float mx = fmaxf(fmaxf(l0, l1), fmaxf(l2, l3));
        const float e0 = __expf(l0 - mx), e1 = __expf(l1 - mx), e2 = __expf(l2 - mx), e3 = __expf(l3 - mx);
        lb[c] = e1 / (e0 + e1 + e2 + e3);
    }
}

__device__ __forceinline__ void convglu_phase(const bf16_t* HID, bf16_t* ACT, int g, const float* cw, const float* cb) {
    const int nch = g ? 1280 : 1536, ch0 = g ? 1536 : 0, ld = 2 * nch, ncg = nch / 8;
    const int total = (MROWS / 16) * ncg;
    for (int task = bidx() * 512 + tidx(); task < total; task += gdim() * 512) {
        const int cgi = task % ncg, run = task / ncg, row0 = run * 16, t0 = row0 & (SEQ - 1), j0 = cgi * 8, ch = ch0 + j0;
        float wv[3][8], wg[3][8], bv[8], bg[8];
#pragma unroll
        for (int k = 0; k < 3; ++k)
#pragma unroll
            for (int e = 0; e < 8; ++e) { wv[k][e] = cw[k * 5632 + ch + e]; wg[k][e] = cw[k * 5632 + 2816 + ch + e]; }
#pragma unroll
        for (int e = 0; e < 8; ++e) { bv[e] = cb[ch + e]; bg[e] = cb[2816 + ch + e]; }
        u32x4 v2 = (u32x4){0, 0, 0, 0}, v1 = v2, g2 = v2, g1 = v2;
        if (t0 >= 2) {
            v2 = *(const u32x4*)(HID + (size_t)(row0 - 2) * ld + j0); g2 = *(const u32x4*)(HID + (size_t)(row0 - 2) * ld + nch + j0);
            v1 = *(const u32x4*)(HID + (size_t)(row0 - 1) * ld + j0); g1 = *(const u32x4*)(HID + (size_t)(row0 - 1) * ld + nch + j0);
        }
        u32x4 va[4], ga[4], vb4[4], gb4[4];
#define CG_LOAD(V, G, r0) do { _Pragma("unroll") for (int q_ = 0; q_ < 4; ++q_) { V[q_] = *(const u32x4*)(HID + (size_t)(row0 + (r0) + q_) * ld + j0); G[q_] = *(const u32x4*)(HID + (size_t)(row0 + (r0) + q_) * ld + nch + j0); } } while (0)
#define CG_ROWS(V, G, r0) do { _Pragma("unroll") for (int q_ = 0; q_ < 4; ++q_) { const u32x4 v0 = V[q_], g0 = G[q_]; u32x4 o; \
            _Pragma("unroll") for (int q = 0; q < 4; ++q) { \
                const float yv0 = wv[0][2 * q] * bflo(v2[q]) + wv[1][2 * q] * bflo(v1[q]) + wv[2][2 * q] * bflo(v0[q]) + bv[2 * q]; \
                const float yv1 = wv[0][2 * q + 1] * bfhi(v2[q]) + wv[1][2 * q + 1] * bfhi(v1[q]) + wv[2][2 * q + 1] * bfhi(v0[q]) + bv[2 * q + 1]; \
                const float yg0 = wg[0][2 * q] * bflo(g2[q]) + wg[1][2 * q] * bflo(g1[q]) + wg[2][2 * q] * bflo(g0[q]) + bg[2 * q]; \
                const float yg1 = wg[0][2 * q + 1] * bfhi(g2[q]) + wg[1][2 * q + 1] * bfhi(g1[q]) + wg[2][2 * q + 1] * bfhi(g0[q]) + bg[2 * q + 1]; \
                o[q] = pack2(yv0 * siluf_(yg0), yv1 * siluf_(yg1)); } \
            *(u32x4*)(ACT + (size_t)(row0 + (r0) + q_) * 2816 + ch) = o; \
            v2 = v1; v1 = v0; g2 = g1; g1 = g0; } } while (0)
        CG_LOAD(va, ga, 0);
        CG_LOAD(vb4, gb4, 4);
        CG_ROWS(va, ga, 0);
        CG_LOAD(va, ga, 8);
        CG_ROWS(vb4, gb4, 4);
        CG_LOAD(vb4, gb4, 12);
        CG_ROWS(va, ga, 8);
        CG_ROWS(vb4, gb4, 12);
#undef CG_LOAD
#undef CG_ROWS
    }
}

template <int KIND>
__device__ __forceinline__ void scan_phase(LAS unsigned char* lds, PPTR p, int j) {
    constexpr int N = (KIND == 2) ? 64 : 128;
    constexpr int NH = (KIND == 2) ? 16 : 8;
    constexpr int RG = N / 16;
    constexpr int STRIDE = (KIND == 0) ? 288 : (KIND == 1 ? 272 : 336);
    constexpr int TC = 32, NC = SEQ / TC;
    constexpr int LDP = (KIND == 0) ? 4352 : (KIND == 1 ? 4096 : 3328);
    LAS float* buf = (LAS float*)lds;
    LAS float* ob = buf + 2 * TC * STRIDE;
    const int tid = tidx(), wave = tid >> 6, lane = tid & 63;
    const bool is_loader = wave >= 4; const int lw = wave - 4;
    const int li = lane & 15, row = (wave & 3) * 4 + (lane >> 4);
    const bf16_t* P = (const bf16_t*)(p->ws + (KIND == 2 ? WS_PROJC : WS_PROJ));
    const bf16_t* L2 = (const bf16_t*)(p->ws + WS_R1);
    bf16_t* O = (bf16_t*)(p->ws + (KIND == 2 ? WS_OC : WS_R1));
    const int G = gdim(); const int vcu = (G % 8 == 0) ? (int)(bidx() % 8) * (G / 8) + (int)(bidx() / 8) : (int)bidx();
    for (int task = vcu; task < 256; task += G) {
        const int bh = task / RG, rg = task % RG, b = bh / NH, h = bh % NH;
        const size_t rbase = (size_t)b * SEQ;
        float cwq[4][2], cwk[4][2], cwv[4]; float expA = 0.f, dtb = 0.f; float lbv[2]; float w0v = 0.f, a0v = 0.f, kkc = 0.f, kac = 0.f;
        if (KIND == 0) { const float* cv = p->in[6] + (size_t)j * 4 * 3072;
#pragma unroll
            for (int jj = 0; jj < 4; ++jj) { cwq[jj][0] = cv[jj * 3072 + h * 128 + 2 * lane]; cwq[jj][1] = cv[jj * 3072 + h * 128 + 2 * lane + 1];
                cwk[jj][0] = cv[jj * 3072 + 1024 + h * 128 + 2 * lane]; cwk[jj][1] = cv[jj * 3072 + 1024 + h * 128 + 2 * lane + 1];
                cwv[jj] = cv[jj * 3072 + 2048 + h * 128 + 16 * rg + (lane & 15)]; }
            expA = __expf(p->in[7][j * 8 + h]); dtb = p->in[8][j * 8 + h]; }
        if (KIND == 1) { const float* lbp = (const float*)(p->ws + WS_MISC) + 4 * 4 * 6144; lbv[0] = lbp[h * 128 + 2 * lane]; lbv[1] = lbp[h * 128 + 2 * lane + 1]; }
        if (KIND == 2) { const int ch = h * 64 + lane; w0v = p->in[17][ch]; a0v = p->in[20][ch]; kkc = p->in[25][ch]; kac = p->in[26][ch]; }
        unsigned x0[11], x1[11], x2[11], x3[8], x4[8];
        f32x2 s[4];
#pragma unroll
        for (int e = 0; e < 4; ++e) s[e] = (f32x2){0.f, 0.f};

#define SCAN_LOAD(cc) do { const int c_ = (cc); \
        if (KIND == 0) { const int tfirst = c_ * TC + 8 * lw - 3; \
            _Pragma("unroll") for (int q = 0; q < 11; ++q) { const int t_ = tfirst + q; const bool valid = t_ >= 0; const bf16_t* rowp = P + (rbase + (valid ? t_ : 0)) * LDP; \
                const unsigned vq = *(const unsigned*)(rowp + h * 128 + 2 * lane), vk = *(const unsigned*)(rowp + 1024 + h * 128 + 2 * lane); \
                const int mcol = lane < 16 ? 2048 + h * 128 + 16 * rg + lane : (lane == 32 ? 4096 + h : (lane == 33 ? 4104 + h : 2048 + h * 128)); \
                const unsigned vm = rowp[mcol]; x0[q] = valid ? vq : 0u; x1[q] = valid ? vk : 0u; x2[q] = valid ? vm : 0u; } } \
        else if (KIND == 1) { const int tfirst = c_ * TC + 8 * lw; \
            _Pragma("unroll") for (int q = 0; q < 8; ++q) { const bf16_t* rowp = P + (rbase + tfirst + q) * LDP; \
                x0[q] = *(const unsigned*)(rowp + h * 128 + 2 * lane); x1[q] = *(const unsigned*)(rowp + 1024 + h * 128 + 2 * lane); \
                x2[q] = rowp[2048 + h * 128 + 16 * rg + (lane & 15)]; } } \
        else { const int tfirst = c_ * TC + 8 * lw; \
            _Pragma("unroll") for (int q = 0; q < 8; ++q) { const bf16_t* rowp = P + (rbase + tfirst + q) * LDP; const bf16_t* l2p = L2 + (rbase + tfirst + q) * 3072; \
                x0[q] = rowp[h * 64 + lane]; x1[q] = rowp[1024 + h * 64 + lane]; x2[q] = rowp[2048 + h * 64 + 16 * rg + (lane & 15)]; \
                x3[q] = l2p[h * 64 + lane]; x4[q] = l2p[1024 + h * 64 + lane]; } } } while (0)

#define SCAN_FLUSH(cc) do { const int c_ = (cc); LAS const float* src = ob + (c_ & 1) * (TC * 16) + (lane >> 1) * 16 + (lane & 1) * 8; \
        u32x4 w; w.x = pack2(src[0], src[1]); w.y = pack2(src[2], src[3]); w.z = pack2(src[4], src[5]); w.w = pack2(src[6], src[7]); \
        *(u32x4*)(O + (rbase + c_ * TC + (lane >> 1)) * DM + h * N + 16 * rg + (lane & 1) * 8) = w; } while (0)

        if (is_loader) SCAN_LOAD(0);
        for (int it = 0; it <= NC; ++it) {
            if (is_loader) {
                if (it < NC) {
                    LAS float* bw = buf + (it & 1) * (TC * STRIDE);
#pragma unroll
                    for (int i = 0; i < 8; ++i) {
                        LAS float* rec = bw + (8 * lw + i) * STRIDE;
                        if (KIND == 0) {
                            float yq0 = 0.f, yq1 = 0.f, yk0 = 0.f, yk1 = 0.f, yv = 0.f;
#pragma unroll
                            for (int jj = 0; jj < 4; ++jj) { yq0 += cwq[jj][0] * bflo(x0[i + jj]); yq1 += cwq[jj][1] * bfhi(x0[i + jj]);
                                yk0 += cwk[jj][0] * bflo(x1[i + jj]); yk1 += cwk[jj][1] * bfhi(x1[i + jj]); yv += cwv[jj] * bf2f(x2[i + jj]); }
                            yq0 = siluf_(yq0); yq1 = siluf_(yq1); yk0 = siluf_(yk0); yk1 = siluf_(yk1);
                            const float ssq = wave_allsum(yq0 * yq0 + yq1 * yq1), ssk = wave_allsum(yk0 * yk0 + yk1 * yk1);
                            const float rq = __builtin_amdgcn_rsqf(ssq + 1e-6f) * 0.08838834764831845f, rk = __builtin_amdgcn_rsqf(ssk + 1e-6f);
                            *(LAS f32x2*)(rec + 2 * lane) = (f32x2){yk0 * rk, yk1 * rk};
                            *(LAS f32x2*)(rec + 128 + 2 * lane) = (f32x2){yq0 * rq, yq1 * rq};
                            const float m3 = bf2f(x2[i + 3]);
                            if (lane < 16) rec[256 + lane] = siluf_(yv);
                            else if (lane == 32) rec[273] = __expf(-expA * softplusf_(m3 + dtb));
                            else if (lane == 33) rec[272] = sigmoidf_(m3);
                        } else if (KIND == 1) {
                            const float q0 = siluf_(bflo(x0[i])), q1 = siluf_(bfhi(x0[i]));
                            const float f0 = lbv[0] + (1.0f - lbv[0]) * sigmoidf_(bflo(x1[i])), f1 = lbv[1] + (1.0f - lbv[1]) * sigmoidf_(bfhi(x1[i]));
                            *(LAS f32x2*)(rec + 2 * lane) = (f32x2){q0, q1};
                            *(LAS f32x2*)(rec + 128 + 2 * lane) = (f32x2){f0, f1};
                            if (lane < 16) rec[256 + lane] = bf2f(x2[i]);
                        } else {
                            const float r = bf2f(x0[i]), kraw = bf2f(x1[i]), whi = bf2f(x3[i]), ahi = bf2f(x4[i]);
                            const float wv = -softplusf_(-(w0v + whi)) - 0.5f; const float d = __expf(-__expf(wv));
                            const float ag = sigmoidf_(a0v + ahi);
                            const float kkx = kraw * kkc; const float ss = wave_allsum(kkx * kkx); const float kk = kkx * __builtin_amdgcn_rsqf(ss + 1e-6f);
                            const float kp = kraw * (1.0f + (ag - 1.0f) * kac);
                            rec[lane] = -kk; rec[64 + lane] = kk * ag; rec[128 + lane] = d; rec[192 + lane] = kp; rec[256 + lane] = r;
                            if (lane < 16) rec[320 + lane] = bf2f(x2[i]);
                        }
                    }
                    if (it + 1 < NC) SCAN_LOAD(it + 1);
                }
                if (it >= 2 && lw == 0) SCAN_FLUSH(it - 2);
            } else if (it >= 1) {
                LAS const float* bc = buf + ((it - 1) & 1) * (TC * STRIDE);
                LAS float* oc = ob + ((it - 1) & 1) * (TC * 16);
                StepRegs R[2][2];
                step_load<KIND>(R[0][0], bc, li, row); step_load<KIND>(R[0][1], bc + STRIDE, li, row);
                float osel = 0.f;
#pragma unroll
                for (int g = 0; g < 16; ++g) {
                    if (g + 1 < 16) { step_load<KIND>(R[(g + 1) & 1][0], bc + (2 * g + 2) * STRIDE, li, row); step_load<KIND>(R[(g + 1) & 1][1], bc + (2 * g + 3) * STRIDE, li, row); }
#pragma unroll
                    for (int u = 0; u < 2; ++u) { const float o = step_compute<KIND>(R[g & 1][u], s); osel = (li == ((2 * g + u) & 15)) ? o : osel; }
                    if (g == 7 || g == 15) oc[((g == 15 ? 16 : 0) + li) * 16 + row] = osel;
                }
            }
            lds_barrier();
        }
        if (is_loader && lw == 0) SCAN_FLUSH(NC - 1);
        lds_barrier();
#undef SCAN_LOAD
#undef SCAN_FLUSH
    }
}


typedef short bf16x4 __attribute__((ext_vector_type(4)));
__device__ __forceinline__ bf16x8 cat4(bf16x4 lo, bf16x4 hi) { return __builtin_shufflevector(lo, hi, 0, 1, 2, 3, 4, 5, 6, 7); }
__device__ __forceinline__ bf16x4 cvt4(f32x4 v) { u32x2 w; w.x = pg8::cvt_pk_bf16(v[0], v[1]); w.y = pg8::cvt_pk_bf16(v[2], v[3]); return __builtin_bit_cast(bf16x4, w); }
constexpr size_t WS_KG = WS_R1 + 64 * MiB;
constexpr size_t WS_AM = 420 * MiB;
constexpr size_t WS_DEC = 428 * MiB;

__device__ __forceinline__ void prep_gla(LAS unsigned char* lds, PPTR p) {
    const int tid = tidx(), w = tid >> 6, lane = tid & 63, n = lane & 15, kg = lane >> 4;
    LAS unsigned char* qs = lds + w * 8704; LAS unsigned char* ks = qs + 4352;
    const bf16_t* P = (const bf16_t*)(p->ws + WS_PROJ);
    bf16_t* Qg = (bf16_t*)(p->ws + WS_R1); bf16_t* Kg = (bf16_t*)(p->ws + WS_KG);
    bf16_t* Amg = (bf16_t*)(p->ws + WS_AM); float* Decg = (float*)(p->ws + WS_DEC);
    const float* lbp = (const float*)(p->ws + WS_MISC) + 4 * 4 * 6144;
    for (int task = bidx() * 8 + w; task < 4 * 512 * 8; task += gdim() * 8) {
        const int h = task & 7, rc = task >> 3; const size_t row0 = (size_t)rc * 16;
        const float lb0 = lbp[h * 128 + 2 * lane], lb1 = lbp[h * 128 + 2 * lane + 1];
        unsigned xq[16], xf[16];
#pragma unroll
        for (int t = 0; t < 16; ++t) { const bf16_t* rowp = P + (row0 + t) * 4096 + h * 128 + 2 * lane; xq[t] = *(const unsigned*)rowp; xf[t] = *(const unsigned*)(rowp + 1024); }
        float bc0 = 0.f, bc1 = 0.f; float kk0[16], kk1[16], bs0[16], bs1[16];
#pragma unroll
        for (int t = 0; t < 16; ++t) {
            const float q0 = siluf_(bflo(xq[t])), q1 = siluf_(bfhi(xq[t]));
            const float f0 = lb0 + (1.0f - lb0) * sigmoidf_(bflo(xf[t])), f1 = lb1 + (1.0f - lb1) * sigmoidf_(bfhi(xf[t]));
            bc0 += __logf(f0); bc1 += __logf(f1);
            kk0[t] = 1.0f - f0; kk1[t] = 1.0f - f1; bs0[t] = bc0; bs1[t] = bc1;
            const unsigned qp = pack2(q0 * __expf(bc0), q1 * __expf(bc1));
            *(unsigned*)(Qg + (row0 + t) * 1024 + h * 128 + 2 * lane) = qp;
            *(LAS unsigned*)(qs + t * 272 + 4 * lane) = qp;
        }
#pragma unroll
        for (int t = 0; t < 16; ++t) {
            *(unsigned*)(Kg + (row0 + t) * 1024 + h * 128 + 2 * lane) = pack2(kk0[t] * __expf(bc0 - bs0[t]), kk1[t] * __expf(bc1 - bs1[t]));
            *(LAS unsigned*)(ks + t * 272 + 4 * lane) = pack2(kk0[t] * __expf(-bs0[t]), kk1[t] * __expf(-bs1[t]));
        }
        *(f32x2*)(Decg + (size_t)task * 128 + 2 * lane) = (f32x2){__expf(bc0), __expf(bc1)};
        asm volatile("s_waitcnt lgkmcnt(0)" ::: "memory");
        f32x4 acc = (f32x4){0.f, 0.f, 0.f, 0.f};
#pragma unroll
        for (int a = 0; a < 4; ++a) {
            const bf16x8 af = *(LAS const bf16x8*)(qs + n * 272 + (32 * a + 8 * kg) * 2);
            const bf16x8 bfr = *(LAS const bf16x8*)(ks + n * 272 + (32 * a + 8 * kg) * 2);
            acc = __builtin_amdgcn_mfma_f32_16x16x32_bf16(af, bfr, acc, 0, 0, 0);
        }
#pragma unroll
        for (int jj = 0; jj < 4; ++jj) { const int t = 4 * kg + jj; Amg[(size_t)task * 256 + t * 16 + n] = (bf16_t)f2bf(n <= t ? acc[jj] : 0.f); }
        asm volatile("s_waitcnt lgkmcnt(0)" ::: "memory");
    }
}

__device__ __forceinline__ void scan_gla(LAS unsigned char* lds, PPTR p) {
    constexpr int QOFF = 0, KTOFF = 4352, VOFF = 9472, AMOFF = 13824, DECOFF = 14336, BUFB = 14848;
    const int tid = tidx(), w = tid >> 6, lane = tid & 63, n = lane & 15, kg = lane >> 4;
    const bf16_t* P = (const bf16_t*)(p->ws + WS_PROJ);
    bf16_t* Qg = (bf16_t*)(p->ws + WS_R1); const bf16_t* Kg = (const bf16_t*)(p->ws + WS_KG);
    const bf16_t* Amg = (const bf16_t*)(p->ws + WS_AM); const float* Decg = (const float*)(p->ws + WS_DEC);
    bf16_t* Og = (bf16_t*)(p->ws + WS_OC);
    const bf16x4 z4 = (bf16x4){0, 0, 0, 0};
    for (int task = bidx(); task < 32; task += gdim()) {
        const int b = task >> 3, h = task & 7; const size_t rowbase = (size_t)b * SEQ;
        f32x4 S[8]; bf16x8 Sb[4];
#pragma unroll
        for (int i = 0; i < 8; ++i) S[i] = (f32x4){0.f, 0.f, 0.f, 0.f};
#pragma unroll
        for (int a = 0; a < 4; ++a) Sb[a] = (bf16x8){0, 0, 0, 0, 0, 0, 0, 0};
        const int lt = (tid & 255) >> 4, pc = tid & 15;
        constexpr int PD = 8;
        u32x4 g0[PD], g1[PD];
#define GLA_LOAD(cc, sl) do { const int c_ = (cc); const size_t r_ = rowbase + (size_t)c_ * 16 + lt; \
            if (tid < 256) { g0[sl] = *(const u32x4*)(Qg + r_ * 1024 + h * 128 + 8 * pc); g1[sl] = *(const u32x4*)(P + r_ * 4096 + 2048 + h * 128 + 8 * pc); } \
            else { g0[sl] = *(const u32x4*)(Kg + r_ * 1024 + h * 128 + 8 * pc); const size_t ch_ = ((size_t)(b * 512 + c_) * 8 + h); \
                if (tid < 288) g1[sl] = *(const u32x4*)(Amg + ch_ * 256 + (tid - 256) * 8); else if (tid < 320) g1[sl] = *(const u32x4*)(Decg + ch_ * 128 + (tid - 288) * 4); } } while (0)
#define GLA_STORE(cc, sl) do { LAS unsigned char* bb_ = lds + ((cc) & 1) * BUFB; \
            if (tid < 256) { *(LAS u32x4*)(bb_ + QOFF + lt * 272 + 16 * pc) = g0[sl]; *(LAS u32x4*)(bb_ + VOFF + lt * 272 + 16 * pc) = g1[sl]; } \
            else { _Pragma("unroll") for (int e = 0; e < 4; ++e) { *(LAS unsigned short*)(bb_ + KTOFF + (8 * pc + 2 * e) * 40 + 2 * lt) = (unsigned short)(g0[sl][e] & 0xffffu); \
                    *(LAS unsigned short*)(bb_ + KTOFF + (8 * pc + 2 * e + 1) * 40 + 2 * lt) = (unsigned short)(g0[sl][e] >> 16); } \
                if (tid < 288) *(LAS u32x4*)(bb_ + AMOFF + (tid - 256) * 16) = g1[sl]; else if (tid < 320) *(LAS u32x4*)(bb_ + DECOFF + (tid - 288) * 16) = g1[sl]; } } while (0)
#pragma unroll
        for (int d = 0; d < PD; ++d) GLA_LOAD(d, d);
        GLA_STORE(0, 0); lds_barrier();
        for (int c0 = 0; c0 < 512; c0 += PD) {
#pragma unroll
          for (int d = 0; d < PD; ++d) {
            const int c = c0 + d;
            if (c + PD < 512) GLA_LOAD(c + PD, d);
            LAS const unsigned char* bb = lds + (c & 1) * BUFB;
            f32x4 Z = (f32x4){0.f, 0.f, 0.f, 0.f};
#pragma unroll
            for (int a = 0; a < 4; ++a) {
                const bf16x4 lo = *(LAS const bf16x4*)(bb + QOFF + n * 272 + (32 * a + 4 * kg) * 2), hi = *(LAS const bf16x4*)(bb + QOFF + n * 272 + (32 * a + 16 + 4 * kg) * 2);
                Z = __builtin_amdgcn_mfma_f32_16x16x32_bf16(cat4(lo, hi), Sb[a], Z, 0, 0, 0);
            }
            bf16x4 vb;
#pragma unroll
            for (int j = 0; j < 4; ++j) vb[j] = *(LAS const short*)(bb + VOFF + (4 * kg + j) * 272 + (16 * w + n) * 2);
            const bf16x8 Vb = cat4(vb, z4);
            const bf16x4 am = *(LAS const bf16x4*)(bb + AMOFF + n * 32 + 8 * kg);
            const f32x4 o = __builtin_amdgcn_mfma_f32_16x16x32_bf16(cat4(am, z4), Vb, Z, 0, 0, 0);
#pragma unroll
            for (int i = 0; i < 8; ++i) {
                const f32x4 d4 = *(LAS const f32x4*)(bb + DECOFF + (16 * i + 4 * kg) * 4);
                const bf16x4 kt = *(LAS const bf16x4*)(bb + KTOFF + (16 * i + n) * 40 + 8 * kg);
                S[i] = __builtin_amdgcn_mfma_f32_16x16x32_bf16(cat4(kt, z4), Vb, S[i] * d4, 0, 0, 0);
            }
#pragma unroll
            for (int a = 0; a < 4; ++a) Sb[a] = cat4(cvt4(S[2 * a]), cvt4(S[2 * a + 1]));
#pragma unroll
            for (int j = 0; j < 4; ++j) Og[(rowbase + (size_t)c * 16 + 4 * kg + j) * 1024 + h * 128 + 16 * w + n] = (bf16_t)f2bf(o[j]);
            if (c + 1 < 512) GLA_STORE(c + 1, (d + 1) % PD);
            lds_barrier();
          }
        }
#undef GLA_LOAD
#undef GLA_STORE
    }
}


template <int SGN>
__device__ __forceinline__ void tri_inv16(LAS const float* Lm, int n, float (&x)[16]) {
    x[0] = (n == 0) ? 1.f : 0.f;
    {
        f32x4 la[12];
#pragma unroll
        for (int t = 1; t <= 4; ++t) la[t - 1] = *(LAS const f32x4*)(Lm + t * 16);
#pragma unroll
        for (int t = 5; t <= 8; ++t) { la[4 + 2 * (t - 5)] = *(LAS const f32x4*)(Lm + t * 16); la[5 + 2 * (t - 5)] = *(LAS const f32x4*)(Lm + t * 16 + 4); }
        __builtin_amdgcn_sched_barrier(0);
#pragma unroll
        for (int t = 1; t <= 8; ++t) { float acc = (n == t) ? 1.f : 0.f;
#pragma unroll
            for (int q = 0; q < (t + 3) / 4; ++q) { const f32x4 l4 = (t <= 4) ? la[t - 1] : la[4 + 2 * (t - 5) + q];
#pragma unroll
                for (int e = 0; e < 4; ++e) if (4 * q + e < t) acc += (float)SGN * l4[e] * x[4 * q + e]; }
            x[t] = acc; }
    }
    __builtin_amdgcn_sched_barrier(0);
    {   f32x4 lb[12];
#pragma unroll
        for (int t = 9; t <= 12; ++t)
#pragma unroll
            for (int q = 0; q < 3; ++q) lb[3 * (t - 9) + q] = *(LAS const f32x4*)(Lm + t * 16 + 4 * q);
        __builtin_amdgcn_sched_barrier(0);
#pragma unroll
        for (int t = 9; t <= 12; ++t) { float acc = (n == t) ? 1.f : 0.f;
#pragma unroll
            for (int q = 0; q < 3; ++q) { const f32x4 l4 = lb[3 * (t - 9) + q];
#pragma unroll
                for (int e = 0; e < 4; ++e) if (4 * q + e < t) acc += (float)SGN * l4[e] * x[4 * q + e]; }
            x[t] = acc; }
    }
    __builtin_amdgcn_sched_barrier(0);
    {   f32x4 lc[12];
#pragma unroll
        for (int t = 13; t <= 15; ++t)
#pragma unroll
            for (int q = 0; q < 4; ++q) lc[4 * (t - 13) + q] = *(LAS const f32x4*)(Lm + t * 16 + 4 * q);
        __builtin_amdgcn_sched_barrier(0);
#pragma unroll
        for (int t = 13; t <= 15; ++t) { float acc = (n == t) ? 1.f : 0.f;
#pragma unroll
            for (int q = 0; q < 4; ++q) { const f32x4 l4 = lc[4 * (t - 13) + q];
#pragma unroll
                for (int e = 0; e < 4; ++e) if (4 * q + e < t) acc += (float)SGN * l4[e] * x[4 * q + e]; }
            x[t] = acc; }
    }
}

constexpr size_t WS_TA = 436 * MiB;
constexpr size_t WS_AMA = 444 * MiB;
constexpr size_t WS_SCA = 452 * MiB;

__device__ __forceinline__ void prep_delta(LAS unsigned char* lds, PPTR p, int j) {
    const int tid = tidx(), w = tid >> 6, lane = tid & 63, n = lane & 15, kg = lane >> 4;
    LAS unsigned char* qs = lds + w * 9984; LAS unsigned char* ks = qs + 4352; LAS float* Lm = (LAS float*)(ks + 4352); LAS float* sc = Lm + 256;
    const bf16_t* P = (const bf16_t*)(p->ws + WS_PROJ);
    bf16_t* Qg = (bf16_t*)(p->ws + WS_R1); bf16_t* Kg = (bf16_t*)(p->ws + WS_KG);
    bf16_t* Tg = (bf16_t*)(p->ws + WS_TA); bf16_t* Amg = (bf16_t*)(p->ws + WS_AMA); float* Scg = (float*)(p->ws + WS_SCA);
    const float* cv = p->in[6] + (size_t)j * 4 * 3072;
    for (int task = bidx() * 8 + w; task < 4 * 512 * 8; task += gdim() * 8) {
        const int h = task & 7, rc = task >> 3; const size_t row0 = (size_t)rc * 16; const int t0 = (rc & 511) * 16;
        float cwq[4][2], cwk[4][2];
#pragma unroll
        for (int jj = 0; jj < 4; ++jj) { cwq[jj][0] = cv[jj * 3072 + h * 128 + 2 * lane]; cwq[jj][1] = cv[jj * 3072 + h * 128 + 2 * lane + 1];
            cwk[jj][0] = cv[jj * 3072 + 1024 + h * 128 + 2 * lane]; cwk[jj][1] = cv[jj * 3072 + 1024 + h * 128 + 2 * lane + 1]; }
        unsigned xq[19], xk[19];
#pragma unroll
        for (int r = 0; r < 19; ++r) { const bool valid = (t0 + r - 3) >= 0; const bf16_t* rowp = P + (row0 + (valid ? r - 3 : 0)) * 4352 + h * 128 + 2 * lane;
            const unsigned vq = *(const unsigned*)rowp, vk = *(const unsigned*)(rowp + 1024); xq[r] = valid ? vq : 0u; xk[r] = valid ? vk : 0u; }
        float beta, G;
        { const bf16_t* rowp = P + (row0 + n) * 4352; const float a_raw = bf2f(rowp[4096 + h]), b_raw = bf2f(rowp[4104 + h]);
          beta = sigmoidf_(b_raw); G = -__expf(p->in[7][j * 8 + h]) * softplusf_(a_raw + p->in[8][j * 8 + h]);
          float tq; tq = __int_as_float(__builtin_amdgcn_update_dpp(0, __float_as_int(G), 0x111, 0xf, 0xf, true)); G += tq;
          tq = __int_as_float(__builtin_amdgcn_update_dpp(0, __float_as_int(G), 0x112, 0xf, 0xf, true)); G += tq;
          tq = __int_as_float(__builtin_amdgcn_update_dpp(0, __float_as_int(G), 0x114, 0xf, 0xf, true)); G += tq;
          tq = __int_as_float(__builtin_amdgcn_update_dpp(0, __float_as_int(G), 0x118, 0xf, 0xf, true)); G += tq; }
        const float G15 = __int_as_float(__builtin_amdgcn_readlane(__float_as_int(G), 15));
        if (lane < 16) { sc[lane] = beta; sc[16 + lane] = G;
            float* so = Scg + (size_t)task * 64; so[lane] = beta; so[16 + lane] = __expf(G); so[32 + lane] = __expf(G15 - G); if (lane == 0) so[48] = __expf(G15); }
#pragma unroll
        for (int t = 0; t < 16; ++t) {
            float yq0 = 0.f, yq1 = 0.f, yk0 = 0.f, yk1 = 0.f;
#pragma unroll
            for (int jj = 0; jj < 4; ++jj) { yq0 += cwq[jj][0] * bflo(xq[t + jj]); yq1 += cwq[jj][1] * bfhi(xq[t + jj]); yk0 += cwk[jj][0] * bflo(xk[t + jj]); yk1 += cwk[jj][1] * bfhi(xk[t + jj]); }
            yq0 = siluf_(yq0); yq1 = siluf_(yq1); yk0 = siluf_(yk0); yk1 = siluf_(yk1);
            const float ssq = wave_allsum(yq0 * yq0 + yq1 * yq1), ssk = wave_allsum(yk0 * yk0 + yk1 * yk1);
            const float rq = __builtin_amdgcn_rsqf(ssq + 1e-6f) * 0.08838834764831845f, rk = __builtin_amdgcn_rsqf(ssk + 1e-6f);
            const unsigned qp = pack2(yq0 * rq, yq1 * rq), kp = pack2(yk0 * rk, yk1 * rk);
            *(unsigned*)(Qg + (row0 + t) * 1024 + h * 128 + 2 * lane) = qp; *(unsigned*)(Kg + (row0 + t) * 1024 + h * 128 + 2 * lane) = kp;
            *(LAS unsigned*)(qs + t * 272 + 4 * lane) = qp; *(LAS unsigned*)(ks + t * 272 + 4 * lane) = kp;
        }
        asm volatile("s_waitcnt lgkmcnt(0)" ::: "memory");
        f32x4 akk = (f32x4){0.f, 0.f, 0.f, 0.f}, aqk = akk;
#pragma unroll
        for (int a = 0; a < 4; ++a) {
            const bf16x8 qf = *(LAS const bf16x8*)(qs + n * 272 + (32 * a + 8 * kg) * 2);
            const bf16x8 kf = *(LAS const bf16x8*)(ks + n * 272 + (32 * a + 8 * kg) * 2);
            akk = __builtin_amdgcn_mfma_f32_16x16x32_bf16(kf, kf, akk, 0, 0, 0);
            aqk = __builtin_amdgcn_mfma_f32_16x16x32_bf16(qf, kf, aqk, 0, 0, 0);
        }
        { const float Gn = sc[16 + n]; const f32x4 bt = *(LAS const f32x4*)(sc + 4 * kg), Gt = *(LAS const f32x4*)(sc + 16 + 4 * kg);
#pragma unroll
          for (int jj = 0; jj < 4; ++jj) { const int t = 4 * kg + jj; const float dec = __expf(Gt[jj] - Gn);
              Lm[t * 16 + n] = (n < t) ? bt[jj] * akk[jj] * dec : 0.f;
              Amg[(size_t)task * 256 + t * 16 + n] = (bf16_t)f2bf(n <= t ? aqk[jj] * dec : 0.f); } }
        asm volatile("s_waitcnt lgkmcnt(0)" ::: "memory");
        float x[16];
        tri_inv16<-1>(Lm, n, x);
#pragma unroll
        for (int jj = 0; jj < 4; ++jj) { const float v = (kg == 0) ? x[jj] : (kg == 1 ? x[4 + jj] : (kg == 2 ? x[8 + jj] : x[12 + jj]));
            Tg[(size_t)task * 256 + (4 * kg + jj) * 16 + n] = (bf16_t)f2bf(v); }
        asm volatile("s_waitcnt lgkmcnt(0)" ::: "memory");
    }
}

__device__ __forceinline__ void scan_delta(LAS unsigned char* lds, PPTR p, int j) {
    constexpr int QOFF = 0, KOFF = 4352, KTOFF = 8704, VOFF = 13824, TOFF = 18992, AMOFF = 19504, SCOFF = 20016, BUFB = 20272;
    const int tid = tidx(), w = tid >> 6, lane = tid & 63, n = lane & 15, kg = lane >> 4;
    const bf16_t* P = (const bf16_t*)(p->ws + WS_PROJ);
    bf16_t* Qg = (bf16_t*)(p->ws + WS_R1); const bf16_t* Kg = (const bf16_t*)(p->ws + WS_KG);
    const bf16_t* Tg = (const bf16_t*)(p->ws + WS_TA); const bf16_t* Amg = (const bf16_t*)(p->ws + WS_AMA); const float* Scg = (const float*)(p->ws + WS_SCA);
    const float* cv = p->in[6] + (size_t)j * 4 * 3072;
    const bf16x4 z4 = (bf16x4){0, 0, 0, 0};
    for (int task = bidx(); task < 32; task += gdim()) {
        const int b = task >> 3, h = task & 7; const size_t rowbase = (size_t)b * SEQ;
        float cwv[4];
#pragma unroll
        for (int jj = 0; jj < 4; ++jj) cwv[jj] = cv[jj * 3072 + 2048 + h * 128 + 16 * w + n];
        f32x4 S[8]; bf16x8 Sb[4];
#pragma unroll
        for (int i = 0; i < 8; ++i) S[i] = (f32x4){0.f, 0.f, 0.f, 0.f};
#pragma unroll
        for (int a = 0; a < 4; ++a) Sb[a] = (bf16x8){0, 0, 0, 0, 0, 0, 0, 0};
        const int lt = (tid & 255) >> 4, pc = tid & 15, vr = tid >> 4;
        constexpr int PD = 8;
        u32x4 g0[PD], g1[PD];
#define DL_LOAD(cc, sl) do { const int c_ = (cc); const size_t r_ = rowbase + (size_t)c_ * 16 + lt; const size_t ch_ = ((size_t)(b * 512 + c_) * 8 + h); \
            if (tid < 256) g0[sl] = *(const u32x4*)(Qg + r_ * 1024 + h * 128 + 8 * pc); else g0[sl] = *(const u32x4*)(Kg + r_ * 1024 + h * 128 + 8 * pc); \
            if (tid < 304) { const int tv_ = c_ * 16 + vr - 3; const u32x4 vv_ = *(const u32x4*)(P + (rowbase + (tv_ >= 0 ? tv_ : 0)) * 4352 + 2048 + h * 128 + 8 * pc); g1[sl] = (tv_ >= 0) ? vv_ : (u32x4){0u, 0u, 0u, 0u}; } \
            else if (tid >= 320 && tid < 352) g1[sl] = *(const u32x4*)(Tg + ch_ * 256 + (tid - 320) * 8); \
            else if (tid >= 352 && tid < 384) g1[sl] = *(const u32x4*)(Amg + ch_ * 256 + (tid - 352) * 8); \
            else if (tid >= 384 && tid < 400) g1[sl] = *(const u32x4*)(Scg + ch_ * 64 + (tid - 384) * 4); } while (0)
#define DL_STORE(cc, sl) do { LAS unsigned char* bb_ = lds + ((cc) & 1) * BUFB; \
            if (tid < 256) *(LAS u32x4*)(bb_ + QOFF + lt * 272 + 16 * pc) = g0[sl]; \
            else { *(LAS u32x4*)(bb_ + KOFF + lt * 272 + 16 * pc) = g0[sl]; \
                _Pragma("unroll") for (int e = 0; e < 4; ++e) { *(LAS unsigned short*)(bb_ + KTOFF + (8 * pc + 2 * e) * 40 + 2 * lt) = (unsigned short)(g0[sl][e] & 0xffffu); \
                    *(LAS unsigned short*)(bb_ + KTOFF + (8 * pc + 2 * e + 1) * 40 + 2 * lt) = (unsigned short)(g0[sl][e] >> 16); } } \
            if (tid < 304) *(LAS u32x4*)(bb_ + VOFF + vr * 272 + 16 * pc) = g1[sl]; \
            else if (tid >= 320 && tid < 352) *(LAS u32x4*)(bb_ + TOFF + (tid - 320) * 16) = g1[sl]; \
            else if (tid >= 352 && tid < 384) *(LAS u32x4*)(bb_ + AMOFF + (tid - 352) * 16) = g1[sl]; \
            else if (tid >= 384 && tid < 400) *(LAS u32x4*)(bb_ + SCOFF + (tid - 384) * 16) = g1[sl]; } while (0)
#pragma unroll
        for (int d = 0; d < PD; ++d) DL_LOAD(d, d);
        DL_STORE(0, 0); lds_barrier();
        for (int c0 = 0; c0 < 512; c0 += PD) {
#pragma unroll
          for (int d = 0; d < PD; ++d) {
            const int c = c0 + d;
            if (c + PD < 512) DL_LOAD(c + PD, d);
            LAS const unsigned char* bb = lds + (c & 1) * BUFB;
            float vraw[7];
#pragma unroll
            for (int r = 0; r < 7; ++r) vraw[r] = bf2f(*(LAS const unsigned short*)(bb + VOFF + (4 * kg + r) * 272 + (16 * w + n) * 2));
            f32x4 v4;
#pragma unroll
            for (int jj = 0; jj < 4; ++jj) v4[jj] = siluf_(cwv[0] * vraw[jj] + cwv[1] * vraw[jj + 1] + cwv[2] * vraw[jj + 2] + cwv[3] * vraw[jj + 3]);
            f32x4 X = (f32x4){0.f, 0.f, 0.f, 0.f}, Z = X;
#pragma unroll
            for (int a = 0; a < 4; ++a) {
                const bf16x4 klo = *(LAS const bf16x4*)(bb + KOFF + n * 272 + (32 * a + 4 * kg) * 2), khi = *(LAS const bf16x4*)(bb + KOFF + n * 272 + (32 * a + 16 + 4 * kg) * 2);
                X = __builtin_amdgcn_mfma_f32_16x16x32_bf16(cat4(klo, khi), Sb[a], X, 0, 0, 0);
                const bf16x4 qlo = *(LAS const bf16x4*)(bb + QOFF + n * 272 + (32 * a + 4 * kg) * 2), qhi = *(LAS const bf16x4*)(bb + QOFF + n * 272 + (32 * a + 16 + 4 * kg) * 2);
                Z = __builtin_amdgcn_mfma_f32_16x16x32_bf16(cat4(qlo, qhi), Sb[a], Z, 0, 0, 0);
            }
            const f32x4 be4 = *(LAS const f32x4*)(bb + SCOFF + (4 * kg) * 4), eg4 = *(LAS const f32x4*)(bb + SCOFF + (16 + 4 * kg) * 4), egl4 = *(LAS const f32x4*)(bb + SCOFF + (32 + 4 * kg) * 4);
            const float glast = *(LAS const float*)(bb + SCOFF + 48 * 4);
            const f32x4 R = be4 * (v4 - eg4 * X);
            const bf16x4 tf = *(LAS const bf16x4*)(bb + TOFF + n * 32 + 8 * kg);
            const f32x4 vnew = __builtin_amdgcn_mfma_f32_16x16x32_bf16(cat4(tf, z4), cat4(cvt4(R), z4), (f32x4){0.f, 0.f, 0.f, 0.f}, 0, 0, 0);
            const bf16x4 am = *(LAS const bf16x4*)(bb + AMOFF + n * 32 + 8 * kg);
            const f32x4 o = __builtin_amdgcn_mfma_f32_16x16x32_bf16(cat4(am, z4), cat4(cvt4(vnew), z4), Z * eg4, 0, 0, 0);
            const bf16x8 B2 = cat4(cvt4(vnew * egl4), z4);
#pragma unroll
            for (int i = 0; i < 8; ++i) {
                const bf16x4 kt = *(LAS const bf16x4*)(bb + KTOFF + (16 * i + n) * 40 + 8 * kg);
                S[i] = __builtin_amdgcn_mfma_f32_16x16x32_bf16(cat4(kt, z4), B2, S[i] * glast, 0, 0, 0);
            }
#pragma unroll
            for (int a = 0; a < 4; ++a) Sb[a] = cat4(cvt4(S[2 * a]), cvt4(S[2 * a + 1]));
#pragma unroll
            for (int jj = 0; jj < 4; ++jj) Qg[(rowbase + (size_t)c * 16 + 4 * kg + jj) * 1024 + h * 128 + 16 * w + n] = (bf16_t)f2bf(o[jj]);
            if (c + 1 < 512) DL_STORE(c + 1, (d + 1) % PD);
            lds_barrier();
          }
        }
#undef DL_LOAD
#undef DL_STORE
    }
}


constexpr size_t WS_GCG = 500 * MiB;
constexpr size_t WS_BNG = 508 * MiB;
__device__ __forceinline__ void prep_rwkv_elem(PPTR p) {
    const int tid = tidx(), w = tid >> 6, lane = tid & 63;
    bf16_t* P = (bf16_t*)(p->ws + WS_PROJC); bf16_t* L2 = (bf16_t*)(p->ws + WS_R1);
    float* GCg = (float*)(p->ws + WS_GCG); float* BNg = (float*)(p->ws + WS_BNG);
    for (int task = bidx() * 8 + w; task < 4 * 512 * 16; task += gdim() * 8) {
        const int h = task & 15, rc = task >> 4; const size_t row0 = (size_t)rc * 16; const int ch = h * 64 + lane;
        const float w0v = p->in[17][ch], a0v = p->in[20][ch], kkc = p->in[25][ch], kac = p->in[26][ch], rkc = p->in[27][ch];
        unsigned xr[16], xk[16], xw[16], xa[16];
#pragma unroll
        for (int t = 0; t < 16; ++t) { const bf16_t* rowp = P + (row0 + t) * 3328 + ch; const bf16_t* l2p = L2 + (row0 + t) * 3072 + ch;
            xr[t] = rowp[0]; xk[t] = rowp[1024]; xw[t] = l2p[0]; xa[t] = l2p[1024]; }
        float lg = 0.f;
#pragma unroll
        for (int t = 0; t < 16; ++t) {
            const float r = bf2f(xr[t]), kraw = bf2f(xk[t]), whi = bf2f(xw[t]), ahi = bf2f(xa[t]);
            const float wv = -softplusf_(-(w0v + whi)) - 0.5f; const float ew = __expf(wv);
            const float lgp = lg; lg -= ew;
            const float ag = sigmoidf_(a0v + ahi);
            const float kkx = kraw * kkc; const float ss = wave_allsum(kkx * kkx); const float kk = kkx * __builtin_amdgcn_rsqf(ss + 1e-6f);
            const float kp = kraw * (1.0f + (ag - 1.0f) * kac);
            const float bonus = wave_allsum(r * kp * rkc);
            const float inv = __expf(-lg);
            bf16_t* rowp = P + (row0 + t) * 3328 + ch; bf16_t* l2p = L2 + (row0 + t) * 3072 + ch;
            rowp[0] = (bf16_t)f2bf(-kk * __expf(lgp)); rowp[1024] = (bf16_t)f2bf(r * __expf(lg));
            l2p[0] = (bf16_t)f2bf(kk * ag * inv); l2p[1024] = (bf16_t)f2bf(kp * inv);
            if (lane == 0) BNg[(row0 + t) * 16 + h] = bonus;
        }
        GCg[(size_t)task * 64 + lane] = __expf(lg);
    }
}

__device__ __forceinline__ void scan_rwkv(LAS unsigned char* lds, PPTR p) {
    constexpr int AH = 0, RH = 2304, BMT = 4608, KMT = 7168, TM = 9728, LAK = 10240, MRB = 10752, MRK = 11264, VV = 11776, GC = 14080, SLOT = 14336;
    constexpr int PRIV = 8 * SLOT, PRIVSZ = 5632;
    const int tid = tidx(), wave = tid >> 6, lane = tid & 63, n = lane & 15, kg = lane >> 4;
    const bf16_t* P = (const bf16_t*)(p->ws + WS_PROJC); const bf16_t* L2 = (const bf16_t*)(p->ws + WS_R1);
    bf16_t* Og = (bf16_t*)(p->ws + WS_OC);
    const int G = gdim(); const int vcu = (G % 8 == 0) ? (int)(bidx() % 8) * (G / 8) + (int)(bidx() / 8) : (int)bidx();
    for (int task = vcu; task < 256; task += G) {
        const int bh = task >> 2, slice = task & 3, b = bh >> 4, h = bh & 15; const size_t rowbase = (size_t)b * SEQ;
        const int pwr = (wave >= 1 && wave <= 3) ? wave - 1 : (wave == 5 ? 3 : -1);
        if (pwr >= 0) {
            const int pw = pwr; const int ch = h * 64 + lane;
            LAS unsigned char* bh = lds + PRIV + pw * PRIVSZ; LAS unsigned char* kh = bh + 2304; LAS float* Lm = (LAS float*)(kh + 2304);
            const float* GCg = (const float*)(p->ws + WS_GCG);
            unsigned xr[16], xk[16], xv[16], xw[16], xa[16]; float gCn;
#define RW_LOAD(cc, T0) do { _Pragma("unroll") for (int t = (T0); t < (T0) + 8; ++t) { const size_t r_ = rowbase + (size_t)(cc) * 16 + t; const bf16_t* rowp = P + r_ * 3328 + ch; const bf16_t* l2p = L2 + r_ * 3072 + ch; \
                xr[t] = rowp[0]; xk[t] = rowp[1024]; xv[t] = rowp[2048]; xw[t] = l2p[0]; xa[t] = l2p[1024]; } \
                if ((T0) == 8) gCn = GCg[((size_t)(b * 512 + (cc)) * 16 + h) * 64 + lane]; } while (0)
            RW_LOAD(pw, 0); RW_LOAD(pw, 8);
            for (int m = -1; m < 128; ++m) {
                const int cc = 4 * (m + 1) + pw;
                if (cc < 512) {
                    LAS unsigned char* sl = lds + (cc & 7) * SLOT;
                    const float gC = gCn; float bhat[16], khat[16];
#pragma unroll
                    for (int t = 0; t < 16; ++t) {
                        bhat[t] = bf2f(xw[t]); khat[t] = bf2f(xa[t]);
                        *(LAS unsigned short*)(sl + AH + t * 144 + 2 * lane) = (unsigned short)xr[t];
                        *(LAS unsigned short*)(sl + RH + t * 144 + 2 * lane) = (unsigned short)xk[t];
                        *(LAS unsigned short*)(bh + t * 144 + 2 * lane) = (unsigned short)xw[t];
                        *(LAS unsigned short*)(kh + t * 144 + 2 * lane) = (unsigned short)xa[t];
                        *(LAS unsigned short*)(sl + VV + t * 144 + 2 * lane) = (unsigned short)xv[t];
                    }
                    if (cc + 4 < 512) { RW_LOAD(cc + 4, 0); RW_LOAD(cc + 4, 8); }
                    *(LAS float*)(sl + GC + 4 * lane) = gC;
#pragma unroll
                    for (int q = 0; q < 4; ++q) {
                        u32x2 wb, wk; wb.x = pack2(bhat[4 * q] * gC, bhat[4 * q + 1] * gC); wb.y = pack2(bhat[4 * q + 2] * gC, bhat[4 * q + 3] * gC);
                        wk.x = pack2(khat[4 * q] * gC, khat[4 * q + 1] * gC); wk.y = pack2(khat[4 * q + 2] * gC, khat[4 * q + 3] * gC);
                        *(LAS u32x2*)(sl + BMT + lane * 40 + 8 * q) = wb; *(LAS u32x2*)(sl + KMT + lane * 40 + 8 * q) = wk;
                    }
                    asm volatile("s_waitcnt lgkmcnt(0)" ::: "memory");
                    f32x4 lab = (f32x4){0.f, 0.f, 0.f, 0.f}, lak = lab, mrb = lab, mrk = lab;
#pragma unroll
                    for (int a = 0; a < 2; ++a) {
                        const bf16x8 af = *(LAS const bf16x8*)(sl + AH + n * 144 + (32 * a + 8 * kg) * 2), rf = *(LAS const bf16x8*)(sl + RH + n * 144 + (32 * a + 8 * kg) * 2);
                        const bf16x8 bf_ = *(LAS const bf16x8*)(bh + n * 144 + (32 * a + 8 * kg) * 2), kf = *(LAS const bf16x8*)(kh + n * 144 + (32 * a + 8 * kg) * 2);
                        lab = __builtin_amdgcn_mfma_f32_16x16x32_bf16(af, bf_, lab, 0, 0, 0); lak = __builtin_amdgcn_mfma_f32_16x16x32_bf16(af, kf, lak, 0, 0, 0);
                        mrb = __builtin_amdgcn_mfma_f32_16x16x32_bf16(rf, bf_, mrb, 0, 0, 0); mrk = __builtin_amdgcn_mfma_f32_16x16x32_bf16(rf, kf, mrk, 0, 0, 0);
                    }
#pragma unroll
                    for (int jj = 0; jj < 4; ++jj) { const int t = 4 * kg + jj;
                        Lm[t * 16 + n] = (n < t) ? lab[jj] : 0.f;
                        *(LAS unsigned short*)(sl + LAK + t * 32 + 2 * n) = (unsigned short)f2bf(n < t ? lak[jj] : 0.f);
                        *(LAS unsigned short*)(sl + MRB + t * 32 + 2 * n) = (unsigned short)f2bf(n <= t ? mrb[jj] : 0.f);
                        *(LAS unsigned short*)(sl + MRK + t * 32 + 2 * n) = (unsigned short)f2bf(n <= t ? mrk[jj] : 0.f); }
                    asm volatile("s_waitcnt lgkmcnt(0)" ::: "memory");
                    float x[16];
                    tri_inv16<1>(Lm, n, x);
#pragma unroll
                    for (int jj = 0; jj < 4; ++jj) { const float v = (kg == 0) ? x[jj] : (kg == 1 ? x[4 + jj] : (kg == 2 ? x[8 + jj] : x[12 + jj]));
                        *(LAS unsigned short*)(sl + TM + (4 * kg + jj) * 32 + 2 * n) = (unsigned short)f2bf(v); }
                }
                lds_barrier();
            }
#undef RW_LOAD
        } else if (wave != 0) {
            for (int m = -1; m < 128; ++m) lds_barrier();
        } else {
            const int w = slice;
            f32x4 Zt[4]; bf16x8 Zb[2];
#pragma unroll
            for (int i = 0; i < 4; ++i) Zt[i] = (f32x4){0.f, 0.f, 0.f, 0.f};
            Zb[0] = (bf16x8){0, 0, 0, 0, 0, 0, 0, 0}; Zb[1] = Zb[0];
            struct RwOps { bf16x4 alo[2], ahi[2], rlo[2], rhi[2], vf, lakf, tf, mb, mk, bt[4], kt[4]; f32x4 g4[4]; };
#define RW_OPLOAD(R, cidx) do { LAS const unsigned char* sl_ = lds + ((cidx) & 7) * SLOT; \
                _Pragma("unroll") for (int a = 0; a < 2; ++a) { \
                    R.alo[a] = *(LAS const bf16x4*)(sl_ + AH + n * 144 + (32 * a + 4 * kg) * 2); R.ahi[a] = *(LAS const bf16x4*)(sl_ + AH + n * 144 + (32 * a + 16 + 4 * kg) * 2); \
                    R.rlo[a] = *(LAS const bf16x4*)(sl_ + RH + n * 144 + (32 * a + 4 * kg) * 2); R.rhi[a] = *(LAS const bf16x4*)(sl_ + RH + n * 144 + (32 * a + 16 + 4 * kg) * 2); } \
                _Pragma("unroll") for (int jj = 0; jj < 4; ++jj) R.vf[jj] = *(LAS const short*)(sl_ + VV + (4 * kg + jj) * 144 + (16 * w + n) * 2); \
                R.lakf = *(LAS const bf16x4*)(sl_ + LAK + n * 32 + 8 * kg); R.tf = *(LAS const bf16x4*)(sl_ + TM + n * 32 + 8 * kg); \
                R.mb = *(LAS const bf16x4*)(sl_ + MRB + n * 32 + 8 * kg); R.mk = *(LAS const bf16x4*)(sl_ + MRK + n * 32 + 8 * kg); \
                _Pragma("unroll") for (int i = 0; i < 4; ++i) { R.g4[i] = *(LAS const f32x4*)(sl_ + GC + (16 * i + 4 * kg) * 4); \
                    R.bt[i] = *(LAS const bf16x4*)(sl_ + BMT + (16 * i + n) * 40 + 8 * kg); R.kt[i] = *(LAS const bf16x4*)(sl_ + KMT + (16 * i + n) * 40 + 8 * kg); } } while (0)
#define RW_COMPUTE(R, cidx) do { \
                f32x4 P1 = (f32x4){0.f, 0.f, 0.f, 0.f}, Oa = P1; \
                _Pragma("unroll") for (int a = 0; a < 2; ++a) { P1 = __builtin_amdgcn_mfma_f32_16x16x32_bf16(cat4(R.alo[a], R.ahi[a]), Zb[a], P1, 0, 0, 0); \
                    Oa = __builtin_amdgcn_mfma_f32_16x16x32_bf16(cat4(R.rlo[a], R.rhi[a]), Zb[a], Oa, 0, 0, 0); } \
                P1 = __builtin_amdgcn_mfma_f32_16x16x32_bf16(cat4(R.lakf, z4), cat4(R.vf, z4), P1, 0, 0, 0); \
                const f32x4 Y = __builtin_amdgcn_mfma_f32_16x16x32_bf16(cat4(R.tf, z4), cat4(cvt4(P1), z4), (f32x4){0.f, 0.f, 0.f, 0.f}, 0, 0, 0); \
                const bf16x8 Byv = cat4(cvt4(Y), R.vf); \
                Oa = __builtin_amdgcn_mfma_f32_16x16x32_bf16(cat4(R.mb, R.mk), Byv, Oa, 0, 0, 0); \
                _Pragma("unroll") for (int i = 0; i < 4; ++i) Zt[i] = __builtin_amdgcn_mfma_f32_16x16x32_bf16(cat4(R.bt[i], R.kt[i]), Byv, Zt[i] * R.g4[i], 0, 0, 0); \
                Zb[0] = cat4(cvt4(Zt[0]), cvt4(Zt[1])); Zb[1] = cat4(cvt4(Zt[2]), cvt4(Zt[3])); \
                _Pragma("unroll") for (int jj = 0; jj < 4; ++jj) Og[(rowbase + (size_t)(cidx) * 16 + 4 * kg + jj) * 1024 + h * 64 + 16 * w + n] = (bf16_t)f2bf(Oa[jj]); } while (0)
            const bf16x4 z4 = (bf16x4){0, 0, 0, 0};
            lds_barrier();
            for (int m = 0; m < 128; ++m) {
                RwOps OA, OB;
                RW_OPLOAD(OA, 4 * m);
                RW_OPLOAD(OB, 4 * m + 1); __builtin_amdgcn_sched_barrier(0);
                RW_COMPUTE(OA, 4 * m); __builtin_amdgcn_sched_barrier(0);
                RW_OPLOAD(OA, 4 * m + 2); __builtin_amdgcn_sched_barrier(0);
                RW_COMPUTE(OB, 4 * m + 1); __builtin_amdgcn_sched_barrier(0);
                RW_OPLOAD(OB, 4 * m + 3); __builtin_amdgcn_sched_barrier(0);
                RW_COMPUTE(OA, 4 * m + 2); __builtin_amdgcn_sched_barrier(0);
                RW_COMPUTE(OB, 4 * m + 3);
                lds_barrier();
            }
#undef RW_OPLOAD
#undef RW_COMPUTE
        }
    }
}


template <int KIND>
__device__ __forceinline__ void scan_chunked(LAS unsigned char* lds, PPTR p, int j) {
    constexpr int QOFF = 0, KOFF = 4352, KTOFF = 8704, VOFF = 13824, TOFF = 14464, AMOFF = 14976, SCOFF = 15488, OBOFF = 16000, BUFB = 17024;
    constexpr int LDP = (KIND == 0) ? 4352 : 4096;
    constexpr int VROWS = (KIND == 0) ? 19 : 16, VEND = 512 + 2 * VROWS;
    constexpr int TEND = (KIND == 0) ? VEND + 32 : VEND, AEND = TEND + 32, SEND = AEND + ((KIND == 0) ? 16 : 32);
    const int tid = tidx(), wave = tid >> 6, lane = tid & 63, n = lane & 15, kg = lane >> 4;
    const bf16_t* P = (const bf16_t*)(p->ws + WS_PROJ);
    const bf16_t* Qg = (const bf16_t*)(p->ws + WS_R1); const bf16_t* Kg = (const bf16_t*)(p->ws + WS_KG);
    const bf16_t* Tg = (const bf16_t*)(p->ws + WS_TA);
    const bf16_t* Amg = (const bf16_t*)(p->ws + (KIND == 0 ? WS_AMA : WS_AM));
    const float* Scg = (const float*)(p->ws + (KIND == 0 ? WS_SCA : WS_DEC));
    bf16_t* Og = (KIND == 0) ? (bf16_t*)(p->ws + WS_PROJ) : (bf16_t*)(p->ws + WS_OC);
    constexpr int LDO = (KIND == 0) ? 4352 : 1024;
    const bf16x4 z4 = (bf16x4){0, 0, 0, 0};
    const int G = gdim(); const int vcu = (G % 8 == 0) ? (int)(bidx() % 8) * (G / 8) + (int)(bidx() / 8) : (int)bidx();
    for (int task = vcu; task < 256; task += G) {
        const int bh = task >> 3, w = task & 7, b = bh >> 3, h = bh & 7; const size_t rowbase = (size_t)b * SEQ;
        if (wave == 0) {
            float cwv[4] = {0.f, 0.f, 0.f, 0.f};
            if (KIND == 0) { const float* cv = p->in[6] + (size_t)j * 4 * 3072;
#pragma unroll
                for (int jj = 0; jj < 4; ++jj) cwv[jj] = cv[jj * 3072 + 2048 + h * 128 + 16 * w + n]; }
            f32x4 S[8]; bf16x8 Sb[4];
#pragma unroll
            for (int i = 0; i < 8; ++i) S[i] = (f32x4){0.f, 0.f, 0.f, 0.f};
#pragma unroll
            for (int a = 0; a < 4; ++a) Sb[a] = (bf16x8){0, 0, 0, 0, 0, 0, 0, 0};
            lds_barrier();
            for (int c2 = 0; c2 < 512; c2 += 4) {
#pragma unroll 1
              for (int u = 0; u < 4; ++u) { const int c = c2 + u;
                LAS unsigned char* bb = lds + (c & 7) * BUFB;
                bf16x4 klo[4], khi[4], qlo[4], qhi[4], kt[8], am, tf = z4; f32x4 be4, eg4, egl4, d4[8]; float glast = 0.f; unsigned vr16[7]; bf16x4 vb = z4;
#pragma unroll
                for (int a = 0; a < 4; ++a) {
                    if (KIND == 0) { klo[a] = *(LAS const bf16x4*)(bb + KOFF + n * 272 + (32 * a + 4 * kg) * 2); khi[a] = *(LAS const bf16x4*)(bb + KOFF + n * 272 + (32 * a + 16 + 4 * kg) * 2); }
                    qlo[a] = *(LAS const bf16x4*)(bb + QOFF + n * 272 + (32 * a + 4 * kg) * 2); qhi[a] = *(LAS const bf16x4*)(bb + QOFF + n * 272 + (32 * a + 16 + 4 * kg) * 2); }
                if (KIND == 0) {
#pragma unroll
                    for (int r = 0; r < 7; ++r) vr16[r] = *(LAS const unsigned short*)(bb + VOFF + (4 * kg + r) * 32 + 2 * n);
                    be4 = *(LAS const f32x4*)(bb + SCOFF + (4 * kg) * 4); eg4 = *(LAS const f32x4*)(bb + SCOFF + (16 + 4 * kg) * 4); egl4 = *(LAS const f32x4*)(bb + SCOFF + (32 + 4 * kg) * 4);
                    glast = *(LAS const float*)(bb + SCOFF + 48 * 4); tf = *(LAS const bf16x4*)(bb + TOFF + n * 32 + 8 * kg);
                } else {
#pragma unroll
                    for (int jj = 0; jj < 4; ++jj) vb[jj] = *(LAS const short*)(bb + VOFF + (4 * kg + jj) * 32 + 2 * n);
#pragma unroll
                    for (int i = 0; i < 8; ++i) d4[i] = *(LAS const f32x4*)(bb + SCOFF + (16 * i + 4 * kg) * 4);
                }
                am = *(LAS const bf16x4*)(bb + AMOFF + n * 32 + 8 * kg);
#pragma unroll
                for (int i = 0; i < 8; ++i) kt[i] = *(LAS const bf16x4*)(bb + KTOFF + (16 * i + n) * 40 + 8 * kg);
                __builtin_amdgcn_sched_barrier(0);
                asm volatile("s_waitcnt lgkmcnt(0)" ::: "memory");
                __builtin_amdgcn_sched_barrier(0);
                f32x4 v4 = (f32x4){0.f, 0.f, 0.f, 0.f};
                if (KIND == 0) {
#pragma unroll
                    for (int jj = 0; jj < 4; ++jj) v4[jj] = siluf_(cwv[0] * bf2f(vr16[jj]) + cwv[1] * bf2f(vr16[jj + 1]) + cwv[2] * bf2f(vr16[jj + 2]) + cwv[3] * bf2f(vr16[jj + 3]));
                }
                f32x4 X = (f32x4){0.f, 0.f, 0.f, 0.f}, Z = X;
#pragma unroll
                for (int a = 0; a < 4; ++a) {
                    if (KIND == 0) X = __builtin_amdgcn_mfma_f32_16x16x32_bf16(cat4(klo[a], khi[a]), Sb[a], X, 0, 0, 0);
                    Z = __builtin_amdgcn_mfma_f32_16x16x32_bf16(cat4(qlo[a], qhi[a]), Sb[a], Z, 0, 0, 0);
                }
                f32x4 o; bf16x8 B2;
                if (KIND == 0) {
                    const f32x4 R = be4 * (v4 - eg4 * X);
                    const f32x4 vnew = __builtin_amdgcn_mfma_f32_16x16x32_bf16(cat4(tf, z4), cat4(cvt4(R), z4), (f32x4){0.f, 0.f, 0.f, 0.f}, 0, 0, 0);
                    o = __builtin_amdgcn_mfma_f32_16x16x32_bf16(cat4(am, z4), cat4(cvt4(vnew), z4), Z * eg4, 0, 0, 0);
                    B2 = cat4(cvt4(vnew * egl4), z4);
#pragma unroll
                    for (int i = 0; i < 8; ++i) S[i] = __builtin_amdgcn_mfma_f32_16x16x32_bf16(cat4(kt[i], z4), B2, S[i] * glast, 0, 0, 0);
                } else {
                    B2 = cat4(vb, z4);
                    o = __builtin_amdgcn_mfma_f32_16x16x32_bf16(cat4(am, z4), B2, Z, 0, 0, 0);
#pragma unroll
                    for (int i = 0; i < 8; ++i) S[i] = __builtin_amdgcn_mfma_f32_16x16x32_bf16(cat4(kt[i], z4), B2, S[i] * d4[i], 0, 0, 0);
                }
                *(LAS f32x4*)(bb + OBOFF + lane * 16) = o;
#pragma unroll
                for (int a = 0; a < 4; ++a) Sb[a] = cat4(cvt4(S[2 * a]), cvt4(S[2 * a + 1]));
              }
                lds_barrier();
            }
            lds_barrier();
        } else {
            const int lt = tid - 64, pb = lt + 448;
            const int arow = (lt & 255) >> 4, apc = lt & 15;
            const bf16_t* srcA = (lt < 256 ? Qg : Kg) + (rowbase + arow) * 1024 + h * 128 + 8 * apc;
            const char* srcB; size_t strideB; int kindB;
            if (pb < 512) { kindB = 0; srcB = (const char*)(Kg + (rowbase + ((pb - 256) >> 4)) * 1024 + h * 128 + 8 * (pb & 15)); strideB = (size_t)16 * 1024 * 2; }
            else if (pb < VEND) { kindB = 1; const int vr_ = (pb - 512) >> 1, hf_ = (pb - 512) & 1; srcB = (const char*)(P + (rowbase + vr_) * LDP + 2048 + h * 128 + 16 * w + 8 * hf_); strideB = (size_t)16 * LDP * 2; }
            else if (pb < TEND) { kindB = 2; srcB = (const char*)(Tg + ((size_t)(b * 512) * 8 + h) * 256 + (pb - VEND) * 8); strideB = (size_t)8 * 256 * 2; }
            else if (pb < AEND) { kindB = 3; srcB = (const char*)(Amg + ((size_t)(b * 512) * 8 + h) * 256 + (pb - TEND) * 8); strideB = (size_t)8 * 256 * 2; }
            else if (pb < SEND) { kindB = 4; srcB = (const char*)(Scg + ((size_t)(b * 512) * 8 + h) * (KIND == 0 ? 64 : 128) + (pb - AEND) * 4); strideB = (size_t)8 * (KIND == 0 ? 64 : 128) * 4; }
            else { kindB = 5; srcB = (const char*)srcA; strideB = (size_t)16 * 1024 * 2; }
            const int vrow = (pb - 512) >> 1;
            const bool doflush = (wave == 2);
            constexpr int PD = 8;
            u32x4 g0[PD], g1[PD];
#define SC_LOAD(cc, sl) do { const int c_ = (cc); g0[sl] = *(const u32x4*)(srcA + (size_t)c_ * 16 * 1024); \
                const int tv_ = c_ * 16 + vrow - 3; const bool vh_ = (KIND == 0) && (kindB == 1); \
                const ptrdiff_t ofs_ = vh_ ? (ptrdiff_t)(tv_ >= 0 ? tv_ - vrow : -vrow) * (LDP * 2) : (ptrdiff_t)((size_t)c_ * strideB); \
                const u32x4 vv_ = *(const u32x4*)(srcB + ofs_); g1[sl] = (vh_ && tv_ < 0) ? (u32x4){0u, 0u, 0u, 0u} : vv_; } while (0)
#define SC_KSTORE(bb_, reg, row, pc) do { if (KIND == 0) *(LAS u32x4*)((bb_) + KOFF + (row) * 272 + 16 * (pc)) = (reg); \
                _Pragma("unroll") for (int e = 0; e < 4; ++e) { *(LAS unsigned short*)((bb_) + KTOFF + (8 * (pc) + 2 * e) * 40 + 2 * (row)) = (unsigned short)((reg)[e] & 0xffffu); \
                    *(LAS unsigned short*)((bb_) + KTOFF + (8 * (pc) + 2 * e + 1) * 40 + 2 * (row)) = (unsigned short)((reg)[e] >> 16); } } while (0)
#define SC_STORE(cc, sl) do { LAS unsigned char* bb_ = lds + ((cc) & 7) * BUFB; \
                if (lt < 256) *(LAS u32x4*)(bb_ + QOFF + arow * 272 + 16 * apc) = g0[sl]; else SC_KSTORE(bb_, g0[sl], arow, apc); \
                if (kindB == 0) SC_KSTORE(bb_, g1[sl], ((pb - 256) >> 4), (pb & 15)); \
                else if (kindB == 1) *(LAS u32x4*)(bb_ + VOFF + vrow * 32 + 16 * ((pb - 512) & 1)) = g1[sl]; \
                else if (kindB == 2) *(LAS u32x4*)(bb_ + TOFF + (pb - VEND) * 16) = g1[sl]; \
                else if (kindB == 3) *(LAS u32x4*)(bb_ + AMOFF + (pb - TEND) * 16) = g1[sl]; \
                else if (kindB == 4) *(LAS u32x4*)(bb_ + SCOFF + (pb - AEND) * 16) = g1[sl]; } while (0)
#define SC_OFLUSH(cc) do { const int c_ = (cc); const f32x4 o_ = *(LAS const f32x4*)(lds + (c_ & 7) * BUFB + OBOFF + lane * 16); \
                _Pragma("unroll") for (int jj = 0; jj < 4; ++jj) Og[(rowbase + (size_t)c_ * 16 + 4 * kg + jj) * LDO + h * 128 + 16 * w + n] = (bf16_t)f2bf(o_[jj]); } while (0)
#define SC_LOADER_LOOP(FLUSH) do { \
                _Pragma("unroll") for (int d = 0; d < PD; ++d) SC_LOAD(d, d); \
                SC_STORE(0, 0); SC_STORE(1, 1); SC_STORE(2, 2); SC_STORE(3, 3); \
                SC_LOAD(8, 0); SC_LOAD(9, 1); SC_LOAD(10, 2); SC_LOAD(11, 3); \
                lds_barrier(); \
                for (int c0 = 0; c0 < 512; c0 += PD) { \
                    _Pragma("unroll") for (int d = 0; d < PD; d += 4) { const int c = c0 + d; \
                        if (c + 4 < 512) { _Pragma("unroll") for (int u = 0; u < 4; ++u) SC_STORE(c + 4 + u, (d + 4 + u) % PD); } \
                        if (c + 12 < 512) { _Pragma("unroll") for (int u = 0; u < 4; ++u) SC_LOAD(c + 12 + u, (d + 4 + u) % PD); } \
                        if (FLUSH) { if (c > 0) { _Pragma("unroll") for (int u = 0; u < 4; ++u) SC_OFLUSH(c - 4 + u); } } \
                        lds_barrier(); } } \
                if (FLUSH) { _Pragma("unroll") for (int u = 0; u < 4; ++u) SC_OFLUSH(508 + u); } \
                lds_barrier(); } while (0)
            if (doflush) SC_LOADER_LOOP(true); else SC_LOADER_LOOP(false);
#undef SC_LOAD
#undef SC_KSTORE
#undef SC_STORE
#undef SC_OFLUSH
#undef SC_LOADER_LOOP
        }
    }
}

template <int KIND>
__device__ __forceinline__ void post_phase(PPTR p, int j) {
    const int lane = tidx() & 63, wave = tidx() >> 6;
    const int gw = bidx() * 8 + wave, nw = gdim() * 8;
    bf16_t* O = (bf16_t*)(p->ws + (KIND != 0 ? WS_OC : WS_PROJ));
    constexpr int LDO = (KIND == 0) ? 4352 : 1024;
    const bf16_t* P = (const bf16_t*)(p->ws + (KIND == 2 ? WS_PROJC : WS_PROJ));
    if (KIND != 2) {
        const float* nwp = (KIND == 0) ? p->in[9] + j * 128 : p->in[13];
        const float n0 = nwp[2 * lane], n1 = nwp[2 * lane + 1];
        constexpr int LDP = (KIND == 0) ? 4352 : 4096; constexpr int ZOFF = 3072;
        for (int row = gw; row < MROWS; row += nw) {
            unsigned ov[8], zv[8];
#pragma unroll
            for (int h = 0; h < 8; ++h) { ov[h] = *(const unsigned*)(O + (size_t)row * LDO + h * 128 + 2 * lane); zv[h] = *(const unsigned*)(P + (size_t)row * LDP + ZOFF + h * 128 + 2 * lane); }
#pragma unroll
            for (int h = 0; h < 8; ++h) {
                const float o0 = bflo(ov[h]), o1 = bfhi(ov[h]);
                const float ss = wave_allsum(o0 * o0 + o1 * o1); const float rstd = __builtin_amdgcn_rsqf(ss * (1.0f / 128.0f) + 1e-6f);
                *(unsigned*)(O + (size_t)row * LDO + h * 128 + 2 * lane) = pack2(o0 * rstd * n0 * siluf_(bflo(zv[h])), o1 * rstd * n1 * siluf_(bfhi(zv[h])));
            }
        }
    } else {
        const bf16_t* L2 = (const bf16_t*)(p->ws + WS_R1); const float* BNg = (const float*)(p->ws + WS_BNG);
        for (int task = gw; task < MROWS * 2; task += nw) {
            const int row = task >> 1, h0 = (task & 1) * 8;
            unsigned xy[8], xv[8], xg[8]; float bn[8], lw[8], lb_[8];
#pragma unroll
            for (int hh = 0; hh < 8; ++hh) { const int ch = (h0 + hh) * 64 + lane; const bf16_t* rowp = P + (size_t)row * 3328; const bf16_t* l2p = L2 + (size_t)row * 3072;
                xy[hh] = O[(size_t)row * DM + ch]; xv[hh] = rowp[2048 + ch]; xg[hh] = l2p[2048 + ch]; bn[hh] = BNg[(size_t)row * 16 + h0 + hh];
                lw[hh] = p->in[28][ch]; lb_[hh] = p->in[29][ch]; }
#pragma unroll
            for (int hh = 0; hh < 8; ++hh) { const int ch = (h0 + hh) * 64 + lane;
                const float y = bf2f(xy[hh]);
                const float mean = wave_allsum(y) * (1.0f / 64.0f); const float dd = y - mean;
                const float var = wave_allsum(dd * dd) * (1.0f / 64.0f);
                const float gn = dd * __builtin_amdgcn_rsqf(var + 0.04096f) * lw[hh] + lb_[hh];
                O[(size_t)row * DM + ch] = (bf16_t)f2bf((gn + bn[hh] * bf2f(xv[hh])) * bf2f(xg[hh]));
            }
        }
    }
}

#define XB_TMO      128
#define XB_XCNT(j)  (256  + 64 * (j))
#define XB_XSUB(j)  (1280 + 64 * (j))
#define XB_XGEN(j)  (2304 + 64 * (j))
#define XB_TOP      3328
#define XB_TOPGEN   3392
#define XCD_BAR_WORDS 3456
#define XB_SPIN_CAP (1u << 18)
constexpr size_t WS_BAR = WS_MISC + 1 * MiB;
__device__ __forceinline__ unsigned xb_ld(unsigned* p)              { return __hip_atomic_load(p, __ATOMIC_RELAXED, __HIP_MEMORY_SCOPE_AGENT); }
__device__ __forceinline__ unsigned xb_add(unsigned* p, unsigned v) { return __hip_atomic_fetch_add(p, v, __ATOMIC_RELAXED, __HIP_MEMORY_SCOPE_AGENT); }
__device__ __forceinline__ unsigned xb_xcc_id() { return (unsigned)__builtin_amdgcn_s_getreg((3 << 11) | 20) & 0xFu; }
#define XB_SPIN(cond, bar) do { unsigned _sp = 0; while (cond) { __builtin_amdgcn_s_sleep(1); \
    if ((++_sp & 255u) == 0u) { if (xb_ld(&(bar)[XB_TMO])) break; if (_sp > XB_SPIN_CAP) { atomicAdd(&(bar)[XB_TMO], 1u); break; } } } } while (0)
struct XcdBarrier { unsigned* bar; unsigned x; volatile LAS unsigned* st; };
__device__ __forceinline__ XcdBarrier xcd_barrier_post(unsigned* bar, volatile LAS unsigned* st) {
    XcdBarrier b; b.bar = bar; b.x = xb_xcc_id(); b.st = st;
    if (threadIdx.x == 0) (void)xb_add(&bar[XB_XCNT(b.x)], 1u);
    return b;
}
__device__ __forceinline__ void xcd_barrier_complete(unsigned* bar, unsigned x, unsigned& nloc, unsigned& nx) {
    const unsigned G = gridDim.x * gridDim.y * gridDim.z;
    unsigned sum, cnt, mine, sp = 0u;
    for (;;) {
        sum = 0u; cnt = 0u; mine = 0u;
#pragma unroll
        for (unsigned j = 0; j < 16; ++j) { const unsigned c = xb_ld(&bar[XB_XCNT(j)]); sum += c; cnt += (c > 0u) ? 1u : 0u; mine = (j == x) ? c : mine; }
        if (sum == G) break;
        __builtin_amdgcn_s_sleep(1);
        if ((++sp & 255u) == 0u) { if (xb_ld(&bar[XB_TMO])) break; if (sp > XB_SPIN_CAP) { atomicAdd(&bar[XB_TMO], 1u); break; } }
    }
    nloc = mine > 0u ? mine : 1u; nx = cnt > 0u ? cnt : 1u;
}
__device__ __forceinline__ void xcd_barrier(const XcdBarrier& b) {
    asm volatile("s_waitcnt vmcnt(0)" ::: "memory");
    __syncthreads();
    if (threadIdx.x == 0) {
        unsigned* bar = b.bar;
        __builtin_amdgcn_s_waitcnt(0);
        unsigned nloc = b.st[0], nx = b.st[1];
        if (nloc == 0u) { xcd_barrier_complete(bar, b.x, nloc, nx); b.st[0] = nloc; b.st[1] = nx; }
        const unsigned old = xb_add(&bar[XB_XSUB(b.x)], 1u);
        const unsigned gen = old / nloc;
        if (old + 1u == (gen + 1u) * nloc) {
            __builtin_amdgcn_fence(__ATOMIC_RELEASE, "agent");
            asm volatile("s_waitcnt vmcnt(0)" ::: "memory");
            const unsigned og = xb_add(&bar[XB_TOP], 1u);
            const unsigned tg = og / nx;
            if (og + 1u == (tg + 1u) * nx) xb_add(&bar[XB_TOPGEN], 1u);
            else XB_SPIN(xb_ld(&bar[XB_TOPGEN]) == tg, bar);
            __builtin_amdgcn_fence(__ATOMIC_ACQUIRE, "agent");
            xb_add(&bar[XB_XGEN(b.x)], 1u);
            asm volatile("s_waitcnt vmcnt(0)" ::: "memory");
        } else {
            XB_SPIN(xb_ld(&bar[XB_XGEN(b.x)]) == gen, bar);
            __builtin_amdgcn_fence(__ATOMIC_ACQUIRE, "agent");
            asm volatile("s_waitcnt vmcnt(0)" ::: "memory");
        }
    }
    __syncthreads();
}

constexpr int NPH = 54;
__host__ __device__ inline int step_of(int ph) { const int si = (ph - 1) % 13; return si < 3 ? si : (si == 3 ? 12 : si - 1); }
__host__ __device__ inline bool phase_is_noop(int ph) {
    if (ph == 0 || ph == NPH - 1) return false;
    const int l = (ph - 1) / 13, st = step_of(ph);
    return st == 12 && (l % 3) != 2;
}

__global__ void __launch_bounds__(512, 2) mega(const Params pv) {
    extern __shared__ __attribute__((aligned(16))) unsigned char shm[];
    PPTR p = &pv;
    LAS unsigned char* lds = (LAS unsigned char*)shm;
    cg::grid_group grid = cg::this_grid();
    volatile LAS unsigned* xb_st = (volatile LAS unsigned*)(lds + 147440);
    if (threadIdx.x == 0) { xb_st[0] = 0u; xb_st[1] = 0u; }
    __syncthreads();
    const XcdBarrier xb = xcd_barrier_post((unsigned*)(pv.ws + WS_BAR), xb_st);
    const int ph_lo = p->ph_lo, ph_hi = p->ph_hi;
    for (int ph = ph_lo; ph < ph_hi; ++ph) {
        if (phase_is_noop(ph)) continue;
        float* mod = (float*)(p->ws + WS_MISC);
        bf16_t* W = (bf16_t*)(p->ws + WS_W);
        if (ph == 0) { pre_phase(lds, p); __syncthreads(); cvt_layer(lds, p, 0); }
        else if (ph == NPH - 1) { if (PHMASK & 2) final_phase(p->out, p->in[35]); }
        else {
            const int l = (ph - 1) / 13, st = step_of(ph), kind = l % 3, j = l / 3;
            const float* hin = (l == 0) ? p->in[0] : p->out;
            const float* modl = mod + (size_t)l * 4 * 6144;
            bf16_t* R1 = (bf16_t*)(p->ws + WS_R1);
            for (int rep = 0; rep < 1 + (((REPMASK >> st) & 1) & ((REPL >> l) & 1)); ++rep) {
            if (rep) grid.sync();
            if (!(PHMASK & (4 << st))) {} else if (st == 0) {
                if (l > 0) cvt_layer(lds, p, l);
                if (kind == 2) norm_phase<true>(hin, p->in[2] + (size_t)(l * 2 + 0) * 1024, modl, 0, R1, 2048);
                else norm_phase<false>(hin, p->in[2] + (size_t)(l * 2 + 0) * 1024, modl, 0, R1, 1024);
            } else if (st == 12) {
                prep_rwkv_elem(p);
            } else if (st == 2 && kind == 1) {
                prep_gla(lds, p);
            } else if (st == 2 && kind == 0) {
                prep_delta(lds, p, j);
            } else if (st == 1 || st == 2 || st == 7 || st == 9) {
                pg8::EpiBf16S E; E.act = 0; const bf16_t* A; const bf16_t* Bt; int lda, N, K;
                if (st == 1) {
                    A = R1; Bt = W + W_IN / 2;
                    if (kind == 0) { E.O = (bf16_t*)(p->ws + WS_PROJ); E.ldc = 4352; lda = 1024; N = 4352; K = 1024; }
                    else if (kind == 1) { E.O = (bf16_t*)(p->ws + WS_PROJ); E.ldc = 4096; lda = 1024; N = 4096; K = 1024; }
                    else { E.O = (bf16_t*)(p->ws + WS_PROJC); E.ldc = 3328; E.act = 1; lda = 2048; N = 3328; K = 2048; }
                } else if (st == 2) {
                    A = (const bf16_t*)(p->ws + WS_PROJC) + 3072; Bt = W + W_L2 / 2; E.O = R1; E.ldc = 3072; lda = 3328; N = 3072; K = 256;
                } else {
                    const int g = (st == 9);
                    A = R1; Bt = W + W_UP / 2 + (size_t)(g ? 3072 : 0) * 1024; N = g ? 2560 : 3072; E.O = (bf16_t*)(p->ws + WS_HID); E.ldc = N; lda = 1024; K = 1024;
                }
                run_gemm(lds, A, lda, Bt, N, K, E);
            } else if (st == 5 || st == 11) {
                pg8::EpiRes E; const bf16_t* A; const bf16_t* Bt; int lda, K;
                if (st == 5) { E.res = hin; E.out = p->out; E.gate = modl + 2 * 1024; A = (const bf16_t*)(p->ws + (kind != 0 ? WS_OC : WS_PROJ)); lda = (kind == 0) ? 4352 : 1024; Bt = W + W_OUT / 2; K = 1024; }
                else { E.res = p->out; E.out = p->out; E.gate = modl + 5 * 1024; A = (const bf16_t*)(p->ws + WS_ACT); lda = 2816; Bt = W + W_DN / 2; K = 2816; }
                run_gemm(lds, A, lda, Bt, 1024, K, E);
            } else if (st == 3) {
                if (kind == 0) scan_chunked<0>(lds, p, j); else if (kind == 1) scan_chunked<1>(lds, p, j); else scan_rwkv(lds, p);
            } else if (st == 4) {
                if (kind == 0) post_phase<0>(p, j); else if (kind == 1) post_phase<1>(p, j); else post_phase<2>(p, j);
            } else if (st == 6) {
                norm_phase<false>(p->out, p->in[2] + (size_t)(l * 2 + 1) * 1024, modl, 3, R1, 1024);
            } else if (st == 8 || st == 10) {
                const int g = (st == 10);
                convglu_phase((const bf16_t*)(p->ws + WS_HID), (bf16_t*)(p->ws + WS_ACT), g, p->in[32] + (size_t)l * 3 * 5632, p->in[33] + (size_t)l * 5632);
            }
            }
        }
        if (ph + 1 < ph_hi) { if (ph_hi > 1000000) grid.sync(); else xcd_barrier(xb); }
    }
}

extern "C" void kernel_launch(void* const* d_in, const int* in_sizes, int n_in, void* d_out, int out_size, void* d_ws, size_t ws_size, hipStream_t stream) {
    constexpr int LDS_BYTES = 144 * 1024;
    static int grid_blocks = 0;
    if (!grid_blocks) {
        int dev = 0, cus = 0, per_cu = 0;
        hipGetDevice(&dev);
        hipDeviceGetAttribute(&cus, hipDeviceAttributeMultiprocessorCount, dev);
        if (hipFuncSetAttribute((const void*)mega, hipFuncAttributeMaxDynamicSharedMemorySize, LDS_BYTES) != hipSuccess) fprintf(stderr, "hipFuncSetAttribute failed\n");
        hipOccupancyMaxActiveBlocksPerMultiprocessor(&per_cu, (const void*)mega, 512, LDS_BYTES);
        if (per_cu < 1) per_cu = 1;
        if (per_cu > 1) per_cu = 1;
        grid_blocks = cus * per_cu;
        if (ws_size < 512 * MiB) fprintf(stderr, "workspace too small: %zu\n", ws_size);
    }
    (void)hipMemsetAsync((char*)d_ws + WS_BAR, 0, XCD_BAR_WORDS * sizeof(unsigned), stream);
    Params p{};
    for (int i = 0; i < 36; ++i) p.in[i] = (const float*)d_in[i];
    p.out = (float*)d_out; p.ws = (unsigned char*)d_ws;
#if SINGLE_LAUNCH
    p.ph_lo = 0; p.ph_hi = NPH;
    void* args[] = {&p};
    hipError_t e = hipLaunchCooperativeKernel((const void*)mega, dim3(grid_blocks), dim3(512), args, LDS_BYTES, stream);
    if (e != hipSuccess) fprintf(stderr, "cooperative launch failed: %s (grid %d)\n", hipGetErrorString(e), grid_blocks);
#else
    for (int ph = 0; ph < NPH; ++ph) {
        if (phase_is_noop(ph)) continue;
        p.ph_lo = ph; p.ph_hi = ph + 1;
        hipLaunchKernelGGL(mega, dim3(grid_blocks), dim3(512), LDS_BYTES, stream, p);
    }
#endif
}
```
